# Optimizing an MI355X kernel written in HIP

```python
import jax, jax.numpy as jnp
from jax import lax
import numpy as np

D_MODEL = 1024
BATCH = 8
SEQ = 2048
DEPTH = 1
DEC_BATCH = 128
DEC_SEQ = 8
PAST_LEN = 16384
PAGE_SIZE = 128

MIX_WIDTH = D_MODEL
GM_WIDTH = MIX_WIDTH // 2
ML_WIDTH = MIX_WIDTH - GM_WIDTH
GM_HEADS = 4
GM_HEAD_DIM = GM_WIDTH // GM_HEADS
ML_HEADS = 4
ML_HEAD_DIM = ML_WIDTH // ML_HEADS
CHUNK = 128
ML_CHUNK = 128
D_FF = 4 * D_MODEL
PLE_DIM = 256
EPS = 1e-6
SPLITS = (GM_WIDTH, 2 * GM_WIDTH, 2 * GM_WIDTH + ML_WIDTH, 2 * GM_WIDTH + 2 * ML_WIDTH,
          2 * GM_WIDTH + 3 * ML_WIDTH, 2 * GM_WIDTH + 4 * ML_WIDTH, 2 * GM_WIDTH + 4 * ML_WIDTH + ML_HEADS)
IN_COLS = 2 * GM_WIDTH + 4 * ML_WIDTH + 2 * ML_HEADS

kernel_name = "hymba_gmlp_mlstm_decoder_step"


def rmsnorm(x, g):
    xf = x.astype(jnp.float32)
    y = xf * lax.rsqrt(jnp.mean(xf * xf, axis=-1, keepdims=True) + EPS)
    return (y * g.astype(jnp.float32)).astype(x.dtype)


def layernorm(x, g, b):
    xf = x.astype(jnp.float32)
    mu = jnp.mean(xf, axis=-1, keepdims=True)
    var = jnp.mean(jnp.square(xf - mu), axis=-1, keepdims=True)
    y = (xf - mu) * lax.rsqrt(var + EPS)
    return (y * g.astype(jnp.float32) + b.astype(jnp.float32)).astype(x.dtype)


def _gmlp_mix(u, vn, w_s, b_s, L):
    B, T, _ = vn.shape
    n = T // L
    vh = vn.reshape(B, n, L, GM_HEADS, GM_HEAD_DIM)
    w = w_s[:, :L, :L]
    w = jnp.where(jnp.tril(jnp.ones((L, L), dtype=bool)), w, jnp.zeros_like(w))
    s = jnp.einsum('htj,bnjhd->bnthd', w, vh) + jnp.transpose(b_s[:, :L])[None, None, :, :, None]
    return u * s.reshape(B, T, GM_WIDTH)


def _mlstm_chunk(carry, inp):
    C, n, m = carry
    q, k, v, ig, lf = inp
    L = q.shape[2]
    b = jnp.cumsum(lf, axis=-1)
    g = b + m[..., None]
    D = b[..., :, None] - b[..., None, :] + ig[..., None, :]
    D = jnp.where(jnp.tril(jnp.ones((L, L), dtype=bool)), D, -jnp.inf)
    m_t = jnp.maximum(g, jnp.max(D, axis=-1))
    w_intra = jnp.exp(D - m_t[..., None])
    w_inter = jnp.exp(g - m_t)
    s = jnp.einsum('bhtd,bhsd->bhts', q, k) * w_intra
    num = jnp.einsum('bhts,bhse->bhte', s, v) + w_inter[..., None] * jnp.einsum('bhtd,bhde->bhte', q, C)
    den = jnp.sum(s, axis=-1) + w_inter * jnp.einsum('bhtd,bhd->bht', q, n)
    h = num / jnp.maximum(jnp.abs(den), jnp.exp(-m_t))[..., None]
    m_new = m_t[..., -1]
    w_end = jnp.exp(D[..., -1, :] - m_new[..., None])
    dec = jnp.exp(g[..., -1] - m_new)
    C_new = dec[..., None, None] * C + jnp.einsum('bhs,bhsd,bhse->bhde', w_end, k, v)
    n_new = dec[..., None] * n + jnp.einsum('bhs,bhsd->bhd', w_end, k)
    return (C_new, n_new, m_new), h


def _mlstm(q, k, v, ig, lf, state, L):
    B, T, _ = q.shape
    n = T // L

    def to_chunks(a):
        return a.astype(jnp.float32).reshape(B, n, L, ML_HEADS, ML_HEAD_DIM).transpose(1, 0, 3, 2, 4)

    def gate_chunks(a):
        return a.reshape(B, n, L, ML_HEADS).transpose(1, 0, 3, 2)

    xs = (to_chunks(q), to_chunks(k) * (ML_HEAD_DIM ** -0.5), to_chunks(v), gate_chunks(ig), gate_chunks(lf))
    state, h = lax.scan(_mlstm_chunk, state, xs)
    h = h.transpose(1, 0, 3, 2, 4).reshape(B, T, ML_WIDTH)
    return h, state


def _layer(h, pe, state, gm_len, ml_len, norm_mix, w_in, gm_ln_g, gm_ln_b, gm_ws, gm_bs,
           ml_b_i, ml_b_f, ml_norm, w_out, norm_ffn, w_up, w_down, norm_ple, w_ple_gate, w_ple_proj):
    B, T, _ = h.shape
    a = rmsnorm(h, norm_mix)
    z = a @ w_in
    u, vg, q, k, vm, o, zi, zf = jnp.split(z, SPLITS, axis=-1)
    u = jax.nn.gelu(u)
    vg = layernorm(jax.nn.gelu(vg), gm_ln_g, gm_ln_b)
    y_gm = _gmlp_mix(u, vg, gm_ws, gm_bs, gm_len)
    ig = (zi + ml_b_i).astype(jnp.float32)
    lf = jax.nn.log_sigmoid((zf + ml_b_f).astype(jnp.float32))
    hm, state = _mlstm(q, k, vm, ig, lf, state, ml_len)
    hm = rmsnorm(hm.reshape(B, T, ML_HEADS, ML_HEAD_DIM), ml_norm.reshape(ML_HEADS, ML_HEAD_DIM))
    y_ml = jax.nn.sigmoid(o) * hm.reshape(B, T, ML_WIDTH).astype(o.dtype)
    h = h + jnp.concatenate([y_gm, y_ml], axis=-1) @ w_out
    f = rmsnorm(h, norm_ffn) @ w_up
    h = h + jnp.square(jax.nn.relu(f)) @ w_down
    gate = jax.nn.sigmoid(rmsnorm(h, norm_ple) @ w_ple_gate)
    h = h + gate * (pe @ w_ple_proj)
    return h, state, vg


def setup_inputs(seed: int = 0) -> dict:
    key = jax.random.key(seed)
    ks = jax.random.split(key, 32)
    f32 = jnp.float32

    def nrm(k, shape, scale):
        return jax.random.normal(k, shape, f32) * scale

    def gain(k, shape):
        return 1.0 + 0.05 * jax.random.normal(k, shape, f32)

    f_bias = jnp.linspace(3.0, 6.0, ML_HEADS, dtype=f32)[None, :] + 0.1 * jax.random.normal(ks[11], (DEPTH, ML_HEADS), f32)
    return {
        "x_prompt": nrm(ks[0], (BATCH, SEQ, D_MODEL), 1.0),
        "x_sample": nrm(ks[1], (DEC_BATCH, DEC_SEQ, D_MODEL), 1.0),
        "p_prompt": nrm(ks[2], (DEPTH, BATCH, SEQ, PLE_DIM), 1.0),
        "p_sample": nrm(ks[3], (DEPTH, DEC_BATCH, DEC_SEQ, PLE_DIM), 1.0),
        "state_C": nrm(ks[4], (DEPTH, DEC_BATCH, ML_HEADS, ML_HEAD_DIM, ML_HEAD_DIM), 0.1),
        "state_n": jnp.abs(nrm(ks[5], (DEPTH, DEC_BATCH, ML_HEADS, ML_HEAD_DIM), 0.1)),
        "state_m": nrm(ks[6], (DEPTH, DEC_BATCH, ML_HEADS), 1.0),
        "norm_mix": gain(ks[7], (DEPTH, D_MODEL)),
        "w_in": nrm(ks[8], (DEPTH, D_MODEL, IN_COLS), D_MODEL ** -0.5),
        "gm_ln_g": gain(ks[9], (DEPTH, GM_WIDTH)),
        "gm_ln_b": nrm(ks[10], (DEPTH, GM_WIDTH), 0.02),
        "gm_ws": nrm(ks[12], (DEPTH, GM_HEADS, CHUNK, CHUNK), 0.5 * CHUNK ** -0.5),
        "gm_bs": gain(ks[13], (DEPTH, GM_HEADS, CHUNK)),
        "ml_b_i": nrm(ks[14], (DEPTH, ML_HEADS), 0.1),
        "ml_b_f": f_bias,
        "ml_norm": gain(ks[15], (DEPTH, ML_WIDTH)),
        "w_out": nrm(ks[16], (DEPTH, MIX_WIDTH, D_MODEL), MIX_WIDTH ** -0.5),
        "norm_ffn": gain(ks[17], (DEPTH, D_MODEL)),
        "w_up": nrm(ks[18], (DEPTH, D_MODEL, D_FF), D_MODEL ** -0.5),
        "w_down": nrm(ks[19], (DEPTH, D_FF, D_MODEL), D_FF ** -0.5),
        "norm_ple": gain(ks[20], (DEPTH, D_MODEL)),
        "w_ple_gate": nrm(ks[21], (DEPTH, D_MODEL, D_MODEL), D_MODEL ** -0.5),
        "w_ple_proj": nrm(ks[22], (DEPTH, PLE_DIM, D_MODEL), PLE_DIM ** -0.5),
        "norm_final": gain(ks[23], (D_MODEL,)),
    }


def reference(x_prompt, x_sample, p_prompt, p_sample, state_C, state_n, state_m,
              norm_mix, w_in, gm_ln_g, gm_ln_b, gm_ws, gm_bs, ml_b_i, ml_b_f, ml_norm,
              w_out, norm_ffn, w_up, w_down, norm_ple, w_ple_gate, w_ple_proj, norm_final):
    hp, hs = x_prompt, x_sample
    B = x_prompt.shape[0]
    Cp, Np, Mp, Vp, Cs, Ns, Ms, Vs = [], [], [], [], [], [], [], []
    for l in range(DEPTH):
        w = (norm_mix[l], w_in[l], gm_ln_g[l], gm_ln_b[l], gm_ws[l], gm_bs[l], ml_b_i[l], ml_b_f[l],
             ml_norm[l], w_out[l], norm_ffn[l], w_up[l], w_down[l], norm_ple[l], w_ple_gate[l], w_ple_proj[l])
        st0 = (jnp.zeros((B, ML_HEADS, ML_HEAD_DIM, ML_HEAD_DIM), jnp.float32),
               jnp.zeros((B, ML_HEADS, ML_HEAD_DIM), jnp.float32),
               jnp.zeros((B, ML_HEADS), jnp.float32))
        hp, (c, n, m), vg = _layer(hp, p_prompt[l], st0, CHUNK, ML_CHUNK, *w)
        Cp.append(c); Np.append(n); Mp.append(m); Vp.append(vg[:, -CHUNK:])
        sts = (state_C[l].astype(jnp.float32), state_n[l].astype(jnp.float32), state_m[l].astype(jnp.float32))
        hs, (c, n, m), vg = _layer(hs, p_sample[l], sts, DEC_SEQ, DEC_SEQ, *w)
        Cs.append(c); Ns.append(n); Ms.append(m); Vs.append(vg)
    y_prompt = rmsnorm(hp, norm_final)
    y_sample = rmsnorm(hs, norm_final)
    return (y_prompt, y_sample, jnp.stack(Cp), jnp.stack(Np), jnp.stack(Mp), jnp.stack(Vp),
            jnp.stack(Cs), jnp.stack(Ns), jnp.stack(Ms), jnp.stack(Vs))
```

```cpp
#include <hip/hip_runtime.h>
#include <cstdio>
#include <cstdint>
namespace pg8 {
#define PG8_LAS __attribute__((address_space(3)))
typedef unsigned short bf16_t;
typedef short bf16x8 __attribute__((ext_vector_type(8)));
typedef float f32x4 __attribute__((ext_vector_type(4)));
typedef unsigned u32x4 __attribute__((ext_vector_type(4)));
constexpr int BM = 256, BK = 64, HALF = 128, HTB = HALF * BK * 2  , STAGE_BYTES = 8 * HTB, NXCD = 8, WGM = 8;

__host__ __device__ __forceinline__ int lds_byte(int r, int c) { const int st = (r >> 4) * 2 + (c >> 5), rr = r & 15, cc = c & 31, ob = rr * 64 + cc * 2; return st * 1024 + (ob ^ (((ob >> 9) & 1) << 5)); }
__host__ __device__ __forceinline__ void stage_rc(int b, int& R, int& C) { const int st = b / 1024, sb = b % 1024, swz = sb ^ (((sb >> 9) & 1) << 5); R = (st >> 1) * 16 + swz / 64; C = (st & 1) * 32 + (swz % 64) / 2; }
__host__ __device__ __forceinline__ int perm32(int rho) { const int n = rho >> 4, i = rho & 15; return 8 * (i >> 2) + 4 * n + (i & 3); }

struct Unit { int pm, pn; };
struct Gemm { const bf16_t* A; const bf16_t* Bt; int M, N, K; };

struct StaticOrder {
    int nM, nN, nwg, G, c;
    __host__ __device__ void init(int M, int N, int G_, int c_) { nM = M / BM; nN = N / BM; nwg = nM * nN; G = G_; c = c_; }
    __host__ __device__ bool next(int i, Unit& u) const {
        const long L = (long)i * G + c; if (L >= nwg) return false;
        int wgid = (int)L; { const int q = nwg / NXCD, r = nwg % NXCD, xcd = wgid % NXCD, off = wgid / NXCD; wgid = (xcd < r ? xcd * (q + 1) : r * (q + 1) + (xcd - r) * q) + off; }
        const int nig = WGM * nN, gid = wgid / nig, fm = gid * WGM, gsz = (nM - fm) < WGM ? (nM - fm) : WGM;
        u.pm = fm + ((wgid % nig) % gsz); u.pn = (wgid % nig) / gsz; return true;
    }
    __device__ __forceinline__ void a_ready(const Unit&) const {}
    __device__ __forceinline__ void done(const Unit&) const {}
};


typedef float f32x2 __attribute__((ext_vector_type(2)));
typedef __bf16 bf16x2_t __attribute__((ext_vector_type(2)));
typedef unsigned u32x2 __attribute__((ext_vector_type(2)));
__device__ __forceinline__ unsigned cvt_pk_bf16(float lo, float hi) { f32x2 v = {lo, hi}; bf16x2_t b = __builtin_convertvector(v, bf16x2_t); return __builtin_bit_cast(unsigned, b); }
__device__ __forceinline__ float bf_lo(unsigned w) { return __uint_as_float(w << 16); }
__device__ __forceinline__ float bf_hi(unsigned w) { return __uint_as_float(w & 0xffff0000u); }
__device__ __forceinline__ float sigmoid_f(float x) { return __builtin_amdgcn_rcpf(1.0f + __builtin_amdgcn_exp2f(-1.4426950408889634f * x)); }
__device__ __forceinline__ float gelu_tanh_f(float x) { const float t = x * (1.5957691216057308f + 0.07135481627159149f * x * x); return x * sigmoid_f(t); }

constexpr float NORM_EPS = 1e-6f;
__device__ __forceinline__ float row_rs(const float* ss, int row) {
    const f32x4* p = (const f32x4*)(ss + (size_t)row * 16); const f32x4 a = p[0], b = p[1], c = p[2], d = p[3];
    const float s = ((a[0] + a[1]) + (a[2] + a[3])) + ((b[0] + b[1]) + (b[2] + b[3])) + ((c[0] + c[1]) + (c[2] + c[3])) + ((d[0] + d[1]) + (d[2] + d[3]));
    return 1.0f / sqrtf(s * (1.0f / 1024.0f) + NORM_EPS);
}

template <int MODE> struct EpiBf16 {
    static constexpr bool PERM = true, AFTER_DRAIN = false;
    bf16_t* O; int ldc; const float* ss;
    __device__ __forceinline__ void operator()(const f32x4 (&acc)[2][2][4][2], const Unit& u, int wr, int wc, int fr, int fq) const {
        const int row0 = u.pm * BM + wr * 64 + fr, col0 = u.pn * BM + wc * 32 + 8 * fq;
        const int act = (MODE == 0) ? (u.pn < 4 ? 1 : (u.pn >= 10 ? 2 : 0)) : 0;
#pragma unroll
        for (int ai = 0; ai < 2; ++ai)
#pragma unroll
            for (int m = 0; m < 4; ++m) { const int row = row0 + ai * HALF + m * 16; bf16_t* rowp = O + (size_t)row * ldc + col0;
#pragma unroll
                for (int bj = 0; bj < 2; ++bj) { f32x4 v0 = acc[ai][bj][m][0], v1 = acc[ai][bj][m][1];
                    if (MODE == 0) {
                        if (act == 1) {
#pragma unroll
                            for (int e = 0; e < 4; ++e) { v0[e] = gelu_tanh_f(v0[e]); v1[e] = gelu_tanh_f(v1[e]); } }
                        else if (act == 2) {
#pragma unroll
                            for (int e = 0; e < 4; ++e) { v0[e] = sigmoid_f(v0[e]); v1[e] = sigmoid_f(v1[e]); } }
                    }
                    if (MODE == 2) {
#pragma unroll
                        for (int e = 0; e < 4; ++e) { const float a = fmaxf(v0[e], 0.f), b = fmaxf(v1[e], 0.f); v0[e] = a * a; v1[e] = b * b; } }
                    u32x4 w; w.x = cvt_pk_bf16(v0[0], v0[1]); w.y = cvt_pk_bf16(v0[2], v0[3]); w.z = cvt_pk_bf16(v1[0], v1[1]); w.w = cvt_pk_bf16(v1[2], v1[3]);
                    *(u32x4*)(rowp + bj * HALF) = w; } }
    }
};

template <int MODE> struct EpiRes {
    static constexpr bool PERM = false, AFTER_DRAIN = false;
    const float* rn;
    const bf16_t* Hb; bf16_t* Ho; float* SSO; const float* SSI; const bf16_t* PROJ;
    __device__ __forceinline__ void operator()(const f32x4 (&acc)[2][2][4][2], const Unit& u, int wr, int wc, int fr, int fq) const {
        const int row0 = u.pm * BM + wr * 64 + fr, col0 = u.pn * BM + wc * 32 + 4 * fq;
#pragma unroll
        for (int ai = 0; ai < 2; ++ai)
#pragma unroll
            for (int m = 0; m < 4; ++m) { const int row = row0 + ai * HALF + m * 16; const size_t off = (size_t)row * 1024 + col0;
                float rsc; if (MODE != 0) { rsc = row_rs(SSI, row); if (MODE == 1) rsc = rsc * rsc; } else rsc = rn[row];
                float sq = 0.f;
#pragma unroll
                for (int bj = 0; bj < 2; ++bj)
#pragma unroll
                    for (int n = 0; n < 2; ++n) { const size_t o2 = off + bj * HALF + n * 16; f32x4 h; const f32x4 a = acc[ai][bj][m][n];
                        { const u32x2 hw = *(const u32x2*)(Hb + o2); const f32x4 r = (f32x4){bf_lo(hw.x), bf_hi(hw.x), bf_lo(hw.y), bf_hi(hw.y)};
                            if (MODE == 0) h = r * rsc + a;
                            else if (MODE == 1) h = r + a * rsc;
                            else { const u32x2 pw = *(const u32x2*)(PROJ + o2);
                                h[0] = r[0] + sigmoid_f(a[0] * rsc) * bf_lo(pw.x); h[1] = r[1] + sigmoid_f(a[1] * rsc) * bf_hi(pw.x);
                                h[2] = r[2] + sigmoid_f(a[2] * rsc) * bf_lo(pw.y); h[3] = r[3] + sigmoid_f(a[3] * rsc) * bf_hi(pw.y); } }
                        u32x2 w; w.x = cvt_pk_bf16(h[0], h[1]); w.y = cvt_pk_bf16(h[2], h[3]); *(u32x2*)(Ho + o2) = w;
                        sq += (h[0] * h[0] + h[1] * h[1]) + (h[2] * h[2] + h[3] * h[3]); }
                sq += __shfl_xor(sq, 16); sq += __shfl_xor(sq, 32);
                if (fq == 0) SSO[(size_t)row * 16 + u.pn * 4 + wc] = sq; }
    }
};

template <class Epi, class Sched, bool ALIGN_EPI = false, bool SP2 = false>
__device__ __forceinline__ void gemm_phase(PG8_LAS unsigned char* lds, const Gemm g, const Sched& S, const Epi& E) {
    const int tid = threadIdx.x, wid = __builtin_amdgcn_readfirstlane(tid >> 6), lane = tid & 63, wr = wid >> 2, wc = wid & 3, fr = lane & 15, fq = lane >> 4;
    int K = g.K; asm volatile("" : "+s"(K));
    const int nt = K / BK;
    unsigned voffA[2], voffB[2];
#pragma unroll
    for (int i = 0; i < 2; ++i) { int R, C; stage_rc(tid * 16 + i * 8192, R, C); const int Rb = Epi::PERM ? ((R & ~31) + perm32(R & 31)) : R;
        voffA[i] = (unsigned)(R * K + C) * 2u; voffB[i] = (unsigned)(Rb * K + C) * 2u; }
    const size_t kstep = (size_t)(BK * 2);
    const size_t hstep = (size_t)HALF * K * 2;
    const size_t tstep = 2 * hstep;
    const unsigned ldsw = (unsigned)wid * 1024u;
    const int aoff = lds_byte(wr * 64 + fr, fq * 8), boff = lds_byte(wc * 32 + fr, fq * 8);
#define PG8_SA(b, h) (((b) * 2 + (h)) * HTB)
#define PG8_SB(b, h) ((4 + (b) * 2 + (h)) * HTB)
#define PG8_STAGE(bufoff, gbase, voff) do { _Pragma("unroll") for (int _i = 0; _i < 2; ++_i) \
        __builtin_amdgcn_global_load_lds((const unsigned*)((const char*)(gbase) + (voff)[_i]), (PG8_LAS unsigned*)(lds + (bufoff) + ldsw + _i * 8192), 16, 0, 0); } while (0)
#define PG8_LDA(dst, b, h) do { _Pragma("unroll") for (int m = 0; m < 4; ++m) _Pragma("unroll") for (int k = 0; k < 2; ++k) dst[m][k] = *(const PG8_LAS bf16x8*)(lds + PG8_SA(b, h) + aoff + m * 2048 + k * 1024); } while (0)
#define PG8_LDB(dst, b, h) do { _Pragma("unroll") for (int n = 0; n < 2; ++n) _Pragma("unroll") for (int k = 0; k < 2; ++k) dst[n][k] = *(const PG8_LAS bf16x8*)(lds + PG8_SB(b, h) + boff + n * 2048 + k * 1024); } while (0)
#define PG8_MMA(ai, bj, At, Bt) do { __builtin_amdgcn_s_setprio(1); _Pragma("unroll") for (int m = 0; m < 4; ++m) _Pragma("unroll") for (int n = 0; n < 2; ++n) _Pragma("unroll") for (int k = 0; k < 2; ++k) \
        acc[ai][bj][m][n] = __builtin_amdgcn_mfma_f32_16x16x32_bf16(Bt[n][k], At[m][k], acc[ai][bj][m][n], 0, 0, 0); __builtin_amdgcn_s_setprio(0); } while (0)
#define PG8_WAIT_V(n) asm volatile("s_waitcnt vmcnt(" #n ")" ::: "memory")
#define PG8_WAIT_L(n) asm volatile("s_waitcnt lgkmcnt(" #n ")" ::: "memory")
#define PG8_BAR __builtin_amdgcn_s_barrier()
#define PG8_SCHED __builtin_amdgcn_sched_barrier(0)
    Unit cur, nxt; int ui = 0;
    if (!S.next(0, cur)) return;
    f32x4 acc[2][2][4][2];
#pragma unroll
    for (int a = 0; a < 2; ++a)
#pragma unroll
        for (int b = 0; b < 2; ++b)
#pragma unroll
            for (int m = 0; m < 4; ++m)
#pragma unroll
                for (int n = 0; n < 2; ++n) acc[a][b][m][n] = (f32x4){0.f, 0.f, 0.f, 0.f};
    bf16x8 At[4][2], B0[2][2], B1[2][2];
    const char* cA = (const char*)g.A + (size_t)cur.pm * tstep; const char* cB = (const char*)g.Bt + (size_t)cur.pn * tstep;
    S.a_ready(cur);
    if constexpr (SP2) {
        PG8_STAGE(PG8_SB(0, 0), cB, voffB); PG8_STAGE(PG8_SB(0, 1), cB + hstep, voffB); PG8_STAGE(PG8_SA(0, 0), cA, voffA); PG8_STAGE(PG8_SA(0, 1), cA + hstep, voffA);
        if (wr == 1) PG8_BAR;
        PG8_WAIT_V(2); PG8_BAR;
        PG8_STAGE(PG8_SB(1, 0), cB + kstep, voffB); PG8_STAGE(PG8_SA(1, 0), cA + kstep, voffA); PG8_STAGE(PG8_SB(1, 1), cB + hstep + kstep, voffB);
        PG8_WAIT_V(6); PG8_BAR;
    } else {
        PG8_STAGE(PG8_SB(0, 0), cB, voffB); PG8_STAGE(PG8_SA(0, 0), cA, voffA); PG8_STAGE(PG8_SB(0, 1), cB + hstep, voffB); PG8_STAGE(PG8_SA(0, 1), cA + hstep, voffA);
        if (wr == 1) PG8_BAR;
        PG8_WAIT_V(4); PG8_BAR;
        PG8_STAGE(PG8_SB(1, 0), cB + kstep, voffB); PG8_STAGE(PG8_SA(1, 0), cA + kstep, voffA); PG8_STAGE(PG8_SB(1, 1), cB + hstep + kstep, voffB);
        PG8_WAIT_V(6); PG8_BAR;
    }
    for (;;) {
        const bool has_next = S.next(ui + 1, nxt);
        const char* nA = has_next ? (const char*)g.A + (size_t)nxt.pm * tstep : cA; const char* nB = has_next ? (const char*)g.Bt + (size_t)nxt.pn * tstep : cB;
        for (int t = 0; t < nt; t += 2) {
            const bool last = (t == nt - 2);
            const char* a1 = cA + (size_t)(t + 1) * kstep;
            const char* a2 = last ? nA : cA + (size_t)(t + 2) * kstep; const char* b2 = last ? nB : cB + (size_t)(t + 2) * kstep;
            const char* a3 = a2 + kstep; const char* b3 = b2 + kstep;
            if (last && has_next) S.a_ready(nxt);
            if constexpr (SP2) {
            PG8_LDB(B0, 0, 0); PG8_LDB(B1, 0, 1); PG8_SCHED; PG8_LDA(At, 0, 0); PG8_STAGE(PG8_SA(1, 1), a1 + hstep, voffA);
            PG8_WAIT_V(8); PG8_WAIT_L(0); PG8_BAR; PG8_MMA(0, 0, At, B0); PG8_MMA(0, 1, At, B1); PG8_BAR; PG8_SCHED;
            PG8_LDA(At, 0, 1); PG8_STAGE(PG8_SB(0, 0), b2, voffB); PG8_STAGE(PG8_SB(0, 1), b2 + hstep, voffB); PG8_STAGE(PG8_SA(0, 0), a2, voffA);
            PG8_WAIT_V(8); PG8_WAIT_L(0); PG8_BAR; PG8_MMA(1, 0, At, B0); PG8_MMA(1, 1, At, B1); PG8_BAR; PG8_SCHED;
            PG8_LDB(B0, 1, 0); PG8_LDB(B1, 1, 1); PG8_SCHED; PG8_LDA(At, 1, 0); PG8_STAGE(PG8_SA(0, 1), a2 + hstep, voffA);
            PG8_WAIT_V(8); PG8_WAIT_L(0); PG8_BAR; PG8_MMA(0, 0, At, B0); PG8_MMA(0, 1, At, B1); PG8_BAR; PG8_SCHED;
            PG8_LDA(At, 1, 1); PG8_STAGE(PG8_SB(1, 0), b3, voffB); PG8_STAGE(PG8_SB(1, 1), b3 + hstep, voffB); PG8_STAGE(PG8_SA(1, 0), a3, voffA);
            PG8_WAIT_V(8); PG8_WAIT_L(0); PG8_BAR; PG8_MMA(1, 0, At, B0); PG8_MMA(1, 1, At, B1); PG8_BAR; PG8_SCHED;
            } else {
            PG8_LDB(B0, 0, 0); PG8_SCHED; PG8_LDA(At, 0, 0); PG8_STAGE(PG8_SA(1, 1), a1 + hstep, voffA);
            PG8_WAIT_L(8); PG8_BAR; PG8_WAIT_L(0); PG8_MMA(0, 0, At, B0); PG8_BAR; PG8_SCHED;
            PG8_LDB(B1, 0, 1); PG8_STAGE(PG8_SB(0, 0), b2, voffB);
            PG8_BAR; PG8_WAIT_L(0); PG8_MMA(0, 1, At, B1); PG8_BAR;
            PG8_LDA(At, 0, 1); PG8_STAGE(PG8_SA(0, 0), a2, voffA);
            PG8_BAR; PG8_WAIT_L(0); PG8_MMA(1, 0, At, B0); PG8_BAR; PG8_SCHED;
            PG8_STAGE(PG8_SB(0, 1), b2 + hstep, voffB);
            PG8_WAIT_V(6); PG8_BAR; PG8_MMA(1, 1, At, B1); PG8_BAR;
            PG8_LDB(B0, 1, 0); PG8_SCHED; PG8_LDA(At, 1, 0); PG8_STAGE(PG8_SA(0, 1), a2 + hstep, voffA);
            PG8_WAIT_L(8); PG8_BAR; PG8_WAIT_L(0); PG8_MMA(0, 0, At, B0); PG8_BAR; PG8_SCHED;
            PG8_LDB(B1, 1, 1); PG8_STAGE(PG8_SB(1, 0), b3, voffB);
            PG8_BAR; PG8_WAIT_L(0); PG8_MMA(0, 1, At, B1); PG8_BAR;
            PG8_LDA(At, 1, 1); PG8_STAGE(PG8_SA(1, 0), a3, voffA);
            PG8_BAR; PG8_WAIT_L(0); PG8_MMA(1, 0, At, B0); PG8_BAR; PG8_SCHED;
            PG8_STAGE(PG8_SB(1, 1), b3 + hstep, voffB);
            PG8_WAIT_V(6); PG8_BAR; PG8_MMA(1, 1, At, B1); PG8_BAR;
            }
        }
        if constexpr (ALIGN_EPI) { if (wr == 0) PG8_BAR; }
        if constexpr (!Epi::AFTER_DRAIN) { E(acc, cur, wr, wc, fr, fq); S.done(cur); }
        if (!has_next) break;
#pragma unroll
        for (int a = 0; a < 2; ++a)
#pragma unroll
            for (int b = 0; b < 2; ++b)
#pragma unroll
                for (int m = 0; m < 4; ++m)
#pragma unroll
                    for (int n = 0; n < 2; ++n) acc[a][b][m][n] = (f32x4){0.f, 0.f, 0.f, 0.f};
        cur = nxt; cA = nA; cB = nB; ++ui;
        if constexpr (ALIGN_EPI) { if (wr == 1) PG8_BAR; }
    }
    PG8_WAIT_V(0);
    if constexpr (!ALIGN_EPI) { if (wr == 0) PG8_BAR; }
    PG8_BAR;
    if constexpr (Epi::AFTER_DRAIN) { E.fused(acc, cur, wr, wc, fr, fq, lds, wid, lane); S.done(cur); }
#undef PG8_SA
#undef PG8_SB
#undef PG8_STAGE
#undef PG8_LDA
#undef PG8_LDB
#undef PG8_MMA
#undef PG8_WAIT_V
#undef PG8_WAIT_L
#undef PG8_BAR
#undef PG8_SCHED
}
}

namespace mix {
#define LAS __attribute__((address_space(3)))
using pg8::bf16_t; using pg8::bf16x8; using pg8::f32x4; using pg8::u32x4; using pg8::u32x2; using pg8::cvt_pk_bf16; using pg8::bf_lo; using pg8::bf_hi; using pg8::sigmoid_f;
typedef short v4i16_t __attribute__((ext_vector_type(4)));
constexpr int NP = 16384, NS = 1024, ZLD = 3072;
constexpr int ZU = 0, ZVG = 512, ZQ = 1024, ZK = 1536, ZV = 2048, ZO = 2560;
constexpr int TS = 288;
constexpr int IMG = 128 * TS;
constexpr int IMG0 = 0, IMG1 = IMG, IMG2 = 2 * IMG, SC_OFF = 3 * IMG;
constexpr float EPS = 1e-6f;

template <int CTRL> __device__ __forceinline__ float dpp_mov(float v) { return __int_as_float(__builtin_amdgcn_update_dpp(0, __float_as_int(v), CTRL, 0xF, 0xF, true)); }
__device__ __forceinline__ float row_sum16(float v) { v += dpp_mov<0xB1>(v); v += dpp_mov<0x4E>(v); v += dpp_mov<0x141>(v); v += dpp_mov<0x140>(v); return v; }
__device__ __forceinline__ float row_max16(float v) { v = fmaxf(v, dpp_mov<0xB1>(v)); v = fmaxf(v, dpp_mov<0x4E>(v)); v = fmaxf(v, dpp_mov<0x141>(v)); v = fmaxf(v, dpp_mov<0x140>(v)); return v; }
__device__ __forceinline__ float rl(float v, int l) { return __int_as_float(__builtin_amdgcn_readlane(__float_as_int(v), l)); }
__device__ __forceinline__ float wave_sum(float v) { v = row_sum16(v); return (rl(v, 0) + rl(v, 16)) + (rl(v, 32) + rl(v, 48)); }
__device__ __forceinline__ float wave_max(float v) { v = row_max16(v); return fmaxf(fmaxf(rl(v, 0), rl(v, 16)), fmaxf(rl(v, 32), rl(v, 48))); }
__device__ __forceinline__ float scan_add(float v, int lane) {
#pragma unroll
    for (int o = 1; o < 64; o <<= 1) { const float t = __shfl_up(v, o); if (lane >= o) v += t; }
    return v;
}
__device__ __forceinline__ float scan_max(float v, int lane) {
#pragma unroll
    for (int o = 1; o < 64; o <<= 1) { const float t = __shfl_up(v, o); if (lane >= o) v = fmaxf(v, t); }
    return v;
}
__device__ __forceinline__ bf16x8 tr2(LAS const unsigned char* p0, LAS const unsigned char* p1) {
    const v4i16_t a = __builtin_amdgcn_ds_read_tr16_b64_v4i16((LAS v4i16_t*)p0);
    const v4i16_t b = __builtin_amdgcn_ds_read_tr16_b64_v4i16((LAS v4i16_t*)p1);
    return (bf16x8){a[0], a[1], a[2], a[3], b[0], b[1], b[2], b[3]};
}
__device__ __forceinline__ void unpack8(const u32x4 w, float (&x)[8]) {
    x[0] = bf_lo(w.x); x[1] = bf_hi(w.x); x[2] = bf_lo(w.y); x[3] = bf_hi(w.y); x[4] = bf_lo(w.z); x[5] = bf_hi(w.z); x[6] = bf_lo(w.w); x[7] = bf_hi(w.w);
}
__device__ __forceinline__ u32x4 pack8(const float (&x)[8]) {
    u32x4 w; w.x = cvt_pk_bf16(x[0], x[1]); w.y = cvt_pk_bf16(x[2], x[3]); w.z = cvt_pk_bf16(x[4], x[5]); w.w = cvt_pk_bf16(x[6], x[7]); return w;
}

struct MixP {
    const bf16_t* Z; bf16_t* YC; const float* IG; const float* LF;
    const bf16_t* WSb;
    const float *gm_ws, *lng, *lnb, *bs, *mlnorm;
    float *KV, *NLOC, *NST, *CH, *MST;
    const float *stC, *stN, *stM;
    float *oCp, *oNp, *oMp, *oVp, *oCs, *oNs, *oMs, *oVs;
};

__device__ __forceinline__ void gmlp_unit(LAS unsigned char* lds, const MixP& P, int b, int c, int h, int tid) {
    const int lane = tid & 63, w = __builtin_amdgcn_readfirstlane(tid >> 6), fr = lane & 15, kq = lane >> 4, q = fr >> 2, p = fr & 3;
    const int r0 = b * 2048 + c * 128;
    LAS unsigned char* img = lds + IMG0;
    float g8[8], b8[8];
    { const f32x4 a = *(const f32x4*)(P.lng + 8 * lane), a2 = *(const f32x4*)(P.lng + 8 * lane + 4), c0 = *(const f32x4*)(P.lnb + 8 * lane), c1 = *(const f32x4*)(P.lnb + 8 * lane + 4);
#pragma unroll
      for (int e = 0; e < 4; ++e) { g8[e] = a[e]; g8[4 + e] = a2[e]; b8[e] = c0[e]; b8[4 + e] = c1[e]; } }
    float* vout = (c == 15) ? P.oVp + (size_t)b * 128 * 512 : nullptr;
    u32x4 raw[16];
#pragma unroll
    for (int i = 0; i < 16; ++i) raw[i] = *(const u32x4*)(P.Z + (size_t)(r0 + 16 * w + i) * ZLD + ZVG + 8 * lane);
    const bf16_t* Wrow = P.WSb + ((size_t)h * 128 + 16 * w + fr) * 128 + 8 * kq;
    bf16x8 wf[4];
#pragma unroll
    for (int st = 0; st < 4; ++st) wf[st] = *(const bf16x8*)(Wrow + 32 * st);
    const bf16_t* urow = P.Z + (size_t)(r0 + 16 * w + fr) * ZLD + ZU + h * 128 + 4 * kq;
    u32x2 uw[8];
#pragma unroll
    for (int n = 0; n < 8; ++n) uw[n] = *(const u32x2*)(urow + 16 * n);
    const float bsv = P.bs[h * 128 + 16 * w + fr];
#pragma unroll
    for (int i = 0; i < 16; ++i) { const int t = 16 * w + i;
        float x[8]; unpack8(raw[i], x);
        float s = ((x[0] + x[1]) + (x[2] + x[3])) + ((x[4] + x[5]) + (x[6] + x[7]));
        const float mean = wave_sum(s) * (1.0f / 512.0f);
        float q2 = 0.f;
#pragma unroll
        for (int e = 0; e < 8; ++e) { x[e] -= mean; q2 += x[e] * x[e]; }
        const float rstd = 1.0f / sqrtf(wave_sum(q2) * (1.0f / 512.0f) + EPS);
        if (kq == h) {
#pragma unroll
            for (int e = 0; e < 8; ++e) x[e] = x[e] * rstd * g8[e] + b8[e];
            *(LAS u32x4*)(img + t * TS + fr * 16) = pack8(x);
            if (vout) { float* vo = vout + (size_t)t * 512 + 8 * lane; *(f32x4*)vo = (f32x4){x[0], x[1], x[2], x[3]}; *(f32x4*)(vo + 4) = (f32x4){x[4], x[5], x[6], x[7]}; }
        }
    }
    __syncthreads();
    f32x4 acc[8];
#pragma unroll
    for (int n = 0; n < 8; ++n) acc[n] = (f32x4){0.f, 0.f, 0.f, 0.f};
    const int nsteps = (w >> 1) + 1;
    LAS const unsigned char* trb = img + (8 * kq + q) * TS + 8 * p;
#pragma unroll
    for (int st = 0; st < 4; ++st) if (st < nsteps) {
#pragma unroll
        for (int n = 0; n < 8; ++n) { const bf16x8 vf = tr2(trb + (32 * st) * TS + 32 * n, trb + (32 * st + 4) * TS + 32 * n);
            acc[n] = __builtin_amdgcn_mfma_f32_16x16x32_bf16(vf, wf[st], acc[n], 0, 0, 0); }
    }
    { const int t = 16 * w + fr;
      bf16_t* yrow = P.YC + (size_t)(r0 + t) * 1024 + h * 128 + 4 * kq;
#pragma unroll
      for (int n = 0; n < 8; ++n) { u32x2 o;
          o.x = cvt_pk_bf16(bf_lo(uw[n].x) * (acc[n][0] + bsv), bf_hi(uw[n].x) * (acc[n][1] + bsv));
          o.y = cvt_pk_bf16(bf_lo(uw[n].y) * (acc[n][2] + bsv), bf_hi(uw[n].y) * (acc[n][3] + bsv));
          *(u32x2*)(yrow + 16 * n) = o; } }
    __syncthreads();
}

__device__ __forceinline__ void kv_unit(LAS unsigned char* lds, const MixP& P, int b, int h, int c, int tid) {
    const int lane = tid & 63, w = __builtin_amdgcn_readfirstlane(tid >> 6), fr = lane & 15, kq = lane >> 4, q = fr >> 2, p = fr & 3;
    const int r0 = b * 2048 + c * 128, unit = (b * 4 + h) * 16 + c;
    LAS float* wl = (LAS float*)(lds + SC_OFF);
    float lf0 = 0.f, lf1 = 0.f, ig0 = 0.f, ig1 = 0.f;
    if (w == 0) { const int s0 = r0 + 2 * lane; lf0 = P.LF[(size_t)s0 * 4 + h]; lf1 = P.LF[(size_t)(s0 + 1) * 4 + h]; ig0 = P.IG[(size_t)s0 * 4 + h]; ig1 = P.IG[(size_t)(s0 + 1) * 4 + h]; }
    u32x4 kraw[4], vraw[4];
#pragma unroll
    for (int i = 0; i < 4; ++i) { const int id = tid + 512 * i, row = id >> 4, ch = id & 15;
        const bf16_t* zr = P.Z + (size_t)(r0 + row) * ZLD + h * 128 + ch * 8; kraw[i] = *(const u32x4*)(zr + ZK); vraw[i] = *(const u32x4*)(zr + ZV); }
    if (w == 0) {
        const float Pc = scan_add(lf0 + lf1, lane), b1 = Pc, b0 = Pc - lf1, B = __shfl(Pc, 63);
        const float x0 = ig0 - b0, x1 = ig1 - b1, xm = wave_max(fmaxf(x0, x1));
        wl[2 * lane] = __expf(x0 - xm); wl[2 * lane + 1] = __expf(x1 - xm);
        if (lane == 0) { P.CH[unit * 2] = B; P.CH[unit * 2 + 1] = B + xm; }
    }
    __syncthreads();
#pragma unroll
    for (int i = 0; i < 4; ++i) { const int id = tid + 512 * i, row = id >> 4, ch = id & 15;
        float x[8]; unpack8(kraw[i], x); const float ws = wl[row];
#pragma unroll
        for (int e = 0; e < 8; ++e) x[e] *= ws;
        *(LAS u32x4*)(lds + IMG0 + row * TS + ch * 16) = pack8(x);
        *(LAS u32x4*)(lds + IMG1 + row * TS + ch * 16) = vraw[i]; }
    __syncthreads();
    f32x4 acc[8], accn = (f32x4){0.f, 0.f, 0.f, 0.f};
#pragma unroll
    for (int n = 0; n < 8; ++n) acc[n] = (f32x4){0.f, 0.f, 0.f, 0.f};
    const bf16x8 ones = (bf16x8){0x3F80, 0x3F80, 0x3F80, 0x3F80, 0x3F80, 0x3F80, 0x3F80, 0x3F80};
    LAS const unsigned char* trk = lds + IMG0 + (8 * kq + q) * TS + 8 * p + 32 * w;
    LAS const unsigned char* trv = lds + IMG1 + (8 * kq + q) * TS + 8 * p;
#pragma unroll
    for (int st = 0; st < 4; ++st) {
        const bf16x8 kf = tr2(trk + (32 * st) * TS, trk + (32 * st + 4) * TS);
        accn = __builtin_amdgcn_mfma_f32_16x16x32_bf16(ones, kf, accn, 0, 0, 0);
#pragma unroll
        for (int n = 0; n < 8; ++n) { const bf16x8 vf = tr2(trv + (32 * st) * TS + 32 * n, trv + (32 * st + 4) * TS + 32 * n);
            acc[n] = __builtin_amdgcn_mfma_f32_16x16x32_bf16(vf, kf, acc[n], 0, 0, 0); }
    }
    float* kvp = P.KV + (size_t)unit * 16384 + (16 * w + fr) * 128 + 4 * kq;
#pragma unroll
    for (int n = 0; n < 8; ++n) *(f32x4*)(kvp + 16 * n) = acc[n];
    if (kq == 0) P.NLOC[unit * 128 + 16 * w + fr] = accn[0];
    __syncthreads();
}

__device__ __forceinline__ void scan_unit(const MixP& P, int bh, int slice, int tid) {
    const size_t base = (size_t)bh * 16 * 16384 + slice * 2048 + tid * 4;
    f32x4 C = (f32x4){0.f, 0.f, 0.f, 0.f}; float M = 0.f, nv = 0.f;
    const bool nthr = (slice == 0 && tid < 128);
    f32x4 kvv[16];
#pragma unroll
    for (int c = 0; c < 16; ++c) kvv[c] = *(const f32x4*)(P.KV + base + (size_t)c * 16384);
#pragma unroll
    for (int c = 0; c < 16; ++c) {
        const float B = P.CH[(bh * 16 + c) * 2], a = P.CH[(bh * 16 + c) * 2 + 1];
        const float Mn = fmaxf(B + M, a), dec = __expf(B + M - Mn), add = __expf(a - Mn);
        float* kp = P.KV + base + (size_t)c * 16384;
        const f32x4 kv = kvv[c]; *(f32x4*)kp = C; C = dec * C + add * kv;
        if (nthr) { const float nl = P.NLOC[(bh * 16 + c) * 128 + tid]; P.NST[(bh * 16 + c) * 128 + tid] = nv; nv = dec * nv + add * nl; if (tid == 0) P.MST[bh * 16 + c] = M; }
        M = Mn;
    }
    *(f32x4*)(P.oCp + (size_t)bh * 16384 + slice * 2048 + tid * 4) = C;
    if (nthr) { P.oNp[bh * 128 + tid] = nv; if (tid == 0) P.oMp[bh] = M; }
}

__device__ __forceinline__ void mlo_unit(LAS unsigned char* lds, const MixP& P, int b, int h, int c, int tid) {
    const int lane = tid & 63, w = __builtin_amdgcn_readfirstlane(tid >> 6), fr = lane & 15, kq = lane >> 4, q = fr >> 2, p = fr & 3;
    const int r0 = b * 2048 + c * 128, unit = (b * 4 + h) * 16 + c;
    LAS float* xs = (LAS float*)(lds + SC_OFF); LAS float* ys = xs + 128; LAS float* wint = xs + 256; LAS float* emt = xs + 384; LAS float* nst = xs + 512;
    const float Mc = P.MST[unit];
    float lf0 = 0.f, lf1 = 0.f, ig0 = 0.f, ig1 = 0.f, n0v = 0.f, n1v = 0.f;
    if (w == 0) { const int s0 = r0 + 2 * lane; lf0 = P.LF[(size_t)s0 * 4 + h]; lf1 = P.LF[(size_t)(s0 + 1) * 4 + h]; ig0 = P.IG[(size_t)s0 * 4 + h]; ig1 = P.IG[(size_t)(s0 + 1) * 4 + h]; }
    else if (w == 1) { n0v = P.NST[unit * 128 + lane]; n1v = P.NST[unit * 128 + lane + 64]; }
    const int t = 16 * w + fr;
    const bf16_t* zrow = P.Z + (size_t)(r0 + t) * ZLD + h * 128;
    u32x4 kraw[4], vraw[4]; f32x4 craw[8]; bf16x8 qf[4];
#pragma unroll
    for (int i = 0; i < 4; ++i) { const int id = tid + 512 * i, row = id >> 4, ch = id & 15;
        const bf16_t* zr = P.Z + (size_t)(r0 + row) * ZLD + h * 128 + ch * 8; kraw[i] = *(const u32x4*)(zr + ZK); vraw[i] = *(const u32x4*)(zr + ZV); }
    { const float* cs = P.KV + (size_t)unit * 16384;
#pragma unroll
      for (int i = 0; i < 8; ++i) { const int id = tid + 512 * i, row = id >> 5, c4 = id & 31; craw[i] = *(const f32x4*)(cs + row * 128 + c4 * 4); } }
#pragma unroll
    for (int ds = 0; ds < 4; ++ds) qf[ds] = *(const bf16x8*)(zrow + ZQ + 32 * ds + 8 * kq);
    if (w == 0) {
        const float Pc = scan_add(lf0 + lf1, lane), b1 = Pc, b0 = Pc - lf1;
        const float x0 = ig0 - b0, x1 = ig1 - b1;
        const float PM = scan_max(fmaxf(x0, x1), lane); float prev = __shfl_up(PM, 1); if (lane == 0) prev = -INFINITY;
        const float y0 = fmaxf(Mc, fmaxf(prev, x0)), y1 = fmaxf(Mc, PM);
        xs[2 * lane] = x0; xs[2 * lane + 1] = x1; ys[2 * lane] = y0; ys[2 * lane + 1] = y1;
        wint[2 * lane] = __expf(Mc - y0); wint[2 * lane + 1] = __expf(Mc - y1);
        emt[2 * lane] = __expf(-(b0 + y0)); emt[2 * lane + 1] = __expf(-(b1 + y1));
    } else if (w == 1) { nst[lane] = n0v; nst[lane + 64] = n1v; }
#pragma unroll
    for (int i = 0; i < 4; ++i) { const int id = tid + 512 * i, row = id >> 4, ch = id & 15;
        *(LAS u32x4*)(lds + IMG0 + row * TS + ch * 16) = kraw[i];
        *(LAS u32x4*)(lds + IMG1 + row * TS + ch * 16) = vraw[i]; }
#pragma unroll
    for (int i = 0; i < 8; ++i) { const int id = tid + 512 * i, row = id >> 5, c4 = id & 31;
        u32x2 o; o.x = cvt_pk_bf16(craw[i][0], craw[i][1]); o.y = cvt_pk_bf16(craw[i][2], craw[i][3]); *(LAS u32x2*)(lds + IMG2 + row * TS + c4 * 8) = o; }
    __syncthreads();
    u32x2 ow[8];
#pragma unroll
    for (int n = 0; n < 8; ++n) ow[n] = *(const u32x2*)(zrow + ZO + 16 * n + 4 * kq);
    float dn = 0.f;
#pragma unroll
    for (int ds = 0; ds < 4; ++ds)
#pragma unroll
        for (int e = 0; e < 8; ++e) dn += __uint_as_float(((unsigned)(unsigned short)qf[ds][e]) << 16) * nst[32 * ds + 8 * kq + e];
    dn += __shfl_xor(dn, 16); dn += __shfl_xor(dn, 32);
    LAS const unsigned char* trv = lds + IMG1 + (4 * kq + q) * TS + 8 * p;
    LAS const unsigned char* trc = lds + IMG2 + (8 * kq + q) * TS + 8 * p;
    const float wi = wint[t];
    f32x4 o1[8];
#pragma unroll
    for (int n = 0; n < 8; ++n) o1[n] = (f32x4){0.f, 0.f, 0.f, 0.f};
#pragma unroll
    for (int ds = 0; ds < 4; ++ds)
#pragma unroll
        for (int n = 0; n < 8; ++n) { const bf16x8 cf = tr2(trc + (32 * ds) * TS + 32 * n, trc + (32 * ds + 4) * TS + 32 * n);
            o1[n] = __builtin_amdgcn_mfma_f32_16x16x32_bf16(cf, qf[ds], o1[n], 0, 0, 0); }
#pragma unroll
    for (int n = 0; n < 8; ++n) o1[n] = o1[n] * wi;
    f32x4 aS[8];
#pragma unroll
    for (int j = 0; j < 8; ++j) aS[j] = (f32x4){0.f, 0.f, 0.f, 0.f};
#pragma unroll
    for (int j = 0; j < 8; ++j) if (j <= w) {
#pragma unroll
        for (int ds = 0; ds < 4; ++ds) { const bf16x8 kf = *(LAS const bf16x8*)(lds + IMG0 + (16 * j + fr) * TS + (32 * ds + 8 * kq) * 2);
            aS[j] = __builtin_amdgcn_mfma_f32_16x16x32_bf16(kf, qf[ds], aS[j], 0, 0, 0); } }
    const float yt = ys[t]; float dsum = 0.f;
#pragma unroll
    for (int j = 0; j < 8; ++j) if (j <= w) {
#pragma unroll
        for (int r = 0; r < 4; ++r) { const int s = 16 * j + 4 * kq + r; const float wg = (s <= t) ? __expf(xs[s] - yt) : 0.f; aS[j][r] *= wg; dsum += aS[j][r]; } }
    dsum += __shfl_xor(dsum, 16); dsum += __shfl_xor(dsum, 32);
    const float den = dsum + wi * dn, rinv = 1.0f / fmaxf(fabsf(den), emt[t]);
#pragma unroll
    for (int st = 0; st < 4; ++st) if (2 * st <= w) {
        u32x4 sw; sw.x = cvt_pk_bf16(aS[2 * st][0], aS[2 * st][1]); sw.y = cvt_pk_bf16(aS[2 * st][2], aS[2 * st][3]);
        sw.z = cvt_pk_bf16(aS[2 * st + 1][0], aS[2 * st + 1][1]); sw.w = cvt_pk_bf16(aS[2 * st + 1][2], aS[2 * st + 1][3]);
        const bf16x8 sf = __builtin_bit_cast(bf16x8, sw);
#pragma unroll
        for (int n = 0; n < 8; ++n) { const bf16x8 vf = tr2(trv + (32 * st) * TS + 32 * n, trv + (32 * st + 16) * TS + 32 * n);
            o1[n] = __builtin_amdgcn_mfma_f32_16x16x32_bf16(vf, sf, o1[n], 0, 0, 0); } }
    float ssq = 0.f;
#pragma unroll
    for (int n = 0; n < 8; ++n)
#pragma unroll
        for (int r = 0; r < 4; ++r) { const float hv = o1[n][r] * rinv; o1[n][r] = hv; ssq += hv * hv; }
    ssq += __shfl_xor(ssq, 16); ssq += __shfl_xor(ssq, 32);
    const float rn = 1.0f / sqrtf(ssq * (1.0f / 128.0f) + EPS);
    bf16_t* yrow = P.YC + (size_t)(r0 + t) * 1024 + 512 + h * 128 + 4 * kq;
#pragma unroll
    for (int n = 0; n < 8; ++n) { const f32x4 g = *(const f32x4*)(P.mlnorm + h * 128 + 4 * kq + 16 * n); u32x2 o;
        o.x = cvt_pk_bf16(bf_lo(ow[n].x) * o1[n][0] * rn * g[0], bf_hi(ow[n].x) * o1[n][1] * rn * g[1]);
        o.y = cvt_pk_bf16(bf_lo(ow[n].y) * o1[n][2] * rn * g[2], bf_hi(ow[n].y) * o1[n][3] * rn * g[3]);
        *(u32x2*)(yrow + 16 * n) = o; }
    __syncthreads();
}

__device__ __forceinline__ void sample_unit(LAS unsigned char* lds, const MixP& P, int b, int h, int tid) {
    const int lane = tid & 63, w = __builtin_amdgcn_readfirstlane(tid >> 6);
    const int r0 = NP + b * 8, bh = b * 4 + h;
    LAS float* ql = (LAS float*)lds; LAS float* kl = ql + 1024; LAS float* vl = ql + 2048; LAS float* vnl = ql + 3072; LAS float* Sl = ql + 4096;
    LAS float* gsx = ql + 4160; LAS float* gsy = gsx + 8; LAS float* gwi = gsx + 16; LAS float* gem = gsx + 24; LAS float* gwe = gsx + 32; LAS float* gsc = gsx + 40; LAS float* qn = gsx + 48;
    LAS float* red = (LAS float*)(lds + 32768);
    f32x4 cvv[8];
    { const float* cs = P.stC + (size_t)bh * 16384 + (tid >> 5) * 128 + 4 * (tid & 31);
#pragma unroll
      for (int i = 0; i < 8; ++i) cvv[i] = *(const f32x4*)(cs + (size_t)(16 * i) * 128); }
    if (tid == 0) {
        const float m0 = P.stM[bh]; float bc = 0.f, pm = -INFINITY, mt = 0.f; float xv[8];
#pragma unroll
        for (int t = 0; t < 8; ++t) { const float lf = P.LF[(size_t)(r0 + t) * 4 + h], ig = P.IG[(size_t)(r0 + t) * 4 + h];
            bc += lf; const float x = ig - bc; pm = fmaxf(pm, x); const float y = fmaxf(m0, pm); mt = bc + y; xv[t] = x;
            gsx[t] = x; gsy[t] = y; gwi[t] = __expf(m0 - y); gem[t] = __expf(-mt); }
        const float mnew = mt;
#pragma unroll
        for (int t = 0; t < 8; ++t) gwe[t] = __expf(bc + xv[t] - mnew);
        gsc[0] = __expf(bc + m0 - mnew); gsc[1] = mnew;
    }
    { const int t = tid >> 6, e = 2 * (tid & 63); const bf16_t* zr = P.Z + (size_t)(r0 + t) * ZLD + h * 128 + e;
      const unsigned qw = *(const unsigned*)(zr + ZQ), kw = *(const unsigned*)(zr + ZK), vw = *(const unsigned*)(zr + ZV);
      ql[t * 128 + e] = bf_lo(qw); ql[t * 128 + e + 1] = bf_hi(qw); kl[t * 128 + e] = bf_lo(kw); kl[t * 128 + e + 1] = bf_hi(kw); vl[t * 128 + e] = bf_lo(vw); vl[t * 128 + e + 1] = bf_hi(vw); }
    { const int t = w;
      const u32x4 raw = *(const u32x4*)(P.Z + (size_t)(r0 + t) * ZLD + ZVG + 8 * lane);
      float x[8]; unpack8(raw, x);
      float s = ((x[0] + x[1]) + (x[2] + x[3])) + ((x[4] + x[5]) + (x[6] + x[7]));
      const float mean = wave_sum(s) * (1.0f / 512.0f); float q2 = 0.f;
#pragma unroll
      for (int e = 0; e < 8; ++e) { x[e] -= mean; q2 += x[e] * x[e]; }
      const float rstd = 1.0f / sqrtf(wave_sum(q2) * (1.0f / 512.0f) + EPS);
      if ((lane >> 4) == h) { const f32x4 a = *(const f32x4*)(P.lng + 8 * lane), a2 = *(const f32x4*)(P.lng + 8 * lane + 4), c0 = *(const f32x4*)(P.lnb + 8 * lane), c1 = *(const f32x4*)(P.lnb + 8 * lane + 4);
#pragma unroll
          for (int e = 0; e < 4; ++e) { x[e] = x[e] * rstd * a[e] + c0[e]; x[4 + e] = x[4 + e] * rstd * a2[e] + c1[e]; }
          float* vo = P.oVs + ((size_t)b * 8 + t) * 512 + 8 * lane; *(f32x4*)vo = (f32x4){x[0], x[1], x[2], x[3]}; *(f32x4*)(vo + 4) = (f32x4){x[4], x[5], x[6], x[7]};
#pragma unroll
          for (int e = 0; e < 8; ++e) vnl[t * 128 + 8 * (lane & 15) + e] = x[e]; } }
    __syncthreads();
    if (tid < 64) { const int t = tid >> 3, s = tid & 7; float dot = 0.f;
        for (int d = 0; d < 128; ++d) dot += ql[t * 128 + d] * kl[s * 128 + d];
        Sl[tid] = (s <= t) ? dot * __expf(gsx[s] - gsy[t]) : 0.f; }
    else if (tid < 72) { const int t = tid - 64; float dot = 0.f; for (int d = 0; d < 128; ++d) dot += ql[t * 128 + d] * P.stN[bh * 128 + d]; qn[t] = dot; }
    { const int t = w, e = 2 * lane; float s0 = 0.f, s1 = 0.f;
      for (int j = 0; j <= t; ++j) { const float wv = P.gm_ws[(size_t)h * 16384 + t * 128 + j]; s0 += wv * vnl[j * 128 + e]; s1 += wv * vnl[j * 128 + e + 1]; }
      const float bsv = P.bs[h * 128 + t]; const unsigned uw = *(const unsigned*)(P.Z + (size_t)(r0 + t) * ZLD + ZU + h * 128 + e);
      *(unsigned*)(P.YC + (size_t)(r0 + t) * 1024 + h * 128 + e) = cvt_pk_bf16(bf_lo(uw) * (s0 + bsv), bf_hi(uw) * (s1 + bsv)); }
    const float dec = gsc[0];
    { const int eg = tid & 31, dq = tid >> 5;
      f32x4 aq[8];
#pragma unroll
      for (int t = 0; t < 8; ++t) aq[t] = (f32x4){0.f, 0.f, 0.f, 0.f};
      f32x4 v4[8];
#pragma unroll
      for (int s = 0; s < 8; ++s) v4[s] = *(LAS const f32x4*)(vl + s * 128 + 4 * eg);
      float* co = P.oCs + (size_t)bh * 16384;
#pragma unroll
      for (int i = 0; i < 8; ++i) { const int d = dq + 16 * i; const f32x4 cv = cvv[i];
          f32x4 cn = dec * cv;
#pragma unroll
          for (int t = 0; t < 8; ++t) { aq[t] += ql[t * 128 + d] * cv; cn += (gwe[t] * kl[t * 128 + d]) * v4[t]; }
          *(f32x4*)(co + d * 128 + 4 * eg) = cn; }
#pragma unroll
      for (int t = 0; t < 8; ++t) *(LAS f32x4*)(red + (dq * 8 + t) * 128 + 4 * eg) = aq[t]; }
    __syncthreads();
    { const int t = w, e = 2 * lane; float qc0 = 0.f, qc1 = 0.f;
#pragma unroll
      for (int dq = 0; dq < 16; ++dq) { qc0 += red[(dq * 8 + t) * 128 + e]; qc1 += red[(dq * 8 + t) * 128 + e + 1]; }
      float n0 = 0.f, n1 = 0.f, dsum = 0.f;
#pragma unroll
      for (int s = 0; s < 8; ++s) { const float sv = Sl[t * 8 + s]; n0 += sv * vl[s * 128 + e]; n1 += sv * vl[s * 128 + e + 1]; dsum += sv; }
      const float wi = gwi[t], den = dsum + wi * qn[t], rinv = 1.0f / fmaxf(fabsf(den), gem[t]);
      const float h0 = (n0 + wi * qc0) * rinv, h1 = (n1 + wi * qc1) * rinv;
      const float rn = 1.0f / sqrtf(wave_sum(h0 * h0 + h1 * h1) * (1.0f / 128.0f) + EPS);
      const unsigned ow = *(const unsigned*)(P.Z + (size_t)(r0 + t) * ZLD + ZO + h * 128 + e);
      *(unsigned*)(P.YC + (size_t)(r0 + t) * 1024 + 512 + h * 128 + e) = cvt_pk_bf16(bf_lo(ow) * h0 * rn * P.mlnorm[h * 128 + e], bf_hi(ow) * h1 * rn * P.mlnorm[h * 128 + e + 1]); }
    if (tid < 128) { float nn = dec * P.stN[bh * 128 + tid];
#pragma unroll
        for (int s = 0; s < 8; ++s) nn += gwe[s] * kl[s * 128 + tid];
        P.oNs[bh * 128 + tid] = nn; if (tid == 0) P.oMs[bh] = gsc[1]; }
    __syncthreads();
}
}

namespace sg {
using pg8::bf16_t; using pg8::bf16x8; using pg8::f32x4; using pg8::u32x4; using pg8::u32x2; using pg8::cvt_pk_bf16; using pg8::bf_lo; using pg8::bf_hi; using pg8::sigmoid_f; using pg8::gelu_tanh_f; using pg8::row_rs;
constexpr int ROW0 = 16384;

struct Epi { bf16_t* O; int ldc; const float* rn; const bf16_t* Hb; bf16_t* Ho; float* SSO; const float* SSI; const bf16_t* PROJ; };

template <int MODE> __device__ __forceinline__ void epilogue(const Epi& E, int lrow, int ct, int j, float (&v)[8]) {
    const int row = ROW0 + lrow, col = 64 * ct + 8 * j;
    if (MODE == 0) {
        if (col < 1024) {
#pragma unroll
            for (int e = 0; e < 8; ++e) v[e] = gelu_tanh_f(v[e]); }
        else if (col >= 2560) {
#pragma unroll
            for (int e = 0; e < 8; ++e) v[e] = sigmoid_f(v[e]); }
    }
    if (MODE == 2) {
#pragma unroll
        for (int e = 0; e < 8; ++e) { const float a = fmaxf(v[e], 0.f); v[e] = a * a; } }
    if (MODE <= 2) { u32x4 w; w.x = cvt_pk_bf16(v[0], v[1]); w.y = cvt_pk_bf16(v[2], v[3]); w.z = cvt_pk_bf16(v[4], v[5]); w.w = cvt_pk_bf16(v[6], v[7]);
        *(u32x4*)(E.O + (size_t)row * E.ldc + col) = w; return; }
    const size_t off = (size_t)row * 1024 + col;
    if (MODE == 3) { const u32x4 hw = *(const u32x4*)(E.Hb + off); const float r[8] = {bf_lo(hw.x), bf_hi(hw.x), bf_lo(hw.y), bf_hi(hw.y), bf_lo(hw.z), bf_hi(hw.z), bf_lo(hw.w), bf_hi(hw.w)};
        const float rnv = E.rn[row];
#pragma unroll
        for (int e = 0; e < 8; ++e) v[e] += r[e] * rnv; }
    else { const u32x4 hw = *(const u32x4*)(E.Hb + off); const float r[8] = {bf_lo(hw.x), bf_hi(hw.x), bf_lo(hw.y), bf_hi(hw.y), bf_lo(hw.z), bf_hi(hw.z), bf_lo(hw.w), bf_hi(hw.w)};
        float rs = row_rs(E.SSI, row);
        if (MODE == 4) { rs = rs * rs;
#pragma unroll
            for (int e = 0; e < 8; ++e) v[e] = r[e] + v[e] * rs; }
        else { const u32x4 pw = *(const u32x4*)(E.PROJ + off); const float pr[8] = {bf_lo(pw.x), bf_hi(pw.x), bf_lo(pw.y), bf_hi(pw.y), bf_lo(pw.z), bf_hi(pw.z), bf_lo(pw.w), bf_hi(pw.w)};
#pragma unroll
            for (int e = 0; e < 8; ++e) v[e] = r[e] + sigmoid_f(v[e] * rs) * pr[e]; } }
    { u32x4 w; w.x = cvt_pk_bf16(v[0], v[1]); w.y = cvt_pk_bf16(v[2], v[3]); w.z = cvt_pk_bf16(v[4], v[5]); w.w = cvt_pk_bf16(v[6], v[7]); *(u32x4*)(E.Ho + off) = w; }
    float sq = 0.f;
#pragma unroll
    for (int e = 0; e < 8; ++e) sq += v[e] * v[e];
    sq += __shfl_xor(sq, 1); sq += __shfl_xor(sq, 2); sq += __shfl_xor(sq, 4);
    if (j == 0) E.SSO[(size_t)row * 16 + ct] = sq;
}

template <int KSTEP> struct Frag { bf16x8 a[4][KSTEP / 32], b[4][KSTEP / 32]; };
template <int KSTEP> __device__ __forceinline__ void load_frag(Frag<KSTEP>& F, const bf16_t* A, const bf16_t* Bt, int K, int rt, int ct, int koff, int fr, int kq) {
    constexpr int LW = KSTEP / 4, NH = KSTEP / 32;
    const bf16_t* ap = A + (size_t)(64 * rt + fr) * K + koff + LW * kq;
    const bf16_t* bp = Bt + (size_t)(64 * ct + fr) * K + koff + LW * kq;
#pragma unroll
    for (int m = 0; m < 4; ++m)
#pragma unroll
        for (int hh = 0; hh < NH; ++hh) { F.a[m][hh] = *(const bf16x8*)(ap + (size_t)(16 * m) * K + 8 * hh); F.b[m][hh] = *(const bf16x8*)(bp + (size_t)(16 * m) * K + 8 * hh); }
}
template <int KSTEP> __device__ __forceinline__ void mma_frag(f32x4 (&acc)[4][4], const Frag<KSTEP>& F) {
#pragma unroll
    for (int m = 0; m < 4; ++m)
#pragma unroll
        for (int n = 0; n < 4; ++n)
#pragma unroll
            for (int hh = 0; hh < KSTEP / 32; ++hh) acc[m][n] = __builtin_amdgcn_mfma_f32_16x16x32_bf16(F.b[n][hh], F.a[m][hh], acc[m][n], 0, 0, 0);
}
template <int MODE> __device__ __forceinline__ void reduce_epilogue(LAS unsigned char* lds, f32x4 (&acc)[4][4], const Epi& E, int rt, int ct, int tid, int w, int fr, int kq) {
#pragma unroll
    for (int m = 0; m < 4; ++m)
#pragma unroll
        for (int n = 0; n < 4; ++n) { const int row = 16 * m + fr, ch = (4 * n + kq) ^ (row & 15);
            *(LAS f32x4*)(lds + (((w * 64 + row) * 16 + ch) << 4)) = acc[m][n]; acc[m][n] = (f32x4){0.f, 0.f, 0.f, 0.f}; }
    __syncthreads();
    { const int row = tid >> 3, j = tid & 7, c0 = (2 * j) ^ (row & 15), c1 = (2 * j + 1) ^ (row & 15);
      f32x4 s0 = (f32x4){0.f, 0.f, 0.f, 0.f}, s1 = s0;
#pragma unroll
      for (int ww = 0; ww < 8; ++ww) { s0 += *(LAS const f32x4*)(lds + (((ww * 64 + row) * 16 + c0) << 4)); s1 += *(LAS const f32x4*)(lds + (((ww * 64 + row) * 16 + c1) << 4)); }
      float v[8] = {s0[0], s0[1], s0[2], s0[3], s1[0], s1[1], s1[2], s1[3]};
      epilogue<MODE>(E, 64 * rt + row, ct, j, v); }
    __syncthreads();
}
template <int MODE, int KSTEP> __device__ __forceinline__ void phase(LAS unsigned char* lds, const bf16_t* A0, const bf16_t* Bt, int K, int N, const Epi& E, int vcu, int G, int tid) {
    const int lane = tid & 63, w = __builtin_amdgcn_readfirstlane(tid >> 6), fr = lane & 15, kq = lane >> 4;
    const bf16_t* A = A0 + (size_t)ROW0 * K;
    const int nu = 16 * (N >> 6), kw = K >> 3, iters = kw / KSTEP, kb = w * kw;
    if (vcu >= nu) return;
    const int nmine = (nu - vcu + G - 1) / G, total = nmine * iters;
    f32x4 acc[4][4];
#pragma unroll
    for (int m = 0; m < 4; ++m)
#pragma unroll
        for (int n = 0; n < 4; ++n) acc[m][n] = (f32x4){0.f, 0.f, 0.f, 0.f};
    if (iters & 1) {
        for (int ui = 0; ui < nmine; ++ui) { const int u = vcu + ui * G; Frag<KSTEP> F;
            for (int ki = 0; ki < iters; ++ki) { load_frag<KSTEP>(F, A, Bt, K, u & 15, u >> 4, kb + ki * KSTEP, fr, kq); mma_frag<KSTEP>(acc, F); }
            reduce_epilogue<MODE>(lds, acc, E, u & 15, u >> 4, tid, w, fr, kq); }
        return;
    }
    Frag<KSTEP> F0, F1;
    load_frag<KSTEP>(F0, A, Bt, K, vcu & 15, vcu >> 4, kb, fr, kq);
    for (int i = 0; i < total; i += 2) {
        const int ui = i / iters, ki = i - ui * iters, u = vcu + ui * G;
        load_frag<KSTEP>(F1, A, Bt, K, u & 15, u >> 4, kb + (ki + 1) * KSTEP, fr, kq);
        mma_frag<KSTEP>(acc, F0);
        const bool last = (ki + 2 == iters);
        if (i + 2 < total) { const int u2 = last ? u + G : u, k2 = last ? 0 : ki + 2; load_frag<KSTEP>(F0, A, Bt, K, u2 & 15, u2 >> 4, kb + k2 * KSTEP, fr, kq); }
        mma_frag<KSTEP>(acc, F1);
        if (last) reduce_epilogue<MODE>(lds, acc, E, u & 15, u >> 4, tid, w, fr, kq);
    }
}
}

#ifndef HOST_DUP_PHASE
#define HOST_DUP_PHASE -1
#endif
#ifndef HOST_EXTRA_BARS
#define HOST_EXTRA_BARS 0
#endif
#ifndef MK_ONE_LAUNCH
#define MK_ONE_LAUNCH 1
#endif
constexpr int NWAVES = 8;
constexpr int D = 1024, NPR = 16384, NSR = 1024, M = NPR + NSR, NIN = 3072, INC = 3080, FF = 4096, PLE = 256;
constexpr int N_PHASES = 10;
constexpr size_t MiB = 1u << 20;
constexpr size_t WS_CTL = 0, CTL_ZERO_BYTES = 65536;
constexpr int CW_BAR = 1024;
constexpr size_t WS_WIN = 1 * MiB;
constexpr size_t WS_WOUT = WS_WIN + (size_t)NIN * D * 2;
constexpr size_t WS_WUP = WS_WOUT + (size_t)D * D * 2;
constexpr size_t WS_WDOWN = WS_WUP + (size_t)FF * D * 2;
constexpr size_t WS_WGATE = WS_WDOWN + (size_t)D * FF * 2;
constexpr size_t WS_WPROJ = WS_WGATE + (size_t)D * D * 2;
constexpr size_t WS_WSB = WS_WPROJ + (size_t)D * PLE * 2;
constexpr size_t WS_IG = WS_WSB + 4 * 128 * 128 * 2;
constexpr size_t WS_LF = WS_IG + (size_t)M * 16;
constexpr size_t WS_SS1 = WS_LF + (size_t)M * 16;
constexpr size_t WS_SS2 = WS_SS1 + (size_t)M * 64;
constexpr size_t WS_SS3 = WS_SS2 + (size_t)M * 64;
constexpr size_t WS_CH = WS_SS3 + (size_t)M * 64;
constexpr size_t WS_MST = WS_CH + 4096;
constexpr size_t WS_NLOC = WS_MST + 4096;
constexpr size_t WS_NST = WS_NLOC + 512 * 128 * 4;
constexpr size_t WS_RN = WS_NST + 512 * 128 * 4;
constexpr size_t WS_PE = WS_RN + 69632;
constexpr size_t WS_RA = WS_PE + (size_t)M * PLE * 2;
constexpr size_t WS_RB = WS_RA + (size_t)M * D * 2;
constexpr size_t WS_YC = WS_RB + (size_t)M * NIN * 2;
constexpr size_t WS_KV = WS_RB + (size_t)M * FF * 2;
constexpr size_t WS_END = WS_KV + (size_t)M * D * 2;
static_assert(WS_END <= 256 * MiB, "d_ws map");
static_assert(WS_WIN % 256 == 0 && WS_IG % 256 == 0 && WS_PE % 256 == 0 && WS_RA % 256 == 0 && WS_RB % 256 == 0 && WS_YC % 256 == 0 && WS_KV % 256 == 0, "alignment");
constexpr size_t O_Y = 0, O_CP = (size_t)M * D, O_NP = O_CP + 8 * 4 * 16384, O_MP = O_NP + 8 * 4 * 128, O_VP = O_MP + 32, O_CS = O_VP + 8 * 128 * 512,
                 O_NS = O_CS + (size_t)128 * 4 * 16384, O_MS = O_NS + 128 * 4 * 128, O_VS = O_MS + 512, O_END = O_VS + 128 * 8 * 512;
constexpr int RING_OFF = 0, RING_BYTES = 131072, LDSCTL_OFF = RING_BYTES, MISC_OFF = LDSCTL_OFF + 320, LDS_BYTES = 147456;

typedef unsigned short bf16;
typedef unsigned v4u __attribute__((ext_vector_type(4)));
typedef float f32x4 __attribute__((ext_vector_type(4)));
#define GAS __attribute__((address_space(1)))
typedef GAS unsigned gu32;
#define RLX_AGENT __ATOMIC_RELAXED, __HIP_MEMORY_SCOPE_AGENT
#define LDS_WAIT() asm volatile("s_waitcnt lgkmcnt(0)" ::: "memory")

struct Args { const float* in[24]; float* out; unsigned char* ws; int ph_lo, ph_hi, flags, extra_bars; };

#define XB_TMO      128
#define XB_XCNT(j)  (256  + 64 * (j))
#define XB_XSUB(j)  (1280 + 64 * (j))
#define XB_XGEN(j)  (2304 + 64 * (j))
#define XB_TOP      3328
#define XB_TOPGEN   3392
#define XCD_BAR_WORDS 3456
#define XB_SPIN_CAP (1u << 18)

__device__ __forceinline__ unsigned xb_ld(unsigned* p)              { return __hip_atomic_load(p, __ATOMIC_RELAXED, __HIP_MEMORY_SCOPE_AGENT); }
__device__ __forceinline__ unsigned xb_add(unsigned* p, unsigned v) { return __hip_atomic_fetch_add(p, v, __ATOMIC_RELAXED, __HIP_MEMORY_SCOPE_AGENT); }
__device__ __forceinline__ unsigned xb_xcc_id() { return (unsigned)__builtin_amdgcn_s_getreg((3 << 11) | 20) & 0xFu; }
#define XB_SPIN(cond, bar) do { unsigned _sp = 0; while (cond) { __builtin_amdgcn_s_sleep(1); \
    if ((++_sp & 255u) == 0u) { if (xb_ld(&(bar)[XB_TMO])) break; if (_sp > XB_SPIN_CAP) { atomicAdd(&(bar)[XB_TMO], 1u); break; } } } } while (0)

struct XcdBarrier {
    unsigned* bar; unsigned x;
    volatile LAS unsigned* st;
};

__device__ __forceinline__ XcdBarrier xcd_barrier_post(unsigned* bar, volatile LAS unsigned* st) {
    XcdBarrier b; b.bar = bar; b.x = xb_xcc_id(); b.st = st;
    if (threadIdx.x == 0) (void)xb_add(&bar[XB_XCNT(b.x)], 1u);
    return b;
}
__device__ __forceinline__ void xcd_barrier_complete(unsigned* bar, unsigned x, unsigned& nloc, unsigned& nx) {
    const unsigned G = gridDim.x * gridDim.y * gridDim.z;
    unsigned sum, cnt, mine, sp = 0u;
    for (;;) {
        sum = 0u; cnt = 0u; mine = 0u;
#pragma unroll
        for (unsigned j = 0; j < 16; ++j) { const unsigned c = xb_ld(&bar[XB_XCNT(j)]); sum += c; cnt += (c > 0u) ? 1u : 0u; mine = (j == x) ? c : mine; }
        if (sum == G) break;
        __builtin_amdgcn_s_sleep(1);
        if ((++sp & 255u) == 0u) { if (xb_ld(&bar[XB_TMO])) break; if (sp > XB_SPIN_CAP) { atomicAdd(&bar[XB_TMO], 1u); break; } }
    }
    nloc = mine > 0u ? mine : 1u; nx = cnt > 0u ? cnt : 1u;
}

__device__ __forceinline__ void xcd_barrier(const XcdBarrier& b) {
    asm volatile("s_waitcnt vmcnt(0)" ::: "memory");
    __syncthreads();
    if (threadIdx.x == 0) {
        unsigned* bar = b.bar;
        __builtin_amdgcn_s_waitcnt(0);
        unsigned nloc = b.st[0], nx = b.st[1];
        if (nloc == 0u) { xcd_barrier_complete(bar, b.x, nloc, nx); b.st[0] = nloc; b.st[1] = nx; }
        const unsigned old = xb_add(&bar[XB_XSUB(b.x)], 1u);
        const unsigned gen = old / nloc;
        if (old + 1u == (gen + 1u) * nloc) {
            __builtin_amdgcn_fence(__ATOMIC_RELEASE, "agent");
            asm volatile("s_waitcnt vmcnt(0)" ::: "memory");
            const unsigned og = xb_add(&bar[XB_TOP], 1u);
            const unsigned tg = og / nx;
            if (og + 1u == (tg + 1u) * nx) xb_add(&bar[XB_TOPGEN], 1u);
            else XB_SPIN(xb_ld(&bar[XB_TOPGEN]) == tg, bar);
            __builtin_amdgcn_fence(__ATOMIC_ACQUIRE, "agent");
            xb_add(&bar[XB_XGEN(b.x)], 1u);
            asm volatile("s_waitcnt vmcnt(0)" ::: "memory");
        } else {
            XB_SPIN(xb_ld(&bar[XB_XGEN(b.x)]) == gen, bar);
            __builtin_amdgcn_fence(__ATOMIC_ACQUIRE, "agent");
            asm volatile("s_waitcnt vmcnt(0)" ::: "memory");
        }
    }
    __syncthreads();
}

__device__ __forceinline__ void p0_transpose_item(const float* W, int ldw, int K, int N, const float* gain, bf16* WT, LAS float* scr, int item, int lane, bool kscale) {
    const int nblk = N / 32, kb = item / nblk, nb = item % nblk, k0 = 64 * kb, n0 = 32 * nb;
    const float cs = (kscale && n0 >= 1536 && n0 < 2048) ? 0.08838834764831845f : 1.0f;
    float wv[32];
#pragma unroll
    for (int i = 0; i < 32; ++i) { const int kk = 2 * i + (lane >> 5); wv[i] = W[(size_t)(k0 + kk) * ldw + n0 + (lane & 31)]; }
#pragma unroll
    for (int i = 0; i < 32; ++i) { const int kk = 2 * i + (lane >> 5); const float g = gain ? gain[k0 + kk] * cs : cs; scr[kk * 33 + (lane & 31)] = wv[i] * g; }
    LDS_WAIT(); asm volatile("" ::: "memory");
    const int c = lane & 7;
#pragma unroll
    for (int j = 0; j < 4; ++j) { const int n = (lane >> 3) + 8 * j; const LAS float* s = scr + (8 * c) * 33 + n;
        v4u o; o.x = pg8::cvt_pk_bf16(s[0 * 33], s[1 * 33]); o.y = pg8::cvt_pk_bf16(s[2 * 33], s[3 * 33]); o.z = pg8::cvt_pk_bf16(s[4 * 33], s[5 * 33]); o.w = pg8::cvt_pk_bf16(s[6 * 33], s[7 * 33]);
        *(v4u*)(WT + (size_t)(n0 + n) * K + k0 + 8 * c) = o; }
    LDS_WAIT(); asm volatile("" ::: "memory");
}

__device__ __forceinline__ float log_sigmoid_f(float x) { return fminf(x, 0.f) - log1pf(__expf(-fabsf(x))); }

struct RowIn { f32x4 v[4]; f32x4 pv; };
__device__ __forceinline__ void p0_row_load(const Args& A, int m, int lane, RowIn& R) {
    const float* xrow = (m < NPR) ? A.in[0] + (size_t)m * D : A.in[1] + (size_t)(m - NPR) * D;
    const float* prow = (m < NPR) ? A.in[2] + (size_t)m * PLE : A.in[3] + (size_t)(m - NPR) * PLE;
    const f32x4* xr = (const f32x4*)xrow + lane;
#pragma unroll
    for (int j = 0; j < 4; ++j) R.v[j] = xr[64 * j];
    R.pv = *((const f32x4*)prow + lane);
}
__device__ __forceinline__ void p0_row_finish(unsigned char* ws, int m, int lane, RowIn& R, const float (&gwt)[4][4][8], float gbias) {
    float s = 0.f;
#pragma unroll
    for (int j = 0; j < 4; ++j) s += (R.v[j][0] * R.v[j][0] + R.v[j][1] * R.v[j][1]) + (R.v[j][2] * R.v[j][2] + R.v[j][3] * R.v[j][3]);
    const float rnv = sqrtf(mix::wave_sum(s) * (1.0f / D) + 1e-6f), rinv = 1.0f / rnv;
    if (lane == 8) ((float*)(ws + WS_RN))[m] = rnv;
    unsigned long long* o8 = (unsigned long long*)((bf16*)(ws + WS_RA) + (size_t)m * D) + lane;
    float g8[8];
#pragma unroll
    for (int q = 0; q < 8; ++q) g8[q] = 0.f;
#pragma unroll
    for (int j = 0; j < 4; ++j) { const f32x4 v = R.v[j] * rinv;
        o8[64 * j] = (unsigned long long)pg8::cvt_pk_bf16(v[0], v[1]) | ((unsigned long long)pg8::cvt_pk_bf16(v[2], v[3]) << 32);
#pragma unroll
        for (int c = 0; c < 4; ++c)
#pragma unroll
            for (int q = 0; q < 8; ++q) g8[q] += v[c] * gwt[j][c][q]; }
#pragma unroll
    for (int q = 0; q < 8; ++q) g8[q] = mix::row_sum16(g8[q]);
    const int q8 = lane & 7;
    float val = q8 == 0 ? g8[0] : q8 == 1 ? g8[1] : q8 == 2 ? g8[2] : q8 == 3 ? g8[3] : q8 == 4 ? g8[4] : q8 == 5 ? g8[5] : q8 == 6 ? g8[6] : g8[7];
    val += __shfl_xor(val, 16); val += __shfl_xor(val, 32);
    if (lane < 4) ((float*)(ws + WS_IG))[(size_t)m * 4 + lane] = val + gbias;
    else if (lane < 8) ((float*)(ws + WS_LF))[(size_t)m * 4 + lane - 4] = log_sigmoid_f(val + gbias);
    *((unsigned long long*)((bf16*)(ws + WS_PE) + (size_t)m * PLE) + lane) = (unsigned long long)pg8::cvt_pk_bf16(R.pv[0], R.pv[1]) | ((unsigned long long)pg8::cvt_pk_bf16(R.pv[2], R.pv[3]) << 32);
}

__device__ __forceinline__ void p0_prologue(const Args& A, LAS unsigned char* lds, int vcu, int G, int tid) {
    const int lane = tid & 63, wave = __builtin_amdgcn_readfirstlane(tid >> 6);
    unsigned char* ws = A.ws;
    LAS float* scr = (LAS float*)(lds + RING_OFF + wave * 8704);
    LAS float* gtab = (LAS float*)(lds + RING_OFF + 8 * 8704);
    const int gw = vcu * NWAVES + wave, NGW = G * NWAVES;
    for (int k = tid; k < D; k += NWAVES * 64) { const float g = A.in[7][k]; const float* wp = A.in[8] + (size_t)k * INC + NIN;
        const f32x4 a = *(const f32x4*)wp, b = *(const f32x4*)(wp + 4); *(LAS f32x4*)(gtab + k * 8) = a * g; *(LAS f32x4*)(gtab + k * 8 + 4) = b * g; }
    constexpr int I_IN = (D / 64) * (NIN / 32), I_OUT = (D / 64) * (D / 32), I_UP = (D / 64) * (FF / 32), I_DOWN = (FF / 64) * (D / 32), I_GATE = I_OUT, I_PROJ = (PLE / 64) * (D / 32);
    constexpr int NITEMS = I_IN + I_OUT + I_UP + I_DOWN + I_GATE + I_PROJ;
    for (int it = gw; it < NITEMS; it += NGW) {
        int r = it;
        if (r < I_IN) { p0_transpose_item(A.in[8], INC, D, NIN, A.in[7], (bf16*)(ws + WS_WIN), scr, r, lane, true); continue; } r -= I_IN;
        if (r < I_OUT) { p0_transpose_item(A.in[16], D, D, D, nullptr, (bf16*)(ws + WS_WOUT), scr, r, lane, false); continue; } r -= I_OUT;
        if (r < I_UP) { p0_transpose_item(A.in[18], FF, D, FF, A.in[17], (bf16*)(ws + WS_WUP), scr, r, lane, false); continue; } r -= I_UP;
        if (r < I_DOWN) { p0_transpose_item(A.in[19], D, FF, D, nullptr, (bf16*)(ws + WS_WDOWN), scr, r, lane, false); continue; } r -= I_DOWN;
        if (r < I_GATE) { p0_transpose_item(A.in[21], D, D, D, A.in[20], (bf16*)(ws + WS_WGATE), scr, r, lane, false); continue; } r -= I_GATE;
        p0_transpose_item(A.in[22], D, PLE, D, nullptr, (bf16*)(ws + WS_WPROJ), scr, r, lane, false);
    }
    { const int gt = vcu * 512 + tid, NT = G * 512; const float* wsrc = A.in[11]; bf16* wdst = (bf16*)(ws + WS_WSB);
      for (int i = gt; i < 4 * 128 * 128 / 4; i += NT) { const int e = 4 * i, t = (e >> 7) & 127, j = e & 127; const f32x4 v = *(const f32x4*)(wsrc + e);
          pg8::u32x2 o; o.x = pg8::cvt_pk_bf16(j <= t ? v[0] : 0.f, j + 1 <= t ? v[1] : 0.f); o.y = pg8::cvt_pk_bf16(j + 2 <= t ? v[2] : 0.f, j + 3 <= t ? v[3] : 0.f);
          *(pg8::u32x2*)(wdst + e) = o; } }
    __syncthreads();
    float gwt[4][4][8];
#pragma unroll
    for (int j = 0; j < 4; ++j)
#pragma unroll
        for (int c = 0; c < 4; ++c) { const LAS float* gp = gtab + (4 * lane + 256 * j + c) * 8; const f32x4 a = *(const LAS f32x4*)gp, b = *(const LAS f32x4*)(gp + 4);
#pragma unroll
            for (int q = 0; q < 4; ++q) { gwt[j][c][q] = a[q]; gwt[j][c][4 + q] = b[q]; } }
    const float gbias = (lane < 4) ? A.in[13][lane & 3] : A.in[14][lane & 3];
    for (int m = gw; m < M; m += 2 * NGW) {
        const int m2 = (m + NGW < M) ? m + NGW : m;
        RowIn R0, R1; p0_row_load(A, m, lane, R0); p0_row_load(A, m2, lane, R1);
        p0_row_finish(ws, m, lane, R0, gwt, gbias);
        p0_row_finish(ws, m2, lane, R1, gwt, gbias);
    }
    __syncthreads();
}

__device__ __forceinline__ void p7_final(const Args& A, int vcu, int G, int tid) {
    const int lane = tid & 63, wave = __builtin_amdgcn_readfirstlane(tid >> 6);
    const int gw = vcu * NWAVES + wave, NGW = G * NWAVES;
    const float* ss = (const float*)(A.ws + WS_SS3); const bf16* Hb = (const bf16*)(A.ws + WS_RB);
    const f32x4 g0 = *((const f32x4*)A.in[23] + 2 * lane), g1 = *((const f32x4*)A.in[23] + 2 * lane + 1), g2 = *((const f32x4*)A.in[23] + 128 + 2 * lane), g3 = *((const f32x4*)A.in[23] + 128 + 2 * lane + 1);
    for (int m = gw; m < M; m += NGW) {
        const float rs = pg8::row_rs(ss, m);
        const v4u a = *((const v4u*)(Hb + (size_t)m * D) + lane), b = *((const v4u*)(Hb + (size_t)m * D) + 64 + lane);
        f32x4* yr = (f32x4*)(A.out + (size_t)m * D);
        yr[2 * lane] = (f32x4){pg8::bf_lo(a.x), pg8::bf_hi(a.x), pg8::bf_lo(a.y), pg8::bf_hi(a.y)} * rs * g0;
        yr[2 * lane + 1] = (f32x4){pg8::bf_lo(a.z), pg8::bf_hi(a.z), pg8::bf_lo(a.w), pg8::bf_hi(a.w)} * rs * g1;
        yr[128 + 2 * lane] = (f32x4){pg8::bf_lo(b.x), pg8::bf_hi(b.x), pg8::bf_lo(b.y), pg8::bf_hi(b.y)} * rs * g2;
        yr[128 + 2 * lane + 1] = (f32x4){pg8::bf_lo(b.z), pg8::bf_hi(b.z), pg8::bf_lo(b.w), pg8::bf_hi(b.w)} * rs * g3;
    }
}

__global__ void __launch_bounds__(NWAVES * 64, 2) hymba_fwd(Args args) {
    extern __shared__ __attribute__((aligned(16))) unsigned char lds_raw[];
    LAS unsigned char* lds = (LAS unsigned char*)lds_raw;
    const int tid = threadIdx.x, G = gridDim.x, bx = blockIdx.x;
    const int vcu = (G % 8 == 0) ? (bx % 8) * (G / 8) + bx / 8 : bx;
    unsigned char* ws = args.ws;
#ifndef DUP_PHASE
#define DUP_PHASE -1
#endif
    const int lo = args.ph_lo, hi = args.ph_hi;
#ifndef PH_MASK
#define PH_MASK 0xffff
#endif
#define INC_(k) (((PH_MASK >> (k)) & 1) && lo <= (k) && (k) < hi)
#if DUP_PHASE >= 0
#define IN(k) for (int rep_ = 0; rep_ < ((DUP_PHASE == (k)) ? 2 : 1); ++rep_) if (INC_(k))
#define GRID_BAR(k) do { if (INC_((k) + 1)) xcd_barrier(bar); } while (0)
#else
#define IN(k) if (INC_(k))
#define GRID_BAR(k) do { if (INC_((k) + 1)) xcd_barrier(bar); } while (0)
#endif
    for (int u = tid; u < (LDS_BYTES - LDSCTL_OFF) / 4; u += NWAVES * 64) ((LAS unsigned*)(lds + LDSCTL_OFF))[u] = 0u;
    __syncthreads();
    XcdBarrier bar = xcd_barrier_post((unsigned*)(ws + WS_CTL) + CW_BAR, (volatile LAS unsigned*)(lds + MISC_OFF) + 8);
    float* OUT = args.out;
    bf16* RA = (bf16*)(ws + WS_RA); bf16* Zb = (bf16*)(ws + WS_RB); bf16* YC = (bf16*)(ws + WS_YC); bf16* HID = (bf16*)(ws + WS_RB); bf16* H3 = (bf16*)(ws + WS_RB);     bf16* PROJ = (bf16*)args.out;
    float* SS1 = (float*)(ws + WS_SS1); float* SS2 = (float*)(ws + WS_SS2); float* SS3 = (float*)(ws + WS_SS3);
    mix::MixP MP;
    MP.Z = Zb; MP.YC = YC; MP.IG = (const float*)(ws + WS_IG); MP.LF = (const float*)(ws + WS_LF); MP.WSb = (const bf16*)(ws + WS_WSB);
    MP.gm_ws = args.in[11]; MP.lng = args.in[9]; MP.lnb = args.in[10]; MP.bs = args.in[12]; MP.mlnorm = args.in[15];
    MP.KV = (float*)(ws + WS_KV); MP.NLOC = (float*)(ws + WS_NLOC); MP.NST = (float*)(ws + WS_NST); MP.CH = (float*)(ws + WS_CH); MP.MST = (float*)(ws + WS_MST);
    MP.stC = args.in[4]; MP.stN = args.in[5]; MP.stM = args.in[6];
    MP.oCp = OUT + O_CP; MP.oNp = OUT + O_NP; MP.oMp = OUT + O_MP; MP.oVp = OUT + O_VP; MP.oCs = OUT + O_CS; MP.oNs = OUT + O_NS; MP.oMs = OUT + O_MS; MP.oVs = OUT + O_VS;

    IN(0) { p0_prologue(args, lds, vcu, G, tid); GRID_BAR(0); for (int eb = 0; eb < args.extra_bars; ++eb) xcd_barrier(bar); }
    IN(1) {
        pg8::Gemm g{RA, (const bf16*)(ws + WS_WIN), NPR, NIN, D}; pg8::StaticOrder S; S.init(NPR, NIN, G, bx);
        pg8::EpiBf16<0> E{Zb, NIN, nullptr};
        pg8::gemm_phase<pg8::EpiBf16<0>, pg8::StaticOrder, true, true>(lds + RING_OFF, g, S, E);
        { const sg::Epi SE{Zb, NIN, nullptr, nullptr, nullptr, nullptr, nullptr, nullptr}; sg::phase<0, 64>(lds + RING_OFF, RA, (const bf16*)(ws + WS_WIN), D, NIN, SE, vcu, G, tid); }
        GRID_BAR(1);
    }
    IN(2) {
        for (int u = vcu; u < 1024; u += G) {
            if (u < 512) { const int bc = u >> 2, h = u & 3; mix::gmlp_unit(lds, MP, bc >> 4, bc & 15, h, tid); }
            else { const int v = u - 512; mix::kv_unit(lds, MP, v >> 6, (v >> 4) & 3, v & 15, tid); }
        }
        GRID_BAR(2);
    }
    IN(3) {
        if (!(args.flags & 1)) for (int u = vcu; u < 256; u += G) mix::scan_unit(MP, u >> 3, u & 7, tid);
        for (int u = vcu; u < 512; u += G) mix::sample_unit(lds, MP, u >> 2, u & 3, tid);
        { pg8::Gemm g{(const bf16*)(ws + WS_PE), (const bf16*)(ws + WS_WPROJ), NPR, D, PLE}; pg8::StaticOrder S; S.init(NPR, D, G, bx);
          pg8::EpiBf16<1> E{PROJ, D, nullptr};
          pg8::gemm_phase<pg8::EpiBf16<1>, pg8::StaticOrder, true, true>(lds + RING_OFF, g, S, E);
          const sg::Epi SE{PROJ, D, nullptr, nullptr, nullptr, nullptr, nullptr, nullptr}; sg::phase<1, 32>(lds + RING_OFF, (const bf16*)(ws + WS_PE), (const bf16*)(ws + WS_WPROJ), PLE, D, SE, vcu, G, tid); }
        GRID_BAR(3);
    }
    IN(4) {
        for (int u = vcu; u < 512; u += G) mix::mlo_unit(lds, MP, u >> 6, (u >> 4) & 3, u & 15, tid);
        GRID_BAR(4);
    }
    IN(5) {
        pg8::Gemm g{YC, (const bf16*)(ws + WS_WOUT), NPR, D, D}; pg8::StaticOrder S; S.init(NPR, D, G, bx);
        pg8::EpiRes<0> E{(const float*)(ws + WS_RN), RA, RA, SS1, nullptr, nullptr};
        pg8::gemm_phase<pg8::EpiRes<0>, pg8::StaticOrder, true, true>(lds + RING_OFF, g, S, E);
        { const sg::Epi SE{nullptr, 0, (const float*)(ws + WS_RN), RA, RA, SS1, nullptr, nullptr}; sg::phase<3, 64>(lds + RING_OFF, YC, (const bf16*)(ws + WS_WOUT), D, D, SE, vcu, G, tid); }
        GRID_BAR(5);
    }
    IN(6) {
        pg8::Gemm g{RA, (const bf16*)(ws + WS_WUP), NPR, FF, D}; pg8::StaticOrder S; S.init(NPR, FF, G, bx);
        pg8::EpiBf16<2> E{HID, FF, nullptr};
        pg8::gemm_phase<pg8::EpiBf16<2>, pg8::StaticOrder, true, true>(lds + RING_OFF, g, S, E);
        { const sg::Epi SE{HID, FF, nullptr, nullptr, nullptr, nullptr, nullptr, nullptr}; sg::phase<2, 64>(lds + RING_OFF, RA, (const bf16*)(ws + WS_WUP), D, FF, SE, vcu, G, tid); }
        GRID_BAR(6);
    }
    IN(7) {
        pg8::Gemm g{HID, (const bf16*)(ws + WS_WDOWN), NPR, D, FF}; pg8::StaticOrder S; S.init(NPR, D, G, bx);
        pg8::EpiRes<1> E{nullptr, RA, RA, SS2, SS1, nullptr};
        pg8::gemm_phase<pg8::EpiRes<1>, pg8::StaticOrder, true, true>(lds + RING_OFF, g, S, E);
        { const sg::Epi SE{nullptr, 0, nullptr, RA, RA, SS2, SS1, nullptr}; sg::phase<4, 64>(lds + RING_OFF, HID, (const bf16*)(ws + WS_WDOWN), FF, D, SE, vcu, G, tid); }
        GRID_BAR(7);
    }
    IN(8) {
        pg8::Gemm g{RA, (const bf16*)(ws + WS_WGATE), NPR, D, D}; pg8::StaticOrder S; S.init(NPR, D, G, bx);
        pg8::EpiRes<2> E{nullptr, RA, H3, SS3, SS2, PROJ};
        pg8::gemm_phase<pg8::EpiRes<2>, pg8::StaticOrder, true, true>(lds + RING_OFF, g, S, E);
        { const sg::Epi SE{nullptr, 0, nullptr, RA, H3, SS3, SS2, PROJ}; sg::phase<5, 64>(lds + RING_OFF, RA, (const bf16*)(ws + WS_WGATE), D, D, SE, vcu, G, tid); }
        GRID_BAR(8);
    }
    IN(9) p7_final(args, vcu, G, tid);
#undef IN
#undef GRID_BAR
}

extern "C" void kernel_launch(void* const* d_in, const int* in_sizes, int n_in, void* d_out, int out_size, void* d_ws, size_t ws_size, hipStream_t stream) {
    static int grid = 0;
    if (grid == 0) {
        if (n_in != 24 || (size_t)out_size != O_END || ws_size < WS_END) { fprintf(stderr, "kernel_launch: unexpected problem shape (n_in %d, out %d, ws %zu)\n", n_in, out_size, ws_size); grid = -1; return; }
        int dev = 0, cus = 0, per_cu = 0;
        if (hipGetDevice(&dev) != hipSuccess || hipDeviceGetAttribute(&cus, hipDeviceAttributeMultiprocessorCount, dev) != hipSuccess) { grid = -1; return; }
        if (hipFuncSetAttribute((const void*)hymba_fwd, hipFuncAttributeMaxDynamicSharedMemorySize, LDS_BYTES) != hipSuccess) { fprintf(stderr, "kernel_launch: hipFuncSetAttribute failed\n"); grid = -1; return; }
        if (hipOccupancyMaxActiveBlocksPerMultiprocessor(&per_cu, (const void*)hymba_fwd, NWAVES * 64, LDS_BYTES) != hipSuccess || per_cu < 1) { fprintf(stderr, "kernel_launch: occupancy query says %d blocks per CU\n", per_cu); per_cu = 1; }
        (void)hipGetLastError();
        grid = cus * (per_cu < 1 ? per_cu : 1);
    }
    if (grid < 0) return;
    Args a{};
    for (int i = 0; i < 24; ++i) a.in[i] = (const float*)d_in[i];
    a.out = (float*)d_out; a.ws = (unsigned char*)d_ws;
#if MK_ONE_LAUNCH
    if (hipMemsetAsync((char*)d_ws + WS_CTL, 0, CTL_ZERO_BYTES, stream) != hipSuccess) { fprintf(stderr, "kernel_launch: memset of the control words failed\n"); return; }
    void* kargs[] = {&a};
#if HOST_DUP_PHASE >= 0
    const int cuts[4] = {0, HOST_DUP_PHASE + 1, HOST_DUP_PHASE, N_PHASES};
    for (int li = 0; li < 3; ++li) {
        a.ph_lo = (li == 1) ? HOST_DUP_PHASE : (li == 2 ? HOST_DUP_PHASE + 1 : 0); a.ph_hi = (li == 0 || li == 1) ? HOST_DUP_PHASE + 1 : N_PHASES; a.flags = (li == 1) ? 1 : 0;
        if (li > 0) (void)hipMemsetAsync((char*)d_ws + WS_CTL, 0, CTL_ZERO_BYTES, stream);
        (void)hipLaunchCooperativeKernel((const void*)hymba_fwd, dim3(grid), dim3(NWAVES * 64), kargs, LDS_BYTES, stream);
    }
    (void)cuts;
#else
    a.ph_lo = 0; a.ph_hi = N_PHASES; a.extra_bars = HOST_EXTRA_BARS;
    const hipError_t e = hipLaunchCooperativeKernel((const void*)hymba_fwd, dim3(grid), dim3(NWAVES * 64), kargs, LDS_BYTES, stream);
    if (e != hipSuccess) fprintf(stderr, "kernel_launch: cooperative launch failed: %s (grid %d)\n", hipGetErrorString(e), grid);
#endif
#else
    if (hipMemsetAsync((char*)d_ws + WS_CTL, 0, CTL_ZERO_BYTES, stream) != hipSuccess) return;
    for (int ph = 0; ph < N_PHASES; ++ph) {
        a.ph_lo = ph; a.ph_hi = ph + 1;
        hipLaunchKernelGGL(hymba_fwd, dim3(grid), dim3(NWAVES * 64), LDS_BYTES, stream, a);
    }
#endif
}
```

```cpp
#include <hip/hip_runtime.h>
#include <cstdio>
#include <cstdint>
namespace pg8 {
#define PG8_LAS __attribute__((address_space(3)))
typedef unsigned short bf16_t;
typedef short bf16x8 __attribute__((ext_vector_type(8)));
typedef float f32x4 __attribute__((ext_vector_type(4)));
typedef unsigned u32x4 __attribute__((ext_vector_type(4)));
constexpr int BM = 256, BK = 64, HALF = 128, HTB = HALF * BK * 2  , STAGE_BYTES = 8 * HTB, NXCD = 8, WGM = 8;

__host__ __device__ __forceinline__ int lds_byte(int r, int c) { const int st = (r >> 4) * 2 + (c >> 5), rr = r & 15, cc = c & 31, ob = rr * 64 + cc * 2; return st * 1024 + (ob ^ (((ob >> 9) & 1) << 5)); }
__host__ __device__ __forceinline__ void stage_rc(int b, int& R, int& C) { const int st = b / 1024, sb = b % 1024, swz = sb ^ (((sb >> 9) & 1) << 5); R = (st >> 1) * 16 + swz / 64; C = (st & 1) * 32 + (swz % 64) / 2; }
__host__ __device__ __forceinline__ int perm32(int rho) { const int n = rho >> 4, i = rho & 15; return 8 * (i >> 2) + 4 * n + (i & 3); }

struct Unit { int pm, pn; };
struct Gemm { const bf16_t* A; const bf16_t* Bt; int M, N, K; };

struct StaticOrder {
    int nM, nN, nwg, G, c;
    __host__ __device__ void init(int M, int N, int G_, int c_) { nM = M / BM; nN = N / BM; nwg = nM * nN; G = G_; c = c_; }
    __host__ __device__ bool next(int i, Unit& u) const {
        const long L = (long)i * G + c; if (L >= nwg) return false;
        int wgid = (int)L; { const int q = nwg / NXCD, r = nwg % NXCD, xcd = wgid % NXCD, off = wgid / NXCD; wgid = (xcd < r ? xcd * (q + 1) : r * (q + 1) + (xcd - r) * q) + off; }
        const int nig = WGM * nN, gid = wgid / nig, fm = gid * WGM, gsz = (nM - fm) < WGM ? (nM - fm) : WGM;
        u.pm = fm + ((wgid % nig) % gsz); u.pn = (wgid % nig) / gsz; return true;
    }
    __device__ __forceinline__ void a_ready(const Unit&) const {}
    __device__ __forceinline__ void done(const Unit&) const {}
};


typedef float f32x2 __attribute__((ext_vector_type(2)));
typedef __bf16 bf16x2_t __attribute__((ext_vector_type(2)));
typedef unsigned u32x2 __attribute__((ext_vector_type(2)));
__device__ __forceinline__ unsigned cvt_pk_bf16(float lo, float hi) { f32x2 v = {lo, hi}; bf16x2_t b = __builtin_convertvector(v, bf16x2_t); return __builtin_bit_cast(unsigned, b); }
__device__ __forceinline__ float bf_lo(unsigned w) { return __uint_as_float(w << 16); }
__device__ __forceinline__ float bf_hi(unsigned w) { return __uint_as_float(w & 0xffff0000u); }
__device__ __forceinline__ float sigmoid_f(float x) { return __builtin_amdgcn_rcpf(1.0f + __builtin_amdgcn_exp2f(-1.4426950408889634f * x)); }
__device__ __forceinline__ float gelu_tanh_f(float x) { const float t = x * (1.5957691216057308f + 0.07135481627159149f * x * x); return x * sigmoid_f(t); }

constexpr float NORM_EPS = 1e-6f;
__device__ __forceinline__ float row_rs(const float* ss, int row) {
    const f32x4* p = (const f32x4*)(ss + (size_t)row * 16); const f32x4 a = p[0], b = p[1], c = p[2], d = p[3];
    const float s = ((a[0] + a[1]) + (a[2] + a[3])) + ((b[0] + b[1]) + (b[2] + b[3])) + ((c[0] + c[1]) + (c[2] + c[3])) + ((d[0] + d[1]) + (d[2] + d[3]));
    return 1.0f / sqrtf(s * (1.0f / 1024.0f) + NORM_EPS);
}

template <int MODE> struct EpiBf16 {
    static constexpr bool PERM = true, AFTER_DRAIN = false;
    bf16_t* O; int ldc; const float* ss;
    __device__ __forceinline__ void operator()(const f32x4 (&acc)[2][2][4][2], const Unit& u, int wr, int wc, int fr, int fq) const {
        const int row0 = u.pm * BM + wr * 64 + fr, col0 = u.pn * BM + wc * 32 + 8 * fq;
        const int act = (MODE == 0) ? (u.pn < 4 ? 1 : (u.pn >= 10 ? 2 : 0)) : 0;
#pragma unroll
        for (int ai = 0; ai < 2; ++ai)
#pragma unroll
            for (int m = 0; m < 4; ++m) { const int row = row0 + ai * HALF + m * 16; bf16_t* rowp = O + (size_t)row * ldc + col0;
#pragma unroll
                for (int bj = 0; bj < 2; ++bj) { f32x4 v0 = acc[ai][bj][m][0], v1 = acc[ai][bj][m][1];
                    if (MODE == 0) {
                        if (act == 1) {
#pragma unroll
                            for (int e = 0; e < 4; ++e) { v0[e] = gelu_tanh_f(v0[e]); v1[e] = gelu_tanh_f(v1[e]); } }
                        else if (act == 2) {
#pragma unroll
                            for (int e = 0; e < 4; ++e) { v0[e] = sigmoid_f(v0[e]); v1[e] = sigmoid_f(v1[e]); } }
                    }
                    if (MODE == 2) {
#pragma unroll
                        for (int e = 0; e < 4; ++e) { const float a = fmaxf(v0[e], 0.f), b = fmaxf(v1[e], 0.f); v0[e] = a * a; v1[e] = b * b; } }
                    u32x4 w; w.x = cvt_pk_bf16(v0[0], v0[1]); w.y = cvt_pk_bf16(v0[2], v0[3]); w.z = cvt_pk_bf16(v1[0], v1[1]); w.w = cvt_pk_bf16(v1[2], v1[3]);
                    *(u32x4*)(rowp + bj * HALF) = w; } }
    }
};

template <int MODE> struct EpiRes {
    static constexpr bool PERM = false, AFTER_DRAIN = false;
    const float* rn;
    const bf16_t* Hb; bf16_t* Ho; float* SSO; const float* SSI; const bf16_t* PROJ;
    __device__ __forceinline__ void operator()(const f32x4 (&acc)[2][2][4][2], const Unit& u, int wr, int wc, int fr, int fq) const {
        const int row0 = u.pm * BM + wr * 64 + fr, col0 = u.pn * BM + wc * 32 + 4 * fq;
#pragma unroll
        for (int ai = 0; ai < 2; ++ai)
#pragma unroll
            for (int m = 0; m < 4; ++m) { const int row = row0 + ai * HALF + m * 16; const size_t off = (size_t)row * 1024 + col0;
                float rsc; if (MODE != 0) { rsc = row_rs(SSI, row); if (MODE == 1) rsc = rsc * rsc; } else rsc = rn[row];
                float sq = 0.f;
#pragma unroll
                for (int bj = 0; bj < 2; ++bj)
#pragma unroll
                    for (int n = 0; n < 2; ++n) { const size_t o2 = off + bj * HALF + n * 16; f32x4 h; const f32x4 a = acc[ai][bj][m][n];
                        { const u32x2 hw = *(const u32x2*)(Hb + o2); const f32x4 r = (f32x4){bf_lo(hw.x), bf_hi(hw.x), bf_lo(hw.y), bf_hi(hw.y)};
                            if (MODE == 0) h = r * rsc + a;
                            else if (MODE == 1) h = r + a * rsc;
                            else { const u32x2 pw = *(const u32x2*)(PROJ + o2);
                                h[0] = r[0] + sigmoid_f(a[0] * rsc) * bf_lo(pw.x); h[1] = r[1] + sigmoid_f(a[1] * rsc) * bf_hi(pw.x);
                                h[2] = r[2] + sigmoid_f(a[2] * rsc) * bf_lo(pw.y); h[3] = r[3] + sigmoid_f(a[3] * rsc) * bf_hi(pw.y); } }
                        u32x2 w; w.x = cvt_pk_bf16(h[0], h[1]); w.y = cvt_pk_bf16(h[2], h[3]); *(u32x2*)(Ho + o2) = w;
                        sq += (h[0] * h[0] + h[1] * h[1]) + (h[2] * h[2] + h[3] * h[3]); }
                sq += __shfl_xor(sq, 16); sq += __shfl_xor(sq, 32);
                if (fq == 0) SSO[(size_t)row * 16 + u.pn * 4 + wc] = sq; }
    }
};

template <class Epi, class Sched, bool ALIGN_EPI = false, bool SP2 = false>
__device__ __forceinline__ void gemm_phase(PG8_LAS unsigned char* lds, const Gemm g, const Sched& S, const Epi& E) {
    const int tid = threadIdx.x, wid = __builtin_amdgcn_readfirstlane(tid >> 6), lane = tid & 63, wr = wid >> 2, wc = wid & 3, fr = lane & 15, fq = lane >> 4;
    int K = g.K; asm volatile("" : "+s"(K));
    const int nt = K / BK;
    unsigned voffA[2], voffB[2];
#pragma unroll
    for (int i = 0; i < 2; ++i) { int R, C; stage_rc(tid * 16 + i * 8192, R, C); const int Rb = Epi::PERM ? ((R & ~31) + perm32(R & 31)) : R;
        voffA[i] = (unsigned)(R * K + C) * 2u; voffB[i] = (unsigned)(Rb * K + C) * 2u; }
    const size_t kstep = (size_t)(BK * 2);
    const size_t hstep = (size_t)HALF * K * 2;
    const size_t tstep = 2 * hstep;
    const unsigned ldsw = (unsigned)wid * 1024u;
    const int aoff = lds_byte(wr * 64 + fr, fq * 8), boff = lds_byte(wc * 32 + fr, fq * 8);
#define PG8_SA(b, h) (((b) * 2 + (h)) * HTB)
#define PG8_SB(b, h) ((4 + (b) * 2 + (h)) * HTB)
#define PG8_STAGE(bufoff, gbase, voff) do { _Pragma("unroll") for (int _i = 0; _i < 2; ++_i) \
        __builtin_amdgcn_global_load_lds((const unsigned*)((const char*)(gbase) + (voff)[_i]), (PG8_LAS unsigned*)(lds + (bufoff) + ldsw + _i * 8192), 16, 0, 0); } while (0)
#define PG8_LDA(dst, b, h) do { _Pragma("unroll") for (int m = 0; m < 4; ++m) _Pragma("unroll") for (int k = 0; k < 2; ++k) dst[m][k] = *(const PG8_LAS bf16x8*)(lds + PG8_SA(b, h) + aoff + m * 2048 + k * 1024); } while (0)
#define PG8_LDB(dst, b, h) do { _Pragma("unroll") for (int n = 0; n < 2; ++n) _Pragma("unroll") for (int k = 0; k < 2; ++k) dst[n][k] = *(const PG8_LAS bf16x8*)(lds + PG8_SB(b, h) + boff + n * 2048 + k * 1024); } while (0)
#define PG8_MMA(ai, bj, At, Bt) do { __builtin_amdgcn_s_setprio(1); _Pragma("unroll") for (int m = 0; m < 4; ++m) _Pragma("unroll") for (int n = 0; n < 2; ++n) _Pragma("unroll") for (int k = 0; k < 2; ++k) \
        acc[ai][bj][m][n] = __builtin_amdgcn_mfma_f32_16x16x32_bf16(Bt[n][k], At[m][k], acc[ai][bj][m][n], 0, 0, 0); __builtin_amdgcn_s_setprio(0); } while (0)
#define PG8_WAIT_V(n) asm volatile("s_waitcnt vmcnt(" #n ")" ::: "memory")
#define PG8_WAIT_L(n) asm volatile("s_waitcnt lgkmcnt(" #n ")" ::: "memory")
#define PG8_BAR __builtin_amdgcn_s_barrier()
#define PG8_SCHED __builtin_amdgcn_sched_barrier(0)
    Unit cur, nxt; int ui = 0;
    if (!S.next(0, cur)) return;
    f32x4 acc[2][2][4][2];
#pragma unroll
    for (int a = 0; a < 2; ++a)
#pragma unroll
        for (int b = 0; b < 2; ++b)
#pragma unroll
            for (int m = 0; m < 4; ++m)
#pragma unroll
                for (int n = 0; n < 2; ++n) acc[a][b][m][n] = (f32x4){0.f, 0.f, 0.f, 0.f};
    bf16x8 At[4][2], B0[2][2], B1[2][2];
    const char* cA = (const char*)g.A + (size_t)cur.pm * tstep; const char* cB = (const char*)g.Bt + (size_t)cur.pn * tstep;
    S.a_ready(cur);
    if constexpr (SP2) {
        PG8_STAGE(PG8_SB(0, 0), cB, voffB); PG8_STAGE(PG8_SB(0, 1), cB + hstep, voffB); PG8_STAGE(PG8_SA(0, 0), cA, voffA); PG8_STAGE(PG8_SA(0, 1), cA + hstep, voffA);
        if (wr == 1) PG8_BAR;
        PG8_WAIT_V(2); PG8_BAR;
        PG8_STAGE(PG8_SB(1, 0), cB + kstep, voffB); PG8_STAGE(PG8_SA(1, 0), cA + kstep, voffA); PG8_STAGE(PG8_SB(1, 1), cB + hstep + kstep, voffB);
        PG8_WAIT_V(6); PG8_BAR;
    } else {
        PG8_STAGE(PG8_SB(0, 0), cB, voffB); PG8_STAGE(PG8_SA(0, 0), cA, voffA); PG8_STAGE(PG8_SB(0, 1), cB + hstep, voffB); PG8_STAGE(PG8_SA(0, 1), cA + hstep, voffA);
        if (wr == 1) PG8_BAR;
        PG8_WAIT_V(4); PG8_BAR;
        PG8_STAGE(PG8_SB(1, 0), cB + kstep, voffB); PG8_STAGE(PG8_SA(1, 0), cA + kstep, voffA); PG8_STAGE(PG8_SB(1, 1), cB + hstep + kstep, voffB);
        PG8_WAIT_V(6); PG8_BAR;
    }
    for (;;) {
        const bool has_next = S.next(ui + 1, nxt);
        const char* nA = has_next ? (const char*)g.A + (size_t)nxt.pm * tstep : cA; const char* nB = has_next ? (const char*)g.Bt + (size_t)nxt.pn * tstep : cB;
        for (int t = 0; t < nt; t += 2) {
            const bool last = (t == nt - 2);
            const char* a1 = cA + (size_t)(t + 1) * kstep;
            const char* a2 = last ? nA : cA + (size_t)(t + 2) * kstep; const char* b2 = last ? nB : cB + (size_t)(t + 2) * kstep;
            const char* a3 = a2 + kstep; const char* b3 = b2 + kstep;
            if (last && has_next) S.a_ready(nxt);
            if constexpr (SP2) {
            PG8_LDB(B0, 0, 0); PG8_LDB(B1, 0, 1); PG8_SCHED; PG8_LDA(At, 0, 0); PG8_STAGE(PG8_SA(1, 1), a1 + hstep, voffA);
            PG8_WAIT_V(8); PG8_WAIT_L(0); PG8_BAR; PG8_MMA(0, 0, At, B0); PG8_MMA(0, 1, At, B1); PG8_BAR; PG8_SCHED;
            PG8_LDA(At, 0, 1); PG8_STAGE(PG8_SB(0, 0), b2, voffB); PG8_STAGE(PG8_SB(0, 1), b2 + hstep, voffB); PG8_STAGE(PG8_SA(0, 0), a2, voffA);
            PG8_WAIT_V(8); PG8_WAIT_L(0); PG8_BAR; PG8_MMA(1, 0, At, B0); PG8_MMA(1, 1, At, B1); PG8_BAR; PG8_SCHED;
            PG8_LDB(B0, 1, 0); PG8_LDB(B1, 1, 1); PG8_SCHED; PG8_LDA(At, 1, 0); PG8_STAGE(PG8_SA(0, 1), a2 + hstep, voffA);
            PG8_WAIT_V(8); PG8_WAIT_L(0); PG8_BAR; PG8_MMA(0, 0, At, B0); PG8_MMA(0, 1, At, B1); PG8_BAR; PG8_SCHED;
            PG8_LDA(At, 1, 1); PG8_STAGE(PG8_SB(1, 0), b3, voffB); PG8_STAGE(PG8_SB(1, 1), b3 + hstep, voffB); PG8_STAGE(PG8_SA(1, 0), a3, voffA);
            PG8_WAIT_V(8); PG8_WAIT_L(0); PG8_BAR; PG8_MMA(1, 0, At, B0); PG8_MMA(1, 1, At, B1); PG8_BAR; PG8_SCHED;
            } else {
            PG8_LDB(B0, 0, 0); PG8_SCHED; PG8_LDA(At, 0, 0); PG8_STAGE(PG8_SA(1, 1), a1 + hstep, voffA);
            PG8_WAIT_L(8); PG8_BAR; PG8_WAIT_L(0); PG8_MMA(0, 0, At, B0); PG8_BAR; PG8_SCHED;
            PG8_LDB(B1, 0, 1); PG8_STAGE(PG8_SB(0, 0), b2, voffB);
            PG8_BAR; PG8_WAIT_L(0); PG8_MMA(0, 1, At, B1); PG8_BAR;
            PG8_LDA(At, 0, 1); PG8_STAGE(PG8_SA(0, 0), a2, voffA);
            PG8_BAR; PG8_WAIT_L(0); PG8_MMA(1, 0, At, B0); PG8_BAR; PG8_SCHED;
            PG8_STAGE(PG8_SB(0, 1), b2 + hstep, voffB);
            PG8_WAIT_V(6); PG8_BAR; PG8_MMA(1, 1, At, B1); PG8_BAR;
            PG8_LDB(B0, 1, 0); PG8_SCHED; PG8_LDA(At, 1, 0); PG8_STAGE(PG8_SA(0, 1), a2 + hstep, voffA);
            PG8_WAIT_L(8); PG8_BAR; PG8_WAIT_L(0); PG8_MMA(0, 0, At, B0); PG8_BAR; PG8_SCHED;
            PG8_LDB(B1, 1, 1); PG8_STAGE(PG8_SB(1, 0), b3, voffB);
            PG8_BAR; PG8_WAIT_L(0); PG8_MMA(0, 1, At, B1); PG8_BAR;
            PG8_LDA(At, 1, 1); PG8_STAGE(PG8_SA(1, 0), a3, voffA);
            PG8_BAR; PG8_WAIT_L(0); PG8_MMA(1, 0, At, B0); PG8_BAR; PG8_SCHED;
            PG8_STAGE(PG8_SB(1, 1), b3 + hstep, voffB);
            PG8_WAIT_V(6); PG8_BAR; PG8_MMA(1, 1, At, B1); PG8_BAR;
            }
        }
        if constexpr (ALIGN_EPI) { if (wr == 0) PG8_BAR; }
        if constexpr (!Epi::AFTER_DRAIN) { E(acc, cur, wr, wc, fr, fq); S.done(cur); }
        if (!has_next) break;
#pragma unroll
        for (int a = 0; a < 2; ++a)
#pragma unroll
            for (int b = 0; b < 2; ++b)
#pragma unroll
                for (int m = 0; m < 4; ++m)
#pragma unroll
                    for (int n = 0; n < 2; ++n) acc[a][b][m][n] = (f32x4){0.f, 0.f, 0.f, 0.f};
        cur = nxt; cA = nA; cB = nB; ++ui;
        if constexpr (ALIGN_EPI) { if (wr == 1) PG8_BAR; }
    }
    PG8_WAIT_V(0);
    if constexpr (!ALIGN_EPI) { if (wr == 0) PG8_BAR; }
    PG8_BAR;
    if constexpr (Epi::AFTER_DRAIN) { E.fused(acc, cur, wr, wc, fr, fq, lds, wid, lane); S.done(cur); }
#undef PG8_SA
#undef PG8_SB
#undef PG8_STAGE
#undef PG8_LDA
#undef PG8_LDB
#undef PG8_MMA
#undef PG8_WAIT_V
#undef PG8_WAIT_L
#undef PG8_BAR
#undef PG8_SCHED
}
}

namespace mix {
#define LAS __attribute__((address_space(3)))
using pg8::bf16_t; using pg8::bf16x8; using pg8::f32x4; using pg8::u32x4; using pg8::u32x2; using pg8::cvt_pk_bf16; using pg8::bf_lo; using pg8::bf_hi; using pg8::sigmoid_f;
typedef short v4i16_t __attribute__((ext_vector_type(4)));
constexpr int NP = 16384, NS = 1024, ZLD = 3072;
constexpr int ZU = 0, ZVG = 512, ZQ = 1024, ZK = 1536, ZV = 2048, ZO = 2560;
constexpr int TS = 288;
constexpr int IMG = 128 * TS;
constexpr int IMG0 = 0, IMG1 = IMG, IMG2 = 2 * IMG, SC_OFF = 3 * IMG;
constexpr float EPS = 1e-6f;

template <int CTRL> __device__ __forceinline__ float dpp_mov(float v) { return __int_as_float(__builtin_amdgcn_update_dpp(0, __float_as_int(v), CTRL, 0xF, 0xF, true)); }
__device__ __forceinline__ float row_sum16(float v) { v += dpp_mov<0xB1>(v); v += dpp_mov<0x4E>(v); v += dpp_mov<0x141>(v); v += dpp_mov<0x140>(v); return v; }
__device__ __forceinline__ float row_max16(float v) { v = fmaxf(v, dpp_mov<0xB1>(v)); v = fmaxf(v, dpp_mov<0x4E>(v)); v = fmaxf(v, dpp_mov<0x141>(v)); v = fmaxf(v, dpp_mov<0x140>(v)); return v; }
__device__ __forceinline__ float rl(float v, int l) { return __int_as_float(__builtin_amdgcn_readlane(__float_as_int(v), l)); }
__device__ __forceinline__ float wave_sum(float v) { v = row_sum16(v); return (rl(v, 0) + rl(v, 16)) + (rl(v, 32) + rl(v, 48)); }
__device__ __forceinline__ float wave_max(float v) { v = row_max16(v); return fmaxf(fmaxf(rl(v, 0), rl(v, 16)), fmaxf(rl(v, 32), rl(v, 48))); }
__device__ __forceinline__ float scan_add(float v, int lane) {
#pragma unroll
    for (int o = 1; o < 64; o <<= 1) { const float t = __shfl_up(v, o); if (lane >= o) v += t; }
    return v;
}
__device__ __forceinline__ float scan_max(float v, int lane) {
#pragma unroll
    for (int o = 1; o < 64; o <<= 1) { const float t = __shfl_up(v, o); if (lane >= o) v = fmaxf(v, t); }
    return v;
}
__device__ __forceinline__ bf16x8 tr2(LAS const unsigned char* p0, LAS const unsigned char* p1) {
    const v4i16_t a = __builtin_amdgcn_ds_read_tr16_b64_v4i16((LAS v4i16_t*)p0);
    const v4i16_t b = __builtin_amdgcn_ds_read_tr16_b64_v4i16((LAS v4i16_t*)p1);
    return (bf16x8){a[0], a[1], a[2], a[3], b[0], b[1], b[2], b[3]};
}
__device__ __forceinline__ void unpack8(const u32x4 w, float (&x)[8]) {
    x[0] = bf_lo(w.x); x[1] = bf_hi(w.x); x[2] = bf_lo(w.y); x[3] = bf_hi(w.y); x[4] = bf_lo(w.z); x[5] = bf_hi(w.z); x[6] = bf_lo(w.w); x[7] = bf_hi(w.w);
}
__device__ __forceinline__ u32x4 pack8(const float (&x)[8]) {
    u32x4 w; w.x = cvt_pk_bf16(x[0], x[1]); w.y = cvt_pk_bf16(x[2], x[3]); w.z = cvt_pk_bf16(x[4], x[5]); w.w = cvt_pk_bf16(x[6], x[7]); return w;
}

struct MixP {
    const bf16_t* Z; bf16_t* YC; const float* IG; const float* LF;
    const bf16_t* WSb;
    const float *gm_ws, *lng, *lnb, *bs, *mlnorm;
    float *KV, *NLOC, *NST, *CH, *MST;
    const float *stC, *stN, *stM;
    float *oCp, *oNp, *oMp, *oVp, *oCs, *oNs, *oMs, *oVs;
};

__device__ __forceinline__ void gmlp_unit(LAS unsigned char* lds, const MixP& P, int b, int c, int h, int tid) {
    const int lane = tid & 63, w = __builtin_amdgcn_readfirstlane(tid >> 6), fr = lane & 15, kq = lane >> 4, q = fr >> 2, p = fr & 3;
    const int r0 = b * 2048 + c * 128;
    LAS unsigned char* img = lds + IMG0;
    float g8[8], b8[8];
    { const f32x4 a = *(const f32x4*)(P.lng + 8 * lane), a2 = *(const f32x4*)(P.lng + 8 * lane + 4), c0 = *(const f32x4*)(P.lnb + 8 * lane), c1 = *(const f32x4*)(P.lnb + 8 * lane + 4);
#pragma unroll
      for (int e = 0; e < 4; ++e) { g8[e] = a[e]; g8[4 + e] = a2[e]; b8[e] = c0[e]; b8[4 + e] = c1[e]; } }
    float* vout = (c == 15) ? P.oVp + (size_t)b * 128 * 512 : nullptr;
    u32x4 raw[16];
#pragma unroll
    for (int i = 0; i < 16; ++i) raw[i] = *(const u32x4*)(P.Z + (size_t)(r0 + 16 * w + i) * ZLD + ZVG + 8 * lane);
    const bf16_t* Wrow = P.WSb + ((size_t)h * 128 + 16 * w + fr) * 128 + 8 * kq;
    bf16x8 wf[4];
#pragma unroll
    for (int st = 0; st < 4; ++st) wf[st] = *(const bf16x8*)(Wrow + 32 * st);
    const bf16_t* urow = P.Z + (size_t)(r0 + 16 * w + fr) * ZLD + ZU + h * 128 + 4 * kq;
    u32x2 uw[8];
#pragma unroll
    for (int n = 0; n < 8; ++n) uw[n] = *(const u32x2*)(urow + 16 * n);
    const float bsv = P.bs[h * 128 + 16 * w + fr];
#pragma unroll
    for (int i = 0; i < 16; ++i) { const int t = 16 * w + i;
        float x[8]; unpack8(raw[i], x);
        float s = ((x[0] + x[1]) + (x[2] + x[3])) + ((x[4] + x[5]) + (x[6] + x[7]));
        const float mean = wave_sum(s) * (1.0f / 512.0f);
        float q2 = 0.f;
#pragma unroll
        for (int e = 0; e < 8; ++e) { x[e] -= mean; q2 += x[e] * x[e]; }
        const float rstd = 1.0f / sqrtf(wave_sum(q2) * (1.0f / 512.0f) + EPS);
        if (kq == h) {
#pragma unroll
            for (int e = 0; e < 8; ++e) x[e] = x[e] * rstd * g8[e] + b8[e];
            *(LAS u32x4*)(img + t * TS + fr * 16) = pack8(x);
            if (vout) { float* vo = vout + (size_t)t * 512 + 8 * lane; *(f32x4*)vo = (f32x4){x[0], x[1], x[2], x[3]}; *(f32x4*)(vo + 4) = (f32x4){x[4], x[5], x[6], x[7]}; }
        }
    }
    __syncthreads();
    f32x4 acc[8];
#pragma unroll
    for (int n = 0; n < 8; ++n) acc[n] = (f32x4){0.f, 0.f, 0.f, 0.f};
    const int nsteps = (w >> 1) + 1;
    LAS const unsigned char* trb = img + (8 * kq + q) * TS + 8 * p;
#pragma unroll
    for (int st = 0; st < 4; ++st) if (st < nsteps) {
#pragma unroll
        for (int n = 0; n < 8; ++n) { const bf16x8 vf = tr2(trb + (32 * st) * TS + 32 * n, trb + (32 * st + 4) * TS + 32 * n);
            acc[n] = __builtin_amdgcn_mfma_f32_16x16x32_bf16(vf, wf[st], acc[n], 0, 0, 0); }
    }
    { const int t = 16 * w + fr;
      bf16_t* yrow = P.YC + (size_t)(r0 + t) * 1024 + h * 128 + 4 * kq;
#pragma unroll
      for (int n = 0; n < 8; ++n) { u32x2 o;
          o.x = cvt_pk_bf16(bf_lo(uw[n].x) * (acc[n][0] + bsv), bf_hi(uw[n].x) * (acc[n][1] + bsv));
          o.y = cvt_pk_bf16(bf_lo(uw[n].y) * (acc[n][2] + bsv), bf_hi(uw[n].y) * (acc[n][3] + bsv));
          *(u32x2*)(yrow + 16 * n) = o; } }
    __syncthreads();
}

__device__ __forceinline__ void kv_unit(LAS unsigned char* lds, const MixP& P, int b, int h, int c, int tid) {
    const int lane = tid & 63, w = __builtin_amdgcn_readfirstlane(tid >> 6), fr = lane & 15, kq = lane >> 4, q = fr >> 2, p = fr & 3;
    const int r0 = b * 2048 + c * 128, unit = (b * 4 + h) * 16 + c;
    LAS float* wl = (LAS float*)(lds + SC_OFF);
    float lf0 = 0.f, lf1 = 0.f, ig0 = 0.f, ig1 = 0.f;
    if (w == 0) { const int s0 = r0 + 2 * lane; lf0 = P.LF[(size_t)s0 * 4 + h]; lf1 = P.LF[(size_t)(s0 + 1) * 4 + h]; ig0 = P.IG[(size_t)s0 * 4 + h]; ig1 = P.IG[(size_t)(s0 + 1) * 4 + h]; }
    u32x4 kraw[4], vraw[4];
#pragma unroll
    for (int i = 0; i < 4; ++i) { const int id = tid + 512 * i, row = id >> 4, ch = id & 15;
        const bf16_t* zr = P.Z + (size_t)(r0 + row) * ZLD + h * 128 + ch * 8; kraw[i] = *(const u32x4*)(zr + ZK); vraw[i] = *(const u32x4*)(zr + ZV); }
    if (w == 0) {
        const float Pc = scan_add(lf0 + lf1, lane), b1 = Pc, b0 = Pc - lf1, B = __shfl(Pc, 63);
        const float x0 = ig0 - b0, x1 = ig1 - b1, xm = wave_max(fmaxf(x0, x1));
        wl[2 * lane] = __expf(x0 - xm); wl[2 * lane + 1] = __expf(x1 - xm);
        if (lane == 0) { P.CH[unit * 2] = B; P.CH[unit * 2 + 1] = B + xm; }
    }
    __syncthreads();
#pragma unroll
    for (int i = 0; i < 4; ++i) { const int id = tid + 512 * i, row = id >> 4, ch = id & 15;
        float x[8]; unpack8(kraw[i], x); const float ws = wl[row];
#pragma unroll
        for (int e = 0; e < 8; ++e) x[e] *= ws;
        *(LAS u32x4*)(lds + IMG0 + row * TS + ch * 16) = pack8(x);
        *(LAS u32x4*)(lds + IMG1 + row * TS + ch * 16) = vraw[i]; }
    __syncthreads();
    f32x4 acc[8], accn = (f32x4){0.f, 0.f, 0.f, 0.f};
#pragma unroll
    for (int n = 0; n < 8; ++n) acc[n] = (f32x4){0.f, 0.f, 0.f, 0.f};
    const bf16x8 ones = (bf16x8){0x3F80, 0x3F80, 0x3F80, 0x3F80, 0x3F80, 0x3F80, 0x3F80, 0x3F80};
    LAS const unsigned char* trk = lds + IMG0 + (8 * kq + q) * TS + 8 * p + 32 * w;
    LAS const unsigned char* trv = lds + IMG1 + (8 * kq + q) * TS + 8 * p;
#pragma unroll
    for (int st = 0; st < 4; ++st) {
        const bf16x8 kf = tr2(trk + (32 * st) * TS, trk + (32 * st + 4) * TS);
        accn = __builtin_amdgcn_mfma_f32_16x16x32_bf16(ones, kf, accn, 0, 0, 0);
#pragma unroll
        for (int n = 0; n < 8; ++n) { const bf16x8 vf = tr2(trv + (32 * st) * TS + 32 * n, trv + (32 * st + 4) * TS + 32 * n);
            acc[n] = __builtin_amdgcn_mfma_f32_16x16x32_bf16(vf, kf, acc[n], 0, 0, 0); }
    }
    float* kvp = P.KV + (size_t)unit * 16384 + (16 * w + fr) * 128 + 4 * kq;
#pragma unroll
    for (int n = 0; n < 8; ++n) *(f32x4*)(kvp + 16 * n) = acc[n];
    if (kq == 0) P.NLOC[unit * 128 + 16 * w + fr] = accn[0];
    __syncthreads();
}

__device__ __forceinline__ void scan_unit(const MixP& P, int bh, int slice, int tid) {
    const size_t base = (size_t)bh * 16 * 16384 + slice * 2048 + tid * 4;
    f32x4 C = (f32x4){0.f, 0.f, 0.f, 0.f}; float M = 0.f, nv = 0.f;
    const bool nthr = (slice == 0 && tid < 128);
    f32x4 kvv[16];
#pragma unroll
    for (int c = 0; c < 16; ++c) kvv[c] = *(const f32x4*)(P.KV + base + (size_t)c * 16384);
#pragma unroll
    for (int c = 0; c < 16; ++c) {
        const float B = P.CH[(bh * 16 + c) * 2], a = P.CH[(bh * 16 + c) * 2 + 1];
        const float Mn = fmaxf(B + M, a), dec = __expf(B + M - Mn), add = __expf(a - Mn);
        float* kp = P.KV + base + (size_t)c * 16384;
        const f32x4 kv = kvv[c]; *(f32x4*)kp = C; C = dec * C + add * kv;
        if (nthr) { const float nl = P.NLOC[(bh * 16 + c) * 128 + tid]; P.NST[(bh * 16 + c) * 128 + tid] = nv; nv = dec * nv + add * nl; if (tid == 0) P.MST[bh * 16 + c] = M; }
        M = Mn;
    }
    *(f32x4*)(P.oCp + (size_t)bh * 16384 + slice * 2048 + tid * 4) = C;
    if (nthr) { P.oNp[bh * 128 + tid] = nv; if (tid == 0) P.oMp[bh] = M; }
}

__device__ __forceinline__ void mlo_unit(LAS unsigned char* lds, const MixP& P, int b, int h, int c, int tid) {
    const int lane = tid & 63, w = __builtin_amdgcn_readfirstlane(tid >> 6), fr = lane & 15, kq = lane >> 4, q = fr >> 2, p = fr & 3;
    const int r0 = b * 2048 + c * 128, unit = (b * 4 + h) * 16 + c;
    LAS float* xs = (LAS float*)(lds + SC_OFF); LAS float* ys = xs + 128; LAS float* wint = xs + 256; LAS float* emt = xs + 384; LAS float* nst = xs + 512;
    const float Mc = P.MST[unit];
    float lf0 = 0.f, lf1 = 0.f, ig0 = 0.f, ig1 = 0.f, n0v = 0.f, n1v = 0.f;
    if (w == 0) { const int s0 = r0 + 2 * lane; lf0 = P.LF[(size_t)s0 * 4 + h]; lf1 = P.LF[(size_t)(s0 + 1) * 4 + h]; ig0 = P.IG[(size_t)s0 * 4 + h]; ig1 = P.IG[(size_t)(s0 + 1) * 4 + h]; }
    else if (w == 1) { n0v = P.NST[unit * 128 + lane]; n1v = P.NST[unit * 128 + lane + 64]; }
    const int t = 16 * w + fr;
    const bf16_t* zrow = P.Z + (size_t)(r0 + t) * ZLD + h * 128;
    u32x4 kraw[4], vraw[4]; f32x4 craw[8]; bf16x8 qf[4];
#pragma unroll
    for (int i = 0; i < 4; ++i) { const int id = tid + 512 * i, row = id >> 4, ch = id & 15;
        const bf16_t* zr = P.Z + (size_t)(r0 + row) * ZLD + h * 128 + ch * 8; kraw[i] = *(const u32x4*)(zr + ZK); vraw[i] = *(const u32x4*)(zr + ZV); }
    { const float* cs = P.KV + (size_t)unit * 16384;
#pragma unroll
      for (int i = 0; i < 8; ++i) { const int id = tid + 512 * i, row = id >> 5, c4 = id & 31; craw[i] = *(const f32x4*)(cs + row * 128 + c4 * 4); } }
#pragma unroll
    for (int ds = 0; ds < 4; ++ds) qf[ds] = *(const bf16x8*)(zrow + ZQ + 32 * ds + 8 * kq);
    if (w == 0) {
        const float Pc = scan_add(lf0 + lf1, lane), b1 = Pc, b0 = Pc - lf1;
        const float x0 = ig0 - b0, x1 = ig1 - b1;
        const float PM = scan_max(fmaxf(x0, x1), lane); float prev = __shfl_up(PM, 1); if (lane == 0) prev = -INFINITY;
        const float y0 = fmaxf(Mc, fmaxf(prev, x0)), y1 = fmaxf(Mc, PM);
        xs[2 * lane] = x0; xs[2 * lane + 1] = x1; ys[2 * lane] = y0; ys[2 * lane + 1] = y1;
        wint[2 * lane] = __expf(Mc - y0); wint[2 * lane + 1] = __expf(Mc - y1);
        emt[2 * lane] = __expf(-(b0 + y0)); emt[2 * lane + 1] = __expf(-(b1 + y1));
    } else if (w == 1) { nst[lane] = n0v; nst[lane + 64] = n1v; }
#pragma unroll
    for (int i = 0; i < 4; ++i) { const int id = tid + 512 * i, row = id >> 4, ch = id & 15;
        *(LAS u32x4*)(lds + IMG0 + row * TS + ch * 16) = kraw[i];
        *(LAS u32x4*)(lds + IMG1 + row * TS + ch * 16) = vraw[i]; }
#pragma unroll
    for (int i = 0; i < 8; ++i) { const int id = tid + 512 * i, row = id >> 5, c4 = id & 31;
        u32x2 o; o.x = cvt_pk_bf16(craw[i][0], craw[i][1]); o.y = cvt_pk_bf16(craw[i][2], craw[i][3]); *(LAS u32x2*)(lds + IMG2 + row * TS + c4 * 8) = o; }
    __syncthreads();
    u32x2 ow[8];
#pragma unroll
    for (int n = 0; n < 8; ++n) ow[n] = *(const u32x2*)(zrow + ZO + 16 * n + 4 * kq);
    float dn = 0.f;
#pragma unroll
    for (int ds = 0; ds < 4; ++ds)
#pragma unroll
        for (int e = 0; e < 8; ++e) dn += __uint_as_float(((unsigned)(unsigned short)qf[ds][e]) << 16) * nst[32 * ds + 8 * kq + e];
    dn += __shfl_xor(dn, 16); dn += __shfl_xor(dn, 32);
    LAS const unsigned char* trv = lds + IMG1 + (4 * kq + q) * TS + 8 * p;
    LAS const unsigned char* trc = lds + IMG2 + (8 * kq + q) * TS + 8 * p;
    const float wi = wint[t];
    f32x4 o1[8];
#pragma unroll
    for (int n = 0; n < 8; ++n) o1[n] = (f32x4){0.f, 0.f, 0.f, 0.f};
#pragma unroll
    for (int ds = 0; ds < 4; ++ds)
#pragma unroll
        for (int n = 0; n < 8; ++n) { const bf16x8 cf = tr2(trc + (32 * ds) * TS + 32 * n, trc + (32 * ds + 4) * TS + 32 * n);
            o1[n] = __builtin_amdgcn_mfma_f32_16x16x32_bf16(cf, qf[ds], o1[n], 0, 0, 0); }
#pragma unroll
    for (int n = 0; n < 8; ++n) o1[n] = o1[n] * wi;
    f32x4 aS[8];
#pragma unroll
    for (int j = 0; j < 8; ++j) aS[j] = (f32x4){0.f, 0.f, 0.f, 0.f};
#pragma unroll
    for (int j = 0; j < 8; ++j) if (j <= w) {
#pragma unroll
        for (int ds = 0; ds < 4; ++ds) { const bf16x8 kf = *(LAS const bf16x8*)(lds + IMG0 + (16 * j + fr) * TS + (32 * ds + 8 * kq) * 2);
            aS[j] = __builtin_amdgcn_mfma_f32_16x16x32_bf16(kf, qf[ds], aS[j], 0, 0, 0); } }
    const float yt = ys[t]; float dsum = 0.f;
#pragma unroll
    for (int j = 0; j < 8; ++j) if (j <= w) {
#pragma unroll
        for (int r = 0; r < 4; ++r) { const int s = 16 * j + 4 * kq + r; const float wg = (s <= t) ? __expf(xs[s] - yt) : 0.f; aS[j][r] *= wg; dsum += aS[j][r]; } }
    dsum += __shfl_xor(dsum, 16); dsum += __shfl_xor(dsum, 32);
    const float den = dsum + wi * dn, rinv = 1.0f / fmaxf(fabsf(den), emt[t]);
#pragma unroll
    for (int st = 0; st < 4; ++st) if (2 * st <= w) {
        u32x4 sw; sw.x = cvt_pk_bf16(aS[2 * st][0], aS[2 * st][1]); sw.y = cvt_pk_bf16(aS[2 * st][2], aS[2 * st][3]);
        sw.z = cvt_pk_bf16(aS[2 * st + 1][0], aS[2 * st + 1][1]); sw.w = cvt_pk_bf16(aS[2 * st + 1][2], aS[2 * st + 1][3]);
        const bf16x8 sf = __builtin_bit_cast(bf16x8, sw);
#pragma unroll
        for (int n = 0; n < 8; ++n) { const bf16x8 vf = tr2(trv + (32 * st) * TS + 32 * n, trv + (32 * st + 16) * TS + 32 * n);
            o1[n] = __builtin_amdgcn_mfma_f32_16x16x32_bf16(vf, sf, o1[n], 0, 0, 0); } }
    float ssq = 0.f;
#pragma unroll
    for (int n = 0; n < 8; ++n)
#pragma unroll
        for (int r = 0; r < 4; ++r) { const float hv = o1[n][r] * rinv; o1[n][r] = hv; ssq += hv * hv; }
    ssq += __shfl_xor(ssq, 16); ssq += __shfl_xor(ssq, 32);
    const float rn = 1.0f / sqrtf(ssq * (1.0f / 128.0f) + EPS);
    bf16_t* yrow = P.YC + (size_t)(r0 + t) * 1024 + 512 + h * 128 + 4 * kq;
#pragma unroll
    for (int n = 0; n < 8; ++n) { const f32x4 g = *(const f32x4*)(P.mlnorm + h * 128 + 4 * kq + 16 * n); u32x2 o;
        o.x = cvt_pk_bf16(bf_lo(ow[n].x) * o1[n][0] * rn * g[0], bf_hi(ow[n].x) * o1[n][1] * rn * g[1]);
        o.y = cvt_pk_bf16(bf_lo(ow[n].y) * o1[n][2] * rn * g[2], bf_hi(ow[n].y) * o1[n][3] * rn * g[3]);
        *(u32x2*)(yrow + 16 * n) = o; }
    __syncthreads();
}

__device__ __forceinline__ void sample_unit(LAS unsigned char* lds, const MixP& P, int b, int h, int tid) {
    const int lane = tid & 63, w = __builtin_amdgcn_readfirstlane(tid >> 6);
    const int r0 = NP + b * 8, bh = b * 4 + h;
    LAS float* ql = (LAS float*)lds; LAS float* kl = ql + 1024; LAS float* vl = ql + 2048; LAS float* vnl = ql + 3072; LAS float* Sl = ql + 4096;
    LAS float* gsx = ql + 4160; LAS float* gsy = gsx + 8; LAS float* gwi = gsx + 16; LAS float* gem = gsx + 24; LAS float* gwe = gsx + 32; LAS float* gsc = gsx + 40; LAS float* qn = gsx + 48;
    LAS float* red = (LAS float*)(lds + 32768);
    f32x4 cvv[8];
    { const float* cs = P.stC + (size_t)bh * 16384 + (tid >> 5) * 128 + 4 * (tid & 31);
#pragma unroll
      for (int i = 0; i < 8; ++i) cvv[i] = *(const f32x4*)(cs + (size_t)(16 * i) * 128); }
    if (tid == 0) {
        const float m0 = P.stM[bh]; float bc = 0.f, pm = -INFINITY, mt = 0.f; float xv[8];
#pragma unroll
        for (int t = 0; t < 8; ++t) { const float lf = P.LF[(size_t)(r0 + t) * 4 + h], ig = P.IG[(size_t)(r0 + t) * 4 + h];
            bc += lf; const float x = ig - bc; pm = fmaxf(pm, x); const float y = fmaxf(m0, pm); mt = bc + y; xv[t] = x;
            gsx[t] = x; gsy[t] = y; gwi[t] = __expf(m0 - y); gem[t] = __expf(-mt); }
        const float mnew = mt;
#pragma unroll
        for (int t = 0; t < 8; ++t) gwe[t] = __expf(bc + xv[t] - mnew);
        gsc[0] = __expf(bc + m0 - mnew); gsc[1] = mnew;
    }
    { const int t = tid >> 6, e = 2 * (tid & 63); const bf16_t* zr = P.Z + (size_t)(r0 + t) * ZLD + h * 128 + e;
      const unsigned qw = *(const unsigned*)(zr + ZQ), kw = *(const unsigned*)(zr + ZK), vw = *(const unsigned*)(zr + ZV);
      ql[t * 128 + e] = bf_lo(qw); ql[t * 128 + e + 1] = bf_hi(qw); kl[t * 128 + e] = bf_lo(kw); kl[t * 128 + e + 1] = bf_hi(kw); vl[t * 128 + e] = bf_lo(vw); vl[t * 128 + e + 1] = bf_hi(vw); }
    { const int t = w;
      const u32x4 raw = *(const u32x4*)(P.Z + (size_t)(r0 + t) * ZLD + ZVG + 8 * lane);
      float x[8]; unpack8(raw, x);
      float s = ((x[0] + x[1]) + (x[2] + x[3])) + ((x[4] + x[5]) + (x[6] + x[7]));
      const float mean = wave_sum(s) * (1.0f / 512.0f); float q2 = 0.f;
#pragma unroll
      for (int e = 0; e < 8; ++e) { x[e] -= mean; q2 += x[e] * x[e]; }
      const float rstd = 1.0f / sqrtf(wave_sum(q2) * (1.0f / 512.0f) + EPS);
      if ((lane >> 4) == h) { const f32x4 a = *(const f32x4*)(P.lng + 8 * lane), a2 = *(const f32x4*)(P.lng + 8 * lane + 4), c0 = *(const f32x4*)(P.lnb + 8 * lane), c1 = *(const f32x4*)(P.lnb + 8 * lane + 4);
#pragma unroll
          for (int e = 0; e < 4; ++e) { x[e] = x[e] * rstd * a[e] + c0[e]; x[4 + e] = x[4 + e] * rstd * a2[e] + c1[e]; }
          float* vo = P.oVs + ((size_t)b * 8 + t) * 512 + 8 * lane; *(f32x4*)vo = (f32x4){x[0], x[1], x[2], x[3]}; *(f32x4*)(vo + 4) = (f32x4){x[4], x[5], x[6], x[7]};
#pragma unroll
          for (int e = 0; e < 8; ++e) vnl[t * 128 + 8 * (lane & 15) + e] = x[e]; } }
    __syncthreads();
    if (tid < 64) { const int t = tid >> 3, s = tid & 7; float dot = 0.f;
        for (int d = 0; d < 128; ++d) dot += ql[t * 128 + d] * kl[s * 128 + d];
        Sl[tid] = (s <= t) ? dot * __expf(gsx[s] - gsy[t]) : 0.f; }
    else if (tid < 72) { const int t = tid - 64; float dot = 0.f; for (int d = 0; d < 128; ++d) dot += ql[t * 128 + d] * P.stN[bh * 128 + d]; qn[t] = dot; }
    { const int t = w, e = 2 * lane; float s0 = 0.f, s1 = 0.f;
      for (int j = 0; j <= t; ++j) { const float wv = P.gm_ws[(size_t)h * 16384 + t * 128 + j]; s0 += wv * vnl[j * 128 + e]; s1 += wv * vnl[j * 128 + e + 1]; }
      const float bsv = P.bs[h * 128 + t]; const unsigned uw = *(const unsigned*)(P.Z + (size_t)(r0 + t) * ZLD + ZU + h * 128 + e);
      *(unsigned*)(P.YC + (size_t)(r0 + t) * 1024 + h * 128 + e) = cvt_pk_bf16(bf_lo(uw) * (s0 + bsv), bf_hi(uw) * (s1 + bsv)); }
    const float dec = gsc[0];
    { const int eg = tid & 31, dq = tid >> 5;
      f32x4 aq[8];
#pragma unroll
      for (int t = 0; t < 8; ++t) aq[t] = (f32x4){0.f, 0.f, 0.f, 0.f};
      f32x4 v4[8];
#pragma unroll
      for (int s = 0; s < 8; ++s) v4[s] = *(LAS const f32x4*)(vl + s * 128 + 4 * eg);
      float* co = P.oCs + (size_t)bh * 16384;
#pragma unroll
      for (int i = 0; i < 8; ++i) { const int d = dq + 16 * i; const f32x4 cv = cvv[i];
          f32x4 cn = dec * cv;
#pragma unroll
          for (int t = 0; t < 8; ++t) { aq[t] += ql[t * 128 + d] * cv; cn += (gwe[t] * kl[t * 128 + d]) * v4[t]; }
          *(f32x4*)(co + d * 128 + 4 * eg) = cn; }
#pragma unroll
      for (int t = 0; t < 8; ++t) *(LAS f32x4*)(red + (dq * 8 + t) * 128 + 4 * eg) = aq[t]; }
    __syncthreads();
    { const int t = w, e = 2 * lane; float qc0 = 0.f, qc1 = 0.f;
#pragma unroll
      for (int dq = 0; dq < 16; ++dq) { qc0 += red[(dq * 8 + t) * 128 + e]; qc1 += red[(dq * 8 + t) * 128 + e + 1]; }
      float n0 = 0.f, n1 = 0.f, dsum = 0.f;
#pragma unroll
      for (int s = 0; s < 8; ++s) { const float sv = Sl[t * 8 + s]; n0 += sv * vl[s * 128 + e]; n1 += sv * vl[s * 128 + e + 1]; dsum += sv; }
      const float wi = gwi[t], den = dsum + wi * qn[t], rinv = 1.0f / fmaxf(fabsf(den), gem[t]);
      const float h0 = (n0 + wi * qc0) * rinv, h1 = (n1 + wi * qc1) * rinv;
      const float rn = 1.0f / sqrtf(wave_sum(h0 * h0 + h1 * h1) * (1.0f / 128.0f) + EPS);
      const unsigned ow = *(const unsigned*)(P.Z + (size_t)(r0 + t) * ZLD + ZO + h * 128 + e);
      *(unsigned*)(P.YC + (size_t)(r0 + t) * 1024 + 512 + h * 128 + e) = cvt_pk_bf16(bf_lo(ow) * h0 * rn * P.mlnorm[h * 128 + e], bf_hi(ow) * h1 * rn * P.mlnorm[h * 128 + e + 1]); }
    if (tid < 128) { float nn = dec * P.stN[bh * 128 + tid];
#pragma unroll
        for (int s = 0; s < 8; ++s) nn += gwe[s] * kl[s * 128 + tid];
        P.oNs[bh * 128 + tid] = nn; if (tid == 0) P.oMs[bh] = gsc[1]; }
    __syncthreads();
}
}
namespace sg {
using pg8::bf16_t; using pg8::bf16x8; using pg8::f32x4; using pg8::u32x4; using pg8::u32x2; using pg8::cvt_pk_bf16; using pg8::bf_lo; using pg8::bf_hi; using pg8::sigmoid_f; using pg8::gelu_tanh_f; using pg8::row_rs;
constexpr int ROW0 = 16384;

struct Epi { bf16_t* O; int ldc; const float* rn; const bf16_t* Hb; bf16_t* Ho; float* SSO; const float* SSI; const bf16_t* PROJ; };

template <int MODE> __device__ __forceinline__ void epilogue(const Epi& E, int lrow, int ct, int kq, f32x4 (&acc)[4]) {
    const int row = ROW0 + lrow;
    float rs = 1.f;
    if (MODE == 3) rs = E.rn[row];
    if (MODE == 4) { rs = row_rs(E.SSI, row); rs = rs * rs; }
    if (MODE == 5) rs = row_rs(E.SSI, row);
    float sq = 0.f;
#pragma unroll
    for (int n = 0; n < 4; ++n) { const int col = 64 * ct + 16 * n + 4 * kq; f32x4 v = acc[n];
        if (MODE == 0) {
            if (col < 1024) {
#pragma unroll
                for (int e = 0; e < 4; ++e) v[e] = gelu_tanh_f(v[e]); }
            else if (col >= 2560) {
#pragma unroll
                for (int e = 0; e < 4; ++e) v[e] = sigmoid_f(v[e]); }
        }
        if (MODE == 2) {
#pragma unroll
            for (int e = 0; e < 4; ++e) { const float a = fmaxf(v[e], 0.f); v[e] = a * a; } }
        if (MODE <= 2) { u32x2 w; w.x = cvt_pk_bf16(v[0], v[1]); w.y = cvt_pk_bf16(v[2], v[3]); *(u32x2*)(E.O + (size_t)row * E.ldc + col) = w; continue; }
        const size_t off = (size_t)row * 1024 + col;
        const u32x2 hw = *(const u32x2*)(E.Hb + off); const f32x4 r = (f32x4){bf_lo(hw.x), bf_hi(hw.x), bf_lo(hw.y), bf_hi(hw.y)};
        if (MODE == 3) v = r * rs + v;
        else if (MODE == 4) v = r + v * rs;
        else { const u32x2 pw = *(const u32x2*)(E.PROJ + off);
            v[0] = r[0] + sigmoid_f(v[0] * rs) * bf_lo(pw.x); v[1] = r[1] + sigmoid_f(v[1] * rs) * bf_hi(pw.x); v[2] = r[2] + sigmoid_f(v[2] * rs) * bf_lo(pw.y); v[3] = r[3] + sigmoid_f(v[3] * rs) * bf_hi(pw.y); }
        { u32x2 w; w.x = cvt_pk_bf16(v[0], v[1]); w.y = cvt_pk_bf16(v[2], v[3]); *(u32x2*)(E.Ho + off) = w; }
        sq += (v[0] * v[0] + v[1] * v[1]) + (v[2] * v[2] + v[3] * v[3]); }
    if (MODE >= 3) { sq += __shfl_xor(sq, 16); sq += __shfl_xor(sq, 32); if (kq == 0) E.SSO[(size_t)row * 16 + ct] = sq; }
}

constexpr int KT = 128;
__device__ __forceinline__ int toff(int row, int ch) { return (row << 8) + ((ch ^ (row & 15)) << 4); }
template <int MODE> __device__ __forceinline__ void phase(LAS unsigned char* lds, const bf16_t* A0, const bf16_t* Bt, int K, int N, const Epi& E, int vcu, int G, int tid) {
    const int lane = tid & 63, w = __builtin_amdgcn_readfirstlane(tid >> 6), fr = lane & 15, kq = lane >> 4, wm = w & 3, wk = w >> 2;
    const bf16_t* A = A0 + (size_t)ROW0 * K;
    const int nu = 16 * (N >> 6), nkt = K / KT;
    if (vcu >= nu) return;
    const int nmine = (nu - vcu + G - 1) / G, total = nmine * nkt;
    const int lrow = tid >> 4, lch = tid & 15;
    f32x4 acc[4];
#pragma unroll
    for (int n = 0; n < 4; ++n) acc[n] = (f32x4){0.f, 0.f, 0.f, 0.f};
    u32x4 pa[2], pb[2];
    { const int u = vcu; const bf16_t* ag = A + (size_t)(64 * (u & 15) + lrow) * K + lch * 8; const bf16_t* bg = Bt + (size_t)(64 * (u >> 4) + lrow) * K + lch * 8;
      pa[0] = *(const u32x4*)ag; pa[1] = *(const u32x4*)(ag + (size_t)32 * K); pb[0] = *(const u32x4*)bg; pb[1] = *(const u32x4*)(bg + (size_t)32 * K); }
    { LAS unsigned char* st = lds;
      *(LAS u32x4*)(st + toff(lrow, lch)) = pa[0]; *(LAS u32x4*)(st + toff(lrow + 32, lch)) = pa[1]; *(LAS u32x4*)(st + 16384 + toff(lrow, lch)) = pb[0]; *(LAS u32x4*)(st + 16384 + toff(lrow + 32, lch)) = pb[1]; }
    int ui = 0, kt = 0, u = vcu;
    for (int i = 0; i < total; ++i) {
        const bool more = (i + 1 < total), lastk = (kt + 1 == nkt);
        if (more) { const int u2 = lastk ? u + G : u, k2 = lastk ? 0 : kt + 1;
            const bf16_t* ag = A + (size_t)(64 * (u2 & 15) + lrow) * K + k2 * KT + lch * 8; const bf16_t* bg = Bt + (size_t)(64 * (u2 >> 4) + lrow) * K + k2 * KT + lch * 8;
            pa[0] = *(const u32x4*)ag; pa[1] = *(const u32x4*)(ag + (size_t)32 * K); pb[0] = *(const u32x4*)bg; pb[1] = *(const u32x4*)(bg + (size_t)32 * K); }
        __syncthreads();
        { LAS const unsigned char* st = lds + (i & 1) * 32768;
#pragma unroll
          for (int ks = 0; ks < 2; ++ks) { const int ch = 4 * (2 * wk + ks) + kq;
              const bf16x8 af = *(LAS const bf16x8*)(st + toff(16 * wm + fr, ch));
#pragma unroll
              for (int n = 0; n < 4; ++n) { const bf16x8 bf = *(LAS const bf16x8*)(st + 16384 + toff(16 * n + fr, ch));
                  acc[n] = __builtin_amdgcn_mfma_f32_16x16x32_bf16(bf, af, acc[n], 0, 0, 0); } } }
        if (more) { LAS unsigned char* st = lds + ((i + 1) & 1) * 32768;
            *(LAS u32x4*)(st + toff(lrow, lch)) = pa[0]; *(LAS u32x4*)(st + toff(lrow + 32, lch)) = pa[1]; *(LAS u32x4*)(st + 16384 + toff(lrow, lch)) = pb[0]; *(LAS u32x4*)(st + 16384 + toff(lrow + 32, lch)) = pb[1]; }
        if (lastk) {
            LAS f32x4* xch = (LAS f32x4*)(lds + 65536) + (wm * 64 + lane) * 4;
            if (wk == 1) {
#pragma unroll
                for (int n = 0; n < 4; ++n) { xch[n] = acc[n]; acc[n] = (f32x4){0.f, 0.f, 0.f, 0.f}; } }
            __syncthreads();
            if (wk == 0) {
#pragma unroll
                for (int n = 0; n < 4; ++n) acc[n] += xch[n];
                epilogue<MODE>(E, 64 * (u & 15) + 16 * wm + fr, u >> 4, kq, acc);
#pragma unroll
                for (int n = 0; n < 4; ++n) acc[n] = (f32x4){0.f, 0.f, 0.f, 0.f}; }
            kt = 0; ++ui; u += G;
        } else ++kt;
    }
    __syncthreads();
}
}

#ifndef HOST_DUP_PHASE
#define HOST_DUP_PHASE -1
#endif
#ifndef TP_A
#define TP_A -1
#define TP_B -1
#endif
#ifndef HOST_DUP_FLAGS
#define HOST_DUP_FLAGS 1
#endif
#ifndef HOST_EXTRA_BARS
#define HOST_EXTRA_BARS 0
#endif
#ifndef MK_ONE_LAUNCH
#define MK_ONE_LAUNCH 1
#endif
constexpr int NWAVES = 8;
constexpr int D = 1024, NPR = 16384, NSR = 1024, M = NPR + NSR, NIN = 3072, INC = 3080, FF = 4096, PLE = 256;
constexpr int N_PHASES = 10;
constexpr size_t MiB = 1u << 20;
constexpr size_t WS_CTL = 0, CTL_ZERO_BYTES = 65536;
constexpr int CW_BAR = 1024;
constexpr size_t WS_WIN = 1 * MiB;
constexpr size_t WS_WOUT = WS_WIN + (size_t)NIN * D * 2;
constexpr size_t WS_WUP = WS_WOUT + (size_t)D * D * 2;
constexpr size_t WS_WDOWN = WS_WUP + (size_t)FF * D * 2;
constexpr size_t WS_WGATE = WS_WDOWN + (size_t)D * FF * 2;
constexpr size_t WS_WPROJ = WS_WGATE + (size_t)D * D * 2;
constexpr size_t WS_WSB = WS_WPROJ + (size_t)D * PLE * 2;
constexpr size_t WS_IG = WS_WSB + 4 * 128 * 128 * 2;
constexpr size_t WS_LF = WS_IG + (size_t)M * 16;
constexpr size_t WS_SS1 = WS_LF + (size_t)M * 16;
constexpr size_t WS_SS2 = WS_SS1 + (size_t)M * 64;
constexpr size_t WS_SS3 = WS_SS2 + (size_t)M * 64;
constexpr size_t WS_CH = WS_SS3 + (size_t)M * 64;
constexpr size_t WS_MST = WS_CH + 4096;
constexpr size_t WS_NLOC = WS_MST + 4096;
constexpr size_t WS_NST = WS_NLOC + 512 * 128 * 4;
constexpr size_t WS_RN = WS_NST + 512 * 128 * 4;
constexpr size_t WS_PE = WS_RN + 69632;
constexpr size_t WS_RA = WS_PE + (size_t)M * PLE * 2;
constexpr size_t WS_RB = WS_RA + (size_t)M * D * 2;
constexpr size_t WS_YC = WS_RB + (size_t)M * NIN * 2;
constexpr size_t WS_KV = WS_RB + (size_t)M * FF * 2;
constexpr size_t WS_END = WS_KV + (size_t)M * D * 2;
static_assert(WS_END <= 256 * MiB, "d_ws map");
static_assert(WS_WIN % 256 == 0 && WS_IG % 256 == 0 && WS_PE % 256 == 0 && WS_RA % 256 == 0 && WS_RB % 256 == 0 && WS_YC % 256 == 0 && WS_KV % 256 == 0, "alignment");
constexpr size_t O_Y = 0, O_CP = (size_t)M * D, O_NP = O_CP + 8 * 4 * 16384, O_MP = O_NP + 8 * 4 * 128, O_VP = O_MP + 32, O_CS = O_VP + 8 * 128 * 512,
                 O_NS = O_CS + (size_t)128 * 4 * 16384, O_MS = O_NS + 128 * 4 * 128, O_VS = O_MS + 512, O_END = O_VS + 128 * 8 * 512;
constexpr int RING_OFF = 0, RING_BYTES = 131072, LDSCTL_OFF = RING_BYTES, MISC_OFF = LDSCTL_OFF + 320, LDS_BYTES = 147456;

typedef unsigned short bf16;
typedef unsigned v4u __attribute__((ext_vector_type(4)));
typedef float f32x4 __attribute__((ext_vector_type(4)));
#define GAS __attribute__((address_space(1)))
typedef GAS unsigned gu32;
#define RLX_AGENT __ATOMIC_RELAXED, __HIP_MEMORY_SCOPE_AGENT
#define LDS_WAIT() asm volatile("s_waitcnt lgkmcnt(0)" ::: "memory")

struct Args { const float* in[24]; float* out; unsigned char* ws; int ph_lo, ph_hi, flags, extra_bars; };

#define XB_TMO      128
#define XB_XCNT(j)  (256  + 64 * (j))
#define XB_XSUB(j)  (1280 + 64 * (j))
#define XB_XGEN(j)  (2304 + 64 * (j))
#define XB_TOP      3328
#define XB_TOPGEN   3392
#define XCD_BAR_WORDS 3456
#define XB_SPIN_CAP (1u << 18)

__device__ __forceinline__ unsigned xb_ld(unsigned* p)              { return __hip_atomic_load(p, __ATOMIC_RELAXED, __HIP_MEMORY_SCOPE_AGENT); }
__device__ __forceinline__ unsigned xb_add(unsigned* p, unsigned v) { return __hip_atomic_fetch_add(p, v, __ATOMIC_RELAXED, __HIP_MEMORY_SCOPE_AGENT); }
__device__ __forceinline__ unsigned xb_xcc_id() { return (unsigned)__builtin_amdgcn_s_getreg((3 << 11) | 20) & 0xFu; }
#define XB_SPIN(cond, bar) do { unsigned _sp = 0; while (cond) { __builtin_amdgcn_s_sleep(1); \
    if ((++_sp & 255u) == 0u) { if (xb_ld(&(bar)[XB_TMO])) break; if (_sp > XB_SPIN_CAP) { atomicAdd(&(bar)[XB_TMO], 1u); break; } } } } while (0)

struct XcdBarrier {
    unsigned* bar; unsigned x;
    volatile LAS unsigned* st;
};

__device__ __forceinline__ XcdBarrier xcd_barrier_post(unsigned* bar, volatile LAS unsigned* st) {
    XcdBarrier b; b.bar = bar; b.x = xb_xcc_id(); b.st = st;
    if (threadIdx.x == 0) (void)xb_add(&bar[XB_XCNT(b.x)], 1u);
    return b;
}
__device__ __forceinline__ void xcd_barrier_complete(unsigned* bar, unsigned x, unsigned& nloc, unsigned& nx) {
    const unsigned G = gridDim.x * gridDim.y * gridDim.z;
    unsigned sum, cnt, mine, sp = 0u;
    for (;;) {
        sum = 0u; cnt = 0u; mine = 0u;
#pragma unroll
        for (unsigned j = 0; j < 16; ++j) { const unsigned c = xb_ld(&bar[XB_XCNT(j)]); sum += c; cnt += (c > 0u) ? 1u : 0u; mine = (j == x) ? c : mine; }
        if (sum == G) break;
        __builtin_amdgcn_s_sleep(1);
        if ((++sp & 255u) == 0u) { if (xb_ld(&bar[XB_TMO])) break; if (sp > XB_SPIN_CAP) { atomicAdd(&bar[XB_TMO], 1u); break; } }
    }
    nloc = mine > 0u ? mine : 1u; nx = cnt > 0u ? cnt : 1u;
}

__device__ __forceinline__ void xcd_barrier(const XcdBarrier& b) {
    asm volatile("s_waitcnt vmcnt(0)" ::: "memory");
    __syncthreads();
    if (threadIdx.x == 0) {
        unsigned* bar = b.bar;
        __builtin_amdgcn_s_waitcnt(0);
        unsigned nloc = b.st[0], nx = b.st[1];
        if (nloc == 0u) { xcd_barrier_complete(bar, b.x, nloc, nx); b.st[0] = nloc; b.st[1] = nx; }
        const unsigned old = xb_add(&bar[XB_XSUB(b.x)], 1u);
        const unsigned gen = old / nloc;
        if (old + 1u == (gen + 1u) * nloc) {
            __builtin_amdgcn_fence(__ATOMIC_RELEASE, "agent");
            asm volatile("s_waitcnt vmcnt(0)" ::: "memory");
            const unsigned og = xb_add(&bar[XB_TOP], 1u);
            const unsigned tg = og / nx;
            if (og + 1u == (tg + 1u) * nx) xb_add(&bar[XB_TOPGEN], 1u);
            else XB_SPIN(xb_ld(&bar[XB_TOPGEN]) == tg, bar);
            __builtin_amdgcn_fence(__ATOMIC_ACQUIRE, "agent");
            xb_add(&bar[XB_XGEN(b.x)], 1u);
            asm volatile("s_waitcnt vmcnt(0)" ::: "memory");
        } else {
            XB_SPIN(xb_ld(&bar[XB_XGEN(b.x)]) == gen, bar);
            __builtin_amdgcn_fence(__ATOMIC_ACQUIRE, "agent");
            asm volatile("s_waitcnt vmcnt(0)" ::: "memory");
        }
    }
    __syncthreads();
}

__device__ __forceinline__ void p0_transpose_item(const float* W, int ldw, int K, int N, const float* gain, bf16* WT, LAS float* scr, int item, int lane, bool kscale) {
    const int nblk = N / 32, kb = item / nblk, nb = item % nblk, k0 = 64 * kb, n0 = 32 * nb;
    const float cs = (kscale && n0 >= 1536 && n0 < 2048) ? 0.08838834764831845f : 1.0f;
    float wv[32];
#pragma unroll
    for (int i = 0; i < 32; ++i) { const int kk = 2 * i + (lane >> 5); wv[i] = W[(size_t)(k0 + kk) * ldw + n0 + (lane & 31)]; }
#pragma unroll
    for (int i = 0; i < 32; ++i) { const int kk = 2 * i + (lane >> 5); const float g = gain ? gain[k0 + kk] * cs : cs; scr[kk * 33 + (lane & 31)] = wv[i] * g; }
    LDS_WAIT(); asm volatile("" ::: "memory");
    const int c = lane & 7;
#pragma unroll
    for (int j = 0; j < 4; ++j) { const int n = (lane >> 3) + 8 * j; const LAS float* s = scr + (8 * c) * 33 + n;
        v4u o; o.x = pg8::cvt_pk_bf16(s[0 * 33], s[1 * 33]); o.y = pg8::cvt_pk_bf16(s[2 * 33], s[3 * 33]); o.z = pg8::cvt_pk_bf16(s[4 * 33], s[5 * 33]); o.w = pg8::cvt_pk_bf16(s[6 * 33], s[7 * 33]);
        *(v4u*)(WT + (size_t)(n0 + n) * K + k0 + 8 * c) = o; }
    LDS_WAIT(); asm volatile("" ::: "memory");
}

__device__ __forceinline__ float log_sigmoid_f(float x) { return fminf(x, 0.f) - log1pf(__expf(-fabsf(x))); }

struct RowIn { f32x4 v[4]; f32x4 pv; };
__device__ __forceinline__ void p0_row_load(const Args& A, int m, int lane, RowIn& R) {
    const float* xrow = (m < NPR) ? A.in[0] + (size_t)m * D : A.in[1] + (size_t)(m - NPR) * D;
    const float* prow = (m < NPR) ? A.in[2] + (size_t)m * PLE : A.in[3] + (size_t)(m - NPR) * PLE;
    const f32x4* xr = (const f32x4*)xrow + lane;
#pragma unroll
    for (int j = 0; j < 4; ++j) R.v[j] = xr[64 * j];
    R.pv = *((const f32x4*)prow + lane);
}
__device__ __forceinline__ void p0_row_finish(unsigned char* ws, int m, int lane, RowIn& R, const float (&gwt)[4][4][8], float gbias) {
    float s = 0.f;
#pragma unroll
    for (int j = 0; j < 4; ++j) s += (R.v[j][0] * R.v[j][0] + R.v[j][1] * R.v[j][1]) + (R.v[j][2] * R.v[j][2] + R.v[j][3] * R.v[j][3]);
    const float rnv = sqrtf(mix::wave_sum(s) * (1.0f / D) + 1e-6f), rinv = 1.0f / rnv;
    if (lane == 8) ((float*)(ws + WS_RN))[m] = rnv;
    unsigned long long* o8 = (unsigned long long*)((bf16*)(ws + WS_RA) + (size_t)m * D) + lane;
    float g8[8];
#pragma unroll
    for (int q = 0; q < 8; ++q) g8[q] = 0.f;
#pragma unroll
    for (int j = 0; j < 4; ++j) { const f32x4 v = R.v[j] * rinv;
        o8[64 * j] = (unsigned long long)pg8::cvt_pk_bf16(v[0], v[1]) | ((unsigned long long)pg8::cvt_pk_bf16(v[2], v[3]) << 32);
#pragma unroll
        for (int c = 0; c < 4; ++c)
#pragma unroll
            for (int q = 0; q < 8; ++q) g8[q] += v[c] * gwt[j][c][q]; }
#pragma unroll
    for (int q = 0; q < 8; ++q) g8[q] = mix::row_sum16(g8[q]);
    const int q8 = lane & 7;
    float val = q8 == 0 ? g8[0] : q8 == 1 ? g8[1] : q8 == 2 ? g8[2] : q8 == 3 ? g8[3] : q8 == 4 ? g8[4] : q8 == 5 ? g8[5] : q8 == 6 ? g8[6] : g8[7];
    val += __shfl_xor(val, 16); val += __shfl_xor(val, 32);
    if (lane < 4) ((float*)(ws + WS_IG))[(size_t)m * 4 + lane] = val + gbias;
    else if (lane < 8) ((float*)(ws + WS_LF))[(size_t)m * 4 + lane - 4] = log_sigmoid_f(val + gbias);
    *((unsigned long long*)((bf16*)(ws + WS_PE) + (size_t)m * PLE) + lane) = (unsigned long long)pg8::cvt_pk_bf16(R.pv[0], R.pv[1]) | ((unsigned long long)pg8::cvt_pk_bf16(R.pv[2], R.pv[3]) << 32);
}

__device__ __forceinline__ void p0_prologue(const Args& A, LAS unsigned char* lds, int vcu, int G, int tid) {
    const int lane = tid & 63, wave = __builtin_amdgcn_readfirstlane(tid >> 6);
    unsigned char* ws = A.ws;
    LAS float* scr = (LAS float*)(lds + RING_OFF + wave * 8704);
    LAS float* gtab = (LAS float*)(lds + RING_OFF + 8 * 8704);
    const int gw = vcu * NWAVES + wave, NGW = G * NWAVES;
    for (int k = tid; k < D; k += NWAVES * 64) { const float g = A.in[7][k]; const float* wp = A.in[8] + (size_t)k * INC + NIN;
        const f32x4 a = *(const f32x4*)wp, b = *(const f32x4*)(wp + 4); *(LAS f32x4*)(gtab + k * 8) = a * g; *(LAS f32x4*)(gtab + k * 8 + 4) = b * g; }
    constexpr int I_IN = (D / 64) * (NIN / 32), I_OUT = (D / 64) * (D / 32), I_UP = (D / 64) * (FF / 32), I_DOWN = (FF / 64) * (D / 32), I_GATE = I_OUT, I_PROJ = (PLE / 64) * (D / 32);
    constexpr int NITEMS = I_IN + I_OUT + I_UP + I_DOWN + I_GATE + I_PROJ;
    for (int it = gw; it < NITEMS; it += NGW) {
        int r = it;
        if (r < I_IN) { p0_transpose_item(A.in[8], INC, D, NIN, A.in[7], (bf16*)(ws + WS_WIN), scr, r, lane, true); continue; } r -= I_IN;
        if (r < I_OUT) { p0_transpose_item(A.in[16], D, D, D, nullptr, (bf16*)(ws + WS_WOUT), scr, r, lane, false); continue; } r -= I_OUT;
        if (r < I_UP) { p0_transpose_item(A.in[18], FF, D, FF, A.in[17], (bf16*)(ws + WS_WUP), scr, r, lane, false); continue; } r -= I_UP;
        if (r < I_DOWN) { p0_transpose_item(A.in[19], D, FF, D, nullptr, (bf16*)(ws + WS_WDOWN), scr, r, lane, false); continue; } r -= I_DOWN;
        if (r < I_GATE) { p0_transpose_item(A.in[21], D, D, D, A.in[20], (bf16*)(ws + WS_WGATE), scr, r, lane, false); continue; } r -= I_GATE;
        p0_transpose_item(A.in[22], D, PLE, D, nullptr, (bf16*)(ws + WS_WPROJ), scr, r, lane, false);
    }
    { const int gt = vcu * 512 + tid, NT = G * 512; const float* wsrc = A.in[11]; bf16* wdst = (bf16*)(ws + WS_WSB);
      for (int i = gt; i < 4 * 128 * 128 / 4; i += NT) { const int e = 4 * i, t = (e >> 7) & 127, j = e & 127; const f32x4 v = *(const f32x4*)(wsrc + e);
          pg8::u32x2 o; o.x = pg8::cvt_pk_bf16(j <= t ? v[0] : 0.f, j + 1 <= t ? v[1] : 0.f); o.y = pg8::cvt_pk_bf16(j + 2 <= t ? v[2] : 0.f, j + 3 <= t ? v[3] : 0.f);
          *(pg8::u32x2*)(wdst + e) = o; } }
    __syncthreads();
    float gwt[4][4][8];
#pragma unroll
    for (int j = 0; j < 4; ++j)
#pragma unroll
        for (int c = 0; c < 4; ++c) { const LAS float* gp = gtab + (4 * lane + 256 * j + c) * 8; const f32x4 a = *(const LAS f32x4*)gp, b = *(const LAS f32x4*)(gp + 4);
#pragma unroll
            for (int q = 0; q < 4; ++q) { gwt[j][c][q] = a[q]; gwt[j][c][4 + q] = b[q]; } }
    const float gbias = (lane < 4) ? A.in[13][lane & 3] : A.in[14][lane & 3];
    for (int m = gw; m < M; m += 2 * NGW) {
        const int m2 = (m + NGW < M) ? m + NGW : m;
        RowIn R0, R1; p0_row_load(A, m, lane, R0); p0_row_load(A, m2, lane, R1);
        p0_row_finish(ws, m, lane, R0, gwt, gbias);
        p0_row_finish(ws, m2, lane, R1, gwt, gbias);
    }
    __syncthreads();
}

__device__ __forceinline__ void p7_final(const Args& A, int vcu, int G, int tid) {
    const int lane = tid & 63, wave = __builtin_amdgcn_readfirstlane(tid >> 6);
    const int gw = vcu * NWAVES + wave, NGW = G * NWAVES;
    const float* ss = (const float*)(A.ws + WS_SS3); const bf16* Hb = (const bf16*)(A.ws + WS_RB);
    const f32x4 g0 = *((const f32x4*)A.in[23] + 2 * lane), g1 = *((const f32x4*)A.in[23] + 2 * lane + 1), g2 = *((const f32x4*)A.in[23] + 128 + 2 * lane), g3 = *((const f32x4*)A.in[23] + 128 + 2 * lane + 1);
    for (int m = gw; m < M; m += NGW) {
        const float rs = pg8::row_rs(ss, m);
        const v4u a = *((const v4u*)(Hb + (size_t)m * D) + lane), b = *((const v4u*)(Hb + (size_t)m * D) + 64 + lane);
        f32x4* yr = (f32x4*)(A.out + (size_t)m * D);
        yr[2 * lane] = (f32x4){pg8::bf_lo(a.x), pg8::bf_hi(a.x), pg8::bf_lo(a.y), pg8::bf_hi(a.y)} * rs * g0;
        yr[2 * lane + 1] = (f32x4){pg8::bf_lo(a.z), pg8::bf_hi(a.z), pg8::bf_lo(a.w), pg8::bf_hi(a.w)} * rs * g1;
        yr[128 + 2 * lane] = (f32x4){pg8::bf_lo(b.x), pg8::bf_hi(b.x), pg8::bf_lo(b.y), pg8::bf_hi(b.y)} * rs * g2;
        yr[128 + 2 * lane + 1] = (f32x4){pg8::bf_lo(b.z), pg8::bf_hi(b.z), pg8::bf_lo(b.w), pg8::bf_hi(b.w)} * rs * g3;
    }
}

__global__ void __launch_bounds__(NWAVES * 64, 2) hymba_fwd(Args args) {
    extern __shared__ __attribute__((aligned(16))) unsigned char lds_raw[];
    LAS unsigned char* lds = (LAS unsigned char*)lds_raw;
    const int tid = threadIdx.x, G = gridDim.x, bx = blockIdx.x;
    const int vcu = (G % 8 == 0) ? (bx % 8) * (G / 8) + bx / 8 : bx;
    unsigned char* ws = args.ws;
#ifndef DUP_PHASE
#define DUP_PHASE -1
#endif
    const int lo = args.ph_lo, hi = args.ph_hi;
#ifndef PH_MASK
#define PH_MASK 0xffff
#endif
#define INC_(k) (((PH_MASK >> (k)) & 1) && lo <= (k) && (k) < hi)
#if DUP_PHASE >= 0
#define IN(k) for (int rep_ = 0; rep_ < ((DUP_PHASE == (k)) ? 2 : 1); ++rep_) if (INC_(k))
#define GRID_BAR(k) do { if (INC_((k) + 1)) xcd_barrier(bar); } while (0)
#else
#define IN(k) if (INC_(k))
#define GRID_BAR(k) do { if (INC_((k) + 1)) xcd_barrier(bar); } while (0)
#endif
    for (int u = tid; u < (LDS_BYTES - LDSCTL_OFF) / 4; u += NWAVES * 64) ((LAS unsigned*)(lds + LDSCTL_OFF))[u] = 0u;
    __syncthreads();
    XcdBarrier bar = xcd_barrier_post((unsigned*)(ws + WS_CTL) + CW_BAR, (volatile LAS unsigned*)(lds + MISC_OFF) + 8);
    float* OUT = args.out;
    const int FL = args.flags;
#if TP_A >= 0
    unsigned long long tp_a = 0ull, tp_b = 0ull;
#define STAMP(id) do { if ((id) == TP_A || (id) == TP_B) { asm volatile("s_waitcnt vmcnt(0) lgkmcnt(0)" ::: "memory"); const unsigned long long t_ = __builtin_amdgcn_s_memrealtime(); if ((id) == TP_A) tp_a = t_; if ((id) == TP_B) tp_b = t_; } } while (0)
#else
#define STAMP(id) do { } while (0)
#endif
    bf16* RA = (bf16*)(ws + WS_RA); bf16* Zb = (bf16*)(ws + WS_RB); bf16* YC = (bf16*)(ws + WS_YC); bf16* HID = (bf16*)(ws + WS_RB); bf16* H3 = (bf16*)(ws + WS_RB);     bf16* PROJ = (bf16*)args.out;
    float* SS1 = (float*)(ws + WS_SS1); float* SS2 = (float*)(ws + WS_SS2); float* SS3 = (float*)(ws + WS_SS3);
    mix::MixP MP;
    MP.Z = Zb; MP.YC = YC; MP.IG = (const float*)(ws + WS_IG); MP.LF = (const float*)(ws + WS_LF); MP.WSb = (const bf16*)(ws + WS_WSB);
    MP.gm_ws = args.in[11]; MP.lng = args.in[9]; MP.lnb = args.in[10]; MP.bs = args.in[12]; MP.mlnorm = args.in[15];
    MP.KV = (float*)(ws + WS_KV); MP.NLOC = (float*)(ws + WS_NLOC); MP.NST = (float*)(ws + WS_NST); MP.CH = (float*)(ws + WS_CH); MP.MST = (float*)(ws + WS_MST);
    MP.stC = args.in[4]; MP.stN = args.in[5]; MP.stM = args.in[6];
    MP.oCp = OUT + O_CP; MP.oNp = OUT + O_NP; MP.oMp = OUT + O_MP; MP.oVp = OUT + O_VP; MP.oCs = OUT + O_CS; MP.oNs = OUT + O_NS; MP.oMs = OUT + O_MS; MP.oVs = OUT + O_VS;

    STAMP(0);
    IN(0) { p0_prologue(args, lds, vcu, G, tid); STAMP(1); GRID_BAR(0); for (int eb = 0; eb < args.extra_bars; ++eb) xcd_barrier(bar); }
    STAMP(2);
    IN(1) {
        pg8::Gemm g{RA, (const bf16*)(ws + WS_WIN), NPR, NIN, D}; pg8::StaticOrder S; S.init(NPR, NIN, G, bx);
        pg8::EpiBf16<0> E{Zb, NIN, nullptr};
        if (!(FL & 2)) pg8::gemm_phase<pg8::EpiBf16<0>, pg8::StaticOrder, true, true>(lds + RING_OFF, g, S, E);
        STAMP(3);
        if (!(FL & 4)) { const sg::Epi SE{Zb, NIN, nullptr, nullptr, nullptr, nullptr, nullptr, nullptr}; sg::phase<0>(lds + RING_OFF, RA, (const bf16*)(ws + WS_WIN), D, NIN, SE, vcu, G, tid); }
        GRID_BAR(1);
    }
    STAMP(4);
    IN(2) {
        for (int u = vcu; u < 1024; u += G) {
            if (u < 512) { if (FL & 16) continue; const int bc = u >> 2, h = u & 3; mix::gmlp_unit(lds, MP, bc >> 4, bc & 15, h, tid); }
            else { if (FL & 32) continue; if (u == vcu + 512) STAMP(5); const int v = u - 512; mix::kv_unit(lds, MP, v >> 6, (v >> 4) & 3, v & 15, tid); }
        }
        GRID_BAR(2);
    }
    STAMP(6);
    IN(3) {
        if (!(FL & 1)) for (int u = vcu; u < 256; u += G) mix::scan_unit(MP, u >> 3, u & 7, tid);
        STAMP(7);
        if (!(FL & 64)) for (int u = vcu; u < 512; u += G) mix::sample_unit(lds, MP, u >> 2, u & 3, tid);
        STAMP(21);
        if (!(FL & 128)) { pg8::Gemm g{(const bf16*)(ws + WS_PE), (const bf16*)(ws + WS_WPROJ), NPR, D, PLE}; pg8::StaticOrder S; S.init(NPR, D, G, bx);
          pg8::EpiBf16<1> E{PROJ, D, nullptr};
          if (!(FL & 2)) pg8::gemm_phase<pg8::EpiBf16<1>, pg8::StaticOrder, true, true>(lds + RING_OFF, g, S, E);
          STAMP(22);
          const sg::Epi SE{PROJ, D, nullptr, nullptr, nullptr, nullptr, nullptr, nullptr}; if (!(FL & 4)) sg::phase<1>(lds + RING_OFF, (const bf16*)(ws + WS_PE), (const bf16*)(ws + WS_WPROJ), PLE, D, SE, vcu, G, tid); }
        GRID_BAR(3);
    }
    STAMP(8);
    IN(4) {
        for (int u = vcu; u < 512; u += G) mix::mlo_unit(lds, MP, u >> 6, (u >> 4) & 3, u & 15, tid);
        GRID_BAR(4);
    }
    STAMP(10);
    IN(5) {
        pg8::Gemm g{YC, (const bf16*)(ws + WS_WOUT), NPR, D, D}; pg8::StaticOrder S; S.init(NPR, D, G, bx);
        pg8::EpiRes<0> E{(const float*)(ws + WS_RN), RA, RA, SS1, nullptr, nullptr};
        if (!(FL & 2)) pg8::gemm_phase<pg8::EpiRes<0>, pg8::StaticOrder, true, true>(lds + RING_OFF, g, S, E);
        STAMP(11);
        if (!(FL & 4)) { const sg::Epi SE{nullptr, 0, (const float*)(ws + WS_RN), RA, RA, SS1, nullptr, nullptr}; sg::phase<3>(lds + RING_OFF, YC, (const bf16*)(ws + WS_WOUT), D, D, SE, vcu, G, tid); }
        GRID_BAR(5);
    }
    STAMP(12);
    IN(6) {
        pg8::Gemm g{RA, (const bf16*)(ws + WS_WUP), NPR, FF, D}; pg8::StaticOrder S; S.init(NPR, FF, G, bx);
        pg8::EpiBf16<2> E{HID, FF, nullptr};
        if (!(FL & 2)) pg8::gemm_phase<pg8::EpiBf16<2>, pg8::StaticOrder, true, true>(lds + RING_OFF, g, S, E);
        STAMP(13);
        if (!(FL & 4)) { const sg::Epi SE{HID, FF, nullptr, nullptr, nullptr, nullptr, nullptr, nullptr}; sg::phase<2>(lds + RING_OFF, RA, (const bf16*)(ws + WS_WUP), D, FF, SE, vcu, G, tid); }
        GRID_BAR(6);
    }
    STAMP(14);
    IN(7) {
        pg8::Gemm g{HID, (const bf16*)(ws + WS_WDOWN), NPR, D, FF}; pg8::StaticOrder S; S.init(NPR, D, G, bx);
        pg8::EpiRes<1> E{nullptr, RA, (FL & 8) ? (bf16*)(ws + WS_KV) : RA, (FL & 8) ? SS3 : SS2, SS1, nullptr};
        if (!(FL & 2)) pg8::gemm_phase<pg8::EpiRes<1>, pg8::StaticOrder, true, true>(lds + RING_OFF, g, S, E);
        STAMP(15);
        if (!(FL & 4)) { const sg::Epi SE{nullptr, 0, nullptr, RA, (FL & 8) ? (bf16*)(ws + WS_KV) : RA, (FL & 8) ? SS3 : SS2, SS1, nullptr}; sg::phase<4>(lds + RING_OFF, HID, (const bf16*)(ws + WS_WDOWN), FF, D, SE, vcu, G, tid); }
        GRID_BAR(7);
    }
    STAMP(16);
    IN(8) {
        pg8::Gemm g{RA, (const bf16*)(ws + WS_WGATE), NPR, D, D}; pg8::StaticOrder S; S.init(NPR, D, G, bx);
        pg8::EpiRes<2> E{nullptr, RA, (FL & 8) ? (bf16*)(ws + WS_KV) : H3, (FL & 8) ? SS1 : SS3, SS2, PROJ};
        if (!(FL & 2)) pg8::gemm_phase<pg8::EpiRes<2>, pg8::StaticOrder, true, true>(lds + RING_OFF, g, S, E);
        STAMP(17);
        if (!(FL & 4)) { const sg::Epi SE{nullptr, 0, nullptr, RA, (FL & 8) ? (bf16*)(ws + WS_KV) : H3, (FL & 8) ? SS1 : SS3, SS2, PROJ}; sg::phase<5>(lds + RING_OFF, RA, (const bf16*)(ws + WS_WGATE), D, D, SE, vcu, G, tid); }
        GRID_BAR(8);
    }
    STAMP(18);
    IN(9) p7_final(args, vcu, G, tid);
    STAMP(20);
#if TP_A >= 0
    if (bx == 0 && tid == 0) { asm volatile("s_waitcnt vmcnt(0)" ::: "memory"); OUT[O_MP] = (float)(tp_b - tp_a); }
#endif
#undef IN
#undef GRID_BAR
}

extern "C" void kernel_launch(void* const* d_in, const int* in_sizes, int n_in, void* d_out, int out_size, void* d_ws, size_t ws_size, hipStream_t stream) {
    static int grid = 0;
    if (grid == 0) {
        if (n_in != 24 || (size_t)out_size != O_END || ws_size < WS_END) { fprintf(stderr, "kernel_launch: unexpected problem shape (n_in %d, out %d, ws %zu)\n", n_in, out_size, ws_size); grid = -1; return; }
        int dev = 0, cus = 0, per_cu = 0;
        if (hipGetDevice(&dev) != hipSuccess || hipDeviceGetAttribute(&cus, hipDeviceAttributeMultiprocessorCount, dev) != hipSuccess) { grid = -1; return; }
        if (hipFuncSetAttribute((const void*)hymba_fwd, hipFuncAttributeMaxDynamicSharedMemorySize, LDS_BYTES) != hipSuccess) { fprintf(stderr, "kernel_launch: hipFuncSetAttribute failed\n"); grid = -1; return; }
        if (hipOccupancyMaxActiveBlocksPerMultiprocessor(&per_cu, (const void*)hymba_fwd, NWAVES * 64, LDS_BYTES) != hipSuccess || per_cu < 1) { fprintf(stderr, "kernel_launch: occupancy query says %d blocks per CU\n", per_cu); per_cu = 1; }
        (void)hipGetLastError();
        grid = cus * (per_cu < 1 ? per_cu : 1);
    }
    if (grid < 0) return;
    Args a{};
    for (int i = 0; i < 24; ++i) a.in[i] = (const float*)d_in[i];
    a.out = (float*)d_out; a.ws = (unsigned char*)d_ws;
#if MK_ONE_LAUNCH
    if (hipMemsetAsync((char*)d_ws + WS_CTL, 0, CTL_ZERO_BYTES, stream) != hipSuccess) { fprintf(stderr, "kernel_launch: memset of the control words failed\n"); return; }
    void* kargs[] = {&a};
#if HOST_DUP_PHASE >= 0
    const int cuts[4] = {0, HOST_DUP_PHASE + 1, HOST_DUP_PHASE, N_PHASES};
    for (int li = 0; li < 3; ++li) {
        a.ph_lo = (li == 1) ? HOST_DUP_PHASE : (li == 2 ? HOST_DUP_PHASE + 1 : 0); a.ph_hi = (li == 0 || li == 1) ? HOST_DUP_PHASE + 1 : N_PHASES; a.flags = (li == 1) ? HOST_DUP_FLAGS : 0;
        if (li > 0) (void)hipMemsetAsync((char*)d_ws + WS_CTL, 0, CTL_ZERO_BYTES, stream);
        (void)hipLaunchCooperativeKernel((const void*)hymba_fwd, dim3(grid), dim3(NWAVES * 64), kargs, LDS_BYTES, stream);
    }
    (void)cuts;
#else
    a.ph_lo = 0; a.ph_hi = N_PHASES; a.extra_bars = HOST_EXTRA_BARS;
    const hipError_t e = hipLaunchCooperativeKernel((const void*)hymba_fwd, dim3(grid), dim3(NWAVES * 64), kargs, LDS_BYTES, stream);
    if (e != hipSuccess) fprintf(stderr, "kernel_launch: cooperative launch failed: %s (grid %d)\n", hipGetErrorString(e), grid);
#endif
#else
    if (hipMemsetAsync((char*)d_ws + WS_CTL, 0, CTL_ZERO_BYTES, stream) != hipSuccess) return;
    for (int ph = 0; ph < N_PHASES; ++ph) {
        a.ph_lo = ph; a.ph_hi = ph + 1;
        hipLaunchKernelGGL(hymba_fwd, dim3(grid), dim3(NWAVES * 64), LDS_BYTES, stream, a);
    }
#endif
}
```

```cpp
#include <hip/hip_runtime.h>
#include <cstdio>
#include <cstdint>
namespace pg8 {
#define PG8_LAS __attribute__((address_space(3)))
typedef unsigned short bf16_t;
typedef short bf16x8 __attribute__((ext_vector_type(8)));
typedef float f32x4 __attribute__((ext_vector_type(4)));
typedef unsigned u32x4 __attribute__((ext_vector_type(4)));
constexpr int BM = 256, BK = 64, HALF = 128, HTB = HALF * BK * 2  , STAGE_BYTES = 8 * HTB, NXCD = 8, WGM = 8;

__host__ __device__ __forceinline__ int lds_byte(int r, int c) { const int st = (r >> 4) * 2 + (c >> 5), rr = r & 15, cc = c & 31, ob = rr * 64 + cc * 2; return st * 1024 + (ob ^ (((ob >> 9) & 1) << 5)); }
__host__ __device__ __forceinline__ void stage_rc(int b, int& R, int& C) { const int st = b / 1024, sb = b % 1024, swz = sb ^ (((sb >> 9) & 1) << 5); R = (st >> 1) * 16 + swz / 64; C = (st & 1) * 32 + (swz % 64) / 2; }
__host__ __device__ __forceinline__ int perm32(int rho) { const int n = rho >> 4, i = rho & 15; return 8 * (i >> 2) + 4 * n + (i & 3); }

struct Unit { int pm, pn; };
struct Gemm { const bf16_t* A; const bf16_t* Bt; int M, N, K; };

struct StaticOrder {
    int nM, nN, nwg, G, c;
    __host__ __device__ void init(int M, int N, int G_, int c_) { nM = M / BM; nN = N / BM; nwg = nM * nN; G = G_; c = c_; }
    __host__ __device__ bool next(int i, Unit& u) const {
        const long L = (long)i * G + c; if (L >= nwg) return false;
        int wgid = (int)L; { const int q = nwg / NXCD, r = nwg % NXCD, xcd = wgid % NXCD, off = wgid / NXCD; wgid = (xcd < r ? xcd * (q + 1) : r * (q + 1) + (xcd - r) * q) + off; }
        const int nig = WGM * nN, gid = wgid / nig, fm = gid * WGM, gsz = (nM - fm) < WGM ? (nM - fm) : WGM;
        u.pm = fm + ((wgid % nig) % gsz); u.pn = (wgid % nig) / gsz; return true;
    }
    __device__ __forceinline__ void a_ready(const Unit&) const {}
    __device__ __forceinline__ void done(const Unit&) const {}
};


typedef float f32x2 __attribute__((ext_vector_type(2)));
typedef __bf16 bf16x2_t __attribute__((ext_vector_type(2)));
typedef unsigned u32x2 __attribute__((ext_vector_type(2)));
__device__ __forceinline__ unsigned cvt_pk_bf16(float lo, float hi) { f32x2 v = {lo, hi}; bf16x2_t b = __builtin_convertvector(v, bf16x2_t); return __builtin_bit_cast(unsigned, b); }
__device__ __forceinline__ float bf_lo(unsigned w) { return __uint_as_float(w << 16); }
__device__ __forceinline__ float bf_hi(unsigned w) { return __uint_as_float(w & 0xffff0000u); }
__device__ __forceinline__ float sigmoid_f(float x) { return __builtin_amdgcn_rcpf(1.0f + __builtin_amdgcn_exp2f(-1.4426950408889634f * x)); }
__device__ __forceinline__ float gelu_tanh_f(float x) { const float t = x * (1.5957691216057308f + 0.07135481627159149f * x * x); return x * sigmoid_f(t); }

constexpr float NORM_EPS = 1e-6f;
__device__ __forceinline__ float row_rs(const float* ss, int row) {
    const f32x4* p = (const f32x4*)(ss + (size_t)row * 16); const f32x4 a = p[0], b = p[1], c = p[2], d = p[3];
    const float s = ((a[0] + a[1]) + (a[2] + a[3])) + ((b[0] + b[1]) + (b[2] + b[3])) + ((c[0] + c[1]) + (c[2] + c[3])) + ((d[0] + d[1]) + (d[2] + d[3]));
    return 1.0f / sqrtf(s * (1.0f / 1024.0f) + NORM_EPS);
}

template <int MODE> struct EpiBf16 {
    static constexpr bool PERM = true, AFTER_DRAIN = false;
    bf16_t* O; int ldc; const float* ss;
    __device__ __forceinline__ void operator()(const f32x4 (&acc)[2][2][4][2], const Unit& u, int wr, int wc, int fr, int fq) const {
        const int row0 = u.pm * BM + wr * 64 + fr, col0 = u.pn * BM + wc * 32 + 8 * fq;
        const int act = (MODE == 0) ? (u.pn < 4 ? 1 : (u.pn >= 10 ? 2 : 0)) : 0;
#pragma unroll
        for (int ai = 0; ai < 2; ++ai)
#pragma unroll
            for (int m = 0; m < 4; ++m) { const int row = row0 + ai * HALF + m * 16; bf16_t* rowp = O + (size_t)row * ldc + col0;
#pragma unroll
                for (int bj = 0; bj < 2; ++bj) { f32x4 v0 = acc[ai][bj][m][0], v1 = acc[ai][bj][m][1];
                    if (MODE == 0) {
                        if (act == 1) {
#pragma unroll
                            for (int e = 0; e < 4; ++e) { v0[e] = gelu_tanh_f(v0[e]); v1[e] = gelu_tanh_f(v1[e]); } }
                        else if (act == 2) {
#pragma unroll
                            for (int e = 0; e < 4; ++e) { v0[e] = sigmoid_f(v0[e]); v1[e] = sigmoid_f(v1[e]); } }
                    }
                    if (MODE == 2) {
#pragma unroll
                        for (int e = 0; e < 4; ++e) { const float a = fmaxf(v0[e], 0.f), b = fmaxf(v1[e], 0.f); v0[e] = a * a; v1[e] = b * b; } }
                    u32x4 w; w.x = cvt_pk_bf16(v0[0], v0[1]); w.y = cvt_pk_bf16(v0[2], v0[3]); w.z = cvt_pk_bf16(v1[0], v1[1]); w.w = cvt_pk_bf16(v1[2], v1[3]);
                    *(u32x4*)(rowp + bj * HALF) = w; } }
    }
};

template <int MODE> struct EpiRes {
    static constexpr bool PERM = false, AFTER_DRAIN = false;
    const float* rn;
    const bf16_t* Hb; bf16_t* Ho; float* SSO; const float* SSI; const bf16_t* PROJ;
    __device__ __forceinline__ void operator()(const f32x4 (&acc)[2][2][4][2], const Unit& u, int wr, int wc, int fr, int fq) const {
        const int row0 = u.pm * BM + wr * 64 + fr, col0 = u.pn * BM + wc * 32 + 4 * fq;
#pragma unroll
        for (int ai = 0; ai < 2; ++ai)
#pragma unroll
            for (int m = 0; m < 4; ++m) { const int row = row0 + ai * HALF + m * 16; const size_t off = (size_t)row * 1024 + col0;
                float rsc; if (MODE != 0) { rsc = row_rs(SSI, row); if (MODE == 1) rsc = rsc * rsc; } else rsc = rn[row];
                float sq = 0.f;
#pragma unroll
                for (int bj = 0; bj < 2; ++bj)
#pragma unroll
                    for (int n = 0; n < 2; ++n) { const size_t o2 = off + bj * HALF + n * 16; f32x4 h; const f32x4 a = acc[ai][bj][m][n];
                        { const u32x2 hw = *(const u32x2*)(Hb + o2); const f32x4 r = (f32x4){bf_lo(hw.x), bf_hi(hw.x), bf_lo(hw.y), bf_hi(hw.y)};
                            if (MODE == 0) h = r * rsc + a;
                            else if (MODE == 1) h = r + a * rsc;
                            else { const u32x2 pw = *(const u32x2*)(PROJ + o2);
                                h[0] = r[0] + sigmoid_f(a[0] * rsc) * bf_lo(pw.x); h[1] = r[1] + sigmoid_f(a[1] * rsc) * bf_hi(pw.x);
                                h[2] = r[2] + sigmoid_f(a[2] * rsc) * bf_lo(pw.y); h[3] = r[3] + sigmoid_f(a[3] * rsc) * bf_hi(pw.y); } }
                        u32x2 w; w.x = cvt_pk_bf16(h[0], h[1]); w.y = cvt_pk_bf16(h[2], h[3]); *(u32x2*)(Ho + o2) = w;
                        sq += (h[0] * h[0] + h[1] * h[1]) + (h[2] * h[2] + h[3] * h[3]); }
                sq += __shfl_xor(sq, 16); sq += __shfl_xor(sq, 32);
                if (fq == 0) SSO[(size_t)row * 16 + u.pn * 4 + wc] = sq; }
    }
};

template <class Epi, class Sched, bool ALIGN_EPI = false, bool SP2 = false>
__device__ __forceinline__ void gemm_phase(PG8_LAS unsigned char* lds, const Gemm g, const Sched& S, const Epi& E) {
    const int tid = threadIdx.x, wid = __builtin_amdgcn_readfirstlane(tid >> 6), lane = tid & 63, wr = wid >> 2, wc = wid & 3, fr = lane & 15, fq = lane >> 4;
    int K = g.K; asm volatile("" : "+s"(K));
    const int nt = K / BK;
    unsigned voffA[2], voffB[2];
#pragma unroll
    for (int i = 0; i < 2; ++i) { int R, C; stage_rc(tid * 16 + i * 8192, R, C); const int Rb = Epi::PERM ? ((R & ~31) + perm32(R & 31)) : R;
        voffA[i] = (unsigned)(R * K + C) * 2u; voffB[i] = (unsigned)(Rb * K + C) * 2u; }
    const size_t kstep = (size_t)(BK * 2);
    const size_t hstep = (size_t)HALF * K * 2;
    const size_t tstep = 2 * hstep;
    const unsigned ldsw = (unsigned)wid * 1024u;
    const int aoff = lds_byte(wr * 64 + fr, fq * 8), boff = lds_byte(wc * 32 + fr, fq * 8);
#define PG8_SA(b, h) (((b) * 2 + (h)) * HTB)
#define PG8_SB(b, h) ((4 + (b) * 2 + (h)) * HTB)
#define PG8_STAGE(bufoff, gbase, voff) do { _Pragma("unroll") for (int _i = 0; _i < 2; ++_i) \
        __builtin_amdgcn_global_load_lds((const unsigned*)((const char*)(gbase) + (voff)[_i]), (PG8_LAS unsigned*)(lds + (bufoff) + ldsw + _i * 8192), 16, 0, 0); } while (0)
#define PG8_LDA(dst, b, h) do { _Pragma("unroll") for (int m = 0; m < 4; ++m) _Pragma("unroll") for (int k = 0; k < 2; ++k) dst[m][k] = *(const PG8_LAS bf16x8*)(lds + PG8_SA(b, h) + aoff + m * 2048 + k * 1024); } while (0)
#define PG8_LDB(dst, b, h) do { _Pragma("unroll") for (int n = 0; n < 2; ++n) _Pragma("unroll") for (int k = 0; k < 2; ++k) dst[n][k] = *(const PG8_LAS bf16x8*)(lds + PG8_SB(b, h) + boff + n * 2048 + k * 1024); } while (0)
#define PG8_MMA(ai, bj, At, Bt) do { __builtin_amdgcn_s_setprio(1); _Pragma("unroll") for (int m = 0; m < 4; ++m) _Pragma("unroll") for (int n = 0; n < 2; ++n) _Pragma("unroll") for (int k = 0; k < 2; ++k) \
        acc[ai][bj][m][n] = __builtin_amdgcn_mfma_f32_16x16x32_bf16(Bt[n][k], At[m][k], acc[ai][bj][m][n], 0, 0, 0); __builtin_amdgcn_s_setprio(0); } while (0)
#define PG8_WAIT_V(n) asm volatile("s_waitcnt vmcnt(" #n ")" ::: "memory")
#define PG8_WAIT_L(n) asm volatile("s_waitcnt lgkmcnt(" #n ")" ::: "memory")
#define PG8_BAR __builtin_amdgcn_s_barrier()
#define PG8_SCHED __builtin_amdgcn_sched_barrier(0)
    Unit cur, nxt; int ui = 0;
    if (!S.next(0, cur)) return;
    f32x4 acc[2][2][4][2];
#pragma unroll
    for (int a = 0; a < 2; ++a)
#pragma unroll
        for (int b = 0; b < 2; ++b)
#pragma unroll
            for (int m = 0; m < 4; ++m)
#pragma unroll
                for (int n = 0; n < 2; ++n) acc[a][b][m][n] = (f32x4){0.f, 0.f, 0.f, 0.f};
    bf16x8 At[4][2], B0[2][2], B1[2][2];
    const char* cA = (const char*)g.A + (size_t)cur.pm * tstep; const char* cB = (const char*)g.Bt + (size_t)cur.pn * tstep;
    S.a_ready(cur);
    if constexpr (SP2) {
        PG8_STAGE(PG8_SB(0, 0), cB, voffB); PG8_STAGE(PG8_SB(0, 1), cB + hstep, voffB); PG8_STAGE(PG8_SA(0, 0), cA, voffA); PG8_STAGE(PG8_SA(0, 1), cA + hstep, voffA);
        if (wr == 1) PG8_BAR;
        PG8_WAIT_V(2); PG8_BAR;
        PG8_STAGE(PG8_SB(1, 0), cB + kstep, voffB); PG8_STAGE(PG8_SA(1, 0), cA + kstep, voffA); PG8_STAGE(PG8_SB(1, 1), cB + hstep + kstep, voffB);
        PG8_WAIT_V(6); PG8_BAR;
    } else {
        PG8_STAGE(PG8_SB(0, 0), cB, voffB); PG8_STAGE(PG8_SA(0, 0), cA, voffA); PG8_STAGE(PG8_SB(0, 1), cB + hstep, voffB); PG8_STAGE(PG8_SA(0, 1), cA + hstep, voffA);
        if (wr == 1) PG8_BAR;
        PG8_WAIT_V(4); PG8_BAR;
        PG8_STAGE(PG8_SB(1, 0), cB + kstep, voffB); PG8_STAGE(PG8_SA(1, 0), cA + kstep, voffA); PG8_STAGE(PG8_SB(1, 1), cB + hstep + kstep, voffB);
        PG8_WAIT_V(6); PG8_BAR;
    }
    for (;;) {
        const bool has_next = S.next(ui + 1, nxt);
        const char* nA = has_next ? (const char*)g.A + (size_t)nxt.pm * tstep : cA; const char* nB = has_next ? (const char*)g.Bt + (size_t)nxt.pn * tstep : cB;
        for (int t = 0; t < nt; t += 2) {
            const bool last = (t == nt - 2);
            const char* a1 = cA + (size_t)(t + 1) * kstep;
            const char* a2 = last ? nA : cA + (size_t)(t + 2) * kstep; const char* b2 = last ? nB : cB + (size_t)(t + 2) * kstep;
            const char* a3 = a2 + kstep; const char* b3 = b2 + kstep;
            if (last && has_next) S.a_ready(nxt);
            if constexpr (SP2) {
            PG8_LDB(B0, 0, 0); PG8_LDB(B1, 0, 1); PG8_SCHED; PG8_LDA(At, 0, 0); PG8_STAGE(PG8_SA(1, 1), a1 + hstep, voffA);
            PG8_WAIT_V(8); PG8_WAIT_L(0); PG8_BAR; PG8_MMA(0, 0, At, B0); PG8_MMA(0, 1, At, B1); PG8_BAR; PG8_SCHED;
            PG8_LDA(At, 0, 1); PG8_STAGE(PG8_SB(0, 0), b2, voffB); PG8_STAGE(PG8_SB(0, 1), b2 + hstep, voffB); PG8_STAGE(PG8_SA(0, 0), a2, voffA);
            PG8_WAIT_V(8); PG8_WAIT_L(0); PG8_BAR; PG8_MMA(1, 0, At, B0); PG8_MMA(1, 1, At, B1); PG8_BAR; PG8_SCHED;
            PG8_LDB(B0, 1, 0); PG8_LDB(B1, 1, 1); PG8_SCHED; PG8_LDA(At, 1, 0); PG8_STAGE(PG8_SA(0, 1), a2 + hstep, voffA);
            PG8_WAIT_V(8); PG8_WAIT_L(0); PG8_BAR; PG8_MMA(0, 0, At, B0); PG8_MMA(0, 1, At, B1); PG8_BAR; PG8_SCHED;
            PG8_LDA(At, 1, 1); PG8_STAGE(PG8_SB(1, 0), b3, voffB); PG8_STAGE(PG8_SB(1, 1), b3 + hstep, voffB); PG8_STAGE(PG8_SA(1, 0), a3, voffA);
            PG8_WAIT_V(8); PG8_WAIT_L(0); PG8_BAR; PG8_MMA(1, 0, At, B0); PG8_MMA(1, 1, At, B1); PG8_BAR; PG8_SCHED;
            } else {
            PG8_LDB(B0, 0, 0); PG8_SCHED; PG8_LDA(At, 0, 0); PG8_STAGE(PG8_SA(1, 1), a1 + hstep, voffA);
            PG8_WAIT_L(8); PG8_BAR; PG8_WAIT_L(0); PG8_MMA(0, 0, At, B0); PG8_BAR; PG8_SCHED;
            PG8_LDB(B1, 0, 1); PG8_STAGE(PG8_SB(0, 0), b2, voffB);
            PG8_BAR; PG8_WAIT_L(0); PG8_MMA(0, 1, At, B1); PG8_BAR;
            PG8_LDA(At, 0, 1); PG8_STAGE(PG8_SA(0, 0), a2, voffA);
            PG8_BAR; PG8_WAIT_L(0); PG8_MMA(1, 0, At, B0); PG8_BAR; PG8_SCHED;
            PG8_STAGE(PG8_SB(0, 1), b2 + hstep, voffB);
            PG8_WAIT_V(6); PG8_BAR; PG8_MMA(1, 1, At, B1); PG8_BAR;
            PG8_LDB(B0, 1, 0); PG8_SCHED; PG8_LDA(At, 1, 0); PG8_STAGE(PG8_SA(0, 1), a2 + hstep, voffA);
            PG8_WAIT_L(8); PG8_BAR; PG8_WAIT_L(0); PG8_MMA(0, 0, At, B0); PG8_BAR; PG8_SCHED;
            PG8_LDB(B1, 1, 1); PG8_STAGE(PG8_SB(1, 0), b3, voffB);
            PG8_BAR; PG8_WAIT_L(0); PG8_MMA(0, 1, At, B1); PG8_BAR;
            PG8_LDA(At, 1, 1); PG8_STAGE(PG8_SA(1, 0), a3, voffA);
            PG8_BAR; PG8_WAIT_L(0); PG8_MMA(1, 0, At, B0); PG8_BAR; PG8_SCHED;
            PG8_STAGE(PG8_SB(1, 1), b3 + hstep, voffB);
            PG8_WAIT_V(6); PG8_BAR; PG8_MMA(1, 1, At, B1); PG8_BAR;
            }
        }
        if constexpr (ALIGN_EPI) { if (wr == 0) PG8_BAR; }
        if constexpr (!Epi::AFTER_DRAIN) { E(acc, cur, wr, wc, fr, fq); S.done(cur); }
        if (!has_next) break;
#pragma unroll
        for (int a = 0; a < 2; ++a)
#pragma unroll
            for (int b = 0; b < 2; ++b)
#pragma unroll
                for (int m = 0; m < 4; ++m)
#pragma unroll
                    for (int n = 0; n < 2; ++n) acc[a][b][m][n] = (f32x4){0.f, 0.f, 0.f, 0.f};
        cur = nxt; cA = nA; cB = nB; ++ui;
        if constexpr (ALIGN_EPI) { if (wr == 1) PG8_BAR; }
    }
    PG8_WAIT_V(0);
    if constexpr (!ALIGN_EPI) { if (wr == 0) PG8_BAR; }
    PG8_BAR;
    if constexpr (Epi::AFTER_DRAIN) { E.fused(acc, cur, wr, wc, fr, fq, lds, wid, lane); S.done(cur); }
#undef PG8_SA
#undef PG8_SB
#undef PG8_STAGE
#undef PG8_LDA
#undef PG8_LDB
#undef PG8_MMA
#undef PG8_WAIT_V
#undef PG8_WAIT_L
#undef PG8_BAR
#undef PG8_SCHED
}
}

namespace mix {
#define LAS __attribute__((address_space(3)))
using pg8::bf16_t; using pg8::bf16x8; using pg8::f32x4; using pg8::u32x4; using pg8::u32x2; using pg8::cvt_pk_bf16; using pg8::bf_lo; using pg8::bf_hi; using pg8::sigmoid_f;
typedef short v4i16_t __attribute__((ext_vector_type(4)));
constexpr int NP = 16384, NS = 1024, ZLD = 3072;
constexpr int ZU = 0, ZVG = 512, ZQ = 1024, ZK = 1536, ZV = 2048, ZO = 2560;
constexpr int TS = 288;
constexpr int IMG = 128 * TS;
constexpr int IMG0 = 0, IMG1 = IMG, IMG2 = 2 * IMG, SC_OFF = 3 * IMG;
constexpr float EPS = 1e-6f;

template <int CTRL> __device__ __forceinline__ float dpp_mov(float v) { return __int_as_float(__builtin_amdgcn_update_dpp(0, __float_as_int(v), CTRL, 0xF, 0xF, true)); }
__device__ __forceinline__ float row_sum16(float v) { v += dpp_mov<0xB1>(v); v += dpp_mov<0x4E>(v); v += dpp_mov<0x141>(v); v += dpp_mov<0x140>(v); return v; }
__device__ __forceinline__ float row_max16(float v) { v = fmaxf(v, dpp_mov<0xB1>(v)); v = fmaxf(v, dpp_mov<0x4E>(v)); v = fmaxf(v, dpp_mov<0x141>(v)); v = fmaxf(v, dpp_mov<0x140>(v)); return v; }
__device__ __forceinline__ float rl(float v, int l) { return __int_as_float(__builtin_amdgcn_readlane(__float_as_int(v), l)); }
__device__ __forceinline__ float wave_sum(float v) { v = row_sum16(v); return (rl(v, 0) + rl(v, 16)) + (rl(v, 32) + rl(v, 48)); }
__device__ __forceinline__ float wave_max(float v) { v = row_max16(v); return fmaxf(fmaxf(rl(v, 0), rl(v, 16)), fmaxf(rl(v, 32), rl(v, 48))); }
__device__ __forceinline__ float scan_add(float v, int lane) {
#pragma unroll
    for (int o = 1; o < 64; o <<= 1) { const float t = __shfl_up(v, o); if (lane >= o) v += t; }
    return v;
}
__device__ __forceinline__ float scan_max(float v, int lane) {
#pragma unroll
    for (int o = 1; o < 64; o <<= 1) { const float t = __shfl_up(v, o); if (lane >= o) v = fmaxf(v, t); }
    return v;
}
__device__ __forceinline__ bf16x8 tr2(LAS const unsigned char* p0, LAS const unsigned char* p1) {
    const v4i16_t a = __builtin_amdgcn_ds_read_tr16_b64_v4i16((LAS v4i16_t*)p0);
    const v4i16_t b = __builtin_amdgcn_ds_read_tr16_b64_v4i16((LAS v4i16_t*)p1);
    return (bf16x8){a[0], a[1], a[2], a[3], b[0], b[1], b[2], b[3]};
}
__device__ __forceinline__ void unpack8(const u32x4 w, float (&x)[8]) {
    x[0] = bf_lo(w.x); x[1] = bf_hi(w.x); x[2] = bf_lo(w.y); x[3] = bf_hi(w.y); x[4] = bf_lo(w.z); x[5] = bf_hi(w.z); x[6] = bf_lo(w.w); x[7] = bf_hi(w.w);
}
__device__ __forceinline__ u32x4 pack8(const float (&x)[8]) {
    u32x4 w; w.x = cvt_pk_bf16(x[0], x[1]); w.y = cvt_pk_bf16(x[2], x[3]); w.z = cvt_pk_bf16(x[4], x[5]); w.w = cvt_pk_bf16(x[6], x[7]); return w;
}

struct MixP {
    const bf16_t* Z; bf16_t* YC; const float* IG; const float* LF;
    const bf16_t* WSb;
    const float *gm_ws, *lng, *lnb, *bs, *mlnorm;
    float *KV, *NLOC, *NST, *CH, *MST;
    const float *stC, *stN, *stM;
    float *oCp, *oNp, *oMp, *oVp, *oCs, *oNs, *oMs, *oVs;
};

__device__ __forceinline__ void gmlp_unit(LAS unsigned char* lds, const MixP& P, int b, int c, int h, int tid) {
    const int lane = tid & 63, w = __builtin_amdgcn_readfirstlane(tid >> 6), fr = lane & 15, kq = lane >> 4, q = fr >> 2, p = fr & 3;
    const int r0 = b * 2048 + c * 128;
    LAS unsigned char* img = lds + IMG0;
    float g8[8], b8[8];
    { const f32x4 a = *(const f32x4*)(P.lng + 8 * lane), a2 = *(const f32x4*)(P.lng + 8 * lane + 4), c0 = *(const f32x4*)(P.lnb + 8 * lane), c1 = *(const f32x4*)(P.lnb + 8 * lane + 4);
#pragma unroll
      for (int e = 0; e < 4; ++e) { g8[e] = a[e]; g8[4 + e] = a2[e]; b8[e] = c0[e]; b8[4 + e] = c1[e]; } }
    float* vout = (c == 15) ? P.oVp + (size_t)b * 128 * 512 : nullptr;
    u32x4 raw[16];
#pragma unroll
    for (int i = 0; i < 16; ++i) raw[i] = *(const u32x4*)(P.Z + (size_t)(r0 + 16 * w + i) * ZLD + ZVG + 8 * lane);
    const bf16_t* Wrow = P.WSb + ((size_t)h * 128 + 16 * w + fr) * 128 + 8 * kq;
    bf16x8 wf[4];
#pragma unroll
    for (int st = 0; st < 4; ++st) wf[st] = *(const bf16x8*)(Wrow + 32 * st);
    const bf16_t* urow = P.Z + (size_t)(r0 + 16 * w + fr) * ZLD + ZU + h * 128 + 4 * kq;
    u32x2 uw[8];
#pragma unroll
    for (int n = 0; n < 8; ++n) uw[n] = *(const u32x2*)(urow + 16 * n);
    const float bsv = P.bs[h * 128 + 16 * w + fr];
#pragma unroll
    for (int i = 0; i < 16; ++i) { const int t = 16 * w + i;
        float x[8]; unpack8(raw[i], x);
        float s = ((x[0] + x[1]) + (x[2] + x[3])) + ((x[4] + x[5]) + (x[6] + x[7]));
        const float mean = wave_sum(s) * (1.0f / 512.0f);
        float q2 = 0.f;
#pragma unroll
        for (int e = 0; e < 8; ++e) { x[e] -= mean; q2 += x[e] * x[e]; }
        const float rstd = 1.0f / sqrtf(wave_sum(q2) * (1.0f / 512.0f) + EPS);
        if (kq == h) {
#pragma unroll
            for (int e = 0; e < 8; ++e) x[e] = x[e] * rstd * g8[e] + b8[e];
            *(LAS u32x4*)(img + t * TS + fr * 16) = pack8(x);
            if (vout) { float* vo = vout + (size_t)t * 512 + 8 * lane; *(f32x4*)vo = (f32x4){x[0], x[1], x[2], x[3]}; *(f32x4*)(vo + 4) = (f32x4){x[4], x[5], x[6], x[7]}; }
        }
    }
    __syncthreads();
    f32x4 acc[8];
#pragma unroll
    for (int n = 0; n < 8; ++n) acc[n] = (f32x4){0.f, 0.f, 0.f, 0.f};
    const int nsteps = (w >> 1) + 1;
    LAS const unsigned char* trb = img + (8 * kq + q) * TS + 8 * p;
#pragma unroll
    for (int st = 0; st < 4; ++st) if (st < nsteps) {
#pragma unroll
        for (int n = 0; n < 8; ++n) { const bf16x8 vf = tr2(trb + (32 * st) * TS + 32 * n, trb + (32 * st + 4) * TS + 32 * n);
            acc[n] = __builtin_amdgcn_mfma_f32_16x16x32_bf16(vf, wf[st], acc[n], 0, 0, 0); }
    }
    { const int t = 16 * w + fr;
      bf16_t* yrow = P.YC + (size_t)(r0 + t) * 1024 + h * 128 + 4 * kq;
#pragma unroll
      for (int n = 0; n < 8; ++n) { u32x2 o;
          o.x = cvt_pk_bf16(bf_lo(uw[n].x) * (acc[n][0] + bsv), bf_hi(uw[n].x) * (acc[n][1] + bsv));
          o.y = cvt_pk_bf16(bf_lo(uw[n].y) * (acc[n][2] + bsv), bf_hi(uw[n].y) * (acc[n][3] + bsv));
          *(u32x2*)(yrow + 16 * n) = o; } }
    __syncthreads();
}

__device__ __forceinline__ void kv_unit(LAS unsigned char* lds, const MixP& P, int b, int h, int c, int tid) {
    const int lane = tid & 63, w = __builtin_amdgcn_readfirstlane(tid >> 6), fr = lane & 15, kq = lane >> 4, q = fr >> 2, p = fr & 3;
    const int r0 = b * 2048 + c * 128, unit = (b * 4 + h) * 16 + c;
    LAS float* wl = (LAS float*)(lds + SC_OFF);
    float lf0 = 0.f, lf1 = 0.f, ig0 = 0.f, ig1 = 0.f;
    if (w == 0) { const int s0 = r0 + 2 * lane; lf0 = P.LF[(size_t)s0 * 4 + h]; lf1 = P.LF[(size_t)(s0 + 1) * 4 + h]; ig0 = P.IG[(size_t)s0 * 4 + h]; ig1 = P.IG[(size_t)(s0 + 1) * 4 + h]; }
    u32x4 kraw[4], vraw[4];
#pragma unroll
    for (int i = 0; i < 4; ++i) { const int id = tid + 512 * i, row = id >> 4, ch = id & 15;
        const bf16_t* zr = P.Z + (size_t)(r0 + row) * ZLD + h * 128 + ch * 8; kraw[i] = *(const u32x4*)(zr + ZK); vraw[i] = *(const u32x4*)(zr + ZV); }
    if (w == 0) {
        const float Pc = scan_add(lf0 + lf1, lane), b1 = Pc, b0 = Pc - lf1, B = __shfl(Pc, 63);
        const float x0 = ig0 - b0, x1 = ig1 - b1, xm = wave_max(fmaxf(x0, x1));
        wl[2 * lane] = __expf(x0 - xm); wl[2 * lane + 1] = __expf(x1 - xm);
        if (lane == 0) { P.CH[unit * 2] = B; P.CH[unit * 2 + 1] = B + xm; }
    }
    __syncthreads();
#pragma unroll
    for (int i = 0; i < 4; ++i) { const int id = tid + 512 * i, row = id >> 4, ch = id & 15;
        float x[8]; unpack8(kraw[i], x); const float ws = wl[row];
#pragma unroll
        for (int e = 0; e < 8; ++e) x[e] *= ws;
        *(LAS u32x4*)(lds + IMG0 + row * TS + ch * 16) = pack8(x);
        *(LAS u32x4*)(lds + IMG1 + row * TS + ch * 16) = vraw[i]; }
    __syncthreads();
    f32x4 acc[8], accn = (f32x4){0.f, 0.f, 0.f, 0.f};
#pragma unroll
    for (int n = 0; n < 8; ++n) acc[n] = (f32x4){0.f, 0.f, 0.f, 0.f};
    const bf16x8 ones = (bf16x8){0x3F80, 0x3F80, 0x3F80, 0x3F80, 0x3F80, 0x3F80, 0x3F80, 0x3F80};
    LAS const unsigned char* trk = lds + IMG0 + (8 * kq + q) * TS + 8 * p + 32 * w;
    LAS const unsigned char* trv = lds + IMG1 + (8 * kq + q) * TS + 8 * p;
#pragma unroll
    for (int st = 0; st < 4; ++st) {
        const bf16x8 kf = tr2(trk + (32 * st) * TS, trk + (32 * st + 4) * TS);
        accn = __builtin_amdgcn_mfma_f32_16x16x32_bf16(ones, kf, accn, 0, 0, 0);
#pragma unroll
        for (int n = 0; n < 8; ++n) { const bf16x8 vf = tr2(trv + (32 * st) * TS + 32 * n, trv + (32 * st + 4) * TS + 32 * n);
            acc[n] = __builtin_amdgcn_mfma_f32_16x16x32_bf16(vf, kf, acc[n], 0, 0, 0); }
    }
    float* kvp = P.KV + (size_t)unit * 16384 + (16 * w + fr) * 128 + 4 * kq;
#pragma unroll
    for (int n = 0; n < 8; ++n) *(f32x4*)(kvp + 16 * n) = acc[n];
    if (kq == 0) P.NLOC[unit * 128 + 16 * w + fr] = accn[0];
    __syncthreads();
}

__device__ __forceinline__ void scan_unit(const MixP& P, int bh, int slice, int tid) {
    const size_t base = (size_t)bh * 16 * 16384 + slice * 2048 + tid * 4;
    f32x4 C = (f32x4){0.f, 0.f, 0.f, 0.f}; float M = 0.f, nv = 0.f;
    const bool nthr = (slice == 0 && tid < 128);
    f32x4 kvv[16];
#pragma unroll
    for (int c = 0; c < 16; ++c) kvv[c] = *(const f32x4*)(P.KV + base + (size_t)c * 16384);
#pragma unroll
    for (int c = 0; c < 16; ++c) {
        const float B = P.CH[(bh * 16 + c) * 2], a = P.CH[(bh * 16 + c) * 2 + 1];
        const float Mn = fmaxf(B + M, a), dec = __expf(B + M - Mn), add = __expf(a - Mn);
        float* kp = P.KV + base + (size_t)c * 16384;
        const f32x4 kv = kvv[c]; *(f32x4*)kp = C; C = dec * C + add * kv;
        if (nthr) { const float nl = P.NLOC[(bh * 16 + c) * 128 + tid]; P.NST[(bh * 16 + c) * 128 + tid] = nv; nv = dec * nv + add * nl; if (tid == 0) P.MST[bh * 16 + c] = M; }
        M = Mn;
    }
    *(f32x4*)(P.oCp + (size_t)bh * 16384 + slice * 2048 + tid * 4) = C;
    if (nthr) { P.oNp[bh * 128 + tid] = nv; if (tid == 0) P.oMp[bh] = M; }
}

__device__ __forceinline__ void mlo_unit(LAS unsigned char* lds, const MixP& P, int b, int h, int c, int tid) {
    const int lane = tid & 63, w = __builtin_amdgcn_readfirstlane(tid >> 6), fr = lane & 15, kq = lane >> 4, q = fr >> 2, p = fr & 3;
    const int r0 = b * 2048 + c * 128, unit = (b * 4 + h) * 16 + c;
    LAS float* xs = (LAS float*)(lds + SC_OFF); LAS float* ys = xs + 128; LAS float* wint = xs + 256; LAS float* emt = xs + 384; LAS float* nst = xs + 512;
    const float Mc = P.MST[unit];
    float lf0 = 0.f, lf1 = 0.f, ig0 = 0.f, ig1 = 0.f, n0v = 0.f, n1v = 0.f;
    if (w == 0) { const int s0 = r0 + 2 * lane; lf0 = P.LF[(size_t)s0 * 4 + h]; lf1 = P.LF[(size_t)(s0 + 1) * 4 + h]; ig0 = P.IG[(size_t)s0 * 4 + h]; ig1 = P.IG[(size_t)(s0 + 1) * 4 + h]; }
    else if (w == 1) { n0v = P.NST[unit * 128 + lane]; n1v = P.NST[unit * 128 + lane + 64]; }
    const int t = 16 * w + fr;
    const bf16_t* zrow = P.Z + (size_t)(r0 + t) * ZLD + h * 128;
    u32x4 kraw[4], vraw[4]; f32x4 craw[8]; bf16x8 qf[4];
#pragma unroll
    for (int i = 0; i < 4; ++i) { const int id = tid + 512 * i, row = id >> 4, ch = id & 15;
        const bf16_t* zr = P.Z + (size_t)(r0 + row) * ZLD + h * 128 + ch * 8; kraw[i] = *(const u32x4*)(zr + ZK); vraw[i] = *(const u32x4*)(zr + ZV); }
    { const float* cs = P.KV + (size_t)unit * 16384;
#pragma unroll
      for (int i = 0; i < 8; ++i) { const int id = tid + 512 * i, row = id >> 5, c4 = id & 31; craw[i] = *(const f32x4*)(cs + row * 128 + c4 * 4); } }
#pragma unroll
    for (int ds = 0; ds < 4; ++ds) qf[ds] = *(const bf16x8*)(zrow + ZQ + 32 * ds + 8 * kq);
    if (w == 0) {
        const float Pc = scan_add(lf0 + lf1, lane), b1 = Pc, b0 = Pc - lf1;
        const float x0 = ig0 - b0, x1 = ig1 - b1;
        const float PM = scan_max(fmaxf(x0, x1), lane); float prev = __shfl_up(PM, 1); if (lane == 0) prev = -INFINITY;
        const float y0 = fmaxf(Mc, fmaxf(prev, x0)), y1 = fmaxf(Mc, PM);
        xs[2 * lane] = x0; xs[2 * lane + 1] = x1; ys[2 * lane] = y0; ys[2 * lane + 1] = y1;
        wint[2 * lane] = __expf(Mc - y0); wint[2 * lane + 1] = __expf(Mc - y1);
        emt[2 * lane] = __expf(-(b0 + y0)); emt[2 * lane + 1] = __expf(-(b1 + y1));
    } else if (w == 1) { nst[lane] = n0v; nst[lane + 64] = n1v; }
#pragma unroll
    for (int i = 0; i < 4; ++i) { const int id = tid + 512 * i, row = id >> 4, ch = id & 15;
        *(LAS u32x4*)(lds + IMG0 + row * TS + ch * 16) = kraw[i];
        *(LAS u32x4*)(lds + IMG1 + row * TS + ch * 16) = vraw[i]; }
#pragma unroll
    for (int i = 0; i < 8; ++i) { const int id = tid + 512 * i, row = id >> 5, c4 = id & 31;
        u32x2 o; o.x = cvt_pk_bf16(craw[i][0], craw[i][1]); o.y = cvt_pk_bf16(craw[i][2], craw[i][3]); *(LAS u32x2*)(lds + IMG2 + row * TS + c4 * 8) = o; }
    __syncthreads();
    u32x2 ow[8];
#pragma unroll
    for (int n = 0; n < 8; ++n) ow[n] = *(const u32x2*)(zrow + ZO + 16 * n + 4 * kq);
    float dn = 0.f;
#pragma unroll
    for (int ds = 0; ds < 4; ++ds)
#pragma unroll
        for (int e = 0; e < 8; ++e) dn += __uint_as_float(((unsigned)(unsigned short)qf[ds][e]) << 16) * nst[32 * ds + 8 * kq + e];
    dn += __shfl_xor(dn, 16); dn += __shfl_xor(dn, 32);
    LAS const unsigned char* trv = lds + IMG1 + (4 * kq + q) * TS + 8 * p;
    LAS const unsigned char* trc = lds + IMG2 + (8 * kq + q) * TS + 8 * p;
    const float wi = wint[t];
    f32x4 o1[8];
#pragma unroll
    for (int n = 0; n < 8; ++n) o1[n] = (f32x4){0.f, 0.f, 0.f, 0.f};
#pragma unroll
    for (int ds = 0; ds < 4; ++ds)
#pragma unroll
        for (int n = 0; n < 8; ++n) { const bf16x8 cf = tr2(trc + (32 * ds) * TS + 32 * n, trc + (32 * ds + 4) * TS + 32 * n);
            o1[n] = __builtin_amdgcn_mfma_f32_16x16x32_bf16(cf, qf[ds], o1[n], 0, 0, 0); }
#pragma unroll
    for (int n = 0; n < 8; ++n) o1[n] = o1[n] * wi;
    f32x4 aS[8];
#pragma unroll
    for (int j = 0; j < 8; ++j) aS[j] = (f32x4){0.f, 0.f, 0.f, 0.f};
#pragma unroll
    for (int j = 0; j < 8; ++j) if (j <= w) {
#pragma unroll
        for (int ds = 0; ds < 4; ++ds) { const bf16x8 kf = *(LAS const bf16x8*)(lds + IMG0 + (16 * j + fr) * TS + (32 * ds + 8 * kq) * 2);
            aS[j] = __builtin_amdgcn_mfma_f32_16x16x32_bf16(kf, qf[ds], aS[j], 0, 0, 0); } }
    const float yt = ys[t]; float dsum = 0.f;
#pragma unroll
    for (int j = 0; j < 8; ++j) if (j <= w) {
#pragma unroll
        for (int r = 0; r < 4; ++r) { const int s = 16 * j + 4 * kq + r; const float wg = (s <= t) ? __expf(xs[s] - yt) : 0.f; aS[j][r] *= wg; dsum += aS[j][r]; } }
    dsum += __shfl_xor(dsum, 16); dsum += __shfl_xor(dsum, 32);
    const float den = dsum + wi * dn, rinv = 1.0f / fmaxf(fabsf(den), emt[t]);
#pragma unroll
    for (int st = 0; st < 4; ++st) if (2 * st <= w) {
        u32x4 sw; sw.x = cvt_pk_bf16(aS[2 * st][0], aS[2 * st][1]); sw.y = cvt_pk_bf16(aS[2 * st][2], aS[2 * st][3]);
        sw.z = cvt_pk_bf16(aS[2 * st + 1][0], aS[2 * st + 1][1]); sw.w = cvt_pk_bf16(aS[2 * st + 1][2], aS[2 * st + 1][3]);
        const bf16x8 sf = __builtin_bit_cast(bf16x8, sw);
#pragma unroll
        for (int n = 0; n < 8; ++n) { const bf16x8 vf = tr2(trv + (32 * st) * TS + 32 * n, trv + (32 * st + 16) * TS + 32 * n);
            o1[n] = __builtin_amdgcn_mfma_f32_16x16x32_bf16(vf, sf, o1[n], 0, 0, 0); } }
    float ssq = 0.f;
#pragma unroll
    for (int n = 0; n < 8; ++n)
#pragma unroll
        for (int r = 0; r < 4; ++r) { const float hv = o1[n][r] * rinv; o1[n][r] = hv; ssq += hv * hv; }
    ssq += __shfl_xor(ssq, 16); ssq += __shfl_xor(ssq, 32);
    const float rn = 1.0f / sqrtf(ssq * (1.0f / 128.0f) + EPS);
    bf16_t* yrow = P.YC + (size_t)(r0 + t) * 1024 + 512 + h * 128 + 4 * kq;
#pragma unroll
    for (int n = 0; n < 8; ++n) { const f32x4 g = *(const f32x4*)(P.mlnorm + h * 128 + 4 * kq + 16 * n); u32x2 o;
        o.x = cvt_pk_bf16(bf_lo(ow[n].x) * o1[n][0] * rn * g[0], bf_hi(ow[n].x) * o1[n][1] * rn * g[1]);
        o.y = cvt_pk_bf16(bf_lo(ow[n].y) * o1[n][2] * rn * g[2], bf_hi(ow[n].y) * o1[n][3] * rn * g[3]);
        *(u32x2*)(yrow + 16 * n) = o; }
    __syncthreads();
}

__device__ __forceinline__ void sample_unit(LAS unsigned char* lds, const MixP& P, int b, int h, int tid) {
    const int lane = tid & 63, w = __builtin_amdgcn_readfirstlane(tid >> 6);
    const int r0 = NP + b * 8, bh = b * 4 + h;
    LAS float* ql = (LAS float*)lds; LAS float* kl = ql + 1024; LAS float* vl = ql + 2048; LAS float* vnl = ql + 3072; LAS float* Sl = ql + 4096;
    LAS float* gsx = ql + 4160; LAS float* gsy = gsx + 8; LAS float* gwi = gsx + 16; LAS float* gem = gsx + 24; LAS float* gwe = gsx + 32; LAS float* gsc = gsx + 40; LAS float* qn = gsx + 48;
    LAS float* red = (LAS float*)(lds + 32768);
    f32x4 cvv[8];
    { const float* cs = P.stC + (size_t)bh * 16384 + (tid >> 5) * 128 + 4 * (tid & 31);
#pragma unroll
      for (int i = 0; i < 8; ++i) cvv[i] = *(const f32x4*)(cs + (size_t)(16 * i) * 128); }
    if (tid == 0) {
        const float m0 = P.stM[bh]; float bc = 0.f, pm = -INFINITY, mt = 0.f; float xv[8];
#pragma unroll
        for (int t = 0; t < 8; ++t) { const float lf = P.LF[(size_t)(r0 + t) * 4 + h], ig = P.IG[(size_t)(r0 + t) * 4 + h];
            bc += lf; const float x = ig - bc; pm = fmaxf(pm, x); const float y = fmaxf(m0, pm); mt = bc + y; xv[t] = x;
            gsx[t] = x; gsy[t] = y; gwi[t] = __expf(m0 - y); gem[t] = __expf(-mt); }
        const float mnew = mt;
#pragma unroll
        for (int t = 0; t < 8; ++t) gwe[t] = __expf(bc + xv[t] - mnew);
        gsc[0] = __expf(bc + m0 - mnew); gsc[1] = mnew;
    }
    { const int t = tid >> 6, e = 2 * (tid & 63); const bf16_t* zr = P.Z + (size_t)(r0 + t) * ZLD + h * 128 + e;
      const unsigned qw = *(const unsigned*)(zr + ZQ), kw = *(const unsigned*)(zr + ZK), vw = *(const unsigned*)(zr + ZV);
      ql[t * 128 + e] = bf_lo(qw); ql[t * 128 + e + 1] = bf_hi(qw); kl[t * 128 + e] = bf_lo(kw); kl[t * 128 + e + 1] = bf_hi(kw); vl[t * 128 + e] = bf_lo(vw); vl[t * 128 + e + 1] = bf_hi(vw); }
    { const int t = w;
      const u32x4 raw = *(const u32x4*)(P.Z + (size_t)(r0 + t) * ZLD + ZVG + 8 * lane);
      float x[8]; unpack8(raw, x);
      float s = ((x[0] + x[1]) + (x[2] + x[3])) + ((x[4] + x[5]) + (x[6] + x[7]));
      const float mean = wave_sum(s) * (1.0f / 512.0f); float q2 = 0.f;
#pragma unroll
      for (int e = 0; e < 8; ++e) { x[e] -= mean; q2 += x[e] * x[e]; }
      const float rstd = 1.0f / sqrtf(wave_sum(q2) * (1.0f / 512.0f) + EPS);
      if ((lane >> 4) == h) { const f32x4 a = *(const f32x4*)(P.lng + 8 * lane), a2 = *(const f32x4*)(P.lng + 8 * lane + 4), c0 = *(const f32x4*)(P.lnb + 8 * lane), c1 = *(const f32x4*)(P.lnb + 8 * lane + 4);
#pragma unroll
          for (int e = 0; e < 4; ++e) { x[e] = x[e] * rstd * a[e] + c0[e]; x[4 + e] = x[4 + e] * rstd * a2[e] + c1[e]; }
          float* vo = P.oVs + ((size_t)b * 8 + t) * 512 + 8 * lane; *(f32x4*)vo = (f32x4){x[0], x[1], x[2], x[3]}; *(f32x4*)(vo + 4) = (f32x4){x[4], x[5], x[6], x[7]};
#pragma unroll
          for (int e = 0; e < 8; ++e) vnl[t * 128 + 8 * (lane & 15) + e] = x[e]; } }
    __syncthreads();
    if (tid < 64) { const int t = tid >> 3, s = tid & 7; float dot = 0.f;
        for (int d = 0; d < 128; ++d) dot += ql[t * 128 + d] * kl[s * 128 + d];
        Sl[tid] = (s <= t) ? dot * __expf(gsx[s] - gsy[t]) : 0.f; }
    else if (tid < 72) { const int t = tid - 64; float dot = 0.f; for (int d = 0; d < 128; ++d) dot += ql[t * 128 + d] * P.stN[bh * 128 + d]; qn[t] = dot; }
    { const int t = w, e = 2 * lane; float s0 = 0.f, s1 = 0.f;
      for (int j = 0; j <= t; ++j) { const float wv = P.gm_ws[(size_t)h * 16384 + t * 128 + j]; s0 += wv * vnl[j * 128 + e]; s1 += wv * vnl[j * 128 + e + 1]; }
      const float bsv = P.bs[h * 128 + t]; const unsigned uw = *(const unsigned*)(P.Z + (size_t)(r0 + t) * ZLD + ZU + h * 128 + e);
      *(unsigned*)(P.YC + (size_t)(r0 + t) * 1024 + h * 128 + e) = cvt_pk_bf16(bf_lo(uw) * (s0 + bsv), bf_hi(uw) * (s1 + bsv)); }
    const float dec = gsc[0];
    { const int eg = tid & 31, dq = tid >> 5;
      f32x4 aq[8];
#pragma unroll
      for (int t = 0; t < 8; ++t) aq[t] = (f32x4){0.f, 0.f, 0.f, 0.f};
      f32x4 v4[8];
#pragma unroll
      for (int s = 0; s < 8; ++s) v4[s] = *(LAS const f32x4*)(vl + s * 128 + 4 * eg);
      float* co = P.oCs + (size_t)bh * 16384;
#pragma unroll
      for (int i = 0; i < 8; ++i) { const int d = dq + 16 * i; const f32x4 cv = cvv[i];
          f32x4 cn = dec * cv;
#pragma unroll
          for (int t = 0; t < 8; ++t) { aq[t] += ql[t * 128 + d] * cv; cn += (gwe[t] * kl[t * 128 + d]) * v4[t]; }
          *(f32x4*)(co + d * 128 + 4 * eg) = cn; }
#pragma unroll
      for (int t = 0; t < 8; ++t) *(LAS f32x4*)(red + (dq * 8 + t) * 128 + 4 * eg) = aq[t]; }
    __syncthreads();
    { const int t = w, e = 2 * lane; float qc0 = 0.f, qc1 = 0.f;
#pragma unroll
      for (int dq = 0; dq < 16; ++dq) { qc0 += red[(dq * 8 + t) * 128 + e]; qc1 += red[(dq * 8 + t) * 128 + e + 1]; }
      float n0 = 0.f, n1 = 0.f, dsum = 0.f;
#pragma unroll
      for (int s = 0; s < 8; ++s) { const float sv = Sl[t * 8 + s]; n0 += sv * vl[s * 128 + e]; n1 += sv * vl[s * 128 + e + 1]; dsum += sv; }
      const float wi = gwi[t], den = dsum + wi * qn[t], rinv = 1.0f / fmaxf(fabsf(den), gem[t]);
      const float h0 = (n0 + wi * qc0) * rinv, h1 = (n1 + wi * qc1) * rinv;
      const float rn = 1.0f / sqrtf(wave_sum(h0 * h0 + h1 * h1) * (1.0f / 128.0f) + EPS);
      const unsigned ow = *(const unsigned*)(P.Z + (size_t)(r0 + t) * ZLD + ZO + h * 128 + e);
      *(unsigned*)(P.YC + (size_t)(r0 + t) * 1024 + 512 + h * 128 + e) = cvt_pk_bf16(bf_lo(ow) * h0 * rn * P.mlnorm[h * 128 + e], bf_hi(ow) * h1 * rn * P.mlnorm[h * 128 + e + 1]); }
    if (tid < 128) { float nn = dec * P.stN[bh * 128 + tid];
#pragma unroll
        for (int s = 0; s < 8; ++s) nn += gwe[s] * kl[s * 128 + tid];
        P.oNs[bh * 128 + tid] = nn; if (tid == 0) P.oMs[bh] = gsc[1]; }
    __syncthreads();
}
}
namespace sg {
using pg8::bf16_t; using pg8::bf16x8; using pg8::f32x4; using pg8::u32x4; using pg8::u32x2; using pg8::cvt_pk_bf16; using pg8::bf_lo; using pg8::bf_hi; using pg8::sigmoid_f; using pg8::gelu_tanh_f; using pg8::row_rs;
constexpr int ROW0 = 16384;

struct Epi { bf16_t* O; int ldc; const float* rn; const bf16_t* Hb; bf16_t* Ho; float* SSO; const float* SSI; const bf16_t* PROJ; };

template <int MODE> __device__ __forceinline__ void epilogue(const Epi& E, int lrow, int ct, int kq, f32x4 (&acc)[4]) {
    const int row = ROW0 + lrow;
    float rs = 1.f;
    if (MODE == 3) rs = E.rn[row];
    if (MODE == 4) { rs = row_rs(E.SSI, row); rs = rs * rs; }
    if (MODE == 5) rs = row_rs(E.SSI, row);
    float sq = 0.f;
#pragma unroll
    for (int n = 0; n < 4; ++n) { const int col = 64 * ct + 16 * n + 4 * kq; f32x4 v = acc[n];
        if (MODE == 0) {
            if (col < 1024) {
#pragma unroll
                for (int e = 0; e < 4; ++e) v[e] = gelu_tanh_f(v[e]); }
            else if (col >= 2560) {
#pragma unroll
                for (int e = 0; e < 4; ++e) v[e] = sigmoid_f(v[e]); }
        }
        if (MODE == 2) {
#pragma unroll
            for (int e = 0; e < 4; ++e) { const float a = fmaxf(v[e], 0.f); v[e] = a * a; } }
        if (MODE <= 2) { u32x2 w; w.x = cvt_pk_bf16(v[0], v[1]); w.y = cvt_pk_bf16(v[2], v[3]); *(u32x2*)(E.O + (size_t)row * E.ldc + col) = w; continue; }
        const size_t off = (size_t)row * 1024 + col;
        const u32x2 hw = *(const u32x2*)(E.Hb + off); const f32x4 r = (f32x4){bf_lo(hw.x), bf_hi(hw.x), bf_lo(hw.y), bf_hi(hw.y)};
        if (MODE == 3) v = r * rs + v;
        else if (MODE == 4) v = r + v * rs;
        else { const u32x2 pw = *(const u32x2*)(E.PROJ + off);
            v[0] = r[0] + sigmoid_f(v[0] * rs) * bf_lo(pw.x); v[1] = r[1] + sigmoid_f(v[1] * rs) * bf_hi(pw.x); v[2] = r[2] + sigmoid_f(v[2] * rs) * bf_lo(pw.y); v[3] = r[3] + sigmoid_f(v[3] * rs) * bf_hi(pw.y); }
        { u32x2 w; w.x = cvt_pk_bf16(v[0], v[1]); w.y = cvt_pk_bf16(v[2], v[3]); *(u32x2*)(E.Ho + off) = w; }
        sq += (v[0] * v[0] + v[1] * v[1]) + (v[2] * v[2] + v[3] * v[3]); }
    if (MODE >= 3) { sq += __shfl_xor(sq, 16); sq += __shfl_xor(sq, 32); if (kq == 0) E.SSO[(size_t)row * 16 + ct] = sq; }
}

constexpr int KT = 128;
__device__ __forceinline__ int toff(int row, int ch) { return (row << 8) + ((ch ^ (row & 15)) << 4); }
struct Issue { int u, kt, left; };
__device__ __forceinline__ void issue_tile(LAS unsigned char* st, Issue& I, const bf16_t* A, const bf16_t* Bt, int K, int nkt, int G, int w, int lane) {
    if (I.left > 0) {
        const bf16_t* ab = A + (size_t)(64 * (I.u & 15)) * K + I.kt * KT; const bf16_t* bb = Bt + (size_t)(64 * (I.u >> 4)) * K + I.kt * KT;
#pragma unroll
        for (int jj = 0; jj < 2; ++jj) { const int j = 2 * w + jj, row = 4 * j + (lane >> 4), ch = (lane & 15) ^ (row & 15);
            __builtin_amdgcn_global_load_lds((const unsigned*)(ab + (size_t)row * K + ch * 8), (LAS unsigned*)(st + j * 1024), 16, 0, 0);
            __builtin_amdgcn_global_load_lds((const unsigned*)(bb + (size_t)row * K + ch * 8), (LAS unsigned*)(st + 16384 + j * 1024), 16, 0, 0); }
        --I.left; if (++I.kt == nkt) { I.kt = 0; I.u += G; }
    } else {
#pragma unroll
        for (int jj = 0; jj < 2; ++jj) { const int j = 2 * w + jj, row = 4 * j + (lane >> 4), ch = (lane & 15) ^ (row & 15);
            __builtin_amdgcn_global_load_lds((const unsigned*)(A + (size_t)row * K + ch * 8), (LAS unsigned*)(st + j * 1024), 16, 0, 0);
            __builtin_amdgcn_global_load_lds((const unsigned*)(Bt + (size_t)row * K + ch * 8), (LAS unsigned*)(st + 16384 + j * 1024), 16, 0, 0); }
    }
}
template <int MODE> __device__ __forceinline__ void phase(LAS unsigned char* lds, const bf16_t* A0, const bf16_t* Bt, int K, int N, const Epi& E, int vcu, int G, int tid) {
    const int lane = tid & 63, w = __builtin_amdgcn_readfirstlane(tid >> 6), fr = lane & 15, kq = lane >> 4, wm = w & 3, wk = w >> 2;
    const bf16_t* A = A0 + (size_t)ROW0 * K;
    const int nu = 16 * (N >> 6), nkt = K / KT;
    if (vcu >= nu) return;
    const int nmine = (nu - vcu + G - 1) / G, total = nmine * nkt;
    f32x4 acc[4];
#pragma unroll
    for (int n = 0; n < 4; ++n) acc[n] = (f32x4){0.f, 0.f, 0.f, 0.f};
    Issue I{vcu, 0, total};
    issue_tile(lds, I, A, Bt, K, nkt, G, w, lane); issue_tile(lds + 32768, I, A, Bt, K, nkt, G, w, lane); issue_tile(lds + 65536, I, A, Bt, K, nkt, G, w, lane);
    int kt = 0, u = vcu;
    for (int i = 0; i < total; ++i) {
        asm volatile("s_waitcnt vmcnt(8)" ::: "memory");
        __builtin_amdgcn_s_barrier();
        asm volatile("" ::: "memory");
        issue_tile(lds + ((i + 3) & 3) * 32768, I, A, Bt, K, nkt, G, w, lane);
        { LAS const unsigned char* st = lds + (i & 3) * 32768;
#pragma unroll
          for (int ks = 0; ks < 2; ++ks) { const int ch = 4 * (2 * wk + ks) + kq;
              const bf16x8 af = *(LAS const bf16x8*)(st + toff(16 * wm + fr, ch));
#pragma unroll
              for (int n = 0; n < 4; ++n) { const bf16x8 bf = *(LAS const bf16x8*)(st + 16384 + toff(16 * n + fr, ch));
                  acc[n] = __builtin_amdgcn_mfma_f32_16x16x32_bf16(bf, af, acc[n], 0, 0, 0); } } }
        if (kt + 1 == nkt) {
            LAS f32x4* xch = (LAS f32x4*)(lds + 131072) + (wm * 64 + lane) * 4;
            if (wk == 1) {
#pragma unroll
                for (int n = 0; n < 4; ++n) { xch[n] = acc[n]; acc[n] = (f32x4){0.f, 0.f, 0.f, 0.f}; } }
            asm volatile("s_waitcnt lgkmcnt(0)" ::: "memory"); __builtin_amdgcn_s_barrier(); asm volatile("" ::: "memory");
            if (wk == 0) {
#pragma unroll
                for (int n = 0; n < 4; ++n) acc[n] += xch[n];
                epilogue<MODE>(E, 64 * (u & 15) + 16 * wm + fr, u >> 4, kq, acc);
#pragma unroll
                for (int n = 0; n < 4; ++n) acc[n] = (f32x4){0.f, 0.f, 0.f, 0.f}; }
            kt = 0; u += G;
        } else ++kt;
    }
    asm volatile("s_waitcnt vmcnt(0) lgkmcnt(0)" ::: "memory"); __builtin_amdgcn_s_barrier(); asm volatile("" ::: "memory");
}

__device__ __forceinline__ int toff128(int row, int ch) { return (row << 7) + ((ch ^ ((row >> 1) & 7)) << 4); }
__device__ __forceinline__ void issue_tile128(LAS unsigned char* st, Issue& I, const bf16_t* A, const bf16_t* Bt, int K, int nkt, int G, int w, int lane) {
    const bool live = I.left > 0;
    const bf16_t* ab = live ? A + (size_t)(128 * (I.u & 7)) * K + I.kt * 64 : A; const bf16_t* bb = live ? Bt + (size_t)(128 * (I.u >> 3)) * K + I.kt * 64 : Bt;
#pragma unroll
    for (int jj = 0; jj < 2; ++jj) { const int j = 2 * w + jj, row = 8 * j + (lane >> 3), ch = (lane & 7) ^ ((row >> 1) & 7);
        __builtin_amdgcn_global_load_lds((const unsigned*)(ab + (size_t)row * K + ch * 8), (LAS unsigned*)(st + j * 1024), 16, 0, 0);
        __builtin_amdgcn_global_load_lds((const unsigned*)(bb + (size_t)row * K + ch * 8), (LAS unsigned*)(st + 16384 + j * 1024), 16, 0, 0); }
    if (live) { --I.left; if (++I.kt == nkt) { I.kt = 0; I.u += G; } }
}
template <int MODE> __device__ __forceinline__ void phase128(LAS unsigned char* lds, const bf16_t* A0, const bf16_t* Bt, int K, int N, const Epi& E, int vcu, int G, int tid) {
    static_assert(MODE == 0 || MODE == 2, "phase128: bf16-store epilogues only");
    const int lane = tid & 63, w = __builtin_amdgcn_readfirstlane(tid >> 6), fr = lane & 15, kq = lane >> 4, wm = w >> 2, wn = w & 3;
    const bf16_t* A = A0 + (size_t)ROW0 * K;
    const int nu = 8 * (N >> 7), nkt = K / 64;
    if (vcu >= nu) return;
    const int nmine = (nu - vcu + G - 1) / G, total = nmine * nkt;
    f32x4 acc[4][2];
#pragma unroll
    for (int m = 0; m < 4; ++m) { acc[m][0] = (f32x4){0.f, 0.f, 0.f, 0.f}; acc[m][1] = (f32x4){0.f, 0.f, 0.f, 0.f}; }
    Issue I{vcu, 0, total};
    issue_tile128(lds, I, A, Bt, K, nkt, G, w, lane); issue_tile128(lds + 32768, I, A, Bt, K, nkt, G, w, lane); issue_tile128(lds + 65536, I, A, Bt, K, nkt, G, w, lane);
    int kt = 0, u = vcu;
    for (int i = 0; i < total; ++i) {
        asm volatile("s_waitcnt vmcnt(8)" ::: "memory");
        __builtin_amdgcn_s_barrier();
        asm volatile("" ::: "memory");
        issue_tile128(lds + ((i + 3) & 3) * 32768, I, A, Bt, K, nkt, G, w, lane);
        { LAS const unsigned char* st = lds + (i & 3) * 32768;
#pragma unroll
          for (int ks = 0; ks < 2; ++ks) { const int ch = 4 * ks + kq;
              const bf16x8 b0 = *(LAS const bf16x8*)(st + 16384 + toff128(32 * wn + fr, ch)), b1 = *(LAS const bf16x8*)(st + 16384 + toff128(32 * wn + 16 + fr, ch));
#pragma unroll
              for (int m = 0; m < 4; ++m) { const bf16x8 af = *(LAS const bf16x8*)(st + toff128(64 * wm + 16 * m + fr, ch));
                  acc[m][0] = __builtin_amdgcn_mfma_f32_16x16x32_bf16(b0, af, acc[m][0], 0, 0, 0); acc[m][1] = __builtin_amdgcn_mfma_f32_16x16x32_bf16(b1, af, acc[m][1], 0, 0, 0); } } }
        if (kt + 1 == nkt) {
            const int rt = u & 7, ct = u >> 3;
#pragma unroll
            for (int m = 0; m < 4; ++m) { const int row = ROW0 + 128 * rt + 64 * wm + 16 * m + fr;
#pragma unroll
                for (int n = 0; n < 2; ++n) { const int col = 128 * ct + 32 * wn + 16 * n + 4 * kq; f32x4 v = acc[m][n];
                    if (MODE == 0) {
                        if (col < 1024) {
#pragma unroll
                            for (int e = 0; e < 4; ++e) v[e] = gelu_tanh_f(v[e]); }
                        else if (col >= 2560) {
#pragma unroll
                            for (int e = 0; e < 4; ++e) v[e] = sigmoid_f(v[e]); } }
                    if (MODE == 2) {
#pragma unroll
                        for (int e = 0; e < 4; ++e) { const float a = fmaxf(v[e], 0.f); v[e] = a * a; } }
                    u32x2 o; o.x = cvt_pk_bf16(v[0], v[1]); o.y = cvt_pk_bf16(v[2], v[3]); *(u32x2*)(E.O + (size_t)row * E.ldc + col) = o;
                    acc[m][n] = (f32x4){0.f, 0.f, 0.f, 0.f}; } }
            kt = 0; u += G;
        } else ++kt;
    }
    asm volatile("s_waitcnt vmcnt(0) lgkmcnt(0)" ::: "memory"); __builtin_amdgcn_s_barrier(); asm volatile("" ::: "memory");
}
}

#ifndef HOST_DUP_PHASE
#define HOST_DUP_PHASE -1
#endif
#ifndef TP_A
#define TP_A -1
#define TP_B -1
#endif
#ifndef HOST_DUP_FLAGS
#define HOST_DUP_FLAGS 1
#endif
#ifndef HOST_EXTRA_BARS
#define HOST_EXTRA_BARS 0
#endif
#ifndef MK_ONE_LAUNCH
#define MK_ONE_LAUNCH 1
#endif
constexpr int NWAVES = 8;
constexpr int D = 1024, NPR = 16384, NSR = 1024, M = NPR + NSR, NIN = 3072, INC = 3080, FF = 4096, PLE = 256;
constexpr int N_PHASES = 10;
constexpr size_t MiB = 1u << 20;
constexpr size_t WS_CTL = 0, CTL_ZERO_BYTES = 65536;
constexpr int CW_BAR = 1024;
constexpr size_t WS_WIN = 1 * MiB;
constexpr size_t WS_WOUT = WS_WIN + (size_t)NIN * D * 2;
constexpr size_t WS_WUP = WS_WOUT + (size_t)D * D * 2;
constexpr size_t WS_WDOWN = WS_WUP + (size_t)FF * D * 2;
constexpr size_t WS_WGATE = WS_WDOWN + (size_t)D * FF * 2;
constexpr size_t WS_WPROJ = WS_WGATE + (size_t)D * D * 2;
constexpr size_t WS_WSB = WS_WPROJ + (size_t)D * PLE * 2;
constexpr size_t WS_IG = WS_WSB + 4 * 128 * 128 * 2;
constexpr size_t WS_LF = WS_IG + (size_t)M * 16;
constexpr size_t WS_SS1 = WS_LF + (size_t)M * 16;
constexpr size_t WS_SS2 = WS_SS1 + (size_t)M * 64;
constexpr size_t WS_SS3 = WS_SS2 + (size_t)M * 64;
constexpr size_t WS_CH = WS_SS3 + (size_t)M * 64;
constexpr size_t WS_MST = WS_CH + 4096;
constexpr size_t WS_NLOC = WS_MST + 4096;
constexpr size_t WS_NST = WS_NLOC + 512 * 128 * 4;
constexpr size_t WS_RN = WS_NST + 512 * 128 * 4;
constexpr size_t WS_PE = WS_RN + 69632;
constexpr size_t WS_RA = WS_PE + (size_t)M * PLE * 2;
constexpr size_t WS_RB = WS_RA + (size_t)M * D * 2;
constexpr size_t WS_YC = WS_RB + (size_t)M * NIN * 2;
constexpr size_t WS_KV = WS_RB + (size_t)M * FF * 2;
constexpr size_t WS_END = WS_KV + (size_t)M * D * 2;
static_assert(WS_END <= 256 * MiB, "d_ws map");
static_assert(WS_WIN % 256 == 0 && WS_IG % 256 == 0 && WS_PE % 256 == 0 && WS_RA % 256 == 0 && WS_RB % 256 == 0 && WS_YC % 256 == 0 && WS_KV % 256 == 0, "alignment");
constexpr size_t O_Y = 0, O_CP = (size_t)M * D, O_NP = O_CP + 8 * 4 * 16384, O_MP = O_NP + 8 * 4 * 128, O_VP = O_MP + 32, O_CS = O_VP + 8 * 128 * 512,
                 O_NS = O_CS + (size_t)128 * 4 * 16384, O_MS = O_NS + 128 * 4 * 128, O_VS = O_MS + 512, O_END = O_VS + 128 * 8 * 512;
constexpr int RING_OFF = 0, RING_BYTES = 131072, XCH_BYTES = 16384, LDSCTL_OFF = RING_BYTES + XCH_BYTES, MISC_OFF = LDSCTL_OFF + 320, LDS_BYTES = LDSCTL_OFF + 1024;

typedef unsigned short bf16;
typedef unsigned v4u __attribute__((ext_vector_type(4)));
typedef float f32x4 __attribute__((ext_vector_type(4)));
#define GAS __attribute__((address_space(1)))
typedef GAS unsigned gu32;
#define RLX_AGENT __ATOMIC_RELAXED, __HIP_MEMORY_SCOPE_AGENT
#define LDS_WAIT() asm volatile("s_waitcnt lgkmcnt(0)" ::: "memory")

struct Args { const float* in[24]; float* out; unsigned char* ws; int ph_lo, ph_hi, flags, extra_bars; };

#define XB_TMO      128
#define XB_XCNT(j)  (256  + 64 * (j))
#define XB_XSUB(j)  (1280 + 64 * (j))
#define XB_XGEN(j)  (2304 + 64 * (j))
#define XB_TOP      3328
#define XB_TOPGEN   3392
#define XCD_BAR_WORDS 3456
#define XB_SPIN_CAP (1u << 18)

__device__ __forceinline__ unsigned xb_ld(unsigned* p)              { return __hip_atomic_load(p, __ATOMIC_RELAXED, __HIP_MEMORY_SCOPE_AGENT); }
__device__ __forceinline__ unsigned xb_add(unsigned* p, unsigned v) { return __hip_atomic_fetch_add(p, v, __ATOMIC_RELAXED, __HIP_MEMORY_SCOPE_AGENT); }
__device__ __forceinline__ unsigned xb_xcc_id() { return (unsigned)__builtin_amdgcn_s_getreg((3 << 11) | 20) & 0xFu; }
#define XB_SPIN(cond, bar) do { unsigned _sp = 0; while (cond) { __builtin_amdgcn_s_sleep(1); \
    if ((++_sp & 255u) == 0u) { if (xb_ld(&(bar)[XB_TMO])) break; if (_sp > XB_SPIN_CAP) { atomicAdd(&(bar)[XB_TMO], 1u); break; } } } } while (0)

struct XcdBarrier {
    unsigned* bar; unsigned x;
    volatile LAS unsigned* st;
};

__device__ __forceinline__ XcdBarrier xcd_barrier_post(unsigned* bar, volatile LAS unsigned* st) {
    XcdBarrier b; b.bar = bar; b.x = xb_xcc_id(); b.st = st;
    if (threadIdx.x == 0) (void)xb_add(&bar[XB_XCNT(b.x)], 1u);
    return b;
}
__device__ __forceinline__ void xcd_barrier_complete(unsigned* bar, unsigned x, unsigned& nloc, unsigned& nx) {
    const unsigned G = gridDim.x * gridDim.y * gridDim.z;
    unsigned sum, cnt, mine, sp = 0u;
    for (;;) {
        sum = 0u; cnt = 0u; mine = 0u;
#pragma unroll
        for (unsigned j = 0; j < 16; ++j) { const unsigned c = xb_ld(&bar[XB_XCNT(j)]); sum += c; cnt += (c > 0u) ? 1u : 0u; mine = (j == x) ? c : mine; }
        if (sum == G) break;
        __builtin_amdgcn_s_sleep(1);
        if ((++sp & 255u) == 0u) { if (xb_ld(&bar[XB_TMO])) break; if (sp > XB_SPIN_CAP) { atomicAdd(&bar[XB_TMO], 1u); break; } }
    }
    nloc = mine > 0u ? mine : 1u; nx = cnt > 0u ? cnt : 1u;
}

__device__ __forceinline__ void xcd_barrier(const XcdBarrier& b) {
    asm volatile("s_waitcnt vmcnt(0)" ::: "memory");
    __syncthreads();
    if (threadIdx.x == 0) {
        unsigned* bar = b.bar;
        __builtin_amdgcn_s_waitcnt(0);
        unsigned nloc = b.st[0], nx = b.st[1];
        if (nloc == 0u) { xcd_barrier_complete(bar, b.x, nloc, nx); b.st[0] = nloc; b.st[1] = nx; }
        const unsigned old = xb_add(&bar[XB_XSUB(b.x)], 1u);
        const unsigned gen = old / nloc;
        if (old + 1u == (gen + 1u) * nloc) {
            __builtin_amdgcn_fence(__ATOMIC_RELEASE, "agent");
            asm volatile("s_waitcnt vmcnt(0)" ::: "memory");
            const unsigned og = xb_add(&bar[XB_TOP], 1u);
            const unsigned tg = og / nx;
            if (og + 1u == (tg + 1u) * nx) xb_add(&bar[XB_TOPGEN], 1u);
            else XB_SPIN(xb_ld(&bar[XB_TOPGEN]) == tg, bar);
            __builtin_amdgcn_fence(__ATOMIC_ACQUIRE, "agent");
            xb_add(&bar[XB_XGEN(b.x)], 1u);
            asm volatile("s_waitcnt vmcnt(0)" ::: "memory");
        } else {
            XB_SPIN(xb_ld(&bar[XB_XGEN(b.x)]) == gen, bar);
            __builtin_amdgcn_fence(__ATOMIC_ACQUIRE, "agent");
            asm volatile("s_waitcnt vmcnt(0)" ::: "memory");
        }
    }
    __syncthreads();
}

__device__ __forceinline__ void p0_transpose_item(const float* W, int ldw, int K, int N, const float* gain, bf16* WT, LAS float* scr, int item, int lane, bool kscale) {
    const int nblk = N / 32, kb = item / nblk, nb = item % nblk, k0 = 64 * kb, n0 = 32 * nb;
    const float cs = (kscale && n0 >= 1536 && n0 < 2048) ? 0.08838834764831845f : 1.0f;
    float wv[32];
#pragma unroll
    for (int i = 0; i < 32; ++i) { const int kk = 2 * i + (lane >> 5); wv[i] = W[(size_t)(k0 + kk) * ldw + n0 + (lane & 31)]; }
#pragma unroll
    for (int i = 0; i < 32; ++i) { const int kk = 2 * i + (lane >> 5); const float g = gain ? gain[k0 + kk] * cs : cs; scr[kk * 33 + (lane & 31)] = wv[i] * g; }
    LDS_WAIT(); asm volatile("" ::: "memory");
    const int c = lane & 7;
#pragma unroll
    for (int j = 0; j < 4; ++j) { const int n = (lane >> 3) + 8 * j; const LAS float* s = scr + (8 * c) * 33 + n;
        v4u o; o.x = pg8::cvt_pk_bf16(s[0 * 33], s[1 * 33]); o.y = pg8::cvt_pk_bf16(s[2 * 33], s[3 * 33]); o.z = pg8::cvt_pk_bf16(s[4 * 33], s[5 * 33]); o.w = pg8::cvt_pk_bf16(s[6 * 33], s[7 * 33]);
        *(v4u*)(WT + (size_t)(n0 + n) * K + k0 + 8 * c) = o; }
    LDS_WAIT(); asm volatile("" ::: "memory");
}

__device__ __forceinline__ float log_sigmoid_f(float x) { return fminf(x, 0.f) - log1pf(__expf(-fabsf(x))); }

struct RowIn { f32x4 v[4]; f32x4 pv; };
__device__ __forceinline__ void p0_row_load(const Args& A, int m, int lane, RowIn& R) {
    const float* xrow = (m < NPR) ? A.in[0] + (size_t)m * D : A.in[1] + (size_t)(m - NPR) * D;
    const float* prow = (m < NPR) ? A.in[2] + (size_t)m * PLE : A.in[3] + (size_t)(m - NPR) * PLE;
    const f32x4* xr = (const f32x4*)xrow + lane;
#pragma unroll
    for (int j = 0; j < 4; ++j) R.v[j] = xr[64 * j];
    R.pv = *((const f32x4*)prow + lane);
}
__device__ __forceinline__ void p0_row_finish(unsigned char* ws, int m, int lane, RowIn& R, const float (&gwt)[4][4][8], float gbias) {
    float s = 0.f;
#pragma unroll
    for (int j = 0; j < 4; ++j) s += (R.v[j][0] * R.v[j][0] + R.v[j][1] * R.v[j][1]) + (R.v[j][2] * R.v[j][2] + R.v[j][3] * R.v[j][3]);
    const float rnv = sqrtf(mix::wave_sum(s) * (1.0f / D) + 1e-6f), rinv = 1.0f / rnv;
    if (lane == 8) ((float*)(ws + WS_RN))[m] = rnv;
    unsigned long long* o8 = (unsigned long long*)((bf16*)(ws + WS_RA) + (size_t)m * D) + lane;
    float g8[8];
#pragma unroll
    for (int q = 0; q < 8; ++q) g8[q] = 0.f;
#pragma unroll
    for (int j = 0; j < 4; ++j) { const f32x4 v = R.v[j] * rinv;
        o8[64 * j] = (unsigned long long)pg8::cvt_pk_bf16(v[0], v[1]) | ((unsigned long long)pg8::cvt_pk_bf16(v[2], v[3]) << 32);
#pragma unroll
        for (int c = 0; c < 4; ++c)
#pragma unroll
            for (int q = 0; q < 8; ++q) g8[q] += v[c] * gwt[j][c][q]; }
#pragma unroll
    for (int q = 0; q < 8; ++q) g8[q] = mix::row_sum16(g8[q]);
    const int q8 = lane & 7;
    float val = q8 == 0 ? g8[0] : q8 == 1 ? g8[1] : q8 == 2 ? g8[2] : q8 == 3 ? g8[3] : q8 == 4 ? g8[4] : q8 == 5 ? g8[5] : q8 == 6 ? g8[6] : g8[7];
    val += __shfl_xor(val, 16); val += __shfl_xor(val, 32);
    if (lane < 4) ((float*)(ws + WS_IG))[(size_t)m * 4 + lane] = val + gbias;
    else if (lane < 8) ((float*)(ws + WS_LF))[(size_t)m * 4 + lane - 4] = log_sigmoid_f(val + gbias);
    *((unsigned long long*)((bf16*)(ws + WS_PE) + (size_t)m * PLE) + lane) = (unsigned long long)pg8::cvt_pk_bf16(R.pv[0], R.pv[1]) | ((unsigned long long)pg8::cvt_pk_bf16(R.pv[2], R.pv[3]) << 32);
}

__device__ __forceinline__ void p0_prologue(const Args& A, LAS unsigned char* lds, int vcu, int G, int tid) {
    const int lane = tid & 63, wave = __builtin_amdgcn_readfirstlane(tid >> 6);
    unsigned char* ws = A.ws;
    LAS float* scr = (LAS float*)(lds + RING_OFF + wave * 8704);
    LAS float* gtab = (LAS float*)(lds + RING_OFF + 8 * 8704);
    const int gw = vcu * NWAVES + wave, NGW = G * NWAVES;
    for (int k = tid; k < D; k += NWAVES * 64) { const float g = A.in[7][k]; const float* wp = A.in[8] + (size_t)k * INC + NIN;
        const f32x4 a = *(const f32x4*)wp, b = *(const f32x4*)(wp + 4); *(LAS f32x4*)(gtab + k * 8) = a * g; *(LAS f32x4*)(gtab + k * 8 + 4) = b * g; }
    constexpr int I_IN = (D / 64) * (NIN / 32), I_OUT = (D / 64) * (D / 32), I_UP = (D / 64) * (FF / 32), I_DOWN = (FF / 64) * (D / 32), I_GATE = I_OUT, I_PROJ = (PLE / 64) * (D / 32);
    constexpr int NITEMS = I_IN + I_OUT + I_UP + I_DOWN + I_GATE + I_PROJ;
    for (int it = gw; it < NITEMS; it += NGW) {
        int r = it;
        if (r < I_IN) { p0_transpose_item(A.in[8], INC, D, NIN, A.in[7], (bf16*)(ws + WS_WIN), scr, r, lane, true); continue; } r -= I_IN;
        if (r < I_OUT) { p0_transpose_item(A.in[16], D, D, D, nullptr, (bf16*)(ws + WS_WOUT), scr, r, lane, false); continue; } r -= I_OUT;
        if (r < I_UP) { p0_transpose_item(A.in[18], FF, D, FF, A.in[17], (bf16*)(ws + WS_WUP), scr, r, lane, false); continue; } r -= I_UP;
        if (r < I_DOWN) { p0_transpose_item(A.in[19], D, FF, D, nullptr, (bf16*)(ws + WS_WDOWN), scr, r, lane, false); continue; } r -= I_DOWN;
        if (r < I_GATE) { p0_transpose_item(A.in[21], D, D, D, A.in[20], (bf16*)(ws + WS_WGATE), scr, r, lane, false); continue; } r -= I_GATE;
        p0_transpose_item(A.in[22], D, PLE, D, nullptr, (bf16*)(ws + WS_WPROJ), scr, r, lane, false);
    }
    { const int gt = vcu * 512 + tid, NT = G * 512; const float* wsrc = A.in[11]; bf16* wdst = (bf16*)(ws + WS_WSB);
      for (int i = gt; i < 4 * 128 * 128 / 4; i += NT) { const int e = 4 * i, t = (e >> 7) & 127, j = e & 127; const f32x4 v = *(const f32x4*)(wsrc + e);
          pg8::u32x2 o; o.x = pg8::cvt_pk_bf16(j <= t ? v[0] : 0.f, j + 1 <= t ? v[1] : 0.f); o.y = pg8::cvt_pk_bf16(j + 2 <= t ? v[2] : 0.f, j + 3 <= t ? v[3] : 0.f);
          *(pg8::u32x2*)(wdst + e) = o; } }
    __syncthreads();
    float gwt[4][4][8];
#pragma unroll
    for (int j = 0; j < 4; ++j)
#pragma unroll
        for (int c = 0; c < 4; ++c) { const LAS float* gp = gtab + (4 * lane + 256 * j + c) * 8; const f32x4 a = *(const LAS f32x4*)gp, b = *(const LAS f32x4*)(gp + 4);
#pragma unroll
            for (int q = 0; q < 4; ++q) { gwt[j][c][q] = a[q]; gwt[j][c][4 + q] = b[q]; } }
    const float gbias = (lane < 4) ? A.in[13][lane & 3] : A.in[14][lane & 3];
    for (int m = gw; m < M; m += 2 * NGW) {
        const int m2 = (m + NGW < M) ? m + NGW : m;
        RowIn R0, R1; p0_row_load(A, m, lane, R0); p0_row_load(A, m2, lane, R1);
        p0_row_finish(ws, m, lane, R0, gwt, gbias);
        p0_row_finish(ws, m2, lane, R1, gwt, gbias);
    }
    __syncthreads();
}

__device__ __forceinline__ void p7_final(const Args& A, int vcu, int G, int tid) {
    const int lane = tid & 63, wave = __builtin_amdgcn_readfirstlane(tid >> 6);
    const int gw = vcu * NWAVES + wave, NGW = G * NWAVES;
    const float* ss = (const float*)(A.ws + WS_SS3); const bf16* Hb = (const bf16*)(A.ws + WS_RB);
    const f32x4 g0 = *((const f32x4*)A.in[23] + 2 * lane), g1 = *((const f32x4*)A.in[23] + 2 * lane + 1), g2 = *((const f32x4*)A.in[23] + 128 + 2 * lane), g3 = *((const f32x4*)A.in[23] + 128 + 2 * lane + 1);
    for (int m = gw; m < M; m += NGW) {
        const float rs = pg8::row_rs(ss, m);
        const v4u a = *((const v4u*)(Hb + (size_t)m * D) + lane), b = *((const v4u*)(Hb + (size_t)m * D) + 64 + lane);
        f32x4* yr = (f32x4*)(A.out + (size_t)m * D);
        yr[2 * lane] = (f32x4){pg8::bf_lo(a.x), pg8::bf_hi(a.x), pg8::bf_lo(a.y), pg8::bf_hi(a.y)} * rs * g0;
        yr[2 * lane + 1] = (f32x4){pg8::bf_lo(a.z), pg8::bf_hi(a.z), pg8::bf_lo(a.w), pg8::bf_hi(a.w)} * rs * g1;
        yr[128 + 2 * lane] = (f32x4){pg8::bf_lo(b.x), pg8::bf_hi(b.x), pg8::bf_lo(b.y), pg8::bf_hi(b.y)} * rs * g2;
        yr[128 + 2 * lane + 1] = (f32x4){pg8::bf_lo(b.z), pg8::bf_hi(b.z), pg8::bf_lo(b.w), pg8::bf_hi(b.w)} * rs * g3;
    }
}

__global__ void __launch_bounds__(NWAVES * 64, 2) hymba_fwd(Args args) {
    extern __shared__ __attribute__((aligned(16))) unsigned char lds_raw[];
    LAS unsigned char* lds = (LAS unsigned char*)lds_raw;
    const int tid = threadIdx.x, G = gridDim.x, bx = blockIdx.x;
    const int vcu = (G % 8 == 0) ? (bx % 8) * (G / 8) + bx / 8 : bx;
    unsigned char* ws = args.ws;
#ifndef DUP_PHASE
#define DUP_PHASE -1
#endif
    const int lo = args.ph_lo, hi = args.ph_hi;
#ifndef PH_MASK
#define PH_MASK 0xffff
#endif
#define INC_(k) (((PH_MASK >> (k)) & 1) && lo <= (k) && (k) < hi)
#if DUP_PHASE >= 0
#define IN(k) for (int rep_ = 0; rep_ < ((DUP_PHASE == (k)) ? 2 : 1); ++rep_) if (INC_(k))
#define GRID_BAR(k) do { if (INC_((k) + 1)) xcd_barrier(bar); } while (0)
#else
#define IN(k) if (INC_(k))
#define GRID_BAR(k) do { if (INC_((k) + 1)) xcd_barrier(bar); } while (0)
#endif
    for (int u = tid; u < (LDS_BYTES - LDSCTL_OFF) / 4; u += NWAVES * 64) ((LAS unsigned*)(lds + LDSCTL_OFF))[u] = 0u;
    __syncthreads();
    XcdBarrier bar = xcd_barrier_post((unsigned*)(ws + WS_CTL) + CW_BAR, (volatile LAS unsigned*)(lds + MISC_OFF) + 8);
    float* OUT = args.out;
    const int FL = args.flags;
#if TP_A >= 0
    unsigned long long tp_a = 0ull, tp_b = 0ull;
#define STAMP(id) do { if ((id) == TP_A || (id) == TP_B) { asm volatile("s_waitcnt vmcnt(0) lgkmcnt(0)" ::: "memory"); const unsigned long long t_ = __builtin_amdgcn_s_memrealtime(); if ((id) == TP_A) tp_a = t_; if ((id) == TP_B) tp_b = t_; } } while (0)
#else
#define STAMP(id) do { } while (0)
#endif
    bf16* RA = (bf16*)(ws + WS_RA); bf16* Zb = (bf16*)(ws + WS_RB); bf16* YC = (bf16*)(ws + WS_YC); bf16* HID = (bf16*)(ws + WS_RB); bf16* H3 = (bf16*)(ws + WS_RB);     bf16* PROJ = (bf16*)args.out;
    float* SS1 = (float*)(ws + WS_SS1); float* SS2 = (float*)(ws + WS_SS2); float* SS3 = (float*)(ws + WS_SS3);
    mix::MixP MP;
    MP.Z = Zb; MP.YC = YC; MP.IG = (const float*)(ws + WS_IG); MP.LF = (const float*)(ws + WS_LF); MP.WSb = (const bf16*)(ws + WS_WSB);
    MP.gm_ws = args.in[11]; MP.lng = args.in[9]; MP.lnb = args.in[10]; MP.bs = args.in[12]; MP.mlnorm = args.in[15];
    MP.KV = (float*)(ws + WS_KV); MP.NLOC = (float*)(ws + WS_NLOC); MP.NST = (float*)(ws + WS_NST); MP.CH = (float*)(ws + WS_CH); MP.MST = (float*)(ws + WS_MST);
    MP.stC = args.in[4]; MP.stN = args.in[5]; MP.stM = args.in[6];
    MP.oCp = OUT + O_CP; MP.oNp = OUT + O_NP; MP.oMp = OUT + O_MP; MP.oVp = OUT + O_VP; MP.oCs = OUT + O_CS; MP.oNs = OUT + O_NS; MP.oMs = OUT + O_MS; MP.oVs = OUT + O_VS;

    STAMP(0);
    IN(0) { p0_prologue(args, lds, vcu, G, tid); STAMP(1); GRID_BAR(0); for (int eb = 0; eb < args.extra_bars; ++eb) xcd_barrier(bar); }
    STAMP(2);
    IN(1) {
        pg8::Gemm g{RA, (const bf16*)(ws + WS_WIN), NPR, NIN, D}; pg8::StaticOrder S; S.init(NPR, NIN, G, bx);
        pg8::EpiBf16<0> E{Zb, NIN, nullptr};
        if (!(FL & 2)) pg8::gemm_phase<pg8::EpiBf16<0>, pg8::StaticOrder, true, true>(lds + RING_OFF, g, S, E);
        STAMP(3);
        if (!(FL & 4)) { const sg::Epi SE{Zb, NIN, nullptr, nullptr, nullptr, nullptr, nullptr, nullptr}; sg::phase128<0>(lds + RING_OFF, RA, (const bf16*)(ws + WS_WIN), D, NIN, SE, vcu, G, tid); }
        GRID_BAR(1);
    }
    STAMP(4);
    IN(2) {
        for (int u = vcu; u < 1024; u += G) {
            if (u < 512) { if (FL & 16) continue; const int bc = u >> 2, h = u & 3; mix::gmlp_unit(lds, MP, bc >> 4, bc & 15, h, tid); }
            else { if (FL & 32) continue; if (u == vcu + 512) STAMP(5); const int v = u - 512; mix::kv_unit(lds, MP, v >> 6, (v >> 4) & 3, v & 15, tid); }
        }
        GRID_BAR(2);
    }
    STAMP(6);
    IN(3) {
        if (!(FL & 1)) for (int u = vcu; u < 256; u += G) mix::scan_unit(MP, u >> 3, u & 7, tid);
        STAMP(7);
        if (!(FL & 64)) for (int u = vcu; u < 512; u += G) mix::sample_unit(lds, MP, u >> 2, u & 3, tid);
        STAMP(21);
        if (!(FL & 128)) { pg8::Gemm g{(const bf16*)(ws + WS_PE), (const bf16*)(ws + WS_WPROJ), NPR, D, PLE}; pg8::StaticOrder S; S.init(NPR, D, G, bx);
          pg8::EpiBf16<1> E{PROJ, D, nullptr};
          if (!(FL & 2)) pg8::gemm_phase<pg8::EpiBf16<1>, pg8::StaticOrder, true, true>(lds + RING_OFF, g, S, E);
          STAMP(22);
          const sg::Epi SE{PROJ, D, nullptr, nullptr, nullptr, nullptr, nullptr, nullptr}; if (!(FL & 4)) sg::phase<1>(lds + RING_OFF, (const bf16*)(ws + WS_PE), (const bf16*)(ws + WS_WPROJ), PLE, D, SE, vcu, G, tid); }
        GRID_BAR(3);
    }
    STAMP(8);
    IN(4) {
        for (int u = vcu; u < 512; u += G) mix::mlo_unit(lds, MP, u >> 6, (u >> 4) & 3, u & 15, tid);
        GRID_BAR(4);
    }
    STAMP(10);
    IN(5) {
        pg8::Gemm g{YC, (const bf16*)(ws + WS_WOUT), NPR, D, D}; pg8::StaticOrder S; S.init(NPR, D, G, bx);
        pg8::EpiRes<0> E{(const float*)(ws + WS_RN), RA, RA, SS1, nullptr, nullptr};
        if (!(FL & 2)) pg8::gemm_phase<pg8::EpiRes<0>, pg8::StaticOrder, true, true>(lds + RING_OFF, g, S, E);
        STAMP(11);
        if (!(FL & 4)) { const sg::Epi SE{nullptr, 0, (const float*)(ws + WS_RN), RA, RA, SS1, nullptr, nullptr}; sg::phase<3>(lds + RING_OFF, YC, (const bf16*)(ws + WS_WOUT), D, D, SE, vcu, G, tid); }
        GRID_BAR(5);
    }
    STAMP(12);
    IN(6) {
        pg8::Gemm g{RA, (const bf16*)(ws + WS_WUP), NPR, FF, D}; pg8::StaticOrder S; S.init(NPR, FF, G, bx);
        pg8::EpiBf16<2> E{HID, FF, nullptr};
        if (!(FL & 2)) pg8::gemm_phase<pg8::EpiBf16<2>, pg8::StaticOrder, true, true>(lds + RING_OFF, g, S, E);
        STAMP(13);
        if (!(FL & 4)) { const sg::Epi SE{HID, FF, nullptr, nullptr, nullptr, nullptr, nullptr, nullptr}; sg::phase128<2>(lds + RING_OFF, RA, (const bf16*)(ws + WS_WUP), D, FF, SE, vcu, G, tid); }
        GRID_BAR(6);
    }
    STAMP(14);
    IN(7) {
        pg8::Gemm g{HID, (const bf16*)(ws + WS_WDOWN), NPR, D, FF}; pg8::StaticOrder S; S.init(NPR, D, G, bx);
        pg8::EpiRes<1> E{nullptr, RA, (FL & 8) ? (bf16*)(ws + WS_KV) : RA, (FL & 8) ? SS3 : SS2, SS1, nullptr};
        if (!(FL & 2)) pg8::gemm_phase<pg8::EpiRes<1>, pg8::StaticOrder, true, true>(lds + RING_OFF, g, S, E);
        STAMP(15);
        if (!(FL & 4)) { const sg::Epi SE{nullptr, 0, nullptr, RA, (FL & 8) ? (bf16*)(ws + WS_KV) : RA, (FL & 8) ? SS3 : SS2, SS1, nullptr}; sg::phase<4>(lds + RING_OFF, HID, (const bf16*)(ws + WS_WDOWN), FF, D, SE, vcu, G, tid); }
        GRID_BAR(7);
    }
    STAMP(16);
    IN(8) {
        pg8::Gemm g{RA, (const bf16*)(ws + WS_WGATE), NPR, D, D}; pg8::StaticOrder S; S.init(NPR, D, G, bx);
        pg8::EpiRes<2> E{nullptr, RA, (FL & 8) ? (bf16*)(ws + WS_KV) : H3, (FL & 8) ? SS1 : SS3, SS2, PROJ};
        if (!(FL & 2)) pg8::gemm_phase<pg8::EpiRes<2>, pg8::StaticOrder, true, true>(lds + RING_OFF, g, S, E);
        STAMP(17);
        if (!(FL & 4)) { const sg::Epi SE{nullptr, 0, nullptr, RA, (FL & 8) ? (bf16*)(ws + WS_KV) : H3, (FL & 8) ? SS1 : SS3, SS2, PROJ}; sg::phase<5>(lds + RING_OFF, RA, (const bf16*)(ws + WS_WGATE), D, D, SE, vcu, G, tid); }
        GRID_BAR(8);
    }
    STAMP(18);
    IN(9) p7_final(args, vcu, G, tid);
    STAMP(20);
#if TP_A >= 0
    if (bx == 0 && tid == 0) { asm volatile("s_waitcnt vmcnt(0)" ::: "memory"); OUT[O_MP] = (float)(tp_b - tp_a); }
#endif
#undef IN
#undef GRID_BAR
}

extern "C" void kernel_launch(void* const* d_in, const int* in_sizes, int n_in, void* d_out, int out_size, void* d_ws, size_t ws_size, hipStream_t stream) {
    static int grid = 0;
    if (grid == 0) {
        if (n_in != 24 || (size_t)out_size != O_END || ws_size < WS_END) { fprintf(stderr, "kernel_launch: unexpected problem shape (n_in %d, out %d, ws %zu)\n", n_in, out_size, ws_size); grid = -1; return; }
        int dev = 0, cus = 0, per_cu = 0;
        if (hipGetDevice(&dev) != hipSuccess || hipDeviceGetAttribute(&cus, hipDeviceAttributeMultiprocessorCount, dev) != hipSuccess) { grid = -1; return; }
        if (hipFuncSetAttribute((const void*)hymba_fwd, hipFuncAttributeMaxDynamicSharedMemorySize, LDS_BYTES) != hipSuccess) { fprintf(stderr, "kernel_launch: hipFuncSetAttribute failed\n"); grid = -1; return; }
        if (hipOccupancyMaxActiveBlocksPerMultiprocessor(&per_cu, (const void*)hymba_fwd, NWAVES * 64, LDS_BYTES) != hipSuccess || per_cu < 1) { fprintf(stderr, "kernel_launch: occupancy query says %d blocks per CU\n", per_cu); per_cu = 1; }
        (void)hipGetLastError();
        grid = cus * (per_cu < 1 ? per_cu : 1);
    }
    if (grid < 0) return;
    Args a{};
    for (int i = 0; i < 24; ++i) a.in[i] = (const float*)d_in[i];
    a.out = (float*)d_out; a.ws = (unsigned char*)d_ws;
#if MK_ONE_LAUNCH
    if (hipMemsetAsync((char*)d_ws + WS_CTL, 0, CTL_ZERO_BYTES, stream) != hipSuccess) { fprintf(stderr, "kernel_launch: memset of the control words failed\n"); return; }
    void* kargs[] = {&a};
#if HOST_DUP_PHASE >= 0
    const int cuts[4] = {0, HOST_DUP_PHASE + 1, HOST_DUP_PHASE, N_PHASES};
    for (int li = 0; li < 3; ++li) {
        a.ph_lo = (li == 1) ? HOST_DUP_PHASE : (li == 2 ? HOST_DUP_PHASE + 1 : 0); a.ph_hi = (li == 0 || li == 1) ? HOST_DUP_PHASE + 1 : N_PHASES; a.flags = (li == 1) ? HOST_DUP_FLAGS : 0;
        if (li > 0) (void)hipMemsetAsync((char*)d_ws + WS_CTL, 0, CTL_ZERO_BYTES, stream);
        (void)hipLaunchCooperativeKernel((const void*)hymba_fwd, dim3(grid), dim3(NWAVES * 64), kargs, LDS_BYTES, stream);
    }
    (void)cuts;
#else
    a.ph_lo = 0; a.ph_hi = N_PHASES; a.extra_bars = HOST_EXTRA_BARS;
    const hipError_t e = hipLaunchCooperativeKernel((const void*)hymba_fwd, dim3(grid), dim3(NWAVES * 64), kargs, LDS_BYTES, stream);
    if (e != hipSuccess) fprintf(stderr, "kernel_launch: cooperative launch failed: %s (grid %d)\n", hipGetErrorString(e), grid);
#endif
#else
    if (hipMemsetAsync((char*)d_ws + WS_CTL, 0, CTL_ZERO_BYTES, stream) != hipSuccess) return;
    for (int ph = 0; ph < N_PHASES; ++ph) {
        a.ph_lo = ph; a.ph_hi = ph + 1;
        hipLaunchKernelGGL(hymba_fwd, dim3(grid), dim3(NWAVES * 64), LDS_BYTES, stream, a);
    }
#endif
}
```

```cpp
#include <hip/hip_runtime.h>
#include <cstdio>
#include <cstdint>
namespace pg8 {
#define PG8_LAS __attribute__((address_space(3)))
typedef unsigned short bf16_t;
typedef short bf16x8 __attribute__((ext_vector_type(8)));
typedef float f32x4 __attribute__((ext_vector_type(4)));
typedef unsigned u32x4 __attribute__((ext_vector_type(4)));
constexpr int BM = 256, BK = 64, HALF = 128, HTB = HALF * BK * 2  , STAGE_BYTES = 8 * HTB, NXCD = 8, WGM = 8;

__host__ __device__ __forceinline__ int lds_byte(int r, int c) { const int st = (r >> 4) * 2 + (c >> 5), rr = r & 15, cc = c & 31, ob = rr * 64 + cc * 2; return st * 1024 + (ob ^ (((ob >> 9) & 1) << 5)); }
__host__ __device__ __forceinline__ void stage_rc(int b, int& R, int& C) { const int st = b / 1024, sb = b % 1024, swz = sb ^ (((sb >> 9) & 1) << 5); R = (st >> 1) * 16 + swz / 64; C = (st & 1) * 32 + (swz % 64) / 2; }
__host__ __device__ __forceinline__ int perm32(int rho) { const int n = rho >> 4, i = rho & 15; return 8 * (i >> 2) + 4 * n + (i & 3); }

struct Unit { int pm, pn; };
struct Gemm { const bf16_t* A; const bf16_t* Bt; int M, N, K; };

struct StaticOrder {
    int nM, nN, nwg, G, c;
    __host__ __device__ void init(int M, int N, int G_, int c_) { nM = M / BM; nN = N / BM; nwg = nM * nN; G = G_; c = c_; }
    __host__ __device__ bool next(int i, Unit& u) const {
        const long L = (long)i * G + c; if (L >= nwg) return false;
        int wgid = (int)L; { const int q = nwg / NXCD, r = nwg % NXCD, xcd = wgid % NXCD, off = wgid / NXCD; wgid = (xcd < r ? xcd * (q + 1) : r * (q + 1) + (xcd - r) * q) + off; }
        const int nig = WGM * nN, gid = wgid / nig, fm = gid * WGM, gsz = (nM - fm) < WGM ? (nM - fm) : WGM;
        u.pm = fm + ((wgid % nig) % gsz); u.pn = (wgid % nig) / gsz; return true;
    }
    __device__ __forceinline__ void a_ready(const Unit&) const {}
    __device__ __forceinline__ void done(const Unit&) const {}
};


typedef float f32x2 __attribute__((ext_vector_type(2)));
typedef __bf16 bf16x2_t __attribute__((ext_vector_type(2)));
typedef unsigned u32x2 __attribute__((ext_vector_type(2)));
__device__ __forceinline__ unsigned cvt_pk_bf16(float lo, float hi) { f32x2 v = {lo, hi}; bf16x2_t b = __builtin_convertvector(v, bf16x2_t); return __builtin_bit_cast(unsigned, b); }
__device__ __forceinline__ float bf_lo(unsigned w) { return __uint_as_float(w << 16); }
__device__ __forceinline__ float bf_hi(unsigned w) { return __uint_as_float(w & 0xffff0000u); }
__device__ __forceinline__ float sigmoid_f(float x) { return __builtin_amdgcn_rcpf(1.0f + __builtin_amdgcn_exp2f(-1.4426950408889634f * x)); }
__device__ __forceinline__ float gelu_tanh_f(float x) { const float t = x * (1.5957691216057308f + 0.07135481627159149f * x * x); return x * sigmoid_f(t); }

constexpr float NORM_EPS = 1e-6f;
__device__ __forceinline__ float row_rs(const float* ss, int row) {
    const f32x4* p = (const f32x4*)(ss + (size_t)row * 16); const f32x4 a = p[0], b = p[1], c = p[2], d = p[3];
    const float s = ((a[0] + a[1]) + (a[2] + a[3])) + ((b[0] + b[1]) + (b[2] + b[3])) + ((c[0] + c[1]) + (c[2] + c[3])) + ((d[0] + d[1]) + (d[2] + d[3]));
    return 1.0f / sqrtf(s * (1.0f / 1024.0f) + NORM_EPS);
}

template <int MODE> struct EpiBf16 {
    static constexpr bool PERM = true, AFTER_DRAIN = false;
    bf16_t* O; int ldc; float* lns;
    __device__ __forceinline__ void operator()(const f32x4 (&acc)[2][2][4][2], const Unit& u, int wr, int wc, int fr, int fq) const {
        const int row0 = u.pm * BM + wr * 64 + fr, col0 = u.pn * BM + wc * 32 + 8 * fq;
        const int act = (MODE == 0) ? (u.pn < 4 ? 1 : (u.pn >= 10 ? 2 : 0)) : 0;
#pragma unroll
        for (int ai = 0; ai < 2; ++ai)
#pragma unroll
            for (int m = 0; m < 4; ++m) { const int row = row0 + ai * HALF + m * 16; bf16_t* rowp = O + (size_t)row * ldc + col0; float s1 = 0.f, s2 = 0.f;
#pragma unroll
                for (int bj = 0; bj < 2; ++bj) { f32x4 v0 = acc[ai][bj][m][0], v1 = acc[ai][bj][m][1];
                    if (MODE == 0) {
                        if (act == 1) {
#pragma unroll
                            for (int e = 0; e < 4; ++e) { v0[e] = gelu_tanh_f(v0[e]); v1[e] = gelu_tanh_f(v1[e]); } }
                        else if (act == 2) {
#pragma unroll
                            for (int e = 0; e < 4; ++e) { v0[e] = sigmoid_f(v0[e]); v1[e] = sigmoid_f(v1[e]); } }
                    }
                    if (MODE == 2) {
#pragma unroll
                        for (int e = 0; e < 4; ++e) { const float a = fmaxf(v0[e], 0.f), b = fmaxf(v1[e], 0.f); v0[e] = a * a; v1[e] = b * b; } }
                    if (MODE == 0) { const f32x4 t = v0 + v1, q = v0 * v0 + v1 * v1; s1 += (t[0] + t[1]) + (t[2] + t[3]); s2 += (q[0] + q[1]) + (q[2] + q[3]); }
                    u32x4 w; w.x = cvt_pk_bf16(v0[0], v0[1]); w.y = cvt_pk_bf16(v0[2], v0[3]); w.z = cvt_pk_bf16(v1[0], v1[1]); w.w = cvt_pk_bf16(v1[2], v1[3]);
                    *(u32x4*)(rowp + bj * HALF) = w; }
                if (MODE == 0 && (u.pn == 2 || u.pn == 3)) {
                    s1 += __shfl_xor(s1, 16); s1 += __shfl_xor(s1, 32); s2 += __shfl_xor(s2, 16); s2 += __shfl_xor(s2, 32);
                    if (fq == 0) *(f32x2*)(lns + ((size_t)row * 8 + (u.pn - 2) * 4 + wc) * 2) = (f32x2){s1, s2}; } }
    }
};

template <int MODE> struct EpiRes {
    static constexpr bool PERM = false, AFTER_DRAIN = false;
    const float* rn;
    const bf16_t* Hb; bf16_t* Ho; float* SSO; const float* SSI; const bf16_t* PROJ;
    __device__ __forceinline__ void operator()(const f32x4 (&acc)[2][2][4][2], const Unit& u, int wr, int wc, int fr, int fq) const {
        const int row0 = u.pm * BM + wr * 64 + fr, col0 = u.pn * BM + wc * 32 + 4 * fq;
#pragma unroll
        for (int ai = 0; ai < 2; ++ai)
#pragma unroll
            for (int m = 0; m < 4; ++m) { const int row = row0 + ai * HALF + m * 16; const size_t off = (size_t)row * 1024 + col0;
                float rsc; if (MODE != 0) { rsc = row_rs(SSI, row); if (MODE == 1) rsc = rsc * rsc; } else rsc = rn[row];
                float sq = 0.f;
#pragma unroll
                for (int bj = 0; bj < 2; ++bj)
#pragma unroll
                    for (int n = 0; n < 2; ++n) { const size_t o2 = off + bj * HALF + n * 16; f32x4 h; const f32x4 a = acc[ai][bj][m][n];
                        { const u32x2 hw = *(const u32x2*)(Hb + o2); const f32x4 r = (f32x4){bf_lo(hw.x), bf_hi(hw.x), bf_lo(hw.y), bf_hi(hw.y)};
                            if (MODE == 0) h = r * rsc + a;
                            else if (MODE == 1) h = r + a * rsc;
                            else { const u32x2 pw = *(const u32x2*)(PROJ + o2);
                                h[0] = r[0] + sigmoid_f(a[0] * rsc) * bf_lo(pw.x); h[1] = r[1] + sigmoid_f(a[1] * rsc) * bf_hi(pw.x);
                                h[2] = r[2] + sigmoid_f(a[2] * rsc) * bf_lo(pw.y); h[3] = r[3] + sigmoid_f(a[3] * rsc) * bf_hi(pw.y); } }
                        u32x2 w; w.x = cvt_pk_bf16(h[0], h[1]); w.y = cvt_pk_bf16(h[2], h[3]); *(u32x2*)(Ho + o2) = w;
                        sq += (h[0] * h[0] + h[1] * h[1]) + (h[2] * h[2] + h[3] * h[3]); }
                sq += __shfl_xor(sq, 16); sq += __shfl_xor(sq, 32);
                if (fq == 0) SSO[(size_t)row * 16 + u.pn * 4 + wc] = sq; }
    }
};

template <class Epi, class Sched, bool ALIGN_EPI = false, bool SP2 = false>
__device__ __forceinline__ void gemm_phase(PG8_LAS unsigned char* lds, const Gemm g, const Sched& S, const Epi& E) {
    const int tid = threadIdx.x, wid = __builtin_amdgcn_readfirstlane(tid >> 6), lane = tid & 63, wr = wid >> 2, wc = wid & 3, fr = lane & 15, fq = lane >> 4;
    int K = g.K; asm volatile("" : "+s"(K));
    const int nt = K / BK;
    unsigned voffA[2], voffB[2];
#pragma unroll
    for (int i = 0; i < 2; ++i) { int R, C; stage_rc(tid * 16 + i * 8192, R, C); const int Rb = Epi::PERM ? ((R & ~31) + perm32(R & 31)) : R;
        voffA[i] = (unsigned)(R * K + C) * 2u; voffB[i] = (unsigned)(Rb * K + C) * 2u; }
    const size_t kstep = (size_t)(BK * 2);
    const size_t hstep = (size_t)HALF * K * 2;
    const size_t tstep = 2 * hstep;
    const unsigned ldsw = (unsigned)wid * 1024u;
    const int aoff = lds_byte(wr * 64 + fr, fq * 8), boff = lds_byte(wc * 32 + fr, fq * 8);
#define PG8_SA(b, h) (((b) * 2 + (h)) * HTB)
#define PG8_SB(b, h) ((4 + (b) * 2 + (h)) * HTB)
#define PG8_STAGE(bufoff, gbase, voff) do { _Pragma("unroll") for (int _i = 0; _i < 2; ++_i) \
        __builtin_amdgcn_global_load_lds((const unsigned*)((const char*)(gbase) + (voff)[_i]), (PG8_LAS unsigned*)(lds + (bufoff) + ldsw + _i * 8192), 16, 0, 0); } while (0)
#define PG8_LDA(dst, b, h) do { _Pragma("unroll") for (int m = 0; m < 4; ++m) _Pragma("unroll") for (int k = 0; k < 2; ++k) dst[m][k] = *(const PG8_LAS bf16x8*)(lds + PG8_SA(b, h) + aoff + m * 2048 + k * 1024); } while (0)
#define PG8_LDB(dst, b, h) do { _Pragma("unroll") for (int n = 0; n < 2; ++n) _Pragma("unroll") for (int k = 0; k < 2; ++k) dst[n][k] = *(const PG8_LAS bf16x8*)(lds + PG8_SB(b, h) + boff + n * 2048 + k * 1024); } while (0)
#define PG8_MMA(ai, bj, At, Bt) do { __builtin_amdgcn_s_setprio(1); _Pragma("unroll") for (int m = 0; m < 4; ++m) _Pragma("unroll") for (int n = 0; n < 2; ++n) _Pragma("unroll") for (int k = 0; k < 2; ++k) \
        acc[ai][bj][m][n] = __builtin_amdgcn_mfma_f32_16x16x32_bf16(Bt[n][k], At[m][k], acc[ai][bj][m][n], 0, 0, 0); __builtin_amdgcn_s_setprio(0); } while (0)
#define PG8_WAIT_V(n) asm volatile("s_waitcnt vmcnt(" #n ")" ::: "memory")
#define PG8_WAIT_L(n) asm volatile("s_waitcnt lgkmcnt(" #n ")" ::: "memory")
#define PG8_BAR __builtin_amdgcn_s_barrier()
#define PG8_SCHED __builtin_amdgcn_sched_barrier(0)
    Unit cur, nxt; int ui = 0;
    if (!S.next(0, cur)) return;
    f32x4 acc[2][2][4][2];
#pragma unroll
    for (int a = 0; a < 2; ++a)
#pragma unroll
        for (int b = 0; b < 2; ++b)
#pragma unroll
            for (int m = 0; m < 4; ++m)
#pragma unroll
                for (int n = 0; n < 2; ++n) acc[a][b][m][n] = (f32x4){0.f, 0.f, 0.f, 0.f};
    bf16x8 At[4][2], B0[2][2], B1[2][2];
    const char* cA = (const char*)g.A + (size_t)cur.pm * tstep; const char* cB = (const char*)g.Bt + (size_t)cur.pn * tstep;
    S.a_ready(cur);
    if constexpr (SP2) {
        PG8_STAGE(PG8_SB(0, 0), cB, voffB); PG8_STAGE(PG8_SB(0, 1), cB + hstep, voffB); PG8_STAGE(PG8_SA(0, 0), cA, voffA); PG8_STAGE(PG8_SA(0, 1), cA + hstep, voffA);
        if (wr == 1) PG8_BAR;
        PG8_WAIT_V(2); PG8_BAR;
        PG8_STAGE(PG8_SB(1, 0), cB + kstep, voffB); PG8_STAGE(PG8_SA(1, 0), cA + kstep, voffA); PG8_STAGE(PG8_SB(1, 1), cB + hstep + kstep, voffB);
        PG8_WAIT_V(6); PG8_BAR;
    } else {
        PG8_STAGE(PG8_SB(0, 0), cB, voffB); PG8_STAGE(PG8_SA(0, 0), cA, voffA); PG8_STAGE(PG8_SB(0, 1), cB + hstep, voffB); PG8_STAGE(PG8_SA(0, 1), cA + hstep, voffA);
        if (wr == 1) PG8_BAR;
        PG8_WAIT_V(4); PG8_BAR;
        PG8_STAGE(PG8_SB(1, 0), cB + kstep, voffB); PG8_STAGE(PG8_SA(1, 0), cA + kstep, voffA); PG8_STAGE(PG8_SB(1, 1), cB + hstep + kstep, voffB);
        PG8_WAIT_V(6); PG8_BAR;
    }
    for (;;) {
        const bool has_next = S.next(ui + 1, nxt);
        const char* nA = has_next ? (const char*)g.A + (size_t)nxt.pm * tstep : cA; const char* nB = has_next ? (const char*)g.Bt + (size_t)nxt.pn * tstep : cB;
        for (int t = 0; t < nt; t += 2) {
            const bool last = (t == nt - 2);
            const char* a1 = cA + (size_t)(t + 1) * kstep;
            const char* a2 = last ? nA : cA + (size_t)(t + 2) * kstep; const char* b2 = last ? nB : cB + (size_t)(t + 2) * kstep;
            const char* a3 = a2 + kstep; const char* b3 = b2 + kstep;
            if (last && has_next) S.a_ready(nxt);
            if constexpr (SP2) {
            PG8_LDB(B0, 0, 0); PG8_LDB(B1, 0, 1); PG8_SCHED; PG8_LDA(At, 0, 0); PG8_STAGE(PG8_SA(1, 1), a1 + hstep, voffA);
            PG8_WAIT_V(8); PG8_WAIT_L(0); PG8_BAR; PG8_MMA(0, 0, At, B0); PG8_MMA(0, 1, At, B1); PG8_BAR; PG8_SCHED;
            PG8_LDA(At, 0, 1); PG8_STAGE(PG8_SB(0, 0), b2, voffB); PG8_STAGE(PG8_SB(0, 1), b2 + hstep, voffB); PG8_STAGE(PG8_SA(0, 0), a2, voffA);
            PG8_WAIT_V(8); PG8_WAIT_L(0); PG8_BAR; PG8_MMA(1, 0, At, B0); PG8_MMA(1, 1, At, B1); PG8_BAR; PG8_SCHED;
            PG8_LDB(B0, 1, 0); PG8_LDB(B1, 1, 1); PG8_SCHED; PG8_LDA(At, 1, 0); PG8_STAGE(PG8_SA(0, 1), a2 + hstep, voffA);
            PG8_WAIT_V(8); PG8_WAIT_L(0); PG8_BAR; PG8_MMA(0, 0, At, B0); PG8_MMA(0, 1, At, B1); PG8_BAR; PG8_SCHED;
            PG8_LDA(At, 1, 1); PG8_STAGE(PG8_SB(1, 0), b3, voffB); PG8_STAGE(PG8_SB(1, 1), b3 + hstep, voffB); PG8_STAGE(PG8_SA(1, 0), a3, voffA);
            PG8_WAIT_V(8); PG8_WAIT_L(0); PG8_BAR; PG8_MMA(1, 0, At, B0); PG8_MMA(1, 1, At, B1); PG8_BAR; PG8_SCHED;
            } else {
            PG8_LDB(B0, 0, 0); PG8_SCHED; PG8_LDA(At, 0, 0); PG8_STAGE(PG8_SA(1, 1), a1 + hstep, voffA);
            PG8_WAIT_L(8); PG8_BAR; PG8_WAIT_L(0); PG8_MMA(0, 0, At, B0); PG8_BAR; PG8_SCHED;
            PG8_LDB(B1, 0, 1); PG8_STAGE(PG8_SB(0, 0), b2, voffB);
            PG8_BAR; PG8_WAIT_L(0); PG8_MMA(0, 1, At, B1); PG8_BAR;
            PG8_LDA(At, 0, 1); PG8_STAGE(PG8_SA(0, 0), a2, voffA);
            PG8_BAR; PG8_WAIT_L(0); PG8_MMA(1, 0, At, B0); PG8_BAR; PG8_SCHED;
            PG8_STAGE(PG8_SB(0, 1), b2 + hstep, voffB);
            PG8_WAIT_V(6); PG8_BAR; PG8_MMA(1, 1, At, B1); PG8_BAR;
            PG8_LDB(B0, 1, 0); PG8_SCHED; PG8_LDA(At, 1, 0); PG8_STAGE(PG8_SA(0, 1), a2 + hstep, voffA);
            PG8_WAIT_L(8); PG8_BAR; PG8_WAIT_L(0); PG8_MMA(0, 0, At, B0); PG8_BAR; PG8_SCHED;
            PG8_LDB(B1, 1, 1); PG8_STAGE(PG8_SB(1, 0), b3, voffB);
            PG8_BAR; PG8_WAIT_L(0); PG8_MMA(0, 1, At, B1); PG8_BAR;
            PG8_LDA(At, 1, 1); PG8_STAGE(PG8_SA(1, 0), a3, voffA);
            PG8_BAR; PG8_WAIT_L(0); PG8_MMA(1, 0, At, B0); PG8_BAR; PG8_SCHED;
            PG8_STAGE(PG8_SB(1, 1), b3 + hstep, voffB);
            PG8_WAIT_V(6); PG8_BAR; PG8_MMA(1, 1, At, B1); PG8_BAR;
            }
        }
        if constexpr (ALIGN_EPI) { if (wr == 0) PG8_BAR; }
        if constexpr (!Epi::AFTER_DRAIN) { E(acc, cur, wr, wc, fr, fq); S.done(cur); }
        if (!has_next) break;
#pragma unroll
        for (int a = 0; a < 2; ++a)
#pragma unroll
            for (int b = 0; b < 2; ++b)
#pragma unroll
                for (int m = 0; m < 4; ++m)
#pragma unroll
                    for (int n = 0; n < 2; ++n) acc[a][b][m][n] = (f32x4){0.f, 0.f, 0.f, 0.f};
        cur = nxt; cA = nA; cB = nB; ++ui;
        if constexpr (ALIGN_EPI) { if (wr == 1) PG8_BAR; }
    }
    PG8_WAIT_V(0);
    if constexpr (!ALIGN_EPI) { if (wr == 0) PG8_BAR; }
    PG8_BAR;
    if constexpr (Epi::AFTER_DRAIN) { E.fused(acc, cur, wr, wc, fr, fq, lds, wid, lane); S.done(cur); }
#undef PG8_SA
#undef PG8_SB
#undef PG8_STAGE
#undef PG8_LDA
#undef PG8_LDB
#undef PG8_MMA
#undef PG8_WAIT_V
#undef PG8_WAIT_L
#undef PG8_BAR
#undef PG8_SCHED
}
}

namespace mix {
#define LAS __attribute__((address_space(3)))
using pg8::bf16_t; using pg8::bf16x8; using pg8::f32x4; using pg8::u32x4; using pg8::u32x2; using pg8::cvt_pk_bf16; using pg8::bf_lo; using pg8::bf_hi; using pg8::sigmoid_f;
typedef short v4i16_t __attribute__((ext_vector_type(4)));
constexpr int NP = 16384, NS = 1024, ZLD = 3072;
constexpr int ZU = 0, ZVG = 512, ZQ = 1024, ZK = 1536, ZV = 2048, ZO = 2560;
constexpr int TS = 288;
constexpr int IMG = 128 * TS;
constexpr int IMG0 = 0, IMG1 = IMG, IMG2 = 2 * IMG, SC_OFF = 3 * IMG;
constexpr float EPS = 1e-6f;

template <int CTRL> __device__ __forceinline__ float dpp_mov(float v) { return __int_as_float(__builtin_amdgcn_update_dpp(0, __float_as_int(v), CTRL, 0xF, 0xF, true)); }
__device__ __forceinline__ float row_sum16(float v) { v += dpp_mov<0xB1>(v); v += dpp_mov<0x4E>(v); v += dpp_mov<0x141>(v); v += dpp_mov<0x140>(v); return v; }
__device__ __forceinline__ float row_max16(float v) { v = fmaxf(v, dpp_mov<0xB1>(v)); v = fmaxf(v, dpp_mov<0x4E>(v)); v = fmaxf(v, dpp_mov<0x141>(v)); v = fmaxf(v, dpp_mov<0x140>(v)); return v; }
__device__ __forceinline__ float rl(float v, int l) { return __int_as_float(__builtin_amdgcn_readlane(__float_as_int(v), l)); }
__device__ __forceinline__ float wave_sum(float v) { v = row_sum16(v); return (rl(v, 0) + rl(v, 16)) + (rl(v, 32) + rl(v, 48)); }
__device__ __forceinline__ float wave_max(float v) { v = row_max16(v); return fmaxf(fmaxf(rl(v, 0), rl(v, 16)), fmaxf(rl(v, 32), rl(v, 48))); }
__device__ __forceinline__ float scan_add(float v, int lane) {
#pragma unroll
    for (int o = 1; o < 64; o <<= 1) { const float t = __shfl_up(v, o); if (lane >= o) v += t; }
    return v;
}
__device__ __forceinline__ float scan_max(float v, int lane) {
#pragma unroll
    for (int o = 1; o < 64; o <<= 1) { const float t = __shfl_up(v, o); if (lane >= o) v = fmaxf(v, t); }
    return v;
}
__device__ __forceinline__ bf16x8 tr2(LAS const unsigned char* p0, LAS const unsigned char* p1) {
    const v4i16_t a = __builtin_amdgcn_ds_read_tr16_b64_v4i16((LAS v4i16_t*)p0);
    const v4i16_t b = __builtin_amdgcn_ds_read_tr16_b64_v4i16((LAS v4i16_t*)p1);
    return (bf16x8){a[0], a[1], a[2], a[3], b[0], b[1], b[2], b[3]};
}
__device__ __forceinline__ void unpack8(const u32x4 w, float (&x)[8]) {
    x[0] = bf_lo(w.x); x[1] = bf_hi(w.x); x[2] = bf_lo(w.y); x[3] = bf_hi(w.y); x[4] = bf_lo(w.z); x[5] = bf_hi(w.z); x[6] = bf_lo(w.w); x[7] = bf_hi(w.w);
}
__device__ __forceinline__ u32x4 pack8(const float (&x)[8]) {
    u32x4 w; w.x = cvt_pk_bf16(x[0], x[1]); w.y = cvt_pk_bf16(x[2], x[3]); w.z = cvt_pk_bf16(x[4], x[5]); w.w = cvt_pk_bf16(x[6], x[7]); return w;
}

struct MixP {
    const bf16_t* Z; bf16_t* YC; const float* IG; const float* LF; const float* LNS;
    const bf16_t* WSb;
    const float *gm_ws, *lng, *lnb, *bs, *mlnorm;
    float *KV, *NLOC, *NST, *CH, *MST;
    const float *stC, *stN, *stM;
    float *oCp, *oNp, *oMp, *oVp, *oCs, *oNs, *oMs, *oVs;
};

__device__ __forceinline__ void gmlp_unit(LAS unsigned char* lds, const MixP& P, int b, int c, int h, int tid) {
    const int lane = tid & 63, w = __builtin_amdgcn_readfirstlane(tid >> 6), fr = lane & 15, kq = lane >> 4, q = fr >> 2, p = fr & 3;
    const int r0 = b * 2048 + c * 128;
    LAS unsigned char* img = lds + IMG0;
    LAS float* mst = (LAS float*)(lds + SC_OFF);
    const int ch = tid & 15;
    u32x4 raw[4];
#pragma unroll
    for (int i = 0; i < 4; ++i) raw[i] = *(const u32x4*)(P.Z + (size_t)(r0 + (tid >> 4) + 32 * i) * ZLD + ZVG + h * 128 + ch * 8);
    f32x4 st4[4];
    if (tid < 128) { const f32x4* sp = (const f32x4*)(P.LNS + (size_t)(r0 + tid) * 16);
#pragma unroll
        for (int j = 0; j < 4; ++j) st4[j] = sp[j]; }
    float g8[8], b8[8];
    { const float* gp = P.lng + h * 128 + ch * 8; const float* bp = P.lnb + h * 128 + ch * 8;
      const f32x4 a = *(const f32x4*)gp, a2 = *(const f32x4*)(gp + 4), c0 = *(const f32x4*)bp, c1 = *(const f32x4*)(bp + 4);
#pragma unroll
      for (int e = 0; e < 4; ++e) { g8[e] = a[e]; g8[4 + e] = a2[e]; b8[e] = c0[e]; b8[4 + e] = c1[e]; } }
    const bf16_t* Wrow = P.WSb + ((size_t)h * 128 + 16 * w + fr) * 128 + 8 * kq;
    bf16x8 wf[4];
#pragma unroll
    for (int st = 0; st < 4; ++st) wf[st] = *(const bf16x8*)(Wrow + 32 * st);
    const bf16_t* urow = P.Z + (size_t)(r0 + 16 * w + fr) * ZLD + ZU + h * 128 + 4 * kq;
    u32x2 uw[8];
#pragma unroll
    for (int n = 0; n < 8; ++n) uw[n] = *(const u32x2*)(urow + 16 * n);
    const float bsv = P.bs[h * 128 + 16 * w + fr];
    if (tid < 128) { const float s1 = (st4[0][0] + st4[0][2]) + (st4[1][0] + st4[1][2]) + (st4[2][0] + st4[2][2]) + (st4[3][0] + st4[3][2]);
        const float s2 = (st4[0][1] + st4[0][3]) + (st4[1][1] + st4[1][3]) + (st4[2][1] + st4[2][3]) + (st4[3][1] + st4[3][3]);
        const float mean = s1 * (1.0f / 512.0f), var = fmaxf(s2 * (1.0f / 512.0f) - mean * mean, 0.f);
        mst[tid] = mean; mst[128 + tid] = 1.0f / sqrtf(var + EPS); }
    __syncthreads();
    float* vout = (c == 15) ? P.oVp + (size_t)b * 128 * 512 : nullptr;
#pragma unroll
    for (int i = 0; i < 4; ++i) { const int t = (tid >> 4) + 32 * i; const float mean = mst[t], rstd = mst[128 + t];
        float x[8]; unpack8(raw[i], x);
#pragma unroll
        for (int e = 0; e < 8; ++e) x[e] = (x[e] - mean) * rstd * g8[e] + b8[e];
        *(LAS u32x4*)(img + t * TS + ch * 16) = pack8(x);
        if (vout) { float* vo = vout + (size_t)t * 512 + h * 128 + ch * 8; *(f32x4*)vo = (f32x4){x[0], x[1], x[2], x[3]}; *(f32x4*)(vo + 4) = (f32x4){x[4], x[5], x[6], x[7]}; } }
    __syncthreads();
    f32x4 acc[8];
#pragma unroll
    for (int n = 0; n < 8; ++n) acc[n] = (f32x4){0.f, 0.f, 0.f, 0.f};
    const int nsteps = (w >> 1) + 1;
    LAS const unsigned char* trb = img + (8 * kq + q) * TS + 8 * p;
#pragma unroll
    for (int st = 0; st < 4; ++st) if (st < nsteps) {
#pragma unroll
        for (int n = 0; n < 8; ++n) { const bf16x8 vf = tr2(trb + (32 * st) * TS + 32 * n, trb + (32 * st + 4) * TS + 32 * n);
            acc[n] = __builtin_amdgcn_mfma_f32_16x16x32_bf16(vf, wf[st], acc[n], 0, 0, 0); }
    }
    { const int t = 16 * w + fr;
      bf16_t* yrow = P.YC + (size_t)(r0 + t) * 1024 + h * 128 + 4 * kq;
#pragma unroll
      for (int n = 0; n < 8; ++n) { u32x2 o;
          o.x = cvt_pk_bf16(bf_lo(uw[n].x) * (acc[n][0] + bsv), bf_hi(uw[n].x) * (acc[n][1] + bsv));
          o.y = cvt_pk_bf16(bf_lo(uw[n].y) * (acc[n][2] + bsv), bf_hi(uw[n].y) * (acc[n][3] + bsv));
          *(u32x2*)(yrow + 16 * n) = o; } }
    __syncthreads();
}

__device__ __forceinline__ void kv_unit(LAS unsigned char* lds, const MixP& P, int b, int h, int c, int tid) {
    const int lane = tid & 63, w = __builtin_amdgcn_readfirstlane(tid >> 6), fr = lane & 15, kq = lane >> 4, q = fr >> 2, p = fr & 3;
    const int r0 = b * 2048 + c * 128, unit = (b * 4 + h) * 16 + c;
    LAS float* wl = (LAS float*)(lds + SC_OFF);
    float lf0 = 0.f, lf1 = 0.f, ig0 = 0.f, ig1 = 0.f;
    if (w == 0) { const int s0 = r0 + 2 * lane; lf0 = P.LF[(size_t)s0 * 4 + h]; lf1 = P.LF[(size_t)(s0 + 1) * 4 + h]; ig0 = P.IG[(size_t)s0 * 4 + h]; ig1 = P.IG[(size_t)(s0 + 1) * 4 + h]; }
    u32x4 kraw[4], vraw[4];
#pragma unroll
    for (int i = 0; i < 4; ++i) { const int id = tid + 512 * i, row = id >> 4, ch = id & 15;
        const bf16_t* zr = P.Z + (size_t)(r0 + row) * ZLD + h * 128 + ch * 8; kraw[i] = *(const u32x4*)(zr + ZK); vraw[i] = *(const u32x4*)(zr + ZV); }
    if (w == 0) {
        const float Pc = scan_add(lf0 + lf1, lane), b1 = Pc, b0 = Pc - lf1, B = __shfl(Pc, 63);
        const float x0 = ig0 - b0, x1 = ig1 - b1, xm = wave_max(fmaxf(x0, x1));
        wl[2 * lane] = __expf(x0 - xm); wl[2 * lane + 1] = __expf(x1 - xm);
        if (lane == 0) { P.CH[unit * 2] = B; P.CH[unit * 2 + 1] = B + xm; }
    }
    __syncthreads();
#pragma unroll
    for (int i = 0; i < 4; ++i) { const int id = tid + 512 * i, row = id >> 4, ch = id & 15;
        float x[8]; unpack8(kraw[i], x); const float ws = wl[row];
#pragma unroll
        for (int e = 0; e < 8; ++e) x[e] *= ws;
        *(LAS u32x4*)(lds + IMG0 + row * TS + ch * 16) = pack8(x);
        *(LAS u32x4*)(lds + IMG1 + row * TS + ch * 16) = vraw[i]; }
    __syncthreads();
    f32x4 acc[8], accn = (f32x4){0.f, 0.f, 0.f, 0.f};
#pragma unroll
    for (int n = 0; n < 8; ++n) acc[n] = (f32x4){0.f, 0.f, 0.f, 0.f};
    const bf16x8 ones = (bf16x8){0x3F80, 0x3F80, 0x3F80, 0x3F80, 0x3F80, 0x3F80, 0x3F80, 0x3F80};
    LAS const unsigned char* trk = lds + IMG0 + (8 * kq + q) * TS + 8 * p + 32 * w;
    LAS const unsigned char* trv = lds + IMG1 + (8 * kq + q) * TS + 8 * p;
#pragma unroll
    for (int st = 0; st < 4; ++st) {
        const bf16x8 kf = tr2(trk + (32 * st) * TS, trk + (32 * st + 4) * TS);
        accn = __builtin_amdgcn_mfma_f32_16x16x32_bf16(ones, kf, accn, 0, 0, 0);
#pragma unroll
        for (int n = 0; n < 8; ++n) { const bf16x8 vf = tr2(trv + (32 * st) * TS + 32 * n, trv + (32 * st + 4) * TS + 32 * n);
            acc[n] = __builtin_amdgcn_mfma_f32_16x16x32_bf16(vf, kf, acc[n], 0, 0, 0); }
    }
    float* kvp = P.KV + (size_t)unit * 16384 + (16 * w + fr) * 128 + 4 * kq;
#pragma unroll
    for (int n = 0; n < 8; ++n) *(f32x4*)(kvp + 16 * n) = acc[n];
    if (kq == 0) P.NLOC[unit * 128 + 16 * w + fr] = accn[0];
    __syncthreads();
}

__device__ __forceinline__ void scan_unit(const MixP& P, int bh, int slice, int tid) {
    const size_t base = (size_t)bh * 16 * 16384 + slice * 2048 + tid * 4;
    f32x4 C = (f32x4){0.f, 0.f, 0.f, 0.f}; float M = 0.f, nv = 0.f;
    const bool nthr = (slice == 0 && tid < 128);
    f32x4 kvv[16];
#pragma unroll
    for (int c = 0; c < 16; ++c) kvv[c] = *(const f32x4*)(P.KV + base + (size_t)c * 16384);
#pragma unroll
    for (int c = 0; c < 16; ++c) {
        const float B = P.CH[(bh * 16 + c) * 2], a = P.CH[(bh * 16 + c) * 2 + 1];
        const float Mn = fmaxf(B + M, a), dec = __expf(B + M - Mn), add = __expf(a - Mn);
        float* kp = P.KV + base + (size_t)c * 16384;
        const f32x4 kv = kvv[c]; *(f32x4*)kp = C; C = dec * C + add * kv;
        if (nthr) { const float nl = P.NLOC[(bh * 16 + c) * 128 + tid]; P.NST[(bh * 16 + c) * 128 + tid] = nv; nv = dec * nv + add * nl; if (tid == 0) P.MST[bh * 16 + c] = M; }
        M = Mn;
    }
    *(f32x4*)(P.oCp + (size_t)bh * 16384 + slice * 2048 + tid * 4) = C;
    if (nthr) { P.oNp[bh * 128 + tid] = nv; if (tid == 0) P.oMp[bh] = M; }
}

__device__ __forceinline__ void mlo_unit(LAS unsigned char* lds, const MixP& P, int b, int h, int c, int tid) {
    const int lane = tid & 63, w = __builtin_amdgcn_readfirstlane(tid >> 6), fr = lane & 15, kq = lane >> 4, q = fr >> 2, p = fr & 3;
    const int r0 = b * 2048 + c * 128, unit = (b * 4 + h) * 16 + c;
    LAS float* xs = (LAS float*)(lds + SC_OFF); LAS float* ys = xs + 128; LAS float* wint = xs + 256; LAS float* emt = xs + 384; LAS float* nst = xs + 512;
    const float Mc = P.MST[unit];
    float lf0 = 0.f, lf1 = 0.f, ig0 = 0.f, ig1 = 0.f, n0v = 0.f, n1v = 0.f;
    if (w == 0) { const int s0 = r0 + 2 * lane; lf0 = P.LF[(size_t)s0 * 4 + h]; lf1 = P.LF[(size_t)(s0 + 1) * 4 + h]; ig0 = P.IG[(size_t)s0 * 4 + h]; ig1 = P.IG[(size_t)(s0 + 1) * 4 + h]; }
    else if (w == 1) { n0v = P.NST[unit * 128 + lane]; n1v = P.NST[unit * 128 + lane + 64]; }
    const int t = 16 * w + fr;
    const bf16_t* zrow = P.Z + (size_t)(r0 + t) * ZLD + h * 128;
    u32x4 kraw[4], vraw[4]; f32x4 craw[8]; bf16x8 qf[4];
#pragma unroll
    for (int i = 0; i < 4; ++i) { const int id = tid + 512 * i, row = id >> 4, ch = id & 15;
        const bf16_t* zr = P.Z + (size_t)(r0 + row) * ZLD + h * 128 + ch * 8; kraw[i] = *(const u32x4*)(zr + ZK); vraw[i] = *(const u32x4*)(zr + ZV); }
    { const float* cs = P.KV + (size_t)unit * 16384;
#pragma unroll
      for (int i = 0; i < 8; ++i) { const int id = tid + 512 * i, row = id >> 5, c4 = id & 31; craw[i] = *(const f32x4*)(cs + row * 128 + c4 * 4); } }
#pragma unroll
    for (int ds = 0; ds < 4; ++ds) qf[ds] = *(const bf16x8*)(zrow + ZQ + 32 * ds + 8 * kq);
    if (w == 0) {
        const float Pc = scan_add(lf0 + lf1, lane), b1 = Pc, b0 = Pc - lf1;
        const float x0 = ig0 - b0, x1 = ig1 - b1;
        const float PM = scan_max(fmaxf(x0, x1), lane); float prev = __shfl_up(PM, 1); if (lane == 0) prev = -INFINITY;
        const float y0 = fmaxf(Mc, fmaxf(prev, x0)), y1 = fmaxf(Mc, PM);
        xs[2 * lane] = x0; xs[2 * lane + 1] = x1; ys[2 * lane] = y0; ys[2 * lane + 1] = y1;
        wint[2 * lane] = __expf(Mc - y0); wint[2 * lane + 1] = __expf(Mc - y1);
        emt[2 * lane] = __expf(-(b0 + y0)); emt[2 * lane + 1] = __expf(-(b1 + y1));
    } else if (w == 1) { nst[lane] = n0v; nst[lane + 64] = n1v; }
#pragma unroll
    for (int i = 0; i < 4; ++i) { const int id = tid + 512 * i, row = id >> 4, ch = id & 15;
        *(LAS u32x4*)(lds + IMG0 + row * TS + ch * 16) = kraw[i];
        *(LAS u32x4*)(lds + IMG1 + row * TS + ch * 16) = vraw[i]; }
#pragma unroll
    for (int i = 0; i < 8; ++i) { const int id = tid + 512 * i, row = id >> 5, c4 = id & 31;
        u32x2 o; o.x = cvt_pk_bf16(craw[i][0], craw[i][1]); o.y = cvt_pk_bf16(craw[i][2], craw[i][3]); *(LAS u32x2*)(lds + IMG2 + row * TS + c4 * 8) = o; }
    __syncthreads();
    u32x2 ow[8];
#pragma unroll
    for (int n = 0; n < 8; ++n) ow[n] = *(const u32x2*)(zrow + ZO + 16 * n + 4 * kq);
    float dn = 0.f;
#pragma unroll
    for (int ds = 0; ds < 4; ++ds)
#pragma unroll
        for (int e = 0; e < 8; ++e) dn += __uint_as_float(((unsigned)(unsigned short)qf[ds][e]) << 16) * nst[32 * ds + 8 * kq + e];
    dn += __shfl_xor(dn, 16); dn += __shfl_xor(dn, 32);
    LAS const unsigned char* trv = lds + IMG1 + (4 * kq + q) * TS + 8 * p;
    LAS const unsigned char* trc = lds + IMG2 + (8 * kq + q) * TS + 8 * p;
    const float wi = wint[t];
    f32x4 o1[8];
#pragma unroll
    for (int n = 0; n < 8; ++n) o1[n] = (f32x4){0.f, 0.f, 0.f, 0.f};
#pragma unroll
    for (int ds = 0; ds < 4; ++ds)
#pragma unroll
        for (int n = 0; n < 8; ++n) { const bf16x8 cf = tr2(trc + (32 * ds) * TS + 32 * n, trc + (32 * ds + 4) * TS + 32 * n);
            o1[n] = __builtin_amdgcn_mfma_f32_16x16x32_bf16(cf, qf[ds], o1[n], 0, 0, 0); }
#pragma unroll
    for (int n = 0; n < 8; ++n) o1[n] = o1[n] * wi;
    f32x4 aS[8];
#pragma unroll
    for (int j = 0; j < 8; ++j) aS[j] = (f32x4){0.f, 0.f, 0.f, 0.f};
#pragma unroll
    for (int j = 0; j < 8; ++j) if (j <= w) {
#pragma unroll
        for (int ds = 0; ds < 4; ++ds) { const bf16x8 kf = *(LAS const bf16x8*)(lds + IMG0 + (16 * j + fr) * TS + (32 * ds + 8 * kq) * 2);
            aS[j] = __builtin_amdgcn_mfma_f32_16x16x32_bf16(kf, qf[ds], aS[j], 0, 0, 0); } }
    const float yt = ys[t]; float dsum = 0.f;
#pragma unroll
    for (int j = 0; j < 8; ++j) if (j <= w) {
#pragma unroll
        for (int r = 0; r < 4; ++r) { const int s = 16 * j + 4 * kq + r; const float wg = (s <= t) ? __expf(xs[s] - yt) : 0.f; aS[j][r] *= wg; dsum += aS[j][r]; } }
    dsum += __shfl_xor(dsum, 16); dsum += __shfl_xor(dsum, 32);
    const float den = dsum + wi * dn, rinv = 1.0f / fmaxf(fabsf(den), emt[t]);
#pragma unroll
    for (int st = 0; st < 4; ++st) if (2 * st <= w) {
        u32x4 sw; sw.x = cvt_pk_bf16(aS[2 * st][0], aS[2 * st][1]); sw.y = cvt_pk_bf16(aS[2 * st][2], aS[2 * st][3]);
        sw.z = cvt_pk_bf16(aS[2 * st + 1][0], aS[2 * st + 1][1]); sw.w = cvt_pk_bf16(aS[2 * st + 1][2], aS[2 * st + 1][3]);
        const bf16x8 sf = __builtin_bit_cast(bf16x8, sw);
#pragma unroll
        for (int n = 0; n < 8; ++n) { const bf16x8 vf = tr2(trv + (32 * st) * TS + 32 * n, trv + (32 * st + 16) * TS + 32 * n);
            o1[n] = __builtin_amdgcn_mfma_f32_16x16x32_bf16(vf, sf, o1[n], 0, 0, 0); } }
    float ssq = 0.f;
#pragma unroll
    for (int n = 0; n < 8; ++n)
#pragma unroll
        for (int r = 0; r < 4; ++r) { const float hv = o1[n][r] * rinv; o1[n][r] = hv; ssq += hv * hv; }
    ssq += __shfl_xor(ssq, 16); ssq += __shfl_xor(ssq, 32);
    const float rn = 1.0f / sqrtf(ssq * (1.0f / 128.0f) + EPS);
    bf16_t* yrow = P.YC + (size_t)(r0 + t) * 1024 + 512 + h * 128 + 4 * kq;
#pragma unroll
    for (int n = 0; n < 8; ++n) { const f32x4 g = *(const f32x4*)(P.mlnorm + h * 128 + 4 * kq + 16 * n); u32x2 o;
        o.x = cvt_pk_bf16(bf_lo(ow[n].x) * o1[n][0] * rn * g[0], bf_hi(ow[n].x) * o1[n][1] * rn * g[1]);
        o.y = cvt_pk_bf16(bf_lo(ow[n].y) * o1[n][2] * rn * g[2], bf_hi(ow[n].y) * o1[n][3] * rn * g[3]);
        *(u32x2*)(yrow + 16 * n) = o; }
    __syncthreads();
}

__device__ __forceinline__ void sample_unit(LAS unsigned char* lds, const MixP& P, int b, int h, int tid) {
    const int lane = tid & 63, w = __builtin_amdgcn_readfirstlane(tid >> 6);
    const int r0 = NP + b * 8, bh = b * 4 + h;
    LAS float* ql = (LAS float*)lds; LAS float* kl = ql + 1024; LAS float* vl = ql + 2048; LAS float* vnl = ql + 3072; LAS float* Sl = ql + 4096;
    LAS float* gsx = ql + 4160; LAS float* gsy = gsx + 8; LAS float* gwi = gsx + 16; LAS float* gem = gsx + 24; LAS float* gwe = gsx + 32; LAS float* gsc = gsx + 40; LAS float* qn = gsx + 48;
    LAS float* red = (LAS float*)(lds + 32768);
    f32x4 cvv[8];
    { const float* cs = P.stC + (size_t)bh * 16384 + (tid >> 5) * 128 + 4 * (tid & 31);
#pragma unroll
      for (int i = 0; i < 8; ++i) cvv[i] = *(const f32x4*)(cs + (size_t)(16 * i) * 128); }
    if (tid == 0) {
        const float m0 = P.stM[bh]; float bc = 0.f, pm = -INFINITY, mt = 0.f; float xv[8];
#pragma unroll
        for (int t = 0; t < 8; ++t) { const float lf = P.LF[(size_t)(r0 + t) * 4 + h], ig = P.IG[(size_t)(r0 + t) * 4 + h];
            bc += lf; const float x = ig - bc; pm = fmaxf(pm, x); const float y = fmaxf(m0, pm); mt = bc + y; xv[t] = x;
            gsx[t] = x; gsy[t] = y; gwi[t] = __expf(m0 - y); gem[t] = __expf(-mt); }
        const float mnew = mt;
#pragma unroll
        for (int t = 0; t < 8; ++t) gwe[t] = __expf(bc + xv[t] - mnew);
        gsc[0] = __expf(bc + m0 - mnew); gsc[1] = mnew;
    }
    { const int t = tid >> 6, e = 2 * (tid & 63); const bf16_t* zr = P.Z + (size_t)(r0 + t) * ZLD + h * 128 + e;
      const unsigned qw = *(const unsigned*)(zr + ZQ), kw = *(const unsigned*)(zr + ZK), vw = *(const unsigned*)(zr + ZV);
      ql[t * 128 + e] = bf_lo(qw); ql[t * 128 + e + 1] = bf_hi(qw); kl[t * 128 + e] = bf_lo(kw); kl[t * 128 + e + 1] = bf_hi(kw); vl[t * 128 + e] = bf_lo(vw); vl[t * 128 + e + 1] = bf_hi(vw); }
    { const int t = w;
      const u32x4 raw = *(const u32x4*)(P.Z + (size_t)(r0 + t) * ZLD + ZVG + 8 * lane);
      float x[8]; unpack8(raw, x);
      float s = ((x[0] + x[1]) + (x[2] + x[3])) + ((x[4] + x[5]) + (x[6] + x[7]));
      const float mean = wave_sum(s) * (1.0f / 512.0f); float q2 = 0.f;
#pragma unroll
      for (int e = 0; e < 8; ++e) { x[e] -= mean; q2 += x[e] * x[e]; }
      const float rstd = 1.0f / sqrtf(wave_sum(q2) * (1.0f / 512.0f) + EPS);
      if ((lane >> 4) == h) { const f32x4 a = *(const f32x4*)(P.lng + 8 * lane), a2 = *(const f32x4*)(P.lng + 8 * lane + 4), c0 = *(const f32x4*)(P.lnb + 8 * lane), c1 = *(const f32x4*)(P.lnb + 8 * lane + 4);
#pragma unroll
          for (int e = 0; e < 4; ++e) { x[e] = x[e] * rstd * a[e] + c0[e]; x[4 + e] = x[4 + e] * rstd * a2[e] + c1[e]; }
          float* vo = P.oVs + ((size_t)b * 8 + t) * 512 + 8 * lane; *(f32x4*)vo = (f32x4){x[0], x[1], x[2], x[3]}; *(f32x4*)(vo + 4) = (f32x4){x[4], x[5], x[6], x[7]};
#pragma unroll
          for (int e = 0; e < 8; ++e) vnl[t * 128 + 8 * (lane & 15) + e] = x[e]; } }
    __syncthreads();
    if (tid < 64) { const int t = tid >> 3, s = tid & 7; float dot = 0.f;
        for (int d = 0; d < 128; ++d) dot += ql[t * 128 + d] * kl[s * 128 + d];
        Sl[tid] = (s <= t) ? dot * __expf(gsx[s] - gsy[t]) : 0.f; }
    else if (tid < 72) { const int t = tid - 64; float dot = 0.f; for (int d = 0; d < 128; ++d) dot += ql[t * 128 + d] * P.stN[bh * 128 + d]; qn[t] = dot; }
    { const int t = w, e = 2 * lane; float s0 = 0.f, s1 = 0.f;
      for (int j = 0; j <= t; ++j) { const float wv = P.gm_ws[(size_t)h * 16384 + t * 128 + j]; s0 += wv * vnl[j * 128 + e]; s1 += wv * vnl[j * 128 + e + 1]; }
      const float bsv = P.bs[h * 128 + t]; const unsigned uw = *(const unsigned*)(P.Z + (size_t)(r0 + t) * ZLD + ZU + h * 128 + e);
      *(unsigned*)(P.YC + (size_t)(r0 + t) * 1024 + h * 128 + e) = cvt_pk_bf16(bf_lo(uw) * (s0 + bsv), bf_hi(uw) * (s1 + bsv)); }
    const float dec = gsc[0];
    { const int eg = tid & 31, dq = tid >> 5;
      f32x4 aq[8];
#pragma unroll
      for (int t = 0; t < 8; ++t) aq[t] = (f32x4){0.f, 0.f, 0.f, 0.f};
      f32x4 v4[8];
#pragma unroll
      for (int s = 0; s < 8; ++s) v4[s] = *(LAS const f32x4*)(vl + s * 128 + 4 * eg);
      float* co = P.oCs + (size_t)bh * 16384;
#pragma unroll
      for (int i = 0; i < 8; ++i) { const int d = dq + 16 * i; const f32x4 cv = cvv[i];
          f32x4 cn = dec * cv;
#pragma unroll
          for (int t = 0; t < 8; ++t) { aq[t] += ql[t * 128 + d] * cv; cn += (gwe[t] * kl[t * 128 + d]) * v4[t]; }
          *(f32x4*)(co + d * 128 + 4 * eg) = cn; }
#pragma unroll
      for (int t = 0; t < 8; ++t) *(LAS f32x4*)(red + (dq * 8 + t) * 128 + 4 * eg) = aq[t]; }
    __syncthreads();
    { const int t = w, e = 2 * lane; float qc0 = 0.f, qc1 = 0.f;
#pragma unroll
      for (int dq = 0; dq < 16; ++dq) { qc0 += red[(dq * 8 + t) * 128 + e]; qc1 += red[(dq * 8 + t) * 128 + e + 1]; }
      float n0 = 0.f, n1 = 0.f, dsum = 0.f;
#pragma unroll
      for (int s = 0; s < 8; ++s) { const float sv = Sl[t * 8 + s]; n0 += sv * vl[s * 128 + e]; n1 += sv * vl[s * 128 + e + 1]; dsum += sv; }
      const float wi = gwi[t], den = dsum + wi * qn[t], rinv = 1.0f / fmaxf(fabsf(den), gem[t]);
      const float h0 = (n0 + wi * qc0) * rinv, h1 = (n1 + wi * qc1) * rinv;
      const float rn = 1.0f / sqrtf(wave_sum(h0 * h0 + h1 * h1) * (1.0f / 128.0f) + EPS);
      const unsigned ow = *(const unsigned*)(P.Z + (size_t)(r0 + t) * ZLD + ZO + h * 128 + e);
      *(unsigned*)(P.YC + (size_t)(r0 + t) * 1024 + 512 + h * 128 + e) = cvt_pk_bf16(bf_lo(ow) * h0 * rn * P.mlnorm[h * 128 + e], bf_hi(ow) * h1 * rn * P.mlnorm[h * 128 + e + 1]); }
    if (tid < 128) { float nn = dec * P.stN[bh * 128 + tid];
#pragma unroll
        for (int s = 0; s < 8; ++s) nn += gwe[s] * kl[s * 128 + tid];
        P.oNs[bh * 128 + tid] = nn; if (tid == 0) P.oMs[bh] = gsc[1]; }
    __syncthreads();
}
}
namespace sg {
using pg8::bf16_t; using pg8::bf16x8; using pg8::f32x4; using pg8::u32x4; using pg8::u32x2; using pg8::cvt_pk_bf16; using pg8::bf_lo; using pg8::bf_hi; using pg8::sigmoid_f; using pg8::gelu_tanh_f; using pg8::row_rs;
constexpr int ROW0 = 16384;

struct Epi { bf16_t* O; int ldc; const float* rn; const bf16_t* Hb; bf16_t* Ho; float* SSO; const float* SSI; const bf16_t* PROJ; };

template <int MODE> __device__ __forceinline__ void epilogue(const Epi& E, int lrow, int ct, int kq, f32x4 (&acc)[4]) {
    const int row = ROW0 + lrow;
    float rs = 1.f;
    if (MODE == 3) rs = E.rn[row];
    if (MODE == 4) { rs = row_rs(E.SSI, row); rs = rs * rs; }
    if (MODE == 5) rs = row_rs(E.SSI, row);
    float sq = 0.f;
#pragma unroll
    for (int n = 0; n < 4; ++n) { const int col = 64 * ct + 16 * n + 4 * kq; f32x4 v = acc[n];
        if (MODE == 0) {
            if (col < 1024) {
#pragma unroll
                for (int e = 0; e < 4; ++e) v[e] = gelu_tanh_f(v[e]); }
            else if (col >= 2560) {
#pragma unroll
                for (int e = 0; e < 4; ++e) v[e] = sigmoid_f(v[e]); }
        }
        if (MODE == 2) {
#pragma unroll
            for (int e = 0; e < 4; ++e) { const float a = fmaxf(v[e], 0.f); v[e] = a * a; } }
        if (MODE <= 2) { u32x2 w; w.x = cvt_pk_bf16(v[0], v[1]); w.y = cvt_pk_bf16(v[2], v[3]); *(u32x2*)(E.O + (size_t)row * E.ldc + col) = w; continue; }
        const size_t off = (size_t)row * 1024 + col;
        const u32x2 hw = *(const u32x2*)(E.Hb + off); const f32x4 r = (f32x4){bf_lo(hw.x), bf_hi(hw.x), bf_lo(hw.y), bf_hi(hw.y)};
        if (MODE == 3) v = r * rs + v;
        else if (MODE == 4) v = r + v * rs;
        else { const u32x2 pw = *(const u32x2*)(E.PROJ + off);
            v[0] = r[0] + sigmoid_f(v[0] * rs) * bf_lo(pw.x); v[1] = r[1] + sigmoid_f(v[1] * rs) * bf_hi(pw.x); v[2] = r[2] + sigmoid_f(v[2] * rs) * bf_lo(pw.y); v[3] = r[3] + sigmoid_f(v[3] * rs) * bf_hi(pw.y); }
        { u32x2 w; w.x = cvt_pk_bf16(v[0], v[1]); w.y = cvt_pk_bf16(v[2], v[3]); *(u32x2*)(E.Ho + off) = w; }
        sq += (v[0] * v[0] + v[1] * v[1]) + (v[2] * v[2] + v[3] * v[3]); }
    if (MODE >= 3) { sq += __shfl_xor(sq, 16); sq += __shfl_xor(sq, 32); if (kq == 0) E.SSO[(size_t)row * 16 + ct] = sq; }
}

constexpr int KT = 128;
__device__ __forceinline__ int toff(int row, int ch) { return (row << 8) + ((ch ^ (row & 15)) << 4); }
struct Issue { int u, kt, left; };
__device__ __forceinline__ void issue_tile(LAS unsigned char* st, Issue& I, const bf16_t* A, const bf16_t* Bt, int K, int nkt, int G, int w, int lane) {
    if (I.left > 0) {
        const bf16_t* ab = A + (size_t)(64 * (I.u & 15)) * K + I.kt * KT; const bf16_t* bb = Bt + (size_t)(64 * (I.u >> 4)) * K + I.kt * KT;
#pragma unroll
        for (int jj = 0; jj < 2; ++jj) { const int j = 2 * w + jj, row = 4 * j + (lane >> 4), ch = (lane & 15) ^ (row & 15);
            __builtin_amdgcn_global_load_lds((const unsigned*)(ab + (size_t)row * K + ch * 8), (LAS unsigned*)(st + j * 1024), 16, 0, 0);
            __builtin_amdgcn_global_load_lds((const unsigned*)(bb + (size_t)row * K + ch * 8), (LAS unsigned*)(st + 16384 + j * 1024), 16, 0, 0); }
        --I.left; if (++I.kt == nkt) { I.kt = 0; I.u += G; }
    } else {
#pragma unroll
        for (int jj = 0; jj < 2; ++jj) { const int j = 2 * w + jj, row = 4 * j + (lane >> 4), ch = (lane & 15) ^ (row & 15);
            __builtin_amdgcn_global_load_lds((const unsigned*)(A + (size_t)row * K + ch * 8), (LAS unsigned*)(st + j * 1024), 16, 0, 0);
            __builtin_amdgcn_global_load_lds((const unsigned*)(Bt + (size_t)row * K + ch * 8), (LAS unsigned*)(st + 16384 + j * 1024), 16, 0, 0); }
    }
}
template <int MODE> __device__ __forceinline__ void phase(LAS unsigned char* lds, const bf16_t* A0, const bf16_t* Bt, int K, int N, const Epi& E, int vcu, int G, int tid) {
    const int lane = tid & 63, w = __builtin_amdgcn_readfirstlane(tid >> 6), fr = lane & 15, kq = lane >> 4, wm = w & 3, wk = w >> 2;
    const bf16_t* A = A0 + (size_t)ROW0 * K;
    const int nu = 16 * (N >> 6), nkt = K / KT;
    if (vcu >= nu) return;
    const int nmine = (nu - vcu + G - 1) / G, total = nmine * nkt;
    f32x4 acc[4];
#pragma unroll
    for (int n = 0; n < 4; ++n) acc[n] = (f32x4){0.f, 0.f, 0.f, 0.f};
    Issue I{vcu, 0, total};
    issue_tile(lds, I, A, Bt, K, nkt, G, w, lane); issue_tile(lds + 32768, I, A, Bt, K, nkt, G, w, lane); issue_tile(lds + 65536, I, A, Bt, K, nkt, G, w, lane);
    int kt = 0, u = vcu;
    for (int i = 0; i < total; ++i) {
        asm volatile("s_waitcnt vmcnt(8)" ::: "memory");
        __builtin_amdgcn_s_barrier();
        asm volatile("" ::: "memory");
        issue_tile(lds + ((i + 3) & 3) * 32768, I, A, Bt, K, nkt, G, w, lane);
        { LAS const unsigned char* st = lds + (i & 3) * 32768;
#pragma unroll
          for (int ks = 0; ks < 2; ++ks) { const int ch = 4 * (2 * wk + ks) + kq;
              const bf16x8 af = *(LAS const bf16x8*)(st + toff(16 * wm + fr, ch));
#pragma unroll
              for (int n = 0; n < 4; ++n) { const bf16x8 bf = *(LAS const bf16x8*)(st + 16384 + toff(16 * n + fr, ch));
                  acc[n] = __builtin_amdgcn_mfma_f32_16x16x32_bf16(bf, af, acc[n], 0, 0, 0); } } }
        if (kt + 1 == nkt) {
            LAS f32x4* xch = (LAS f32x4*)(lds + 131072) + (wm * 64 + lane) * 4;
            if (wk == 1) {
#pragma unroll
                for (int n = 0; n < 4; ++n) { xch[n] = acc[n]; acc[n] = (f32x4){0.f, 0.f, 0.f, 0.f}; } }
            asm volatile("s_waitcnt lgkmcnt(0)" ::: "memory"); __builtin_amdgcn_s_barrier(); asm volatile("" ::: "memory");
            if (wk == 0) {
#pragma unroll
                for (int n = 0; n < 4; ++n) acc[n] += xch[n];
                epilogue<MODE>(E, 64 * (u & 15) + 16 * wm + fr, u >> 4, kq, acc);
#pragma unroll
                for (int n = 0; n < 4; ++n) acc[n] = (f32x4){0.f, 0.f, 0.f, 0.f}; }
            kt = 0; u += G;
        } else ++kt;
    }
    asm volatile("s_waitcnt vmcnt(0) lgkmcnt(0)" ::: "memory"); __builtin_amdgcn_s_barrier(); asm volatile("" ::: "memory");
}

__device__ __forceinline__ int toff128(int row, int ch) { return (row << 7) + ((ch ^ ((row >> 1) & 7)) << 4); }
__device__ __forceinline__ void issue_tile128(LAS unsigned char* st, Issue& I, const bf16_t* A, const bf16_t* Bt, int K, int nkt, int G, int w, int lane) {
    const bool live = I.left > 0;
    const bf16_t* ab = live ? A + (size_t)(128 * (I.u & 7)) * K + I.kt * 64 : A; const bf16_t* bb = live ? Bt + (size_t)(128 * (I.u >> 3)) * K + I.kt * 64 : Bt;
#pragma unroll
    for (int jj = 0; jj < 2; ++jj) { const int j = 2 * w + jj, row = 8 * j + (lane >> 3), ch = (lane & 7) ^ ((row >> 1) & 7);
        __builtin_amdgcn_global_load_lds((const unsigned*)(ab + (size_t)row * K + ch * 8), (LAS unsigned*)(st + j * 1024), 16, 0, 0);
        __builtin_amdgcn_global_load_lds((const unsigned*)(bb + (size_t)row * K + ch * 8), (LAS unsigned*)(st + 16384 + j * 1024), 16, 0, 0); }
    if (live) { --I.left; if (++I.kt == nkt) { I.kt = 0; I.u += G; } }
}
template <int MODE> __device__ __forceinline__ void phase128(LAS unsigned char* lds, const bf16_t* A0, const bf16_t* Bt, int K, int N, const Epi& E, int vcu, int G, int tid) {
    static_assert(MODE == 0 || MODE == 2, "phase128: bf16-store epilogues only");
    const int lane = tid & 63, w = __builtin_amdgcn_readfirstlane(tid >> 6), fr = lane & 15, kq = lane >> 4, wm = w >> 2, wn = w & 3;
    const bf16_t* A = A0 + (size_t)ROW0 * K;
    const int nu = 8 * (N >> 7), nkt = K / 64;
    if (vcu >= nu) return;
    const int nmine = (nu - vcu + G - 1) / G, total = nmine * nkt;
    f32x4 acc[4][2];
#pragma unroll
    for (int m = 0; m < 4; ++m) { acc[m][0] = (f32x4){0.f, 0.f, 0.f, 0.f}; acc[m][1] = (f32x4){0.f, 0.f, 0.f, 0.f}; }
    Issue I{vcu, 0, total};
    issue_tile128(lds, I, A, Bt, K, nkt, G, w, lane); issue_tile128(lds + 32768, I, A, Bt, K, nkt, G, w, lane); issue_tile128(lds + 65536, I, A, Bt, K, nkt, G, w, lane);
    int kt = 0, u = vcu;
    for (int i = 0; i < total; ++i) {
        asm volatile("s_waitcnt vmcnt(8)" ::: "memory");
        __builtin_amdgcn_s_barrier();
        asm volatile("" ::: "memory");
        issue_tile128(lds + ((i + 3) & 3) * 32768, I, A, Bt, K, nkt, G, w, lane);
        { LAS const unsigned char* st = lds + (i & 3) * 32768;
#pragma unroll
          for (int ks = 0; ks < 2; ++ks) { const int ch = 4 * ks + kq;
              const bf16x8 b0 = *(LAS const bf16x8*)(st + 16384 + toff128(32 * wn + fr, ch)), b1 = *(LAS const bf16x8*)(st + 16384 + toff128(32 * wn + 16 + fr, ch));
#pragma unroll
              for (int m = 0; m < 4; ++m) { const bf16x8 af = *(LAS const bf16x8*)(st + toff128(64 * wm + 16 * m + fr, ch));
                  acc[m][0] = __builtin_amdgcn_mfma_f32_16x16x32_bf16(b0, af, acc[m][0], 0, 0, 0); acc[m][1] = __builtin_amdgcn_mfma_f32_16x16x32_bf16(b1, af, acc[m][1], 0, 0, 0); } } }
        if (kt + 1 == nkt) {
            const int rt = u & 7, ct = u >> 3;
#pragma unroll
            for (int m = 0; m < 4; ++m) { const int row = ROW0 + 128 * rt + 64 * wm + 16 * m + fr;
#pragma unroll
                for (int n = 0; n < 2; ++n) { const int col = 128 * ct + 32 * wn + 16 * n + 4 * kq; f32x4 v = acc[m][n];
                    if (MODE == 0) {
                        if (col < 1024) {
#pragma unroll
                            for (int e = 0; e < 4; ++e) v[e] = gelu_tanh_f(v[e]); }
                        else if (col >= 2560) {
#pragma unroll
                            for (int e = 0; e < 4; ++e) v[e] = sigmoid_f(v[e]); } }
                    if (MODE == 2) {
#pragma unroll
                        for (int e = 0; e < 4; ++e) { const float a = fmaxf(v[e], 0.f); v[e] = a * a; } }
                    u32x2 o; o.x = cvt_pk_bf16(v[0], v[1]); o.y = cvt_pk_bf16(v[2], v[3]); *(u32x2*)(E.O + (size_t)row * E.ldc + col) = o;
                    acc[m][n] = (f32x4){0.f, 0.f, 0.f, 0.f}; } }
            kt = 0; u += G;
        } else ++kt;
    }
    asm volatile("s_waitcnt vmcnt(0) lgkmcnt(0)" ::: "memory"); __builtin_amdgcn_s_barrier(); asm volatile("" ::: "memory");
}
}

#ifndef HOST_DUP_PHASE
#define HOST_DUP_PHASE -1
#endif
#ifndef TP_A
#define TP_A -1
#define TP_B -1
#endif
#ifndef HOST_DUP_FLAGS
#define HOST_DUP_FLAGS 1
#endif
#ifndef HOST_EXTRA_BARS
#define HOST_EXTRA_BARS 0
#endif
#ifndef MK_ONE_LAUNCH
#define MK_ONE_LAUNCH 1
#endif
constexpr int NWAVES = 8;
constexpr int D = 1024, NPR = 16384, NSR = 1024, M = NPR + NSR, NIN = 3072, INC = 3080, FF = 4096, PLE = 256;
constexpr int N_PHASES = 10;
constexpr size_t MiB = 1u << 20;
constexpr size_t WS_CTL = 0, CTL_ZERO_BYTES = 65536;
constexpr int CW_BAR = 1024;
constexpr size_t WS_WIN = 1 * MiB;
constexpr size_t WS_WOUT = WS_WIN + (size_t)NIN * D * 2;
constexpr size_t WS_WUP = WS_WOUT + (size_t)D * D * 2;
constexpr size_t WS_WDOWN = WS_WUP + (size_t)FF * D * 2;
constexpr size_t WS_WGATE = WS_WDOWN + (size_t)D * FF * 2;
constexpr size_t WS_WPROJ = WS_WGATE + (size_t)D * D * 2;
constexpr size_t WS_WSB = WS_WPROJ + (size_t)D * PLE * 2;
constexpr size_t WS_IG = WS_WSB + 4 * 128 * 128 * 2;
constexpr size_t WS_LF = WS_IG + (size_t)M * 16;
constexpr size_t WS_SS1 = WS_LF + (size_t)M * 16;
constexpr size_t WS_SS2 = WS_SS1 + (size_t)M * 64;
constexpr size_t WS_SS3 = WS_SS2 + (size_t)M * 64;
constexpr size_t WS_CH = WS_SS3 + (size_t)M * 64;
constexpr size_t WS_MST = WS_CH + 4096;
constexpr size_t WS_NLOC = WS_MST + 4096;
constexpr size_t WS_NST = WS_NLOC + 512 * 128 * 4;
constexpr size_t WS_RN = WS_NST + 512 * 128 * 4;
constexpr size_t WS_LNS = WS_RN + 69632;
constexpr size_t WS_PE = WS_LNS + (size_t)16384 * 64;
constexpr size_t WS_RA = WS_PE + (size_t)M * PLE * 2;
constexpr size_t WS_RB = WS_RA + (size_t)M * D * 2;
constexpr size_t WS_YC = WS_RB + (size_t)M * NIN * 2;
constexpr size_t WS_KV = WS_RB + (size_t)M * FF * 2;
constexpr size_t WS_END = WS_KV + (size_t)M * D * 2;
static_assert(WS_END <= 256 * MiB, "d_ws map");
static_assert(WS_WIN % 256 == 0 && WS_IG % 256 == 0 && WS_PE % 256 == 0 && WS_RA % 256 == 0 && WS_RB % 256 == 0 && WS_YC % 256 == 0 && WS_KV % 256 == 0, "alignment");
constexpr size_t O_Y = 0, O_CP = (size_t)M * D, O_NP = O_CP + 8 * 4 * 16384, O_MP = O_NP + 8 * 4 * 128, O_VP = O_MP + 32, O_CS = O_VP + 8 * 128 * 512,
                 O_NS = O_CS + (size_t)128 * 4 * 16384, O_MS = O_NS + 128 * 4 * 128, O_VS = O_MS + 512, O_END = O_VS + 128 * 8 * 512;
constexpr int RING_OFF = 0, RING_BYTES = 131072, XCH_BYTES = 16384, LDSCTL_OFF = RING_BYTES + XCH_BYTES, MISC_OFF = LDSCTL_OFF + 320, LDS_BYTES = LDSCTL_OFF + 1024;

typedef unsigned short bf16;
typedef unsigned v4u __attribute__((ext_vector_type(4)));
typedef float f32x4 __attribute__((ext_vector_type(4)));
#define GAS __attribute__((address_space(1)))
typedef GAS unsigned gu32;
#define RLX_AGENT __ATOMIC_RELAXED, __HIP_MEMORY_SCOPE_AGENT
#define LDS_WAIT() asm volatile("s_waitcnt lgkmcnt(0)" ::: "memory")

struct Args { const float* in[24]; float* out; unsigned char* ws; int ph_lo, ph_hi, flags, extra_bars; };

#define XB_TMO      128
#define XB_XCNT(j)  (256  + 64 * (j))
#define XB_XSUB(j)  (1280 + 64 * (j))
#define XB_XGEN(j)  (2304 + 64 * (j))
#define XB_TOP      3328
#define XB_TOPGEN   3392
#define XCD_BAR_WORDS 3456
#define XB_SPIN_CAP (1u << 18)

__device__ __forceinline__ unsigned xb_ld(unsigned* p)              { return __hip_atomic_load(p, __ATOMIC_RELAXED, __HIP_MEMORY_SCOPE_AGENT); }
__device__ __forceinline__ unsigned xb_add(unsigned* p, unsigned v) { return __hip_atomic_fetch_add(p, v, __ATOMIC_RELAXED, __HIP_MEMORY_SCOPE_AGENT); }
__device__ __forceinline__ unsigned xb_xcc_id() { return (unsigned)__builtin_amdgcn_s_getreg((3 << 11) | 20) & 0xFu; }
#define XB_SPIN(cond, bar) do { unsigned _sp = 0; while (cond) { __builtin_amdgcn_s_sleep(1); \
    if ((++_sp & 255u) == 0u) { if (xb_ld(&(bar)[XB_TMO])) break; if (_sp > XB_SPIN_CAP) { atomicAdd(&(bar)[XB_TMO], 1u); break; } } } } while (0)

struct XcdBarrier {
    unsigned* bar; unsigned x;
    volatile LAS unsigned* st;
};

__device__ __forceinline__ XcdBarrier xcd_barrier_post(unsigned* bar, volatile LAS unsigned* st) {
    XcdBarrier b; b.bar = bar; b.x = xb_xcc_id(); b.st = st;
    if (threadIdx.x == 0) (void)xb_add(&bar[XB_XCNT(b.x)], 1u);
    return b;
}
__device__ __forceinline__ void xcd_barrier_complete(unsigned* bar, unsigned x, unsigned& nloc, unsigned& nx) {
    const unsigned G = gridDim.x * gridDim.y * gridDim.z;
    unsigned sum, cnt, mine, sp = 0u;
    for (;;) {
        sum = 0u; cnt = 0u; mine = 0u;
#pragma unroll
        for (unsigned j = 0; j < 16; ++j) { const unsigned c = xb_ld(&bar[XB_XCNT(j)]); sum += c; cnt += (c > 0u) ? 1u : 0u; mine = (j == x) ? c : mine; }
        if (sum == G) break;
        __builtin_amdgcn_s_sleep(1);
        if ((++sp & 255u) == 0u) { if (xb_ld(&bar[XB_TMO])) break; if (sp > XB_SPIN_CAP) { atomicAdd(&bar[XB_TMO], 1u); break; } }
    }
    nloc = mine > 0u ? mine : 1u; nx = cnt > 0u ? cnt : 1u;
}

__device__ __forceinline__ void xcd_barrier(const XcdBarrier& b) {
    asm volatile("s_waitcnt vmcnt(0)" ::: "memory");
    __syncthreads();
    if (threadIdx.x == 0) {
        unsigned* bar = b.bar;
        __builtin_amdgcn_s_waitcnt(0);
        unsigned nloc = b.st[0], nx = b.st[1];
        if (nloc == 0u) { xcd_barrier_complete(bar, b.x, nloc, nx); b.st[0] = nloc; b.st[1] = nx; }
        const unsigned old = xb_add(&bar[XB_XSUB(b.x)], 1u);
        const unsigned gen = old / nloc;
        if (old + 1u == (gen + 1u) * nloc) {
            __builtin_amdgcn_fence(__ATOMIC_RELEASE, "agent");
            asm volatile("s_waitcnt vmcnt(0)" ::: "memory");
            const unsigned og = xb_add(&bar[XB_TOP], 1u);
            const unsigned tg = og / nx;
            if (og + 1u == (tg + 1u) * nx) xb_add(&bar[XB_TOPGEN], 1u);
            else XB_SPIN(xb_ld(&bar[XB_TOPGEN]) == tg, bar);
            __builtin_amdgcn_fence(__ATOMIC_ACQUIRE, "agent");
            xb_add(&bar[XB_XGEN(b.x)], 1u);
            asm volatile("s_waitcnt vmcnt(0)" ::: "memory");
        } else {
            XB_SPIN(xb_ld(&bar[XB_XGEN(b.x)]) == gen, bar);
            __builtin_amdgcn_fence(__ATOMIC_ACQUIRE, "agent");
            asm volatile("s_waitcnt vmcnt(0)" ::: "memory");
        }
    }
    __syncthreads();
}

__device__ __forceinline__ void p0_transpose_item(const float* W, int ldw, int K, int N, const float* gain, bf16* WT, LAS float* scr, int item, int lane, bool kscale) {
    const int nblk = N / 32, kb = item / nblk, nb = item % nblk, k0 = 64 * kb, n0 = 32 * nb;
    const float cs = (kscale && n0 >= 1536 && n0 < 2048) ? 0.08838834764831845f : 1.0f;
    float wv[32];
#pragma unroll
    for (int i = 0; i < 32; ++i) { const int kk = 2 * i + (lane >> 5); wv[i] = W[(size_t)(k0 + kk) * ldw + n0 + (lane & 31)]; }
#pragma unroll
    for (int i = 0; i < 32; ++i) { const int kk = 2 * i + (lane >> 5); const float g = gain ? gain[k0 + kk] * cs : cs; scr[kk * 33 + (lane & 31)] = wv[i] * g; }
    LDS_WAIT(); asm volatile("" ::: "memory");
    const int c = lane & 7;
#pragma unroll
    for (int j = 0; j < 4; ++j) { const int n = (lane >> 3) + 8 * j; const LAS float* s = scr + (8 * c) * 33 + n;
        v4u o; o.x = pg8::cvt_pk_bf16(s[0 * 33], s[1 * 33]); o.y = pg8::cvt_pk_bf16(s[2 * 33], s[3 * 33]); o.z = pg8::cvt_pk_bf16(s[4 * 33], s[5 * 33]); o.w = pg8::cvt_pk_bf16(s[6 * 33], s[7 * 33]);
        *(v4u*)(WT + (size_t)(n0 + n) * K + k0 + 8 * c) = o; }
    LDS_WAIT(); asm volatile("" ::: "memory");
}

__device__ __forceinline__ float log_sigmoid_f(float x) { return fminf(x, 0.f) - log1pf(__expf(-fabsf(x))); }

struct RowIn { f32x4 v[4]; f32x4 pv; };
__device__ __forceinline__ void p0_row_load(const Args& A, int m, int lane, RowIn& R) {
    const float* xrow = (m < NPR) ? A.in[0] + (size_t)m * D : A.in[1] + (size_t)(m - NPR) * D;
    const float* prow = (m < NPR) ? A.in[2] + (size_t)m * PLE : A.in[3] + (size_t)(m - NPR) * PLE;
    const f32x4* xr = (const f32x4*)xrow + lane;
#pragma unroll
    for (int j = 0; j < 4; ++j) R.v[j] = xr[64 * j];
    R.pv = *((const f32x4*)prow + lane);
}
__device__ __forceinline__ void p0_row_finish(unsigned char* ws, int m, int lane, RowIn& R, const float (&gwt)[4][4][8], float gbias) {
    float s = 0.f;
#pragma unroll
    for (int j = 0; j < 4; ++j) s += (R.v[j][0] * R.v[j][0] + R.v[j][1] * R.v[j][1]) + (R.v[j][2] * R.v[j][2] + R.v[j][3] * R.v[j][3]);
    const float rnv = sqrtf(mix::wave_sum(s) * (1.0f / D) + 1e-6f), rinv = 1.0f / rnv;
    if (lane == 8) ((float*)(ws + WS_RN))[m] = rnv;
    unsigned long long* o8 = (unsigned long long*)((bf16*)(ws + WS_RA) + (size_t)m * D) + lane;
    float g8[8];
#pragma unroll
    for (int q = 0; q < 8; ++q) g8[q] = 0.f;
#pragma unroll
    for (int j = 0; j < 4; ++j) { const f32x4 v = R.v[j] * rinv;
        o8[64 * j] = (unsigned long long)pg8::cvt_pk_bf16(v[0], v[1]) | ((unsigned long long)pg8::cvt_pk_bf16(v[2], v[3]) << 32);
#pragma unroll
        for (int c = 0; c < 4; ++c)
#pragma unroll
            for (int q = 0; q < 8; ++q) g8[q] += v[c] * gwt[j][c][q]; }
#pragma unroll
    for (int q = 0; q < 8; ++q) g8[q] = mix::row_sum16(g8[q]);
    const int q8 = lane & 7;
    float val = q8 == 0 ? g8[0] : q8 == 1 ? g8[1] : q8 == 2 ? g8[2] : q8 == 3 ? g8[3] : q8 == 4 ? g8[4] : q8 == 5 ? g8[5] : q8 == 6 ? g8[6] : g8[7];
    val += __shfl_xor(val, 16); val += __shfl_xor(val, 32);
    if (lane < 4) ((float*)(ws + WS_IG))[(size_t)m * 4 + lane] = val + gbias;
    else if (lane < 8) ((float*)(ws + WS_LF))[(size_t)m * 4 + lane - 4] = log_sigmoid_f(val + gbias);
    *((unsigned long long*)((bf16*)(ws + WS_PE) + (size_t)m * PLE) + lane) = (unsigned long long)pg8::cvt_pk_bf16(R.pv[0], R.pv[1]) | ((unsigned long long)pg8::cvt_pk_bf16(R.pv[2], R.pv[3]) << 32);
}

__device__ __forceinline__ void p0_prologue(const Args& A, LAS unsigned char* lds, int vcu, int G, int tid) {
    const int lane = tid & 63, wave = __builtin_amdgcn_readfirstlane(tid >> 6);
    unsigned char* ws = A.ws;
    LAS float* scr = (LAS float*)(lds + RING_OFF + wave * 8704);
    LAS float* gtab = (LAS float*)(lds + RING_OFF + 8 * 8704);
    const int gw = vcu * NWAVES + wave, NGW = G * NWAVES;
    for (int k = tid; k < D; k += NWAVES * 64) { const float g = A.in[7][k]; const float* wp = A.in[8] + (size_t)k * INC + NIN;
        const f32x4 a = *(const f32x4*)wp, b = *(const f32x4*)(wp + 4); *(LAS f32x4*)(gtab + k * 8) = a * g; *(LAS f32x4*)(gtab + k * 8 + 4) = b * g; }
    constexpr int I_IN = (D / 64) * (NIN / 32), I_OUT = (D / 64) * (D / 32), I_UP = (D / 64) * (FF / 32), I_DOWN = (FF / 64) * (D / 32), I_GATE = I_OUT, I_PROJ = (PLE / 64) * (D / 32);
    constexpr int NITEMS = I_IN + I_OUT + I_UP + I_DOWN + I_GATE + I_PROJ;
    for (int it = gw; it < NITEMS; it += NGW) {
        int r = it;
        if (r < I_IN) { p0_transpose_item(A.in[8], INC, D, NIN, A.in[7], (bf16*)(ws + WS_WIN), scr, r, lane, true); continue; } r -= I_IN;
        if (r < I_OUT) { p0_transpose_item(A.in[16], D, D, D, nullptr, (bf16*)(ws + WS_WOUT), scr, r, lane, false); continue; } r -= I_OUT;
        if (r < I_UP) { p0_transpose_item(A.in[18], FF, D, FF, A.in[17], (bf16*)(ws + WS_WUP), scr, r, lane, false); continue; } r -= I_UP;
        if (r < I_DOWN) { p0_transpose_item(A.in[19], D, FF, D, nullptr, (bf16*)(ws + WS_WDOWN), scr, r, lane, false); continue; } r -= I_DOWN;
        if (r < I_GATE) { p0_transpose_item(A.in[21], D, D, D, A.in[20], (bf16*)(ws + WS_WGATE), scr, r, lane, false); continue; } r -= I_GATE;
        p0_transpose_item(A.in[22], D, PLE, D, nullptr, (bf16*)(ws + WS_WPROJ), scr, r, lane, false);
    }
    { const int gt = vcu * 512 + tid, NT = G * 512; const float* wsrc = A.in[11]; bf16* wdst = (bf16*)(ws + WS_WSB);
      for (int i = gt; i < 4 * 128 * 128 / 4; i += NT) { const int e = 4 * i, t = (e >> 7) & 127, j = e & 127; const f32x4 v = *(const f32x4*)(wsrc + e);
          pg8::u32x2 o; o.x = pg8::cvt_pk_bf16(j <= t ? v[0] : 0.f, j + 1 <= t ? v[1] : 0.f); o.y = pg8::cvt_pk_bf16(j + 2 <= t ? v[2] : 0.f, j + 3 <= t ? v[3] : 0.f);
          *(pg8::u32x2*)(wdst + e) = o; } }
    __syncthreads();
    float gwt[4][4][8];
#pragma unroll
    for (int j = 0; j < 4; ++j)
#pragma unroll
        for (int c = 0; c < 4; ++c) { const LAS float* gp = gtab + (4 * lane + 256 * j + c) * 8; const f32x4 a = *(const LAS f32x4*)gp, b = *(const LAS f32x4*)(gp + 4);
#pragma unroll
            for (int q = 0; q < 4; ++q) { gwt[j][c][q] = a[q]; gwt[j][c][4 + q] = b[q]; } }
    const float gbias = (lane < 4) ? A.in[13][lane & 3] : A.in[14][lane & 3];
    for (int m = gw; m < M; m += 2 * NGW) {
        const int m2 = (m + NGW < M) ? m + NGW : m;
        RowIn R0, R1; p0_row_load(A, m, lane, R0); p0_row_load(A, m2, lane, R1);
        p0_row_finish(ws, m, lane, R0, gwt, gbias);
        p0_row_finish(ws, m2, lane, R1, gwt, gbias);
    }
    __syncthreads();
}

__device__ __forceinline__ void p7_final(const Args& A, int vcu, int G, int tid) {
    const int lane = tid & 63, wave = __builtin_amdgcn_readfirstlane(tid >> 6);
    const int gw = vcu * NWAVES + wave, NGW = G * NWAVES;
    const float* ss = (const float*)(A.ws + WS_SS3); const bf16* Hb = (const bf16*)(A.ws + WS_RB);
    const f32x4 g0 = *((const f32x4*)A.in[23] + 2 * lane), g1 = *((const f32x4*)A.in[23] + 2 * lane + 1), g2 = *((const f32x4*)A.in[23] + 128 + 2 * lane), g3 = *((const f32x4*)A.in[23] + 128 + 2 * lane + 1);
    for (int m = gw; m < M; m += NGW) {
        const float rs = pg8::row_rs(ss, m);
        const v4u a = *((const v4u*)(Hb + (size_t)m * D) + lane), b = *((const v4u*)(Hb + (size_t)m * D) + 64 + lane);
        f32x4* yr = (f32x4*)(A.out + (size_t)m * D);
        yr[2 * lane] = (f32x4){pg8::bf_lo(a.x), pg8::bf_hi(a.x), pg8::bf_lo(a.y), pg8::bf_hi(a.y)} * rs * g0;
        yr[2 * lane + 1] = (f32x4){pg8::bf_lo(a.z), pg8::bf_hi(a.z), pg8::bf_lo(a.w), pg8::bf_hi(a.w)} * rs * g1;
        yr[128 + 2 * lane] = (f32x4){pg8::bf_lo(b.x), pg8::bf_hi(b.x), pg8::bf_lo(b.y), pg8::bf_hi(b.y)} * rs * g2;
        yr[128 + 2 * lane + 1] = (f32x4){pg8::bf_lo(b.z), pg8::bf_hi(b.z), pg8::bf_lo(b.w), pg8::bf_hi(b.w)} * rs * g3;
    }
}

__global__ void __launch_bounds__(NWAVES * 64, 2) hymba_fwd(Args args) {
    extern __shared__ __attribute__((aligned(16))) unsigned char lds_raw[];
    LAS unsigned char* lds = (LAS unsigned char*)lds_raw;
    const int tid = threadIdx.x, G = gridDim.x, bx = blockIdx.x;
    const int vcu = (G % 8 == 0) ? (bx % 8) * (G / 8) + bx / 8 : bx;
    unsigned char* ws = args.ws;
#ifndef DUP_PHASE
#define DUP_PHASE -1
#endif
    const int lo = args.ph_lo, hi = args.ph_hi;
#ifndef PH_MASK
#define PH_MASK 0xffff
#endif
#define INC_(k) (((PH_MASK >> (k)) & 1) && lo <= (k) && (k) < hi)
#if DUP_PHASE >= 0
#define IN(k) for (int rep_ = 0; rep_ < ((DUP_PHASE == (k)) ? 2 : 1); ++rep_) if (INC_(k))
#define GRID_BAR(k) do { if (INC_((k) + 1)) xcd_barrier(bar); } while (0)
#else
#define IN(k) if (INC_(k))
#define GRID_BAR(k) do { if (INC_((k) + 1)) xcd_barrier(bar); } while (0)
#endif
    for (int u = tid; u < (LDS_BYTES - LDSCTL_OFF) / 4; u += NWAVES * 64) ((LAS unsigned*)(lds + LDSCTL_OFF))[u] = 0u;
    __syncthreads();
    XcdBarrier bar = xcd_barrier_post((unsigned*)(ws + WS_CTL) + CW_BAR, (volatile LAS unsigned*)(lds + MISC_OFF) + 8);
    float* OUT = args.out;
    const int FL = args.flags;
#if TP_A >= 0
    unsigned long long tp_a = 0ull, tp_b = 0ull;
#define STAMP(id) do { if ((id) == TP_A || (id) == TP_B) { asm volatile("s_waitcnt vmcnt(0) lgkmcnt(0)" ::: "memory"); const unsigned long long t_ = __builtin_amdgcn_s_memrealtime(); if ((id) == TP_A) tp_a = t_; if ((id) == TP_B) tp_b = t_; } } while (0)
#else
#define STAMP(id) do { } while (0)
#endif
    bf16* RA = (bf16*)(ws + WS_RA); bf16* Zb = (bf16*)(ws + WS_RB); bf16* YC = (bf16*)(ws + WS_YC); bf16* HID = (bf16*)(ws + WS_RB); bf16* H3 = (bf16*)(ws + WS_RB);     bf16* PROJ = (bf16*)args.out;
    float* SS1 = (float*)(ws + WS_SS1); float* SS2 = (float*)(ws + WS_SS2); float* SS3 = (float*)(ws + WS_SS3);
    mix::MixP MP;
    MP.Z = Zb; MP.YC = YC; MP.IG = (const float*)(ws + WS_IG); MP.LF = (const float*)(ws + WS_LF); MP.LNS = (const float*)(ws + WS_LNS); MP.WSb = (const bf16*)(ws + WS_WSB);
    MP.gm_ws = args.in[11]; MP.lng = args.in[9]; MP.lnb = args.in[10]; MP.bs = args.in[12]; MP.mlnorm = args.in[15];
    MP.KV = (float*)(ws + WS_KV); MP.NLOC = (float*)(ws + WS_NLOC); MP.NST = (float*)(ws + WS_NST); MP.CH = (float*)(ws + WS_CH); MP.MST = (float*)(ws + WS_MST);
    MP.stC = args.in[4]; MP.stN = args.in[5]; MP.stM = args.in[6];
    MP.oCp = OUT + O_CP; MP.oNp = OUT + O_NP; MP.oMp = OUT + O_MP; MP.oVp = OUT + O_VP; MP.oCs = OUT + O_CS; MP.oNs = OUT + O_NS; MP.oMs = OUT + O_MS; MP.oVs = OUT + O_VS;

    STAMP(0);
    IN(0) { p0_prologue(args, lds, vcu, G, tid); STAMP(1); GRID_BAR(0); for (int eb = 0; eb < args.extra_bars; ++eb) xcd_barrier(bar); }
    STAMP(2);
    IN(1) {
        pg8::Gemm g{RA, (const bf16*)(ws + WS_WIN), NPR, NIN, D}; pg8::StaticOrder S; S.init(NPR, NIN, G, bx);
        pg8::EpiBf16<0> E{Zb, NIN, (float*)(ws + WS_LNS)};
        if (!(FL & 2)) pg8::gemm_phase<pg8::EpiBf16<0>, pg8::StaticOrder, true, true>(lds + RING_OFF, g, S, E);
        STAMP(3);
        if (!(FL & 4)) { const sg::Epi SE{Zb, NIN, nullptr, nullptr, nullptr, nullptr, nullptr, nullptr}; sg::phase128<0>(lds + RING_OFF, RA, (const bf16*)(ws + WS_WIN), D, NIN, SE, vcu, G, tid); }
        GRID_BAR(1);
    }
    STAMP(4);
    IN(2) {
        for (int u = vcu; u < 1024; u += G) {
            if (u < 512) { if (FL & 16) continue; const int bc = u >> 2, h = u & 3; mix::gmlp_unit(lds, MP, bc >> 4, bc & 15, h, tid); }
            else { if (FL & 32) continue; if (u == vcu + 512) STAMP(5); const int v = u - 512; mix::kv_unit(lds, MP, v >> 6, (v >> 4) & 3, v & 15, tid); }
        }
        GRID_BAR(2);
    }
    STAMP(6);
    IN(3) {
        if (!(FL & 1)) for (int u = vcu; u < 256; u += G) mix::scan_unit(MP, u >> 3, u & 7, tid);
        STAMP(7);
        if (!(FL & 64)) for (int u = vcu; u < 512; u += G) mix::sample_unit(lds, MP, u >> 2, u & 3, tid);
        STAMP(21);
        if (!(FL & 128)) { pg8::Gemm g{(const bf16*)(ws + WS_PE), (const bf16*)(ws + WS_WPROJ), NPR, D, PLE}; pg8::StaticOrder S; S.init(NPR, D, G, bx);
          pg8::EpiBf16<1> E{PROJ, D, nullptr};
          if (!(FL & 2)) pg8::gemm_phase<pg8::EpiBf16<1>, pg8::StaticOrder, true, true>(lds + RING_OFF, g, S, E);
          STAMP(22);
          const sg::Epi SE{PROJ, D, nullptr, nullptr, nullptr, nullptr, nullptr, nullptr}; if (!(FL & 4)) sg::phase<1>(lds + RING_OFF, (const bf16*)(ws + WS_PE), (const bf16*)(ws + WS_WPROJ), PLE, D, SE, vcu, G, tid); }
        GRID_BAR(3);
    }
    STAMP(8);
    IN(4) {
        for (int u = vcu; u < 512; u += G) mix::mlo_unit(lds, MP, u >> 6, (u >> 4) & 3, u & 15, tid);
        GRID_BAR(4);
    }
    STAMP(10);
    IN(5) {
        pg8::Gemm g{YC, (const bf16*)(ws + WS_WOUT), NPR, D, D}; pg8::StaticOrder S; S.init(NPR, D, G, bx);
        pg8::EpiRes<0> E{(const float*)(ws + WS_RN), RA, RA, SS1, nullptr, nullptr};
        if (!(FL & 2)) pg8::gemm_phase<pg8::EpiRes<0>, pg8::StaticOrder, true, true>(lds + RING_OFF, g, S, E);
        STAMP(11);
        if (!(FL & 4)) { const sg::Epi SE{nullptr, 0, (const float*)(ws + WS_RN), RA, RA, SS1, nullptr, nullptr}; sg::phase<3>(lds + RING_OFF, YC, (const bf16*)(ws + WS_WOUT), D, D, SE, vcu, G, tid); }
        GRID_BAR(5);
    }
    STAMP(12);
    IN(6) {
        pg8::Gemm g{RA, (const bf16*)(ws + WS_WUP), NPR, FF, D}; pg8::StaticOrder S; S.init(NPR, FF, G, bx);
        pg8::EpiBf16<2> E{HID, FF, nullptr};
        if (!(FL & 2)) pg8::gemm_phase<pg8::EpiBf16<2>, pg8::StaticOrder, true, true>(lds + RING_OFF, g, S, E);
        STAMP(13);
        if (!(FL & 4)) { const sg::Epi SE{HID, FF, nullptr, nullptr, nullptr, nullptr, nullptr, nullptr}; sg::phase128<2>(lds + RING_OFF, RA, (const bf16*)(ws + WS_WUP), D, FF, SE, vcu, G, tid); }
        GRID_BAR(6);
    }
    STAMP(14);
    IN(7) {
        pg8::Gemm g{HID, (const bf16*)(ws + WS_WDOWN), NPR, D, FF}; pg8::StaticOrder S; S.init(NPR, D, G, bx);
        pg8::EpiRes<1> E{nullptr, RA, (FL & 8) ? (bf16*)(ws + WS_KV) : RA, (FL & 8) ? SS3 : SS2, SS1, nullptr};
        if (!(FL & 2)) pg8::gemm_phase<pg8::EpiRes<1>, pg8::StaticOrder, true, true>(lds + RING_OFF, g, S, E);
        STAMP(15);
        if (!(FL & 4)) { const sg::Epi SE{nullptr, 0, nullptr, RA, (FL & 8) ? (bf16*)(ws + WS_KV) : RA, (FL & 8) ? SS3 : SS2, SS1, nullptr}; sg::phase<4>(lds + RING_OFF, HID, (const bf16*)(ws + WS_WDOWN), FF, D, SE, vcu, G, tid); }
        GRID_BAR(7);
    }
    STAMP(16);
    IN(8) {
        pg8::Gemm g{RA, (const bf16*)(ws + WS_WGATE), NPR, D, D}; pg8::StaticOrder S; S.init(NPR, D, G, bx);
        pg8::EpiRes<2> E{nullptr, RA, (FL & 8) ? (bf16*)(ws + WS_KV) : H3, (FL & 8) ? SS1 : SS3, SS2, PROJ};
        if (!(FL & 2)) pg8::gemm_phase<pg8::EpiRes<2>, pg8::StaticOrder, true, true>(lds + RING_OFF, g, S, E);
        STAMP(17);
        if (!(FL & 4)) { const sg::Epi SE{nullptr, 0, nullptr, RA, (FL & 8) ? (bf16*)(ws + WS_KV) : H3, (FL & 8) ? SS1 : SS3, SS2, PROJ}; sg::phase<5>(lds + RING_OFF, RA, (const bf16*)(ws + WS_WGATE), D, D, SE, vcu, G, tid); }
        GRID_BAR(8);
    }
    STAMP(18);
    IN(9) p7_final(args, vcu, G, tid);
    STAMP(20);
#if TP_A >= 0
    if (bx == 0 && tid == 0) { asm volatile("s_waitcnt vmcnt(0)" ::: "memory"); OUT[O_MP] = (float)(tp_b - tp_a); }
#endif
#undef IN
#undef GRID_BAR
}

extern "C" void kernel_launch(void* const* d_in, const int* in_sizes, int n_in, void* d_out, int out_size, void* d_ws, size_t ws_size, hipStream_t stream) {
    static int grid = 0;
    if (grid == 0) {
        if (n_in != 24 || (size_t)out_size != O_END || ws_size < WS_END) { fprintf(stderr, "kernel_launch: unexpected problem shape (n_in %d, out %d, ws %zu)\n", n_in, out_size, ws_size); grid = -1; return; }
        int dev = 0, cus = 0, per_cu = 0;
        if (hipGetDevice(&dev) != hipSuccess || hipDeviceGetAttribute(&cus, hipDeviceAttributeMultiprocessorCount, dev) != hipSuccess) { grid = -1; return; }
        if (hipFuncSetAttribute((const void*)hymba_fwd, hipFuncAttributeMaxDynamicSharedMemorySize, LDS_BYTES) != hipSuccess) { fprintf(stderr, "kernel_launch: hipFuncSetAttribute failed\n"); grid = -1; return; }
        if (hipOccupancyMaxActiveBlocksPerMultiprocessor(&per_cu, (const void*)hymba_fwd, NWAVES * 64, LDS_BYTES) != hipSuccess || per_cu < 1) { fprintf(stderr, "kernel_launch: occupancy query says %d blocks per CU\n", per_cu); per_cu = 1; }
        (void)hipGetLastError();
        grid = cus * (per_cu < 1 ? per_cu : 1);
    }
    if (grid < 0) return;
    Args a{};
    for (int i = 0; i < 24; ++i) a.in[i] = (const float*)d_in[i];
    a.out = (float*)d_out; a.ws = (unsigned char*)d_ws;
#if MK_ONE_LAUNCH
    if (hipMemsetAsync((char*)d_ws + WS_CTL, 0, CTL_ZERO_BYTES, stream) != hipSuccess) { fprintf(stderr, "kernel_launch: memset of the control words failed\n"); return; }
    void* kargs[] = {&a};
#if HOST_DUP_PHASE >= 0
    const int cuts[4] = {0, HOST_DUP_PHASE + 1, HOST_DUP_PHASE, N_PHASES};
    for (int li = 0; li < 3; ++li) {
        a.ph_lo = (li == 1) ? HOST_DUP_PHASE : (li == 2 ? HOST_DUP_PHASE + 1 : 0); a.ph_hi = (li == 0 || li == 1) ? HOST_DUP_PHASE + 1 : N_PHASES; a.flags = (li == 1) ? HOST_DUP_FLAGS : 0;
        if (li > 0) (void)hipMemsetAsync((char*)d_ws + WS_CTL, 0, CTL_ZERO_BYTES, stream);
        (void)hipLaunchCooperativeKernel((const void*)hymba_fwd, dim3(grid), dim3(NWAVES * 64), kargs, LDS_BYTES, stream);
    }
    (void)cuts;
#else
    a.ph_lo = 0; a.ph_hi = N_PHASES; a.extra_bars = HOST_EXTRA_BARS;
    const hipError_t e = hipLaunchCooperativeKernel((const void*)hymba_fwd, dim3(grid), dim3(NWAVES * 64), kargs, LDS_BYTES, stream);
    if (e != hipSuccess) fprintf(stderr, "kernel_launch: cooperative launch failed: %s (grid %d)\n", hipGetErrorString(e), grid);
#endif
#else
    if (hipMemsetAsync((char*)d_ws + WS_CTL, 0, CTL_ZERO_BYTES, stream) != hipSuccess) return;
    for (int ph = 0; ph < N_PHASES; ++ph) {
        a.ph_lo = ph; a.ph_hi = ph + 1;
        hipLaunchKernelGGL(hymba_fwd, dim3(grid), dim3(NWAVES * 64), LDS_BYTES, stream, a);
    }
#endif
}
```

```cpp
#include <hip/hip_runtime.h>
#include <cstdio>
#include <cstdint>
namespace pg8 {
#define PG8_LAS __attribute__((address_space(3)))
typedef unsigned short bf16_t;
typedef short bf16x8 __attribute__((ext_vector_type(8)));
typedef float f32x4 __attribute__((ext_vector_type(4)));
typedef unsigned u32x4 __attribute__((ext_vector_type(4)));
constexpr int BM = 256, BK = 64, HALF = 128, HTB = HALF * BK * 2  , STAGE_BYTES = 8 * HTB, NXCD = 8, WGM = 8;

__host__ __device__ __forceinline__ int lds_byte(int r, int c) { const int st = (r >> 4) * 2 + (c >> 5), rr = r & 15, cc = c & 31, ob = rr * 64 + cc * 2; return st * 1024 + (ob ^ (((ob >> 9) & 1) << 5)); }
__host__ __device__ __forceinline__ void stage_rc(int b, int& R, int& C) { const int st = b / 1024, sb = b % 1024, swz = sb ^ (((sb >> 9) & 1) << 5); R = (st >> 1) * 16 + swz / 64; C = (st & 1) * 32 + (swz % 64) / 2; }
__host__ __device__ __forceinline__ int perm32(int rho) { const int n = rho >> 4, i = rho & 15; return 8 * (i >> 2) + 4 * n + (i & 3); }

struct Unit { int pm, pn; };
struct Gemm { const bf16_t* A; const bf16_t* Bt; int M, N, K; };

struct StaticOrder {
    int nM, nN, nwg, G, c;
    __host__ __device__ void init(int M, int N, int G_, int c_) { nM = M / BM; nN = N / BM; nwg = nM * nN; G = G_; c = c_; }
    __host__ __device__ bool next(int i, Unit& u) const {
        const long L = (long)i * G + c; if (L >= nwg) return false;
        int wgid = (int)L; { const int q = nwg / NXCD, r = nwg % NXCD, xcd = wgid % NXCD, off = wgid / NXCD; wgid = (xcd < r ? xcd * (q + 1) : r * (q + 1) + (xcd - r) * q) + off; }
        const int nig = WGM * nN, gid = wgid / nig, fm = gid * WGM, gsz = (nM - fm) < WGM ? (nM - fm) : WGM;
        u.pm = fm + ((wgid % nig) % gsz); u.pn = (wgid % nig) / gsz; return true;
    }
    __device__ __forceinline__ void a_ready(const Unit&) const {}
    __device__ __forceinline__ void done(const Unit&) const {}
};


typedef float f32x2 __attribute__((ext_vector_type(2)));
typedef __bf16 bf16x2_t __attribute__((ext_vector_type(2)));
typedef unsigned u32x2 __attribute__((ext_vector_type(2)));
__device__ __forceinline__ unsigned cvt_pk_bf16(float lo, float hi) { f32x2 v = {lo, hi}; bf16x2_t b = __builtin_convertvector(v, bf16x2_t); return __builtin_bit_cast(unsigned, b); }
__device__ __forceinline__ float bf_lo(unsigned w) { return __uint_as_float(w << 16); }
__device__ __forceinline__ float bf_hi(unsigned w) { return __uint_as_float(w & 0xffff0000u); }
__device__ __forceinline__ float sigmoid_f(float x) { return __builtin_amdgcn_rcpf(1.0f + __builtin_amdgcn_exp2f(-1.4426950408889634f * x)); }
__device__ __forceinline__ float gelu_tanh_f(float x) { const float t = x * (1.5957691216057308f + 0.07135481627159149f * x * x); return x * sigmoid_f(t); }

constexpr float NORM_EPS = 1e-6f;
__device__ __forceinline__ float row_rs(const float* ss, int row) {
    const f32x4* p = (const f32x4*)(ss + (size_t)row * 16); const f32x4 a = p[0], b = p[1], c = p[2], d = p[3];
    const float s = ((a[0] + a[1]) + (a[2] + a[3])) + ((b[0] + b[1]) + (b[2] + b[3])) + ((c[0] + c[1]) + (c[2] + c[3])) + ((d[0] + d[1]) + (d[2] + d[3]));
    return 1.0f / sqrtf(s * (1.0f / 1024.0f) + NORM_EPS);
}

template <int MODE> struct EpiBf16 {
    static constexpr bool PERM = true, AFTER_DRAIN = false;
    bf16_t* O; int ldc; float* lns;
    __device__ __forceinline__ void operator()(const f32x4 (&acc)[2][2][4][2], const Unit& u, int wr, int wc, int fr, int fq) const {
        const int row0 = u.pm * BM + wr * 64 + fr, col0 = u.pn * BM + wc * 32 + 8 * fq;
        const int act = (MODE == 0) ? (u.pn < 4 ? 1 : (u.pn >= 10 ? 2 : 0)) : 0;
#pragma unroll
        for (int ai = 0; ai < 2; ++ai)
#pragma unroll
            for (int m = 0; m < 4; ++m) { const int row = row0 + ai * HALF + m * 16; bf16_t* rowp = O + (size_t)row * ldc + col0; float s1 = 0.f, s2 = 0.f;
#pragma unroll
                for (int bj = 0; bj < 2; ++bj) { f32x4 v0 = acc[ai][bj][m][0], v1 = acc[ai][bj][m][1];
                    if (MODE == 0) {
                        if (act == 1) {
#pragma unroll
                            for (int e = 0; e < 4; ++e) { v0[e] = gelu_tanh_f(v0[e]); v1[e] = gelu_tanh_f(v1[e]); } }
                        else if (act == 2) {
#pragma unroll
                            for (int e = 0; e < 4; ++e) { v0[e] = sigmoid_f(v0[e]); v1[e] = sigmoid_f(v1[e]); } }
                    }
                    if (MODE == 2) {
#pragma unroll
                        for (int e = 0; e < 4; ++e) { const float a = fmaxf(v0[e], 0.f), b = fmaxf(v1[e], 0.f); v0[e] = a * a; v1[e] = b * b; } }
                    if (MODE == 0) { const f32x4 t = v0 + v1, q = v0 * v0 + v1 * v1; s1 += (t[0] + t[1]) + (t[2] + t[3]); s2 += (q[0] + q[1]) + (q[2] + q[3]); }
                    u32x4 w; w.x = cvt_pk_bf16(v0[0], v0[1]); w.y = cvt_pk_bf16(v0[2], v0[3]); w.z = cvt_pk_bf16(v1[0], v1[1]); w.w = cvt_pk_bf16(v1[2], v1[3]);
                    *(u32x4*)(rowp + bj * HALF) = w; }
                if (MODE == 0 && (u.pn == 2 || u.pn == 3)) {
                    s1 += __shfl_xor(s1, 16); s1 += __shfl_xor(s1, 32); s2 += __shfl_xor(s2, 16); s2 += __shfl_xor(s2, 32);
                    if (fq == 0) *(f32x2*)(lns + ((size_t)row * 8 + (u.pn - 2) * 4 + wc) * 2) = (f32x2){s1, s2}; } }
    }
};

template <int MODE> struct EpiRes {
    static constexpr bool PERM = false, AFTER_DRAIN = false;
    const float* rn;
    const bf16_t* Hb; bf16_t* Ho; float* SSO; const float* SSI; const bf16_t* PROJ;
    __device__ __forceinline__ void operator()(const f32x4 (&acc)[2][2][4][2], const Unit& u, int wr, int wc, int fr, int fq) const {
        const int row0 = u.pm * BM + wr * 64 + fr, col0 = u.pn * BM + wc * 32 + 4 * fq;
#pragma unroll
        for (int ai = 0; ai < 2; ++ai)
#pragma unroll
            for (int m = 0; m < 4; ++m) { const int row = row0 + ai * HALF + m * 16; const size_t off = (size_t)row * 1024 + col0;
                float rsc; if (MODE != 0) { rsc = row_rs(SSI, row); if (MODE == 1) rsc = rsc * rsc; } else rsc = rn[row];
                float sq = 0.f;
#pragma unroll
                for (int bj = 0; bj < 2; ++bj)
#pragma unroll
                    for (int n = 0; n < 2; ++n) { const size_t o2 = off + bj * HALF + n * 16; f32x4 h; const f32x4 a = acc[ai][bj][m][n];
                        { const u32x2 hw = *(const u32x2*)(Hb + o2); const f32x4 r = (f32x4){bf_lo(hw.x), bf_hi(hw.x), bf_lo(hw.y), bf_hi(hw.y)};
                            if (MODE == 0) h = r * rsc + a;
                            else if (MODE == 1) h = r + a * rsc;
                            else { const u32x2 pw = *(const u32x2*)(PROJ + o2);
                                h[0] = r[0] + sigmoid_f(a[0] * rsc) * bf_lo(pw.x); h[1] = r[1] + sigmoid_f(a[1] * rsc) * bf_hi(pw.x);
                                h[2] = r[2] + sigmoid_f(a[2] * rsc) * bf_lo(pw.y); h[3] = r[3] + sigmoid_f(a[3] * rsc) * bf_hi(pw.y); } }
                        u32x2 w; w.x = cvt_pk_bf16(h[0], h[1]); w.y = cvt_pk_bf16(h[2], h[3]); *(u32x2*)(Ho + o2) = w;
                        sq += (h[0] * h[0] + h[1] * h[1]) + (h[2] * h[2] + h[3] * h[3]); }
                sq += __shfl_xor(sq, 16); sq += __shfl_xor(sq, 32);
                if (fq == 0) SSO[(size_t)row * 16 + u.pn * 4 + wc] = sq; }
    }
};

template <class Epi, class Sched, bool ALIGN_EPI = false, bool SP2 = false>
__device__ __forceinline__ void gemm_phase(PG8_LAS unsigned char* lds, const Gemm g, const Sched& S, const Epi& E) {
    const int tid = threadIdx.x, wid = __builtin_amdgcn_readfirstlane(tid >> 6), lane = tid & 63, wr = wid >> 2, wc = wid & 3, fr = lane & 15, fq = lane >> 4;
    int K = g.K; asm volatile("" : "+s"(K));
    const int nt = K / BK;
    unsigned voffA[2], voffB[2];
#pragma unroll
    for (int i = 0; i < 2; ++i) { int R, C; stage_rc(tid * 16 + i * 8192, R, C); const int Rb = Epi::PERM ? ((R & ~31) + perm32(R & 31)) : R;
        voffA[i] = (unsigned)(R * K + C) * 2u; voffB[i] = (unsigned)(Rb * K + C) * 2u; }
    const size_t kstep = (size_t)(BK * 2);
    const size_t hstep = (size_t)HALF * K * 2;
    const size_t tstep = 2 * hstep;
    const unsigned ldsw = (unsigned)wid * 1024u;
    const int aoff = lds_byte(wr * 64 + fr, fq * 8), boff = lds_byte(wc * 32 + fr, fq * 8);
#define PG8_SA(b, h) (((b) * 2 + (h)) * HTB)
#define PG8_SB(b, h) ((4 + (b) * 2 + (h)) * HTB)
#define PG8_STAGE(bufoff, gbase, voff) do { _Pragma("unroll") for (int _i = 0; _i < 2; ++_i) \
        __builtin_amdgcn_global_load_lds((const unsigned*)((const char*)(gbase) + (voff)[_i]), (PG8_LAS unsigned*)(lds + (bufoff) + ldsw + _i * 8192), 16, 0, 0); } while (0)
#define PG8_LDA(dst, b, h) do { _Pragma("unroll") for (int m = 0; m < 4; ++m) _Pragma("unroll") for (int k = 0; k < 2; ++k) dst[m][k] = *(const PG8_LAS bf16x8*)(lds + PG8_SA(b, h) + aoff + m * 2048 + k * 1024); } while (0)
#define PG8_LDB(dst, b, h) do { _Pragma("unroll") for (int n = 0; n < 2; ++n) _Pragma("unroll") for (int k = 0; k < 2; ++k) dst[n][k] = *(const PG8_LAS bf16x8*)(lds + PG8_SB(b, h) + boff + n * 2048 + k * 1024); } while (0)
#define PG8_MMA(ai, bj, At, Bt) do { __builtin_amdgcn_s_setprio(1); _Pragma("unroll") for (int m = 0; m < 4; ++m) _Pragma("unroll") for (int n = 0; n < 2; ++n) _Pragma("unroll") for (int k = 0; k < 2; ++k) \
        acc[ai][bj][m][n] = __builtin_amdgcn_mfma_f32_16x16x32_bf16(Bt[n][k], At[m][k], acc[ai][bj][m][n], 0, 0, 0); __builtin_amdgcn_s_setprio(0); } while (0)
#define PG8_WAIT_V(n) asm volatile("s_waitcnt vmcnt(" #n ")" ::: "memory")
#define PG8_WAIT_L(n) asm volatile("s_waitcnt lgkmcnt(" #n ")" ::: "memory")
#define PG8_BAR __builtin_amdgcn_s_barrier()
#define PG8_SCHED __builtin_amdgcn_sched_barrier(0)
    Unit cur, nxt; int ui = 0;
    if (!S.next(0, cur)) return;
    f32x4 acc[2][2][4][2];
#pragma unroll
    for (int a = 0; a < 2; ++a)
#pragma unroll
        for (int b = 0; b < 2; ++b)
#pragma unroll
            for (int m = 0; m < 4; ++m)
#pragma unroll
                for (int n = 0; n < 2; ++n) acc[a][b][m][n] = (f32x4){0.f, 0.f, 0.f, 0.f};
    bf16x8 At[4][2], B0[2][2], B1[2][2];
    const char* cA = (const char*)g.A + (size_t)cur.pm * tstep; const char* cB = (const char*)g.Bt + (size_t)cur.pn * tstep;
    S.a_ready(cur);
    if constexpr (SP2) {
        PG8_STAGE(PG8_SB(0, 0), cB, voffB); PG8_STAGE(PG8_SB(0, 1), cB + hstep, voffB); PG8_STAGE(PG8_SA(0, 0), cA, voffA); PG8_STAGE(PG8_SA(0, 1), cA + hstep, voffA);
        if (wr == 1) PG8_BAR;
        PG8_WAIT_V(2); PG8_BAR;
        PG8_STAGE(PG8_SB(1, 0), cB + kstep, voffB); PG8_STAGE(PG8_SA(1, 0), cA + kstep, voffA); PG8_STAGE(PG8_SB(1, 1), cB + hstep + kstep, voffB);
        PG8_WAIT_V(6); PG8_BAR;
    } else {
        PG8_STAGE(PG8_SB(0, 0), cB, voffB); PG8_STAGE(PG8_SA(0, 0), cA, voffA); PG8_STAGE(PG8_SB(0, 1), cB + hstep, voffB); PG8_STAGE(PG8_SA(0, 1), cA + hstep, voffA);
        if (wr == 1) PG8_BAR;
        PG8_WAIT_V(4); PG8_BAR;
        PG8_STAGE(PG8_SB(1, 0), cB + kstep, voffB); PG8_STAGE(PG8_SA(1, 0), cA + kstep, voffA); PG8_STAGE(PG8_SB(1, 1), cB + hstep + kstep, voffB);
        PG8_WAIT_V(6); PG8_BAR;
    }
    for (;;) {
        const bool has_next = S.next(ui + 1, nxt);
        const char* nA = has_next ? (const char*)g.A + (size_t)nxt.pm * tstep : cA; const char* nB = has_next ? (const char*)g.Bt + (size_t)nxt.pn * tstep : cB;
        for (int t = 0; t < nt; t += 2) {
            const bool last = (t == nt - 2);
            const char* a1 = cA + (size_t)(t + 1) * kstep;
            const char* a2 = last ? nA : cA + (size_t)(t + 2) * kstep; const char* b2 = last ? nB : cB + (size_t)(t + 2) * kstep;
            const char* a3 = a2 + kstep; const char* b3 = b2 + kstep;
            if (last && has_next) S.a_ready(nxt);
            if constexpr (SP2) {
            PG8_LDB(B0, 0, 0); PG8_LDB(B1, 0, 1); PG8_SCHED; PG8_LDA(At, 0, 0); PG8_STAGE(PG8_SA(1, 1), a1 + hstep, voffA);
            PG8_WAIT_V(8); PG8_WAIT_L(0); PG8_BAR; PG8_MMA(0, 0, At, B0); PG8_MMA(0, 1, At, B1); PG8_BAR; PG8_SCHED;
            PG8_LDA(At, 0, 1); PG8_STAGE(PG8_SB(0, 0), b2, voffB); PG8_STAGE(PG8_SB(0, 1), b2 + hstep, voffB); PG8_STAGE(PG8_SA(0, 0), a2, voffA);
            PG8_WAIT_V(8); PG8_WAIT_L(0); PG8_BAR; PG8_MMA(1, 0, At, B0); PG8_MMA(1, 1, At, B1); PG8_BAR; PG8_SCHED;
            PG8_LDB(B0, 1, 0); PG8_LDB(B1, 1, 1); PG8_SCHED; PG8_LDA(At, 1, 0); PG8_STAGE(PG8_SA(0, 1), a2 + hstep, voffA);
            PG8_WAIT_V(8); PG8_WAIT_L(0); PG8_BAR; PG8_MMA(0, 0, At, B0); PG8_MMA(0, 1, At, B1); PG8_BAR; PG8_SCHED;
            PG8_LDA(At, 1, 1); PG8_STAGE(PG8_SB(1, 0), b3, voffB); PG8_STAGE(PG8_SB(1, 1), b3 + hstep, voffB); PG8_STAGE(PG8_SA(1, 0), a3, voffA);
            PG8_WAIT_V(8); PG8_WAIT_L(0); PG8_BAR; PG8_MMA(1, 0, At, B0); PG8_MMA(1, 1, At, B1); PG8_BAR; PG8_SCHED;
            } else {
            PG8_LDB(B0, 0, 0); PG8_SCHED; PG8_LDA(At, 0, 0); PG8_STAGE(PG8_SA(1, 1), a1 + hstep, voffA);
            PG8_WAIT_L(8); PG8_BAR; PG8_WAIT_L(0); PG8_MMA(0, 0, At, B0); PG8_BAR; PG8_SCHED;
            PG8_LDB(B1, 0, 1); PG8_STAGE(PG8_SB(0, 0), b2, voffB);
            PG8_BAR; PG8_WAIT_L(0); PG8_MMA(0, 1, At, B1); PG8_BAR;
            PG8_LDA(At, 0, 1); PG8_STAGE(PG8_SA(0, 0), a2, voffA);
            PG8_BAR; PG8_WAIT_L(0); PG8_MMA(1, 0, At, B0); PG8_BAR; PG8_SCHED;
            PG8_STAGE(PG8_SB(0, 1), b2 + hstep, voffB);
            PG8_WAIT_V(6); PG8_BAR; PG8_MMA(1, 1, At, B1); PG8_BAR;
            PG8_LDB(B0, 1, 0); PG8_SCHED; PG8_LDA(At, 1, 0); PG8_STAGE(PG8_SA(0, 1), a2 + hstep, voffA);
            PG8_WAIT_L(8); PG8_BAR; PG8_WAIT_L(0); PG8_MMA(0, 0, At, B0); PG8_BAR; PG8_SCHED;
            PG8_LDB(B1, 1, 1); PG8_STAGE(PG8_SB(1, 0), b3, voffB);
            PG8_BAR; PG8_WAIT_L(0); PG8_MMA(0, 1, At, B1); PG8_BAR;
            PG8_LDA(At, 1, 1); PG8_STAGE(PG8_SA(1, 0), a3, voffA);
            PG8_BAR; PG8_WAIT_L(0); PG8_MMA(1, 0, At, B0); PG8_BAR; PG8_SCHED;
            PG8_STAGE(PG8_SB(1, 1), b3 + hstep, voffB);
            PG8_WAIT_V(6); PG8_BAR; PG8_MMA(1, 1, At, B1); PG8_BAR;
            }
        }
        if constexpr (ALIGN_EPI) { if (wr == 0) PG8_BAR; }
        if constexpr (!Epi::AFTER_DRAIN) { E(acc, cur, wr, wc, fr, fq); S.done(cur); }
        if (!has_next) break;
#pragma unroll
        for (int a = 0; a < 2; ++a)
#pragma unroll
            for (int b = 0; b < 2; ++b)
#pragma unroll
                for (int m = 0; m < 4; ++m)
#pragma unroll
                    for (int n = 0; n < 2; ++n) acc[a][b][m][n] = (f32x4){0.f, 0.f, 0.f, 0.f};
        cur = nxt; cA = nA; cB = nB; ++ui;
        if constexpr (ALIGN_EPI) { if (wr == 1) PG8_BAR; }
    }
    PG8_WAIT_V(0);
    if constexpr (!ALIGN_EPI) { if (wr == 0) PG8_BAR; }
    PG8_BAR;
    if constexpr (Epi::AFTER_DRAIN) { E.fused(acc, cur, wr, wc, fr, fq, lds, wid, lane); S.done(cur); }
#undef PG8_SA
#undef PG8_SB
#undef PG8_STAGE
#undef PG8_LDA
#undef PG8_LDB
#undef PG8_MMA
#undef PG8_WAIT_V
#undef PG8_WAIT_L
#undef PG8_BAR
#undef PG8_SCHED
}
}

namespace mix {
#define LAS __attribute__((address_space(3)))
using pg8::bf16_t; using pg8::bf16x8; using pg8::f32x4; using pg8::u32x4; using pg8::u32x2; using pg8::cvt_pk_bf16; using pg8::bf_lo; using pg8::bf_hi; using pg8::sigmoid_f;
typedef short v4i16_t __attribute__((ext_vector_type(4)));
constexpr int NP = 16384, NS = 1024, ZLD = 3072;
constexpr int ZU = 0, ZVG = 512, ZQ = 1024, ZK = 1536, ZV = 2048, ZO = 2560;
constexpr int TS = 288;
constexpr int IMG = 128 * TS;
constexpr int IMG0 = 0, IMG1 = IMG, IMG2 = 2 * IMG, SC_OFF = 3 * IMG;
constexpr float EPS = 1e-6f;

template <int CTRL> __device__ __forceinline__ float dpp_mov(float v) { return __int_as_float(__builtin_amdgcn_update_dpp(0, __float_as_int(v), CTRL, 0xF, 0xF, true)); }
__device__ __forceinline__ float row_sum16(float v) { v += dpp_mov<0xB1>(v); v += dpp_mov<0x4E>(v); v += dpp_mov<0x141>(v); v += dpp_mov<0x140>(v); return v; }
__device__ __forceinline__ float row_max16(float v) { v = fmaxf(v, dpp_mov<0xB1>(v)); v = fmaxf(v, dpp_mov<0x4E>(v)); v = fmaxf(v, dpp_mov<0x141>(v)); v = fmaxf(v, dpp_mov<0x140>(v)); return v; }
__device__ __forceinline__ float rl(float v, int l) { return __int_as_float(__builtin_amdgcn_readlane(__float_as_int(v), l)); }
__device__ __forceinline__ float wave_sum(float v) { v = row_sum16(v); return (rl(v, 0) + rl(v, 16)) + (rl(v, 32) + rl(v, 48)); }
__device__ __forceinline__ float wave_max(float v) { v = row_max16(v); return fmaxf(fmaxf(rl(v, 0), rl(v, 16)), fmaxf(rl(v, 32), rl(v, 48))); }
__device__ __forceinline__ float scan_add(float v, int lane) {
#pragma unroll
    for (int o = 1; o < 64; o <<= 1) { const float t = __shfl_up(v, o); if (lane >= o) v += t; }
    return v;
}
__device__ __forceinline__ float scan_max(float v, int lane) {
#pragma unroll
    for (int o = 1; o < 64; o <<= 1) { const float t = __shfl_up(v, o); if (lane >= o) v = fmaxf(v, t); }
    return v;
}
__device__ __forceinline__ bf16x8 tr2(LAS const unsigned char* p0, LAS const unsigned char* p1) {
    const v4i16_t a = __builtin_amdgcn_ds_read_tr16_b64_v4i16((LAS v4i16_t*)p0);
    const v4i16_t b = __builtin_amdgcn_ds_read_tr16_b64_v4i16((LAS v4i16_t*)p1);
    return (bf16x8){a[0], a[1], a[2], a[3], b[0], b[1], b[2], b[3]};
}
__device__ __forceinline__ void unpack8(const u32x4 w, float (&x)[8]) {
    x[0] = bf_lo(w.x); x[1] = bf_hi(w.x); x[2] = bf_lo(w.y); x[3] = bf_hi(w.y); x[4] = bf_lo(w.z); x[5] = bf_hi(w.z); x[6] = bf_lo(w.w); x[7] = bf_hi(w.w);
}
__device__ __forceinline__ u32x4 pack8(const float (&x)[8]) {
    u32x4 w; w.x = cvt_pk_bf16(x[0], x[1]); w.y = cvt_pk_bf16(x[2], x[3]); w.z = cvt_pk_bf16(x[4], x[5]); w.w = cvt_pk_bf16(x[6], x[7]); return w;
}

struct MixP {
    const bf16_t* Z; bf16_t* YC; const float* IG; const float* LF; const float* LNS;
    const bf16_t* WSb;
    const float *gm_ws, *lng, *lnb, *bs, *mlnorm;
    bf16_t* KV; float *NLOC, *NST, *CH, *MST;
    const float *stC, *stN, *stM;
    float *oCp, *oNp, *oMp, *oVp, *oCs, *oNs, *oMs, *oVs;
};

__device__ __forceinline__ void gmlp_unit(LAS unsigned char* lds, const MixP& P, int b, int c, int h, int tid) {
    const int lane = tid & 63, w = __builtin_amdgcn_readfirstlane(tid >> 6), fr = lane & 15, kq = lane >> 4, q = fr >> 2, p = fr & 3;
    const int r0 = b * 2048 + c * 128;
    LAS unsigned char* img = lds + IMG0;
    LAS float* mst = (LAS float*)(lds + SC_OFF);
    const int ch = tid & 15;
    u32x4 raw[4];
#pragma unroll
    for (int i = 0; i < 4; ++i) raw[i] = *(const u32x4*)(P.Z + (size_t)(r0 + (tid >> 4) + 32 * i) * ZLD + ZVG + h * 128 + ch * 8);
    f32x4 st4[4];
    if (tid < 128) { const f32x4* sp = (const f32x4*)(P.LNS + (size_t)(r0 + tid) * 16);
#pragma unroll
        for (int j = 0; j < 4; ++j) st4[j] = sp[j]; }
    float g8[8], b8[8];
    { const float* gp = P.lng + h * 128 + ch * 8; const float* bp = P.lnb + h * 128 + ch * 8;
      const f32x4 a = *(const f32x4*)gp, a2 = *(const f32x4*)(gp + 4), c0 = *(const f32x4*)bp, c1 = *(const f32x4*)(bp + 4);
#pragma unroll
      for (int e = 0; e < 4; ++e) { g8[e] = a[e]; g8[4 + e] = a2[e]; b8[e] = c0[e]; b8[4 + e] = c1[e]; } }
    const bf16_t* Wrow = P.WSb + ((size_t)h * 128 + 16 * w + fr) * 128 + 8 * kq;
    bf16x8 wf[4];
#pragma unroll
    for (int st = 0; st < 4; ++st) wf[st] = *(const bf16x8*)(Wrow + 32 * st);
    const bf16_t* urow = P.Z + (size_t)(r0 + 16 * w + fr) * ZLD + ZU + h * 128 + 4 * kq;
    u32x2 uw[8];
#pragma unroll
    for (int n = 0; n < 8; ++n) uw[n] = *(const u32x2*)(urow + 16 * n);
    const float bsv = P.bs[h * 128 + 16 * w + fr];
    if (tid < 128) { const float s1 = (st4[0][0] + st4[0][2]) + (st4[1][0] + st4[1][2]) + (st4[2][0] + st4[2][2]) + (st4[3][0] + st4[3][2]);
        const float s2 = (st4[0][1] + st4[0][3]) + (st4[1][1] + st4[1][3]) + (st4[2][1] + st4[2][3]) + (st4[3][1] + st4[3][3]);
        const float mean = s1 * (1.0f / 512.0f), var = fmaxf(s2 * (1.0f / 512.0f) - mean * mean, 0.f);
        mst[tid] = mean; mst[128 + tid] = 1.0f / sqrtf(var + EPS); }
    __syncthreads();
    float* vout = (c == 15) ? P.oVp + (size_t)b * 128 * 512 : nullptr;
#pragma unroll
    for (int i = 0; i < 4; ++i) { const int t = (tid >> 4) + 32 * i; const float mean = mst[t], rstd = mst[128 + t];
        float x[8]; unpack8(raw[i], x);
#pragma unroll
        for (int e = 0; e < 8; ++e) x[e] = (x[e] - mean) * rstd * g8[e] + b8[e];
        *(LAS u32x4*)(img + t * TS + ch * 16) = pack8(x);
        if (vout) { float* vo = vout + (size_t)t * 512 + h * 128 + ch * 8; *(f32x4*)vo = (f32x4){x[0], x[1], x[2], x[3]}; *(f32x4*)(vo + 4) = (f32x4){x[4], x[5], x[6], x[7]}; } }
    __syncthreads();
    f32x4 acc[8];
#pragma unroll
    for (int n = 0; n < 8; ++n) acc[n] = (f32x4){0.f, 0.f, 0.f, 0.f};
    const int nsteps = (w >> 1) + 1;
    LAS const unsigned char* trb = img + (8 * kq + q) * TS + 8 * p;
#pragma unroll
    for (int st = 0; st < 4; ++st) if (st < nsteps) {
#pragma unroll
        for (int n = 0; n < 8; ++n) { const bf16x8 vf = tr2(trb + (32 * st) * TS + 32 * n, trb + (32 * st + 4) * TS + 32 * n);
            acc[n] = __builtin_amdgcn_mfma_f32_16x16x32_bf16(vf, wf[st], acc[n], 0, 0, 0); }
    }
    { const int t = 16 * w + fr;
      bf16_t* yrow = P.YC + (size_t)(r0 + t) * 1024 + h * 128 + 4 * kq;
#pragma unroll
      for (int n = 0; n < 8; ++n) { u32x2 o;
          o.x = cvt_pk_bf16(bf_lo(uw[n].x) * (acc[n][0] + bsv), bf_hi(uw[n].x) * (acc[n][1] + bsv));
          o.y = cvt_pk_bf16(bf_lo(uw[n].y) * (acc[n][2] + bsv), bf_hi(uw[n].y) * (acc[n][3] + bsv));
          *(u32x2*)(yrow + 16 * n) = o; } }
    __syncthreads();
}

__device__ __forceinline__ void kv_unit(LAS unsigned char* lds, const MixP& P, int b, int h, int c, int tid) {
    const int lane = tid & 63, w = __builtin_amdgcn_readfirstlane(tid >> 6), fr = lane & 15, kq = lane >> 4, q = fr >> 2, p = fr & 3;
    const int r0 = b * 2048 + c * 128, unit = (b * 4 + h) * 16 + c;
    LAS float* wl = (LAS float*)(lds + SC_OFF);
    float lf0 = 0.f, lf1 = 0.f, ig0 = 0.f, ig1 = 0.f;
    if (w == 0) { const int s0 = r0 + 2 * lane; lf0 = P.LF[(size_t)s0 * 4 + h]; lf1 = P.LF[(size_t)(s0 + 1) * 4 + h]; ig0 = P.IG[(size_t)s0 * 4 + h]; ig1 = P.IG[(size_t)(s0 + 1) * 4 + h]; }
    u32x4 kraw[4], vraw[4];
#pragma unroll
    for (int i = 0; i < 4; ++i) { const int id = tid + 512 * i, row = id >> 4, ch = id & 15;
        const bf16_t* zr = P.Z + (size_t)(r0 + row) * ZLD + h * 128 + ch * 8; kraw[i] = *(const u32x4*)(zr + ZK); vraw[i] = *(const u32x4*)(zr + ZV); }
    if (w == 0) {
        const float Pc = scan_add(lf0 + lf1, lane), b1 = Pc, b0 = Pc - lf1, B = __shfl(Pc, 63);
        const float x0 = ig0 - b0, x1 = ig1 - b1, xm = wave_max(fmaxf(x0, x1));
        wl[2 * lane] = __expf(x0 - xm); wl[2 * lane + 1] = __expf(x1 - xm);
        if (lane == 0) { P.CH[unit * 2] = B; P.CH[unit * 2 + 1] = B + xm; }
    }
    __syncthreads();
#pragma unroll
    for (int i = 0; i < 4; ++i) { const int id = tid + 512 * i, row = id >> 4, ch = id & 15;
        float x[8]; unpack8(kraw[i], x); const float ws = wl[row];
#pragma unroll
        for (int e = 0; e < 8; ++e) x[e] *= ws;
        *(LAS u32x4*)(lds + IMG0 + row * TS + ch * 16) = pack8(x);
        *(LAS u32x4*)(lds + IMG1 + row * TS + ch * 16) = vraw[i]; }
    __syncthreads();
    f32x4 acc[8], accn = (f32x4){0.f, 0.f, 0.f, 0.f};
#pragma unroll
    for (int n = 0; n < 8; ++n) acc[n] = (f32x4){0.f, 0.f, 0.f, 0.f};
    const bf16x8 ones = (bf16x8){0x3F80, 0x3F80, 0x3F80, 0x3F80, 0x3F80, 0x3F80, 0x3F80, 0x3F80};
    LAS const unsigned char* trk = lds + IMG0 + (8 * kq + q) * TS + 8 * p + 32 * w;
    LAS const unsigned char* trv = lds + IMG1 + (8 * kq + q) * TS + 8 * p;
#pragma unroll
    for (int st = 0; st < 4; ++st) {
        const bf16x8 kf = tr2(trk + (32 * st) * TS, trk + (32 * st + 4) * TS);
        accn = __builtin_amdgcn_mfma_f32_16x16x32_bf16(ones, kf, accn, 0, 0, 0);
#pragma unroll
        for (int n = 0; n < 8; ++n) { const bf16x8 vf = tr2(trv + (32 * st) * TS + 32 * n, trv + (32 * st + 4) * TS + 32 * n);
            acc[n] = __builtin_amdgcn_mfma_f32_16x16x32_bf16(vf, kf, acc[n], 0, 0, 0); }
    }
    bf16_t* kvp = P.KV + (size_t)unit * 16384 + (16 * w + fr) * 128 + 4 * kq;
#pragma unroll
    for (int n = 0; n < 8; ++n) { u32x2 o; o.x = cvt_pk_bf16(acc[n][0], acc[n][1]); o.y = cvt_pk_bf16(acc[n][2], acc[n][3]); *(u32x2*)(kvp + 16 * n) = o; }
    if (kq == 0) P.NLOC[unit * 128 + 16 * w + fr] = accn[0];
    __syncthreads();
}

__device__ __forceinline__ void scan_unit(const MixP& P, int bh, int slice, int tid) {
    const size_t base = (size_t)bh * 16 * 16384 + slice * 2048 + tid * 4;
    f32x4 C = (f32x4){0.f, 0.f, 0.f, 0.f}; float M = 0.f, nv = 0.f;
    const bool nthr = (slice == 0 && tid < 128);
    u32x2 kvv[16];
#pragma unroll
    for (int c = 0; c < 16; ++c) kvv[c] = *(const u32x2*)(P.KV + base + (size_t)c * 16384);
#pragma unroll
    for (int c = 0; c < 16; ++c) {
        const float B = P.CH[(bh * 16 + c) * 2], a = P.CH[(bh * 16 + c) * 2 + 1];
        const float Mn = fmaxf(B + M, a), dec = __expf(B + M - Mn), add = __expf(a - Mn);
        bf16_t* kp = P.KV + base + (size_t)c * 16384;
        const f32x4 kv = (f32x4){bf_lo(kvv[c].x), bf_hi(kvv[c].x), bf_lo(kvv[c].y), bf_hi(kvv[c].y)};
        { u32x2 o; o.x = cvt_pk_bf16(C[0], C[1]); o.y = cvt_pk_bf16(C[2], C[3]); *(u32x2*)kp = o; }
        C = dec * C + add * kv;
        if (nthr) { const float nl = P.NLOC[(bh * 16 + c) * 128 + tid]; P.NST[(bh * 16 + c) * 128 + tid] = nv; nv = dec * nv + add * nl; if (tid == 0) P.MST[bh * 16 + c] = M; }
        M = Mn;
    }
    *(f32x4*)(P.oCp + (size_t)bh * 16384 + slice * 2048 + tid * 4) = C;
    if (nthr) { P.oNp[bh * 128 + tid] = nv; if (tid == 0) P.oMp[bh] = M; }
}

__device__ __forceinline__ void mlo_unit(LAS unsigned char* lds, const MixP& P, int b, int h, int c, int tid) {
    const int lane = tid & 63, w = __builtin_amdgcn_readfirstlane(tid >> 6), fr = lane & 15, kq = lane >> 4, q = fr >> 2, p = fr & 3;
    const int r0 = b * 2048 + c * 128, unit = (b * 4 + h) * 16 + c;
    LAS float* xs = (LAS float*)(lds + SC_OFF); LAS float* ys = xs + 128; LAS float* wint = xs + 256; LAS float* emt = xs + 384; LAS float* nst = xs + 512;
    const float Mc = P.MST[unit];
    float lf0 = 0.f, lf1 = 0.f, ig0 = 0.f, ig1 = 0.f, n0v = 0.f, n1v = 0.f;
    if (w == 0) { const int s0 = r0 + 2 * lane; lf0 = P.LF[(size_t)s0 * 4 + h]; lf1 = P.LF[(size_t)(s0 + 1) * 4 + h]; ig0 = P.IG[(size_t)s0 * 4 + h]; ig1 = P.IG[(size_t)(s0 + 1) * 4 + h]; }
    else if (w == 1) { n0v = P.NST[unit * 128 + lane]; n1v = P.NST[unit * 128 + lane + 64]; }
    const int t = 16 * w + fr;
    const bf16_t* zrow = P.Z + (size_t)(r0 + t) * ZLD + h * 128;
    u32x4 kraw[4], vraw[4], craw[4]; bf16x8 qf[4];
#pragma unroll
    for (int i = 0; i < 4; ++i) { const int id = tid + 512 * i, row = id >> 4, ch = id & 15;
        const bf16_t* zr = P.Z + (size_t)(r0 + row) * ZLD + h * 128 + ch * 8; kraw[i] = *(const u32x4*)(zr + ZK); vraw[i] = *(const u32x4*)(zr + ZV); }
    { const bf16_t* cs = P.KV + (size_t)unit * 16384;
#pragma unroll
      for (int i = 0; i < 4; ++i) { const int id = tid + 512 * i, row = id >> 4, ch = id & 15; craw[i] = *(const u32x4*)(cs + row * 128 + ch * 8); } }
#pragma unroll
    for (int ds = 0; ds < 4; ++ds) qf[ds] = *(const bf16x8*)(zrow + ZQ + 32 * ds + 8 * kq);
    if (w == 0) {
        const float Pc = scan_add(lf0 + lf1, lane), b1 = Pc, b0 = Pc - lf1;
        const float x0 = ig0 - b0, x1 = ig1 - b1;
        const float PM = scan_max(fmaxf(x0, x1), lane); float prev = __shfl_up(PM, 1); if (lane == 0) prev = -INFINITY;
        const float y0 = fmaxf(Mc, fmaxf(prev, x0)), y1 = fmaxf(Mc, PM);
        xs[2 * lane] = x0; xs[2 * lane + 1] = x1; ys[2 * lane] = y0; ys[2 * lane + 1] = y1;
        wint[2 * lane] = __expf(Mc - y0); wint[2 * lane + 1] = __expf(Mc - y1);
        emt[2 * lane] = __expf(-(b0 + y0)); emt[2 * lane + 1] = __expf(-(b1 + y1));
    } else if (w == 1) { nst[lane] = n0v; nst[lane + 64] = n1v; }
#pragma unroll
    for (int i = 0; i < 4; ++i) { const int id = tid + 512 * i, row = id >> 4, ch = id & 15;
        *(LAS u32x4*)(lds + IMG0 + row * TS + ch * 16) = kraw[i];
        *(LAS u32x4*)(lds + IMG1 + row * TS + ch * 16) = vraw[i];
        *(LAS u32x4*)(lds + IMG2 + row * TS + ch * 16) = craw[i]; }
    __syncthreads();
    u32x2 ow[8];
#pragma unroll
    for (int n = 0; n < 8; ++n) ow[n] = *(const u32x2*)(zrow + ZO + 16 * n + 4 * kq);
    float dn = 0.f;
#pragma unroll
    for (int ds = 0; ds < 4; ++ds)
#pragma unroll
        for (int e = 0; e < 8; ++e) dn += __uint_as_float(((unsigned)(unsigned short)qf[ds][e]) << 16) * nst[32 * ds + 8 * kq + e];
    dn += __shfl_xor(dn, 16); dn += __shfl_xor(dn, 32);
    LAS const unsigned char* trv = lds + IMG1 + (4 * kq + q) * TS + 8 * p;
    LAS const unsigned char* trc = lds + IMG2 + (8 * kq + q) * TS + 8 * p;
    const float wi = wint[t];
    f32x4 o1[8];
#pragma unroll
    for (int n = 0; n < 8; ++n) o1[n] = (f32x4){0.f, 0.f, 0.f, 0.f};
#pragma unroll
    for (int ds = 0; ds < 4; ++ds)
#pragma unroll
        for (int n = 0; n < 8; ++n) { const bf16x8 cf = tr2(trc + (32 * ds) * TS + 32 * n, trc + (32 * ds + 4) * TS + 32 * n);
            o1[n] = __builtin_amdgcn_mfma_f32_16x16x32_bf16(cf, qf[ds], o1[n], 0, 0, 0); }
#pragma unroll
    for (int n = 0; n < 8; ++n) o1[n] = o1[n] * wi;
    f32x4 aS[8];
#pragma unroll
    for (int j = 0; j < 8; ++j) aS[j] = (f32x4){0.f, 0.f, 0.f, 0.f};
#pragma unroll
    for (int j = 0; j < 8; ++j) if (j <= w) {
#pragma unroll
        for (int ds = 0; ds < 4; ++ds) { const bf16x8 kf = *(LAS const bf16x8*)(lds + IMG0 + (16 * j + fr) * TS + (32 * ds + 8 * kq) * 2);
            aS[j] = __builtin_amdgcn_mfma_f32_16x16x32_bf16(kf, qf[ds], aS[j], 0, 0, 0); } }
    const float yt = ys[t]; float dsum = 0.f;
#pragma unroll
    for (int j = 0; j < 8; ++j) if (j <= w) {
#pragma unroll
        for (int r = 0; r < 4; ++r) { const int s = 16 * j + 4 * kq + r; const float wg = (s <= t) ? __expf(xs[s] - yt) : 0.f; aS[j][r] *= wg; dsum += aS[j][r]; } }
    dsum += __shfl_xor(dsum, 16); dsum += __shfl_xor(dsum, 32);
    const float den = dsum + wi * dn, rinv = 1.0f / fmaxf(fabsf(den), emt[t]);
#pragma unroll
    for (int st = 0; st < 4; ++st) if (2 * st <= w) {
        u32x4 sw; sw.x = cvt_pk_bf16(aS[2 * st][0], aS[2 * st][1]); sw.y = cvt_pk_bf16(aS[2 * st][2], aS[2 * st][3]);
        sw.z = cvt_pk_bf16(aS[2 * st + 1][0], aS[2 * st + 1][1]); sw.w = cvt_pk_bf16(aS[2 * st + 1][2], aS[2 * st + 1][3]);
        const bf16x8 sf = __builtin_bit_cast(bf16x8, sw);
#pragma unroll
        for (int n = 0; n < 8; ++n) { const bf16x8 vf = tr2(trv + (32 * st) * TS + 32 * n, trv + (32 * st + 16) * TS + 32 * n);
            o1[n] = __builtin_amdgcn_mfma_f32_16x16x32_bf16(vf, sf, o1[n], 0, 0, 0); } }
    float ssq = 0.f;
#pragma unroll
    for (int n = 0; n < 8; ++n)
#pragma unroll
        for (int r = 0; r < 4; ++r) { const float hv = o1[n][r] * rinv; o1[n][r] = hv; ssq += hv * hv; }
    ssq += __shfl_xor(ssq, 16); ssq += __shfl_xor(ssq, 32);
    const float rn = 1.0f / sqrtf(ssq * (1.0f / 128.0f) + EPS);
    bf16_t* yrow = P.YC + (size_t)(r0 + t) * 1024 + 512 + h * 128 + 4 * kq;
#pragma unroll
    for (int n = 0; n < 8; ++n) { const f32x4 g = *(const f32x4*)(P.mlnorm + h * 128 + 4 * kq + 16 * n); u32x2 o;
        o.x = cvt_pk_bf16(bf_lo(ow[n].x) * o1[n][0] * rn * g[0], bf_hi(ow[n].x) * o1[n][1] * rn * g[1]);
        o.y = cvt_pk_bf16(bf_lo(ow[n].y) * o1[n][2] * rn * g[2], bf_hi(ow[n].y) * o1[n][3] * rn * g[3]);
        *(u32x2*)(yrow + 16 * n) = o; }
    __syncthreads();
}

__device__ __forceinline__ void sample_unit(LAS unsigned char* lds, const MixP& P, int b, int h, int tid) {
    const int lane = tid & 63, w = __builtin_amdgcn_readfirstlane(tid >> 6);
    const int r0 = NP + b * 8, bh = b * 4 + h;
    LAS float* ql = (LAS float*)lds; LAS float* kl = ql + 1024; LAS float* vl = ql + 2048; LAS float* vnl = ql + 3072; LAS float* Sl = ql + 4096;
    LAS float* gsx = ql + 4160; LAS float* gsy = gsx + 8; LAS float* gwi = gsx + 16; LAS float* gem = gsx + 24; LAS float* gwe = gsx + 32; LAS float* gsc = gsx + 40; LAS float* qn = gsx + 48;
    LAS float* red = (LAS float*)(lds + 32768);
    f32x4 cvv[8];
    { const float* cs = P.stC + (size_t)bh * 16384 + (tid >> 5) * 128 + 4 * (tid & 31);
#pragma unroll
      for (int i = 0; i < 8; ++i) cvv[i] = *(const f32x4*)(cs + (size_t)(16 * i) * 128); }
    if (tid == 0) {
        const float m0 = P.stM[bh]; float bc = 0.f, pm = -INFINITY, mt = 0.f; float xv[8];
#pragma unroll
        for (int t = 0; t < 8; ++t) { const float lf = P.LF[(size_t)(r0 + t) * 4 + h], ig = P.IG[(size_t)(r0 + t) * 4 + h];
            bc += lf; const float x = ig - bc; pm = fmaxf(pm, x); const float y = fmaxf(m0, pm); mt = bc + y; xv[t] = x;
            gsx[t] = x; gsy[t] = y; gwi[t] = __expf(m0 - y); gem[t] = __expf(-mt); }
        const float mnew = mt;
#pragma unroll
        for (int t = 0; t < 8; ++t) gwe[t] = __expf(bc + xv[t] - mnew);
        gsc[0] = __expf(bc + m0 - mnew); gsc[1] = mnew;
    }
    { const int t = tid >> 6, e = 2 * (tid & 63); const bf16_t* zr = P.Z + (size_t)(r0 + t) * ZLD + h * 128 + e;
      const unsigned qw = *(const unsigned*)(zr + ZQ), kw = *(const unsigned*)(zr + ZK), vw = *(const unsigned*)(zr + ZV);
      ql[t * 128 + e] = bf_lo(qw); ql[t * 128 + e + 1] = bf_hi(qw); kl[t * 128 + e] = bf_lo(kw); kl[t * 128 + e + 1] = bf_hi(kw); vl[t * 128 + e] = bf_lo(vw); vl[t * 128 + e + 1] = bf_hi(vw); }
    { const int t = w;
      const u32x4 raw = *(const u32x4*)(P.Z + (size_t)(r0 + t) * ZLD + ZVG + 8 * lane);
      float x[8]; unpack8(raw, x);
      float s = ((x[0] + x[1]) + (x[2] + x[3])) + ((x[4] + x[5]) + (x[6] + x[7]));
      const float mean = wave_sum(s) * (1.0f / 512.0f); float q2 = 0.f;
#pragma unroll
      for (int e = 0; e < 8; ++e) { x[e] -= mean; q2 += x[e] * x[e]; }
      const float rstd = 1.0f / sqrtf(wave_sum(q2) * (1.0f / 512.0f) + EPS);
      if ((lane >> 4) == h) { const f32x4 a = *(const f32x4*)(P.lng + 8 * lane), a2 = *(const f32x4*)(P.lng + 8 * lane + 4), c0 = *(const f32x4*)(P.lnb + 8 * lane), c1 = *(const f32x4*)(P.lnb + 8 * lane + 4);
#pragma unroll
          for (int e = 0; e < 4; ++e) { x[e] = x[e] * rstd * a[e] + c0[e]; x[4 + e] = x[4 + e] * rstd * a2[e] + c1[e]; }
          float* vo = P.oVs + ((size_t)b * 8 + t) * 512 + 8 * lane; *(f32x4*)vo = (f32x4){x[0], x[1], x[2], x[3]}; *(f32x4*)(vo + 4) = (f32x4){x[4], x[5], x[6], x[7]};
#pragma unroll
          for (int e = 0; e < 8; ++e) vnl[t * 128 + 8 * (lane & 15) + e] = x[e]; } }
    __syncthreads();
    if (tid < 64) { const int t = tid >> 3, s = tid & 7; float dot = 0.f;
        for (int d = 0; d < 128; ++d) dot += ql[t * 128 + d] * kl[s * 128 + d];
        Sl[tid] = (s <= t) ? dot * __expf(gsx[s] - gsy[t]) : 0.f; }
    else if (tid < 72) { const int t = tid - 64; float dot = 0.f; for (int d = 0; d < 128; ++d) dot += ql[t * 128 + d] * P.stN[bh * 128 + d]; qn[t] = dot; }
    { const int t = w, e = 2 * lane; float s0 = 0.f, s1 = 0.f;
      for (int j = 0; j <= t; ++j) { const float wv = P.gm_ws[(size_t)h * 16384 + t * 128 + j]; s0 += wv * vnl[j * 128 + e]; s1 += wv * vnl[j * 128 + e + 1]; }
      const float bsv = P.bs[h * 128 + t]; const unsigned uw = *(const unsigned*)(P.Z + (size_t)(r0 + t) * ZLD + ZU + h * 128 + e);
      *(unsigned*)(P.YC + (size_t)(r0 + t) * 1024 + h * 128 + e) = cvt_pk_bf16(bf_lo(uw) * (s0 + bsv), bf_hi(uw) * (s1 + bsv)); }
    const float dec = gsc[0];
    { const int eg = tid & 31, dq = tid >> 5;
      f32x4 aq[8];
#pragma unroll
      for (int t = 0; t < 8; ++t) aq[t] = (f32x4){0.f, 0.f, 0.f, 0.f};
      f32x4 v4[8];
#pragma unroll
      for (int s = 0; s < 8; ++s) v4[s] = *(LAS const f32x4*)(vl + s * 128 + 4 * eg);
      float* co = P.oCs + (size_t)bh * 16384;
#pragma unroll
      for (int i = 0; i < 8; ++i) { const int d = dq + 16 * i; const f32x4 cv = cvv[i];
          f32x4 cn = dec * cv;
#pragma unroll
          for (int t = 0; t < 8; ++t) { aq[t] += ql[t * 128 + d] * cv; cn += (gwe[t] * kl[t * 128 + d]) * v4[t]; }
          *(f32x4*)(co + d * 128 + 4 * eg) = cn; }
#pragma unroll
      for (int t = 0; t < 8; ++t) *(LAS f32x4*)(red + (dq * 8 + t) * 128 + 4 * eg) = aq[t]; }
    __syncthreads();
    { const int t = w, e = 2 * lane; float qc0 = 0.f, qc1 = 0.f;
#pragma unroll
      for (int dq = 0; dq < 16; ++dq) { qc0 += red[(dq * 8 + t) * 128 + e]; qc1 += red[(dq * 8 + t) * 128 + e + 1]; }
      float n0 = 0.f, n1 = 0.f, dsum = 0.f;
#pragma unroll
      for (int s = 0; s < 8; ++s) { const float sv = Sl[t * 8 + s]; n0 += sv * vl[s * 128 + e]; n1 += sv * vl[s * 128 + e + 1]; dsum += sv; }
      const float wi = gwi[t], den = dsum + wi * qn[t], rinv = 1.0f / fmaxf(fabsf(den), gem[t]);
      const float h0 = (n0 + wi * qc0) * rinv, h1 = (n1 + wi * qc1) * rinv;
      const float rn = 1.0f / sqrtf(wave_sum(h0 * h0 + h1 * h1) * (1.0f / 128.0f) + EPS);
      const unsigned ow = *(const unsigned*)(P.Z + (size_t)(r0 + t) * ZLD + ZO + h * 128 + e);
      *(unsigned*)(P.YC + (size_t)(r0 + t) * 1024 + 512 + h * 128 + e) = cvt_pk_bf16(bf_lo(ow) * h0 * rn * P.mlnorm[h * 128 + e], bf_hi(ow) * h1 * rn * P.mlnorm[h * 128 + e + 1]); }
    if (tid < 128) { float nn = dec * P.stN[bh * 128 + tid];
#pragma unroll
        for (int s = 0; s < 8; ++s) nn += gwe[s] * kl[s * 128 + tid];
        P.oNs[bh * 128 + tid] = nn; if (tid == 0) P.oMs[bh] = gsc[1]; }
    __syncthreads();
}
}
namespace sg {
using pg8::bf16_t; using pg8::bf16x8; using pg8::f32x4; using pg8::u32x4; using pg8::u32x2; using pg8::cvt_pk_bf16; using pg8::bf_lo; using pg8::bf_hi; using pg8::sigmoid_f; using pg8::gelu_tanh_f; using pg8::row_rs;
constexpr int ROW0 = 16384;

struct Epi { bf16_t* O; int ldc; const float* rn; const bf16_t* Hb; bf16_t* Ho; float* SSO; const float* SSI; const bf16_t* PROJ; };

template <int MODE> __device__ __forceinline__ void epilogue(const Epi& E, int lrow, int ct, int kq, f32x4 (&acc)[4]) {
    const int row = ROW0 + lrow;
    float rs = 1.f;
    if (MODE == 3) rs = E.rn[row];
    if (MODE == 4) { rs = row_rs(E.SSI, row); rs = rs * rs; }
    if (MODE == 5) rs = row_rs(E.SSI, row);
    float sq = 0.f;
#pragma unroll
    for (int n = 0; n < 4; ++n) { const int col = 64 * ct + 16 * n + 4 * kq; f32x4 v = acc[n];
        if (MODE == 0) {
            if (col < 1024) {
#pragma unroll
                for (int e = 0; e < 4; ++e) v[e] = gelu_tanh_f(v[e]); }
            else if (col >= 2560) {
#pragma unroll
                for (int e = 0; e < 4; ++e) v[e] = sigmoid_f(v[e]); }
        }
        if (MODE == 2) {
#pragma unroll
            for (int e = 0; e < 4; ++e) { const float a = fmaxf(v[e], 0.f); v[e] = a * a; } }
        if (MODE <= 2) { u32x2 w; w.x = cvt_pk_bf16(v[0], v[1]); w.y = cvt_pk_bf16(v[2], v[3]); *(u32x2*)(E.O + (size_t)row * E.ldc + col) = w; continue; }
        const size_t off = (size_t)row * 1024 + col;
        const u32x2 hw = *(const u32x2*)(E.Hb + off); const f32x4 r = (f32x4){bf_lo(hw.x), bf_hi(hw.x), bf_lo(hw.y), bf_hi(hw.y)};
        if (MODE == 3) v = r * rs + v;
        else if (MODE == 4) v = r + v * rs;
        else { const u32x2 pw = *(const u32x2*)(E.PROJ + off);
            v[0] = r[0] + sigmoid_f(v[0] * rs) * bf_lo(pw.x); v[1] = r[1] + sigmoid_f(v[1] * rs) * bf_hi(pw.x); v[2] = r[2] + sigmoid_f(v[2] * rs) * bf_lo(pw.y); v[3] = r[3] + sigmoid_f(v[3] * rs) * bf_hi(pw.y); }
        { u32x2 w; w.x = cvt_pk_bf16(v[0], v[1]); w.y = cvt_pk_bf16(v[2], v[3]); *(u32x2*)(E.Ho + off) = w; }
        sq += (v[0] * v[0] + v[1] * v[1]) + (v[2] * v[2] + v[3] * v[3]); }
    if (MODE >= 3) { sq += __shfl_xor(sq, 16); sq += __shfl_xor(sq, 32); if (kq == 0) E.SSO[(size_t)row * 16 + ct] = sq; }
}

constexpr int KT = 128;
__device__ __forceinline__ int toff(int row, int ch) { return (row << 8) + ((ch ^ (row & 15)) << 4); }
struct Issue { int u, kt, left; };
__device__ __forceinline__ void issue_tile(LAS unsigned char* st, Issue& I, const bf16_t* A, const bf16_t* Bt, int K, int nkt, int G, int w, int lane) {
    if (I.left > 0) {
        const bf16_t* ab = A + (size_t)(64 * (I.u & 15)) * K + I.kt * KT; const bf16_t* bb = Bt + (size_t)(64 * (I.u >> 4)) * K + I.kt * KT;
#pragma unroll
        for (int jj = 0; jj < 2; ++jj) { const int j = 2 * w + jj, row = 4 * j + (lane >> 4), ch = (lane & 15) ^ (row & 15);
            __builtin_amdgcn_global_load_lds((const unsigned*)(ab + (size_t)row * K + ch * 8), (LAS unsigned*)(st + j * 1024), 16, 0, 0);
            __builtin_amdgcn_global_load_lds((const unsigned*)(bb + (size_t)row * K + ch * 8), (LAS unsigned*)(st + 16384 + j * 1024), 16, 0, 0); }
        --I.left; if (++I.kt == nkt) { I.kt = 0; I.u += G; }
    } else {
#pragma unroll
        for (int jj = 0; jj < 2; ++jj) { const int j = 2 * w + jj, row = 4 * j + (lane >> 4), ch = (lane & 15) ^ (row & 15);
            __builtin_amdgcn_global_load_lds((const unsigned*)(A + (size_t)row * K + ch * 8), (LAS unsigned*)(st + j * 1024), 16, 0, 0);
            __builtin_amdgcn_global_load_lds((const unsigned*)(Bt + (size_t)row * K + ch * 8), (LAS unsigned*)(st + 16384 + j * 1024), 16, 0, 0); }
    }
}
template <int MODE> __device__ __forceinline__ void phase(LAS unsigned char* lds, const bf16_t* A0, const bf16_t* Bt, int K, int N, const Epi& E, int vcu, int G, int tid) {
    const int lane = tid & 63, w = __builtin_amdgcn_readfirstlane(tid >> 6), fr = lane & 15, kq = lane >> 4, wm = w & 3, wk = w >> 2;
    const bf16_t* A = A0 + (size_t)ROW0 * K;
    const int nu = 16 * (N >> 6), nkt = K / KT;
    if (vcu >= nu) return;
    const int nmine = (nu - vcu + G - 1) / G, total = nmine * nkt;
    f32x4 acc[4];
#pragma unroll
    for (int n = 0; n < 4; ++n) acc[n] = (f32x4){0.f, 0.f, 0.f, 0.f};
    Issue I{vcu, 0, total};
    issue_tile(lds, I, A, Bt, K, nkt, G, w, lane); issue_tile(lds + 32768, I, A, Bt, K, nkt, G, w, lane); issue_tile(lds + 65536, I, A, Bt, K, nkt, G, w, lane);
    int kt = 0, u = vcu;
    for (int i = 0; i < total; ++i) {
        asm volatile("s_waitcnt vmcnt(8)" ::: "memory");
        __builtin_amdgcn_s_barrier();
        asm volatile("" ::: "memory");
        issue_tile(lds + ((i + 3) & 3) * 32768, I, A, Bt, K, nkt, G, w, lane);
        { LAS const unsigned char* st = lds + (i & 3) * 32768;
#pragma unroll
          for (int ks = 0; ks < 2; ++ks) { const int ch = 4 * (2 * wk + ks) + kq;
              const bf16x8 af = *(LAS const bf16x8*)(st + toff(16 * wm + fr, ch));
#pragma unroll
              for (int n = 0; n < 4; ++n) { const bf16x8 bf = *(LAS const bf16x8*)(st + 16384 + toff(16 * n + fr, ch));
                  acc[n] = __builtin_amdgcn_mfma_f32_16x16x32_bf16(bf, af, acc[n], 0, 0, 0); } } }
        if (kt + 1 == nkt) {
            LAS f32x4* xch = (LAS f32x4*)(lds + 131072) + (wm * 64 + lane) * 4;
            if (wk == 1) {
#pragma unroll
                for (int n = 0; n < 4; ++n) { xch[n] = acc[n]; acc[n] = (f32x4){0.f, 0.f, 0.f, 0.f}; } }
            asm volatile("s_waitcnt lgkmcnt(0)" ::: "memory"); __builtin_amdgcn_s_barrier(); asm volatile("" ::: "memory");
            if (wk == 0) {
#pragma unroll
                for (int n = 0; n < 4; ++n) acc[n] += xch[n];
                epilogue<MODE>(E, 64 * (u & 15) + 16 * wm + fr, u >> 4, kq, acc);
#pragma unroll
                for (int n = 0; n < 4; ++n) acc[n] = (f32x4){0.f, 0.f, 0.f, 0.f}; }
            kt = 0; u += G;
        } else ++kt;
    }
    asm volatile("s_waitcnt vmcnt(0) lgkmcnt(0)" ::: "memory"); __builtin_amdgcn_s_barrier(); asm volatile("" ::: "memory");
}

__device__ __forceinline__ int toff128(int row, int ch) { return (row << 7) + ((ch ^ ((row >> 1) & 7)) << 4); }
__device__ __forceinline__ void issue_tile128(LAS unsigned char* st, Issue& I, const bf16_t* A, const bf16_t* Bt, int K, int nkt, int G, int w, int lane) {
    const bool live = I.left > 0;
    const bf16_t* ab = live ? A + (size_t)(128 * (I.u & 7)) * K + I.kt * 64 : A; const bf16_t* bb = live ? Bt + (size_t)(128 * (I.u >> 3)) * K + I.kt * 64 : Bt;
#pragma unroll
    for (int jj = 0; jj < 2; ++jj) { const int j = 2 * w + jj, row = 8 * j + (lane >> 3), ch = (lane & 7) ^ ((row >> 1) & 7);
        __builtin_amdgcn_global_load_lds((const unsigned*)(ab + (size_t)row * K + ch * 8), (LAS unsigned*)(st + j * 1024), 16, 0, 0);
        __builtin_amdgcn_global_load_lds((const unsigned*)(bb + (size_t)row * K + ch * 8), (LAS unsigned*)(st + 16384 + j * 1024), 16, 0, 0); }
    if (live) { --I.left; if (++I.kt == nkt) { I.kt = 0; I.u += G; } }
}
template <int MODE> __device__ __forceinline__ void phase128(LAS unsigned char* lds, const bf16_t* A0, const bf16_t* Bt, int K, int N, const Epi& E, int vcu, int G, int tid) {
    static_assert(MODE == 0 || MODE == 2, "phase128: bf16-store epilogues only");
    const int lane = tid & 63, w = __builtin_amdgcn_readfirstlane(tid >> 6), fr = lane & 15, kq = lane >> 4, wm = w >> 2, wn = w & 3;
    const bf16_t* A = A0 + (size_t)ROW0 * K;
    const int nu = 8 * (N >> 7), nkt = K / 64;
    if (vcu >= nu) return;
    const int nmine = (nu - vcu + G - 1) / G, total = nmine * nkt;
    f32x4 acc[4][2];
#pragma unroll
    for (int m = 0; m < 4; ++m) { acc[m][0] = (f32x4){0.f, 0.f, 0.f, 0.f}; acc[m][1] = (f32x4){0.f, 0.f, 0.f, 0.f}; }
    Issue I{vcu, 0, total};
    issue_tile128(lds, I, A, Bt, K, nkt, G, w, lane); issue_tile128(lds + 32768, I, A, Bt, K, nkt, G, w, lane); issue_tile128(lds + 65536, I, A, Bt, K, nkt, G, w, lane);
    int kt = 0, u = vcu;
    for (int i = 0; i < total; ++i) {
        asm volatile("s_waitcnt vmcnt(8)" ::: "memory");
        __builtin_amdgcn_s_barrier();
        asm volatile("" ::: "memory");
        issue_tile128(lds + ((i + 3) & 3) * 32768, I, A, Bt, K, nkt, G, w, lane);
        { LAS const unsigned char* st = lds + (i & 3) * 32768;
#pragma unroll
          for (int ks = 0; ks < 2; ++ks) { const int ch = 4 * ks + kq;
              const bf16x8 b0 = *(LAS const bf16x8*)(st + 16384 + toff128(32 * wn + fr, ch)), b1 = *(LAS const bf16x8*)(st + 16384 + toff128(32 * wn + 16 + fr, ch));
#pragma unroll
              for (int m = 0; m < 4; ++m) { const bf16x8 af = *(LAS const bf16x8*)(st + toff128(64 * wm + 16 * m + fr, ch));
                  acc[m][0] = __builtin_amdgcn_mfma_f32_16x16x32_bf16(b0, af, acc[m][0], 0, 0, 0); acc[m][1] = __builtin_amdgcn_mfma_f32_16x16x32_bf16(b1, af, acc[m][1], 0, 0, 0); } } }
        if (kt + 1 == nkt) {
            const int rt = u & 7, ct = u >> 3;
#pragma unroll
            for (int m = 0; m < 4; ++m) { const int row = ROW0 + 128 * rt + 64 * wm + 16 * m + fr;
#pragma unroll
                for (int n = 0; n < 2; ++n) { const int col = 128 * ct + 32 * wn + 16 * n + 4 * kq; f32x4 v = acc[m][n];
                    if (MODE == 0) {
                        if (col < 1024) {
#pragma unroll
                            for (int e = 0; e < 4; ++e) v[e] = gelu_tanh_f(v[e]); }
                        else if (col >= 2560) {
#pragma unroll
                            for (int e = 0; e < 4; ++e) v[e] = sigmoid_f(v[e]); } }
                    if (MODE == 2) {
#pragma unroll
                        for (int e = 0; e < 4; ++e) { const float a = fmaxf(v[e], 0.f); v[e] = a * a; } }
                    u32x2 o; o.x = cvt_pk_bf16(v[0], v[1]); o.y = cvt_pk_bf16(v[2], v[3]); *(u32x2*)(E.O + (size_t)row * E.ldc + col) = o;
                    acc[m][n] = (f32x4){0.f, 0.f, 0.f, 0.f}; } }
            kt = 0; u += G;
        } else ++kt;
    }
    asm volatile("s_waitcnt vmcnt(0) lgkmcnt(0)" ::: "memory"); __builtin_amdgcn_s_barrier(); asm volatile("" ::: "memory");
}
}

#ifndef HOST_DUP_PHASE
#define HOST_DUP_PHASE -1
#endif
#ifndef TP_A
#define TP_A -1
#define TP_B -1
#endif
#ifndef HOST_DUP_FLAGS
#define HOST_DUP_FLAGS 1
#endif
#ifndef HOST_EXTRA_BARS
#define HOST_EXTRA_BARS 0
#endif
#ifndef MK_ONE_LAUNCH
#define MK_ONE_LAUNCH 1
#endif
constexpr int NWAVES = 8;
constexpr int D = 1024, NPR = 16384, NSR = 1024, M = NPR + NSR, NIN = 3072, INC = 3080, FF = 4096, PLE = 256;
constexpr int N_PHASES = 10;
constexpr size_t MiB = 1u << 20;
constexpr size_t WS_CTL = 0, CTL_ZERO_BYTES = 65536;
constexpr int CW_BAR = 1024;
constexpr size_t WS_WIN = 1 * MiB;
constexpr size_t WS_WOUT = WS_WIN + (size_t)NIN * D * 2;
constexpr size_t WS_WUP = WS_WOUT + (size_t)D * D * 2;
constexpr size_t WS_WDOWN = WS_WUP + (size_t)FF * D * 2;
constexpr size_t WS_WGATE = WS_WDOWN + (size_t)D * FF * 2;
constexpr size_t WS_WPROJ = WS_WGATE + (size_t)D * D * 2;
constexpr size_t WS_WSB = WS_WPROJ + (size_t)D * PLE * 2;
constexpr size_t WS_IG = WS_WSB + 4 * 128 * 128 * 2;
constexpr size_t WS_LF = WS_IG + (size_t)M * 16;
constexpr size_t WS_SS1 = WS_LF + (size_t)M * 16;
constexpr size_t WS_SS2 = WS_SS1 + (size_t)M * 64;
constexpr size_t WS_SS3 = WS_SS2 + (size_t)M * 64;
constexpr size_t WS_CH = WS_SS3 + (size_t)M * 64;
constexpr size_t WS_MST = WS_CH + 4096;
constexpr size_t WS_NLOC = WS_MST + 4096;
constexpr size_t WS_NST = WS_NLOC + 512 * 128 * 4;
constexpr size_t WS_RN = WS_NST + 512 * 128 * 4;
constexpr size_t WS_LNS = WS_RN + 69632;
constexpr size_t WS_PE = WS_LNS + (size_t)16384 * 64;
constexpr size_t WS_RA = WS_PE + (size_t)M * PLE * 2;
constexpr size_t WS_RB = WS_RA + (size_t)M * D * 2;
constexpr size_t WS_YC = WS_RB + (size_t)M * NIN * 2;
constexpr size_t WS_KV = WS_RB + (size_t)M * FF * 2;
constexpr size_t WS_END = WS_KV + (size_t)M * D * 2;
static_assert(WS_END <= 256 * MiB, "d_ws map");
static_assert(WS_WIN % 256 == 0 && WS_IG % 256 == 0 && WS_PE % 256 == 0 && WS_RA % 256 == 0 && WS_RB % 256 == 0 && WS_YC % 256 == 0 && WS_KV % 256 == 0, "alignment");
constexpr size_t O_Y = 0, O_CP = (size_t)M * D, O_NP = O_CP + 8 * 4 * 16384, O_MP = O_NP + 8 * 4 * 128, O_VP = O_MP + 32, O_CS = O_VP + 8 * 128 * 512,
                 O_NS = O_CS + (size_t)128 * 4 * 16384, O_MS = O_NS + 128 * 4 * 128, O_VS = O_MS + 512, O_END = O_VS + 128 * 8 * 512;
constexpr int RING_OFF = 0, RING_BYTES = 131072, XCH_BYTES = 16384, LDSCTL_OFF = RING_BYTES + XCH_BYTES, MISC_OFF = LDSCTL_OFF + 320, LDS_BYTES = LDSCTL_OFF + 1024;

typedef unsigned short bf16;
typedef unsigned v4u __attribute__((ext_vector_type(4)));
typedef float f32x4 __attribute__((ext_vector_type(4)));
#define GAS __attribute__((address_space(1)))
typedef GAS unsigned gu32;
#define RLX_AGENT __ATOMIC_RELAXED, __HIP_MEMORY_SCOPE_AGENT
#define LDS_WAIT() asm volatile("s_waitcnt lgkmcnt(0)" ::: "memory")

struct Args { const float* in[24]; float* out; unsigned char* ws; int ph_lo, ph_hi, flags, extra_bars; };

#define XB_TMO      128
#define XB_XCNT(j)  (256  + 64 * (j))
#define XB_XSUB(j)  (1280 + 64 * (j))
#define XB_XGEN(j)  (2304 + 64 * (j))
#define XB_TOP      3328
#define XB_TOPGEN   3392
#define XCD_BAR_WORDS 3456
#define XB_SPIN_CAP (1u << 18)

__device__ __forceinline__ unsigned xb_ld(unsigned* p)              { return __hip_atomic_load(p, __ATOMIC_RELAXED, __HIP_MEMORY_SCOPE_AGENT); }
__device__ __forceinline__ unsigned xb_add(unsigned* p, unsigned v) { return __hip_atomic_fetch_add(p, v, __ATOMIC_RELAXED, __HIP_MEMORY_SCOPE_AGENT); }
__device__ __forceinline__ unsigned xb_xcc_id() { return (unsigned)__builtin_amdgcn_s_getreg((3 << 11) | 20) & 0xFu; }
#define XB_SPIN(cond, bar) do { unsigned _sp = 0; while (cond) { __builtin_amdgcn_s_sleep(1); \
    if ((++_sp & 255u) == 0u) { if (xb_ld(&(bar)[XB_TMO])) break; if (_sp > XB_SPIN_CAP) { atomicAdd(&(bar)[XB_TMO], 1u); break; } } } } while (0)

struct XcdBarrier {
    unsigned* bar; unsigned x;
    volatile LAS unsigned* st;
};

__device__ __forceinline__ XcdBarrier xcd_barrier_post(unsigned* bar, volatile LAS unsigned* st) {
    XcdBarrier b; b.bar = bar; b.x = xb_xcc_id(); b.st = st;
    if (threadIdx.x == 0) (void)xb_add(&bar[XB_XCNT(b.x)], 1u);
    return b;
}
__device__ __forceinline__ void xcd_barrier_complete(unsigned* bar, unsigned x, unsigned& nloc, unsigned& nx) {
    const unsigned G = gridDim.x * gridDim.y * gridDim.z;
    unsigned sum, cnt, mine, sp = 0u;
    for (;;) {
        sum = 0u; cnt = 0u; mine = 0u;
#pragma unroll
        for (unsigned j = 0; j < 16; ++j) { const unsigned c = xb_ld(&bar[XB_XCNT(j)]); sum += c; cnt += (c > 0u) ? 1u : 0u; mine = (j == x) ? c : mine; }
        if (sum == G) break;
        __builtin_amdgcn_s_sleep(1);
        if ((++sp & 255u) == 0u) { if (xb_ld(&bar[XB_TMO])) break; if (sp > XB_SPIN_CAP) { atomicAdd(&bar[XB_TMO], 1u); break; } }
    }
    nloc = mine > 0u ? mine : 1u; nx = cnt > 0u ? cnt : 1u;
}

__device__ __forceinline__ void xcd_barrier(const XcdBarrier& b) {
    asm volatile("s_waitcnt vmcnt(0)" ::: "memory");
    __syncthreads();
    if (threadIdx.x == 0) {
        unsigned* bar = b.bar;
        __builtin_amdgcn_s_waitcnt(0);
        unsigned nloc = b.st[0], nx = b.st[1];
        if (nloc == 0u) { xcd_barrier_complete(bar, b.x, nloc, nx); b.st[0] = nloc; b.st[1] = nx; }
        const unsigned old = xb_add(&bar[XB_XSUB(b.x)], 1u);
        const unsigned gen = old / nloc;
        if (old + 1u == (gen + 1u) * nloc) {
            __builtin_amdgcn_fence(__ATOMIC_RELEASE, "agent");
            asm volatile("s_waitcnt vmcnt(0)" ::: "memory");
            const unsigned og = xb_add(&bar[XB_TOP], 1u);
            const unsigned tg = og / nx;
            if (og + 1u == (tg + 1u) * nx) xb_add(&bar[XB_TOPGEN], 1u);
            else XB_SPIN(xb_ld(&bar[XB_TOPGEN]) == tg, bar);
            __builtin_amdgcn_fence(__ATOMIC_ACQUIRE, "agent");
            xb_add(&bar[XB_XGEN(b.x)], 1u);
            asm volatile("s_waitcnt vmcnt(0)" ::: "memory");
        } else {
            XB_SPIN(xb_ld(&bar[XB_XGEN(b.x)]) == gen, bar);
            __builtin_amdgcn_fence(__ATOMIC_ACQUIRE, "agent");
            asm volatile("s_waitcnt vmcnt(0)" ::: "memory");
        }
    }
    __syncthreads();
}

__device__ __forceinline__ void p0_transpose_item(const float* W, int ldw, int K, int N, const float* gain, bf16* WT, LAS float* scr, int item, int lane, bool kscale) {
    const int nblk = N / 32, kb = item / nblk, nb = item % nblk, k0 = 64 * kb, n0 = 32 * nb;
    const float cs = (kscale && n0 >= 1536 && n0 < 2048) ? 0.08838834764831845f : 1.0f;
    float wv[32];
#pragma unroll
    for (int i = 0; i < 32; ++i) { const int kk = 2 * i + (lane >> 5); wv[i] = W[(size_t)(k0 + kk) * ldw + n0 + (lane & 31)]; }
#pragma unroll
    for (int i = 0; i < 32; ++i) { const int kk = 2 * i + (lane >> 5); const float g = gain ? gain[k0 + kk] * cs : cs; scr[kk * 33 + (lane & 31)] = wv[i] * g; }
    LDS_WAIT(); asm volatile("" ::: "memory");
    const int c = lane & 7;
#pragma unroll
    for (int j = 0; j < 4; ++j) { const int n = (lane >> 3) + 8 * j; const LAS float* s = scr + (8 * c) * 33 + n;
        v4u o; o.x = pg8::cvt_pk_bf16(s[0 * 33], s[1 * 33]); o.y = pg8::cvt_pk_bf16(s[2 * 33], s[3 * 33]); o.z = pg8::cvt_pk_bf16(s[4 * 33], s[5 * 33]); o.w = pg8::cvt_pk_bf16(s[6 * 33], s[7 * 33]);
        *(v4u*)(WT + (size_t)(n0 + n) * K + k0 + 8 * c) = o; }
    LDS_WAIT(); asm volatile("" ::: "memory");
}

__device__ __forceinline__ float log_sigmoid_f(float x) { return fminf(x, 0.f) - log1pf(__expf(-fabsf(x))); }

struct RowIn { f32x4 v[4]; f32x4 pv; };
__device__ __forceinline__ void p0_row_load(const Args& A, int m, int lane, RowIn& R) {
    const float* xrow = (m < NPR) ? A.in[0] + (size_t)m * D : A.in[1] + (size_t)(m - NPR) * D;
    const float* prow = (m < NPR) ? A.in[2] + (size_t)m * PLE : A.in[3] + (size_t)(m - NPR) * PLE;
    const f32x4* xr = (const f32x4*)xrow + lane;
#pragma unroll
    for (int j = 0; j < 4; ++j) R.v[j] = xr[64 * j];
    R.pv = *((const f32x4*)prow + lane);
}
__device__ __forceinline__ void p0_row_finish(unsigned char* ws, int m, int lane, RowIn& R, const float (&gwt)[4][4][8], float gbias) {
    float s = 0.f;
#pragma unroll
    for (int j = 0; j < 4; ++j) s += (R.v[j][0] * R.v[j][0] + R.v[j][1] * R.v[j][1]) + (R.v[j][2] * R.v[j][2] + R.v[j][3] * R.v[j][3]);
    const float rnv = sqrtf(mix::wave_sum(s) * (1.0f / D) + 1e-6f), rinv = 1.0f / rnv;
    if (lane == 8) ((float*)(ws + WS_RN))[m] = rnv;
    unsigned long long* o8 = (unsigned long long*)((bf16*)(ws + WS_RA) + (size_t)m * D) + lane;
    float g8[8];
#pragma unroll
    for (int q = 0; q < 8; ++q) g8[q] = 0.f;
#pragma unroll
    for (int j = 0; j < 4; ++j) { const f32x4 v = R.v[j] * rinv;
        o8[64 * j] = (unsigned long long)pg8::cvt_pk_bf16(v[0], v[1]) | ((unsigned long long)pg8::cvt_pk_bf16(v[2], v[3]) << 32);
#pragma unroll
        for (int c = 0; c < 4; ++c)
#pragma unroll
            for (int q = 0; q < 8; ++q) g8[q] += v[c] * gwt[j][c][q]; }
#pragma unroll
    for (int q = 0; q < 8; ++q) g8[q] = mix::row_sum16(g8[q]);
    const int q8 = lane & 7;
    float val = q8 == 0 ? g8[0] : q8 == 1 ? g8[1] : q8 == 2 ? g8[2] : q8 == 3 ? g8[3] : q8 == 4 ? g8[4] : q8 == 5 ? g8[5] : q8 == 6 ? g8[6] : g8[7];
    val += __shfl_xor(val, 16); val += __shfl_xor(val, 32);
    if (lane < 4) ((float*)(ws + WS_IG))[(size_t)m * 4 + lane] = val + gbias;
    else if (lane < 8) ((float*)(ws + WS_LF))[(size_t)m * 4 + lane - 4] = log_sigmoid_f(val + gbias);
    *((unsigned long long*)((bf16*)(ws + WS_PE) + (size_t)m * PLE) + lane) = (unsigned long long)pg8::cvt_pk_bf16(R.pv[0], R.pv[1]) | ((unsigned long long)pg8::cvt_pk_bf16(R.pv[2], R.pv[3]) << 32);
}

__device__ __forceinline__ void p0_prologue(const Args& A, LAS unsigned char* lds, int vcu, int G, int tid) {
    const int lane = tid & 63, wave = __builtin_amdgcn_readfirstlane(tid >> 6);
    unsigned char* ws = A.ws;
    LAS float* scr = (LAS float*)(lds + RING_OFF + wave * 8704);
    LAS float* gtab = (LAS float*)(lds + RING_OFF + 8 * 8704);
    const int gw = vcu * NWAVES + wave, NGW = G * NWAVES;
    for (int k = tid; k < D; k += NWAVES * 64) { const float g = A.in[7][k]; const float* wp = A.in[8] + (size_t)k * INC + NIN;
        const f32x4 a = *(const f32x4*)wp, b = *(const f32x4*)(wp + 4); *(LAS f32x4*)(gtab + k * 8) = a * g; *(LAS f32x4*)(gtab + k * 8 + 4) = b * g; }
    constexpr int I_IN = (D / 64) * (NIN / 32), I_OUT = (D / 64) * (D / 32), I_UP = (D / 64) * (FF / 32), I_DOWN = (FF / 64) * (D / 32), I_GATE = I_OUT, I_PROJ = (PLE / 64) * (D / 32);
    constexpr int NITEMS = I_IN + I_OUT + I_UP + I_DOWN + I_GATE + I_PROJ;
    for (int it = gw; it < NITEMS; it += NGW) {
        int r = it;
        if (r < I_IN) { p0_transpose_item(A.in[8], INC, D, NIN, A.in[7], (bf16*)(ws + WS_WIN), scr, r, lane, true); continue; } r -= I_IN;
        if (r < I_OUT) { p0_transpose_item(A.in[16], D, D, D, nullptr, (bf16*)(ws + WS_WOUT), scr, r, lane, false); continue; } r -= I_OUT;
        if (r < I_UP) { p0_transpose_item(A.in[18], FF, D, FF, A.in[17], (bf16*)(ws + WS_WUP), scr, r, lane, false); continue; } r -= I_UP;
        if (r < I_DOWN) { p0_transpose_item(A.in[19], D, FF, D, nullptr, (bf16*)(ws + WS_WDOWN), scr, r, lane, false); continue; } r -= I_DOWN;
        if (r < I_GATE) { p0_transpose_item(A.in[21], D, D, D, A.in[20], (bf16*)(ws + WS_WGATE), scr, r, lane, false); continue; } r -= I_GATE;
        p0_transpose_item(A.in[22], D, PLE, D, nullptr, (bf16*)(ws + WS_WPROJ), scr, r, lane, false);
    }
    { const int gt = vcu * 512 + tid, NT = G * 512; const float* wsrc = A.in[11]; bf16* wdst = (bf16*)(ws + WS_WSB);
      for (int i = gt; i < 4 * 128 * 128 / 4; i += NT) { const int e = 4 * i, t = (e >> 7) & 127, j = e & 127; const f32x4 v = *(const f32x4*)(wsrc + e);
          pg8::u32x2 o; o.x = pg8::cvt_pk_bf16(j <= t ? v[0] : 0.f, j + 1 <= t ? v[1] : 0.f); o.y = pg8::cvt_pk_bf16(j + 2 <= t ? v[2] : 0.f, j + 3 <= t ? v[3] : 0.f);
          *(pg8::u32x2*)(wdst + e) = o; } }
    __syncthreads();
    float gwt[4][4][8];
#pragma unroll
    for (int j = 0; j < 4; ++j)
#pragma unroll
        for (int c = 0; c < 4; ++c) { const LAS float* gp = gtab + (4 * lane + 256 * j + c) * 8; const f32x4 a = *(const LAS f32x4*)gp, b = *(const LAS f32x4*)(gp + 4);
#pragma unroll
            for (int q = 0; q < 4; ++q) { gwt[j][c][q] = a[q]; gwt[j][c][4 + q] = b[q]; } }
    const float gbias = (lane < 4) ? A.in[13][lane & 3] : A.in[14][lane & 3];
    for (int m = gw; m < M; m += 2 * NGW) {
        const int m2 = (m + NGW < M) ? m + NGW : m;
        RowIn R0, R1; p0_row_load(A, m, lane, R0); p0_row_load(A, m2, lane, R1);
        p0_row_finish(ws, m, lane, R0, gwt, gbias);
        p0_row_finish(ws, m2, lane, R1, gwt, gbias);
    }
    __syncthreads();
}

__device__ __forceinline__ void p7_final(const Args& A, int vcu, int G, int tid) {
    const int lane = tid & 63, wave = __builtin_amdgcn_readfirstlane(tid >> 6);
    const int gw = vcu * NWAVES + wave, NGW = G * NWAVES;
    const float* ss = (const float*)(A.ws + WS_SS3); const bf16* Hb = (const bf16*)(A.ws + WS_RB);
    const f32x4 g0 = *((const f32x4*)A.in[23] + 2 * lane), g1 = *((const f32x4*)A.in[23] + 2 * lane + 1), g2 = *((const f32x4*)A.in[23] + 128 + 2 * lane), g3 = *((const f32x4*)A.in[23] + 128 + 2 * lane + 1);
    for (int m = gw; m < M; m += NGW) {
        const float rs = pg8::row_rs(ss, m);
        const v4u a = *((const v4u*)(Hb + (size_t)m * D) + lane), b = *((const v4u*)(Hb + (size_t)m * D) + 64 + lane);
        f32x4* yr = (f32x4*)(A.out + (size_t)m * D);
        yr[2 * lane] = (f32x4){pg8::bf_lo(a.x), pg8::bf_hi(a.x), pg8::bf_lo(a.y), pg8::bf_hi(a.y)} * rs * g0;
        yr[2 * lane + 1] = (f32x4){pg8::bf_lo(a.z), pg8::bf_hi(a.z), pg8::bf_lo(a.w), pg8::bf_hi(a.w)} * rs * g1;
        yr[128 + 2 * lane] = (f32x4){pg8::bf_lo(b.x), pg8::bf_hi(b.x), pg8::bf_lo(b.y), pg8::bf_hi(b.y)} * rs * g2;
        yr[128 + 2 * lane + 1] = (f32x4){pg8::bf_lo(b.z), pg8::bf_hi(b.z), pg8::bf_lo(b.w), pg8::bf_hi(b.w)} * rs * g3;
    }
}

__global__ void __launch_bounds__(NWAVES * 64, 2) hymba_fwd(Args args) {
    extern __shared__ __attribute__((aligned(16))) unsigned char lds_raw[];
    LAS unsigned char* lds = (LAS unsigned char*)lds_raw;
    const int tid = threadIdx.x, G = gridDim.x, bx = blockIdx.x;
    const int vcu = (G % 8 == 0) ? (bx % 8) * (G / 8) + bx / 8 : bx;
    unsigned char* ws = args.ws;
#ifndef DUP_PHASE
#define DUP_PHASE -1
#endif
    const int lo = args.ph_lo, hi = args.ph_hi;
#ifndef PH_MASK
#define PH_MASK 0xffff
#endif
#define INC_(k) (((PH_MASK >> (k)) & 1) && lo <= (k) && (k) < hi)
#if DUP_PHASE >= 0
#define IN(k) for (int rep_ = 0; rep_ < ((DUP_PHASE == (k)) ? 2 : 1); ++rep_) if (INC_(k))
#define GRID_BAR(k) do { if (INC_((k) + 1)) xcd_barrier(bar); } while (0)
#else
#define IN(k) if (INC_(k))
#define GRID_BAR(k) do { if (INC_((k) + 1)) xcd_barrier(bar); } while (0)
#endif
    for (int u = tid; u < (LDS_BYTES - LDSCTL_OFF) / 4; u += NWAVES * 64) ((LAS unsigned*)(lds + LDSCTL_OFF))[u] = 0u;
    __syncthreads();
    XcdBarrier bar = xcd_barrier_post((unsigned*)(ws + WS_CTL) + CW_BAR, (volatile LAS unsigned*)(lds + MISC_OFF) + 8);
    float* OUT = args.out;
    const int FL = args.flags;
#if TP_A >= 0
    unsigned long long tp_a = 0ull, tp_b = 0ull;
#define STAMP(id) do { if ((id) == TP_A || (id) == TP_B) { asm volatile("s_waitcnt vmcnt(0) lgkmcnt(0)" ::: "memory"); const unsigned long long t_ = __builtin_amdgcn_s_memrealtime(); if ((id) == TP_A) tp_a = t_; if ((id) == TP_B) tp_b = t_; } } while (0)
#else
#define STAMP(id) do { } while (0)
#endif
    bf16* RA = (bf16*)(ws + WS_RA); bf16* Zb = (bf16*)(ws + WS_RB); bf16* YC = (bf16*)(ws + WS_YC); bf16* HID = (bf16*)(ws + WS_RB); bf16* H3 = (bf16*)(ws + WS_RB);     bf16* PROJ = (bf16*)args.out;
    float* SS1 = (float*)(ws + WS_SS1); float* SS2 = (float*)(ws + WS_SS2); float* SS3 = (float*)(ws + WS_SS3);
    mix::MixP MP;
    MP.Z = Zb; MP.YC = YC; MP.IG = (const float*)(ws + WS_IG); MP.LF = (const float*)(ws + WS_LF); MP.LNS = (const float*)(ws + WS_LNS); MP.WSb = (const bf16*)(ws + WS_WSB);
    MP.gm_ws = args.in[11]; MP.lng = args.in[9]; MP.lnb = args.in[10]; MP.bs = args.in[12]; MP.mlnorm = args.in[15];
    MP.KV = (bf16*)(ws + WS_KV); MP.NLOC = (float*)(ws + WS_NLOC); MP.NST = (float*)(ws + WS_NST); MP.CH = (float*)(ws + WS_CH); MP.MST = (float*)(ws + WS_MST);
    MP.stC = args.in[4]; MP.stN = args.in[5]; MP.stM = args.in[6];
    MP.oCp = OUT + O_CP; MP.oNp = OUT + O_NP; MP.oMp = OUT + O_MP; MP.oVp = OUT + O_VP; MP.oCs = OUT + O_CS; MP.oNs = OUT + O_NS; MP.oMs = OUT + O_MS; MP.oVs = OUT + O_VS;

    STAMP(0);
    IN(0) { p0_prologue(args, lds, vcu, G, tid); STAMP(1); GRID_BAR(0); for (int eb = 0; eb < args.extra_bars; ++eb) xcd_barrier(bar); }
    STAMP(2);
    IN(1) {
        pg8::Gemm g{RA, (const bf16*)(ws + WS_WIN), NPR, NIN, D}; pg8::StaticOrder S; S.init(NPR, NIN, G, bx);
        pg8::EpiBf16<0> E{Zb, NIN, (float*)(ws + WS_LNS)};
        if (!(FL & 2)) pg8::gemm_phase<pg8::EpiBf16<0>, pg8::StaticOrder, true, true>(lds + RING_OFF, g, S, E);
        STAMP(3);
        if (!(FL & 4)) { const sg::Epi SE{Zb, NIN, nullptr, nullptr, nullptr, nullptr, nullptr, nullptr}; sg::phase128<0>(lds + RING_OFF, RA, (const bf16*)(ws + WS_WIN), D, NIN, SE, vcu, G, tid); }
        GRID_BAR(1);
    }
    STAMP(4);
    IN(2) {
        for (int u = vcu; u < 1024; u += G) {
            if (u < 512) { if (FL & 16) continue; const int bc = u >> 2, h = u & 3; mix::gmlp_unit(lds, MP, bc >> 4, bc & 15, h, tid); }
            else { if (FL & 32) continue; if (u == vcu + 512) STAMP(5); const int v = u - 512; mix::kv_unit(lds, MP, v >> 6, (v >> 4) & 3, v & 15, tid); }
        }
        GRID_BAR(2);
    }
    STAMP(6);
    IN(3) {
        if (!(FL & 1)) for (int u = vcu; u < 256; u += G) mix::scan_unit(MP, u >> 3, u & 7, tid);
        STAMP(7);
        if (!(FL & 64)) for (int u = vcu; u < 512; u += G) mix::sample_unit(lds, MP, u >> 2, u & 3, tid);
        STAMP(21);
        if (!(FL & 128)) { pg8::Gemm g{(const bf16*)(ws + WS_PE), (const bf16*)(ws + WS_WPROJ), NPR, D, PLE}; pg8::StaticOrder S; S.init(NPR, D, G, bx);
          pg8::EpiBf16<1> E{PROJ, D, nullptr};
          if (!(FL & 2)) pg8::gemm_phase<pg8::EpiBf16<1>, pg8::StaticOrder, true, true>(lds + RING_OFF, g, S, E);
          STAMP(22);
          const sg::Epi SE{PROJ, D, nullptr, nullptr, nullptr, nullptr, nullptr, nullptr}; if (!(FL & 4)) sg::phase<1>(lds + RING_OFF, (const bf16*)(ws + WS_PE), (const bf16*)(ws + WS_WPROJ), PLE, D, SE, vcu, G, tid); }
        GRID_BAR(3);
    }
    STAMP(8);
    IN(4) {
        for (int rep = 0; rep < ((FL & 256) ? 3 : 1); ++rep)
        for (int u = vcu; u < 512; u += G) mix::mlo_unit(lds, MP, u >> 6, (u >> 4) & 3, u & 15, tid);
        GRID_BAR(4);
    }
    STAMP(10);
    IN(5) {
        pg8::Gemm g{YC, (const bf16*)(ws + WS_WOUT), NPR, D, D}; pg8::StaticOrder S; S.init(NPR, D, G, bx);
        pg8::EpiRes<0> E{(const float*)(ws + WS_RN), RA, RA, SS1, nullptr, nullptr};
        if (!(FL & 2)) pg8::gemm_phase<pg8::EpiRes<0>, pg8::StaticOrder, true, true>(lds + RING_OFF, g, S, E);
        STAMP(11);
        if (!(FL & 4)) { const sg::Epi SE{nullptr, 0, (const float*)(ws + WS_RN), RA, RA, SS1, nullptr, nullptr}; sg::phase<3>(lds + RING_OFF, YC, (const bf16*)(ws + WS_WOUT), D, D, SE, vcu, G, tid); }
        GRID_BAR(5);
    }
    STAMP(12);
    IN(6) {
        pg8::Gemm g{RA, (const bf16*)(ws + WS_WUP), NPR, FF, D}; pg8::StaticOrder S; S.init(NPR, FF, G, bx);
        pg8::EpiBf16<2> E{HID, FF, nullptr};
        if (!(FL & 2)) pg8::gemm_phase<pg8::EpiBf16<2>, pg8::StaticOrder, true, true>(lds + RING_OFF, g, S, E);
        STAMP(13);
        if (!(FL & 4)) { const sg::Epi SE{HID, FF, nullptr, nullptr, nullptr, nullptr, nullptr, nullptr}; sg::phase128<2>(lds + RING_OFF, RA, (const bf16*)(ws + WS_WUP), D, FF, SE, vcu, G, tid); }
        GRID_BAR(6);
    }
    STAMP(14);
    IN(7) {
        pg8::Gemm g{HID, (const bf16*)(ws + WS_WDOWN), NPR, D, FF}; pg8::StaticOrder S; S.init(NPR, D, G, bx);
        pg8::EpiRes<1> E{nullptr, RA, (FL & 8) ? (bf16*)(ws + WS_KV) : RA, (FL & 8) ? SS3 : SS2, SS1, nullptr};
        if (!(FL & 2)) pg8::gemm_phase<pg8::EpiRes<1>, pg8::StaticOrder, true, true>(lds + RING_OFF, g, S, E);
        STAMP(15);
        if (!(FL & 4)) { const sg::Epi SE{nullptr, 0, nullptr, RA, (FL & 8) ? (bf16*)(ws + WS_KV) : RA, (FL & 8) ? SS3 : SS2, SS1, nullptr}; sg::phase<4>(lds + RING_OFF, HID, (const bf16*)(ws + WS_WDOWN), FF, D, SE, vcu, G, tid); }
        GRID_BAR(7);
    }
    STAMP(16);
    IN(8) {
        pg8::Gemm g{RA, (const bf16*)(ws + WS_WGATE), NPR, D, D}; pg8::StaticOrder S; S.init(NPR, D, G, bx);
        pg8::EpiRes<2> E{nullptr, RA, (FL & 8) ? (bf16*)(ws + WS_KV) : H3, (FL & 8) ? SS1 : SS3, SS2, PROJ};
        if (!(FL & 2)) pg8::gemm_phase<pg8::EpiRes<2>, pg8::StaticOrder, true, true>(lds + RING_OFF, g, S, E);
        STAMP(17);
        if (!(FL & 4)) { const sg::Epi SE{nullptr, 0, nullptr, RA, (FL & 8) ? (bf16*)(ws + WS_KV) : H3, (FL & 8) ? SS1 : SS3, SS2, PROJ}; sg::phase<5>(lds + RING_OFF, RA, (const bf16*)(ws + WS_WGATE), D, D, SE, vcu, G, tid); }
        GRID_BAR(8);
    }
    STAMP(18);
    IN(9) p7_final(args, vcu, G, tid);
    STAMP(20);
#if TP_A >= 0
    if (bx == 0 && tid == 0) { asm volatile("s_waitcnt vmcnt(0)" ::: "memory"); OUT[O_MP] = (float)(tp_b - tp_a); }
#endif
#undef IN
#undef GRID_BAR
}

extern "C" void kernel_launch(void* const* d_in, const int* in_sizes, int n_in, void* d_out, int out_size, void* d_ws, size_t ws_size, hipStream_t stream) {
    static int grid = 0;
    if (grid == 0) {
        if (n_in != 24 || (size_t)out_size != O_END || ws_size < WS_END) { fprintf(stderr, "kernel_launch: unexpected problem shape (n_in %d, out %d, ws %zu)\n", n_in, out_size, ws_size); grid = -1; return; }
        int dev = 0, cus = 0, per_cu = 0;
        if (hipGetDevice(&dev) != hipSuccess || hipDeviceGetAttribute(&cus, hipDeviceAttributeMultiprocessorCount, dev) != hipSuccess) { grid = -1; return; }
        if (hipFuncSetAttribute((const void*)hymba_fwd, hipFuncAttributeMaxDynamicSharedMemorySize, LDS_BYTES) != hipSuccess) { fprintf(stderr, "kernel_launch: hipFuncSetAttribute failed\n"); grid = -1; return; }
        if (hipOccupancyMaxActiveBlocksPerMultiprocessor(&per_cu, (const void*)hymba_fwd, NWAVES * 64, LDS_BYTES) != hipSuccess || per_cu < 1) { fprintf(stderr, "kernel_launch: occupancy query says %d blocks per CU\n", per_cu); per_cu = 1; }
        (void)hipGetLastError();
        grid = cus * (per_cu < 1 ? per_cu : 1);
    }
    if (grid < 0) return;
    Args a{};
    for (int i = 0; i < 24; ++i) a.in[i] = (const float*)d_in[i];
    a.out = (float*)d_out; a.ws = (unsigned char*)d_ws;
#if MK_ONE_LAUNCH
    if (hipMemsetAsync((char*)d_ws + WS_CTL, 0, CTL_ZERO_BYTES, stream) != hipSuccess) { fprintf(stderr, "kernel_launch: memset of the control words failed\n"); return; }
    void* kargs[] = {&a};
#if HOST_DUP_PHASE >= 0
    const int cuts[4] = {0, HOST_DUP_PHASE + 1, HOST_DUP_PHASE, N_PHASES};
    for (int li = 0; li < 3; ++li) {
        a.ph_lo = (li == 1) ? HOST_DUP_PHASE : (li == 2 ? HOST_DUP_PHASE + 1 : 0); a.ph_hi = (li == 0 || li == 1) ? HOST_DUP_PHASE + 1 : N_PHASES; a.flags = (li == 1) ? HOST_DUP_FLAGS : 0;
        if (li > 0) (void)hipMemsetAsync((char*)d_ws + WS_CTL, 0, CTL_ZERO_BYTES, stream);
        (void)hipLaunchCooperativeKernel((const void*)hymba_fwd, dim3(grid), dim3(NWAVES * 64), kargs, LDS_BYTES, stream);
    }
    (void)cuts;
#else
    a.ph_lo = 0; a.ph_hi = N_PHASES; a.extra_bars = HOST_EXTRA_BARS;
    const hipError_t e = hipLaunchCooperativeKernel((const void*)hymba_fwd, dim3(grid), dim3(NWAVES * 64), kargs, LDS_BYTES, stream);
    if (e != hipSuccess) fprintf(stderr, "kernel_launch: cooperative launch failed: %s (grid %d)\n", hipGetErrorString(e), grid);
#endif
#else
    if (hipMemsetAsync((char*)d_ws + WS_CTL, 0, CTL_ZERO_BYTES, stream) != hipSuccess) return;
    for (int ph = 0; ph < N_PHASES; ++ph) {
        a.ph_lo = ph; a.ph_hi = ph + 1;
        hipLaunchKernelGGL(hymba_fwd, dim3(grid), dim3(NWAVES * 64), LDS_BYTES, stream, a);
    }
#endif
}
```

```cpp
#include <hip/hip_runtime.h>
#include <cstdio>
#include <cstdint>
namespace pg8 {
#define PG8_LAS __attribute__((address_space(3)))
typedef unsigned short bf16_t;
typedef short bf16x8 __attribute__((ext_vector_type(8)));
typedef float f32x4 __attribute__((ext_vector_type(4)));
typedef unsigned u32x4 __attribute__((ext_vector_type(4)));
constexpr int BM = 256, BK = 64, HALF = 128, HTB = HALF * BK * 2  , STAGE_BYTES = 8 * HTB, NXCD = 8, WGM = 8;

__host__ __device__ __forceinline__ int lds_byte(int r, int c) { const int st = (r >> 4) * 2 + (c >> 5), rr = r & 15, cc = c & 31, ob = rr * 64 + cc * 2; return st * 1024 + (ob ^ (((ob >> 9) & 1) << 5)); }
__host__ __device__ __forceinline__ void stage_rc(int b, int& R, int& C) { const int st = b / 1024, sb = b % 1024, swz = sb ^ (((sb >> 9) & 1) << 5); R = (st >> 1) * 16 + swz / 64; C = (st & 1) * 32 + (swz % 64) / 2; }
__host__ __device__ __forceinline__ int perm32(int rho) { const int n = rho >> 4, i = rho & 15; return 8 * (i >> 2) + 4 * n + (i & 3); }

struct Unit { int pm, pn; };
struct Gemm { const bf16_t* A; const bf16_t* Bt; int M, N, K; };

struct StaticOrder {
    int nM, nN, nwg, G, c;
    __host__ __device__ void init(int M, int N, int G_, int c_) { nM = M / BM; nN = N / BM; nwg = nM * nN; G = G_; c = c_; }
    __host__ __device__ bool next(int i, Unit& u) const {
        const long L = (long)i * G + c; if (L >= nwg) return false;
        int wgid = (int)L; { const int q = nwg / NXCD, r = nwg % NXCD, xcd = wgid % NXCD, off = wgid / NXCD; wgid = (xcd < r ? xcd * (q + 1) : r * (q + 1) + (xcd - r) * q) + off; }
        const int nig = WGM * nN, gid = wgid / nig, fm = gid * WGM, gsz = (nM - fm) < WGM ? (nM - fm) : WGM;
        u.pm = fm + ((wgid % nig) % gsz); u.pn = (wgid % nig) / gsz; return true;
    }
    __device__ __forceinline__ void a_ready(const Unit&) const {}
    __device__ __forceinline__ void done(const Unit&) const {}
};


typedef float f32x2 __attribute__((ext_vector_type(2)));
typedef __bf16 bf16x2_t __attribute__((ext_vector_type(2)));
typedef unsigned u32x2 __attribute__((ext_vector_type(2)));
__device__ __forceinline__ unsigned cvt_pk_bf16(float lo, float hi) { f32x2 v = {lo, hi}; bf16x2_t b = __builtin_convertvector(v, bf16x2_t); return __builtin_bit_cast(unsigned, b); }
__device__ __forceinline__ float bf_lo(unsigned w) { return __uint_as_float(w << 16); }
__device__ __forceinline__ float bf_hi(unsigned w) { return __uint_as_float(w & 0xffff0000u); }
__device__ __forceinline__ float sigmoid_f(float x) { return __builtin_amdgcn_rcpf(1.0f + __builtin_amdgcn_exp2f(-1.4426950408889634f * x)); }
__device__ __forceinline__ float gelu_tanh_f(float x) { const float t = x * (1.5957691216057308f + 0.07135481627159149f * x * x); return x * sigmoid_f(t); }

constexpr float NORM_EPS = 1e-6f;
__device__ __forceinline__ float row_rs(const float* ss, int row) {
    const f32x4* p = (const f32x4*)(ss + (size_t)row * 16); const f32x4 a = p[0], b = p[1], c = p[2], d = p[3];
    const float s = ((a[0] + a[1]) + (a[2] + a[3])) + ((b[0] + b[1]) + (b[2] + b[3])) + ((c[0] + c[1]) + (c[2] + c[3])) + ((d[0] + d[1]) + (d[2] + d[3]));
    return 1.0f / sqrtf(s * (1.0f / 1024.0f) + NORM_EPS);
}

template <int MODE> struct EpiBf16 {
    static constexpr bool PERM = true, AFTER_DRAIN = false;
    bf16_t* O; int ldc; float* lns;
    __device__ __forceinline__ void operator()(const f32x4 (&acc)[2][2][4][2], const Unit& u, int wr, int wc, int fr, int fq) const {
        const int row0 = u.pm * BM + wr * 64 + fr, col0 = u.pn * BM + wc * 32 + 8 * fq;
        const int act = (MODE == 0) ? (u.pn < 4 ? 1 : (u.pn >= 10 ? 2 : 0)) : 0;
#pragma unroll
        for (int ai = 0; ai < 2; ++ai)
#pragma unroll
            for (int m = 0; m < 4; ++m) { const int row = row0 + ai * HALF + m * 16; bf16_t* rowp = O + (size_t)row * ldc + col0; float s1 = 0.f, s2 = 0.f;
#pragma unroll
                for (int bj = 0; bj < 2; ++bj) { f32x4 v0 = acc[ai][bj][m][0], v1 = acc[ai][bj][m][1];
                    if (MODE == 0) {
                        if (act == 1) {
#pragma unroll
                            for (int e = 0; e < 4; ++e) { v0[e] = gelu_tanh_f(v0[e]); v1[e] = gelu_tanh_f(v1[e]); } }
                        else if (act == 2) {
#pragma unroll
                            for (int e = 0; e < 4; ++e) { v0[e] = sigmoid_f(v0[e]); v1[e] = sigmoid_f(v1[e]); } }
                    }
                    if (MODE == 2) {
#pragma unroll
                        for (int e = 0; e < 4; ++e) { const float a = fmaxf(v0[e], 0.f), b = fmaxf(v1[e], 0.f); v0[e] = a * a; v1[e] = b * b; } }
                    if (MODE == 0) { const f32x4 t = v0 + v1, q = v0 * v0 + v1 * v1; s1 += (t[0] + t[1]) + (t[2] + t[3]); s2 += (q[0] + q[1]) + (q[2] + q[3]); }
                    u32x4 w; w.x = cvt_pk_bf16(v0[0], v0[1]); w.y = cvt_pk_bf16(v0[2], v0[3]); w.z = cvt_pk_bf16(v1[0], v1[1]); w.w = cvt_pk_bf16(v1[2], v1[3]);
                    *(u32x4*)(rowp + bj * HALF) = w; }
                if (MODE == 0 && (u.pn == 2 || u.pn == 3)) {
                    s1 += __shfl_xor(s1, 16); s1 += __shfl_xor(s1, 32); s2 += __shfl_xor(s2, 16); s2 += __shfl_xor(s2, 32);
                    if (fq == 0) *(f32x2*)(lns + ((size_t)row * 8 + (u.pn - 2) * 4 + wc) * 2) = (f32x2){s1, s2}; } }
    }
};

template <int MODE> struct EpiRes {
    static constexpr bool PERM = true, AFTER_DRAIN = false;
    const float* rn;
    const bf16_t* Hb; bf16_t* Ho; float* SSO; const float* SSI; const bf16_t* PROJ;
    __device__ __forceinline__ void operator()(const f32x4 (&acc)[2][2][4][2], const Unit& u, int wr, int wc, int fr, int fq) const {
        const int row0 = u.pm * BM + wr * 64 + fr, col0 = u.pn * BM + wc * 32 + 8 * fq;
#pragma unroll
        for (int ai = 0; ai < 2; ++ai)
#pragma unroll
            for (int m = 0; m < 4; ++m) { const int row = row0 + ai * HALF + m * 16; const size_t off = (size_t)row * 1024 + col0;
                float rsc; if (MODE != 0) { rsc = row_rs(SSI, row); if (MODE == 1) rsc = rsc * rsc; } else rsc = rn[row];
                float sq = 0.f;
#pragma unroll
                for (int bj = 0; bj < 2; ++bj) { const size_t o2 = off + bj * HALF;
                    const u32x4 hw = *(const u32x4*)(Hb + o2);
                    const float r[8] = {bf_lo(hw.x), bf_hi(hw.x), bf_lo(hw.y), bf_hi(hw.y), bf_lo(hw.z), bf_hi(hw.z), bf_lo(hw.w), bf_hi(hw.w)};
                    const f32x4 a0 = acc[ai][bj][m][0], a1 = acc[ai][bj][m][1]; const float a[8] = {a0[0], a0[1], a0[2], a0[3], a1[0], a1[1], a1[2], a1[3]};
                    float h[8];
                    if (MODE == 0) {
#pragma unroll
                        for (int e = 0; e < 8; ++e) h[e] = r[e] * rsc + a[e]; }
                    else if (MODE == 1) {
#pragma unroll
                        for (int e = 0; e < 8; ++e) h[e] = r[e] + a[e] * rsc; }
                    else { const u32x4 pw = *(const u32x4*)(PROJ + o2);
                        const float p[8] = {bf_lo(pw.x), bf_hi(pw.x), bf_lo(pw.y), bf_hi(pw.y), bf_lo(pw.z), bf_hi(pw.z), bf_lo(pw.w), bf_hi(pw.w)};
#pragma unroll
                        for (int e = 0; e < 8; ++e) h[e] = r[e] + sigmoid_f(a[e] * rsc) * p[e]; }
                    u32x4 w; w.x = cvt_pk_bf16(h[0], h[1]); w.y = cvt_pk_bf16(h[2], h[3]); w.z = cvt_pk_bf16(h[4], h[5]); w.w = cvt_pk_bf16(h[6], h[7]); *(u32x4*)(Ho + o2) = w;
#pragma unroll
                    for (int e = 0; e < 8; ++e) sq += h[e] * h[e]; }
                sq += __shfl_xor(sq, 16); sq += __shfl_xor(sq, 32);
                if (fq == 0) SSO[(size_t)row * 16 + u.pn * 4 + wc] = sq; }
    }
};

template <class Epi, class Sched, bool ALIGN_EPI = false, bool SP2 = false>
__device__ __forceinline__ void gemm_phase(PG8_LAS unsigned char* lds, const Gemm g, const Sched& S, const Epi& E) {
    const int tid = threadIdx.x, wid = __builtin_amdgcn_readfirstlane(tid >> 6), lane = tid & 63, wr = wid >> 2, wc = wid & 3, fr = lane & 15, fq = lane >> 4;
    int K = g.K; asm volatile("" : "+s"(K));
    const int nt = K / BK;
    unsigned voffA[2], voffB[2];
#pragma unroll
    for (int i = 0; i < 2; ++i) { int R, C; stage_rc(tid * 16 + i * 8192, R, C); const int Rb = Epi::PERM ? ((R & ~31) + perm32(R & 31)) : R;
        voffA[i] = (unsigned)(R * K + C) * 2u; voffB[i] = (unsigned)(Rb * K + C) * 2u; }
    const size_t kstep = (size_t)(BK * 2);
    const size_t hstep = (size_t)HALF * K * 2;
    const size_t tstep = 2 * hstep;
    const unsigned ldsw = (unsigned)wid * 1024u;
    const int aoff = lds_byte(wr * 64 + fr, fq * 8), boff = lds_byte(wc * 32 + fr, fq * 8);
#define PG8_SA(b, h) (((b) * 2 + (h)) * HTB)
#define PG8_SB(b, h) ((4 + (b) * 2 + (h)) * HTB)
#define PG8_STAGE(bufoff, gbase, voff) do { _Pragma("unroll") for (int _i = 0; _i < 2; ++_i) \
        __builtin_amdgcn_global_load_lds((const unsigned*)((const char*)(gbase) + (voff)[_i]), (PG8_LAS unsigned*)(lds + (bufoff) + ldsw + _i * 8192), 16, 0, 0); } while (0)
#define PG8_LDA(dst, b, h) do { _Pragma("unroll") for (int m = 0; m < 4; ++m) _Pragma("unroll") for (int k = 0; k < 2; ++k) dst[m][k] = *(const PG8_LAS bf16x8*)(lds + PG8_SA(b, h) + aoff + m * 2048 + k * 1024); } while (0)
#define PG8_LDB(dst, b, h) do { _Pragma("unroll") for (int n = 0; n < 2; ++n) _Pragma("unroll") for (int k = 0; k < 2; ++k) dst[n][k] = *(const PG8_LAS bf16x8*)(lds + PG8_SB(b, h) + boff + n * 2048 + k * 1024); } while (0)
#define PG8_MMA(ai, bj, At, Bt) do { __builtin_amdgcn_s_setprio(1); _Pragma("unroll") for (int m = 0; m < 4; ++m) _Pragma("unroll") for (int n = 0; n < 2; ++n) _Pragma("unroll") for (int k = 0; k < 2; ++k) \
        acc[ai][bj][m][n] = __builtin_amdgcn_mfma_f32_16x16x32_bf16(Bt[n][k], At[m][k], acc[ai][bj][m][n], 0, 0, 0); __builtin_amdgcn_s_setprio(0); } while (0)
#define PG8_WAIT_V(n) asm volatile("s_waitcnt vmcnt(" #n ")" ::: "memory")
#define PG8_WAIT_L(n) asm volatile("s_waitcnt lgkmcnt(" #n ")" ::: "memory")
#define PG8_BAR __builtin_amdgcn_s_barrier()
#define PG8_SCHED __builtin_amdgcn_sched_barrier(0)
    Unit cur, nxt; int ui = 0;
    if (!S.next(0, cur)) return;
    f32x4 acc[2][2][4][2];
#pragma unroll
    for (int a = 0; a < 2; ++a)
#pragma unroll
        for (int b = 0; b < 2; ++b)
#pragma unroll
            for (int m = 0; m < 4; ++m)
#pragma unroll
                for (int n = 0; n < 2; ++n) acc[a][b][m][n] = (f32x4){0.f, 0.f, 0.f, 0.f};
    bf16x8 At[4][2], B0[2][2], B1[2][2];
    const char* cA = (const char*)g.A + (size_t)cur.pm * tstep; const char* cB = (const char*)g.Bt + (size_t)cur.pn * tstep;
    S.a_ready(cur);
    if constexpr (SP2) {
        PG8_STAGE(PG8_SB(0, 0), cB, voffB); PG8_STAGE(PG8_SB(0, 1), cB + hstep, voffB); PG8_STAGE(PG8_SA(0, 0), cA, voffA); PG8_STAGE(PG8_SA(0, 1), cA + hstep, voffA);
        if (wr == 1) PG8_BAR;
        PG8_WAIT_V(2); PG8_BAR;
        PG8_STAGE(PG8_SB(1, 0), cB + kstep, voffB); PG8_STAGE(PG8_SA(1, 0), cA + kstep, voffA); PG8_STAGE(PG8_SB(1, 1), cB + hstep + kstep, voffB);
        PG8_WAIT_V(6); PG8_BAR;
    } else {
        PG8_STAGE(PG8_SB(0, 0), cB, voffB); PG8_STAGE(PG8_SA(0, 0), cA, voffA); PG8_STAGE(PG8_SB(0, 1), cB + hstep, voffB); PG8_STAGE(PG8_SA(0, 1), cA + hstep, voffA);
        if (wr == 1) PG8_BAR;
        PG8_WAIT_V(4); PG8_BAR;
        PG8_STAGE(PG8_SB(1, 0), cB + kstep, voffB); PG8_STAGE(PG8_SA(1, 0), cA + kstep, voffA); PG8_STAGE(PG8_SB(1, 1), cB + hstep + kstep, voffB);
        PG8_WAIT_V(6); PG8_BAR;
    }
    for (;;) {
        const bool has_next = S.next(ui + 1, nxt);
        const char* nA = has_next ? (const char*)g.A + (size_t)nxt.pm * tstep : cA; const char* nB = has_next ? (const char*)g.Bt + (size_t)nxt.pn * tstep : cB;
        for (int t = 0; t < nt; t += 2) {
            const bool last = (t == nt - 2);
            const char* a1 = cA + (size_t)(t + 1) * kstep;
            const char* a2 = last ? nA : cA + (size_t)(t + 2) * kstep; const char* b2 = last ? nB : cB + (size_t)(t + 2) * kstep;
            const char* a3 = a2 + kstep; const char* b3 = b2 + kstep;
            if (last && has_next) S.a_ready(nxt);
            if constexpr (SP2) {
            PG8_LDB(B0, 0, 0); PG8_LDB(B1, 0, 1); PG8_SCHED; PG8_LDA(At, 0, 0); PG8_STAGE(PG8_SA(1, 1), a1 + hstep, voffA);
            PG8_WAIT_V(8); PG8_WAIT_L(0); PG8_BAR; PG8_MMA(0, 0, At, B0); PG8_MMA(0, 1, At, B1); PG8_BAR; PG8_SCHED;
            PG8_LDA(At, 0, 1); PG8_STAGE(PG8_SB(0, 0), b2, voffB); PG8_STAGE(PG8_SB(0, 1), b2 + hstep, voffB); PG8_STAGE(PG8_SA(0, 0), a2, voffA);
            PG8_WAIT_V(8); PG8_WAIT_L(0); PG8_BAR; PG8_MMA(1, 0, At, B0); PG8_MMA(1, 1, At, B1); PG8_BAR; PG8_SCHED;
            PG8_LDB(B0, 1, 0); PG8_LDB(B1, 1, 1); PG8_SCHED; PG8_LDA(At, 1, 0); PG8_STAGE(PG8_SA(0, 1), a2 + hstep, voffA);
            PG8_WAIT_V(8); PG8_WAIT_L(0); PG8_BAR; PG8_MMA(0, 0, At, B0); PG8_MMA(0, 1, At, B1); PG8_BAR; PG8_SCHED;
            PG8_LDA(At, 1, 1); PG8_STAGE(PG8_SB(1, 0), b3, voffB); PG8_STAGE(PG8_SB(1, 1), b3 + hstep, voffB); PG8_STAGE(PG8_SA(1, 0), a3, voffA);
            PG8_WAIT_V(8); PG8_WAIT_L(0); PG8_BAR; PG8_MMA(1, 0, At, B0); PG8_MMA(1, 1, At, B1); PG8_BAR; PG8_SCHED;
            } else {
            PG8_LDB(B0, 0, 0); PG8_SCHED; PG8_LDA(At, 0, 0); PG8_STAGE(PG8_SA(1, 1), a1 + hstep, voffA);
            PG8_WAIT_L(8); PG8_BAR; PG8_WAIT_L(0); PG8_MMA(0, 0, At, B0); PG8_BAR; PG8_SCHED;
            PG8_LDB(B1, 0, 1); PG8_STAGE(PG8_SB(0, 0), b2, voffB);
            PG8_BAR; PG8_WAIT_L(0); PG8_MMA(0, 1, At, B1); PG8_BAR;
            PG8_LDA(At, 0, 1); PG8_STAGE(PG8_SA(0, 0), a2, voffA);
            PG8_BAR; PG8_WAIT_L(0); PG8_MMA(1, 0, At, B0); PG8_BAR; PG8_SCHED;
            PG8_STAGE(PG8_SB(0, 1), b2 + hstep, voffB);
            PG8_WAIT_V(6); PG8_BAR; PG8_MMA(1, 1, At, B1); PG8_BAR;
            PG8_LDB(B0, 1, 0); PG8_SCHED; PG8_LDA(At, 1, 0); PG8_STAGE(PG8_SA(0, 1), a2 + hstep, voffA);
            PG8_WAIT_L(8); PG8_BAR; PG8_WAIT_L(0); PG8_MMA(0, 0, At, B0); PG8_BAR; PG8_SCHED;
            PG8_LDB(B1, 1, 1); PG8_STAGE(PG8_SB(1, 0), b3, voffB);
            PG8_BAR; PG8_WAIT_L(0); PG8_MMA(0, 1, At, B1); PG8_BAR;
            PG8_LDA(At, 1, 1); PG8_STAGE(PG8_SA(1, 0), a3, voffA);
            PG8_BAR; PG8_WAIT_L(0); PG8_MMA(1, 0, At, B0); PG8_BAR; PG8_SCHED;
            PG8_STAGE(PG8_SB(1, 1), b3 + hstep, voffB);
            PG8_WAIT_V(6); PG8_BAR; PG8_MMA(1, 1, At, B1); PG8_BAR;
            }
        }
        if constexpr (ALIGN_EPI) { if (wr == 0) PG8_BAR; }
        if constexpr (!Epi::AFTER_DRAIN) { E(acc, cur, wr, wc, fr, fq); S.done(cur); }
        if (!has_next) break;
#pragma unroll
        for (int a = 0; a < 2; ++a)
#pragma unroll
            for (int b = 0; b < 2; ++b)
#pragma unroll
                for (int m = 0; m < 4; ++m)
#pragma unroll
                    for (int n = 0; n < 2; ++n) acc[a][b][m][n] = (f32x4){0.f, 0.f, 0.f, 0.f};
        cur = nxt; cA = nA; cB = nB; ++ui;
        if constexpr (ALIGN_EPI) { if (wr == 1) PG8_BAR; }
    }
    PG8_WAIT_V(0);
    if constexpr (!ALIGN_EPI) { if (wr == 0) PG8_BAR; }
    PG8_BAR;
    if constexpr (Epi::AFTER_DRAIN) { E.fused(acc, cur, wr, wc, fr, fq, lds, wid, lane); S.done(cur); }
#undef PG8_SA
#undef PG8_SB
#undef PG8_STAGE
#undef PG8_LDA
#undef PG8_LDB
#undef PG8_MMA
#undef PG8_WAIT_V
#undef PG8_WAIT_L
#undef PG8_BAR
#undef PG8_SCHED
}
}

namespace mix {
#define LAS __attribute__((address_space(3)))
using pg8::bf16_t; using pg8::bf16x8; using pg8::f32x4; using pg8::u32x4; using pg8::u32x2; using pg8::cvt_pk_bf16; using pg8::bf_lo; using pg8::bf_hi; using pg8::sigmoid_f;
typedef short v4i16_t __attribute__((ext_vector_type(4)));
constexpr int NP = 16384, NS = 1024, ZLD = 3072;
constexpr int ZU = 0, ZVG = 512, ZQ = 1024, ZK = 1536, ZV = 2048, ZO = 2560;
constexpr int TS = 288;
constexpr int IMG = 128 * TS;
constexpr int IMG0 = 0, IMG1 = IMG, IMG2 = 2 * IMG, SC_OFF = 3 * IMG;
constexpr float EPS = 1e-6f;

template <int CTRL> __device__ __forceinline__ float dpp_mov(float v) { return __int_as_float(__builtin_amdgcn_update_dpp(0, __float_as_int(v), CTRL, 0xF, 0xF, true)); }
__device__ __forceinline__ float row_sum16(float v) { v += dpp_mov<0xB1>(v); v += dpp_mov<0x4E>(v); v += dpp_mov<0x141>(v); v += dpp_mov<0x140>(v); return v; }
__device__ __forceinline__ float row_max16(float v) { v = fmaxf(v, dpp_mov<0xB1>(v)); v = fmaxf(v, dpp_mov<0x4E>(v)); v = fmaxf(v, dpp_mov<0x141>(v)); v = fmaxf(v, dpp_mov<0x140>(v)); return v; }
__device__ __forceinline__ float rl(float v, int l) { return __int_as_float(__builtin_amdgcn_readlane(__float_as_int(v), l)); }
__device__ __forceinline__ float wave_sum(float v) { v = row_sum16(v); return (rl(v, 0) + rl(v, 16)) + (rl(v, 32) + rl(v, 48)); }
__device__ __forceinline__ float wave_max(float v) { v = row_max16(v); return fmaxf(fmaxf(rl(v, 0), rl(v, 16)), fmaxf(rl(v, 32), rl(v, 48))); }
__device__ __forceinline__ float scan_add(float v, int lane) {
#pragma unroll
    for (int o = 1; o < 64; o <<= 1) { const float t = __shfl_up(v, o); if (lane >= o) v += t; }
    return v;
}
__device__ __forceinline__ float scan_max(float v, int lane) {
#pragma unroll
    for (int o = 1; o < 64; o <<= 1) { const float t = __shfl_up(v, o); if (lane >= o) v = fmaxf(v, t); }
    return v;
}
__device__ __forceinline__ bf16x8 tr2(LAS const unsigned char* p0, LAS const unsigned char* p1) {
    const v4i16_t a = __builtin_amdgcn_ds_read_tr16_b64_v4i16((LAS v4i16_t*)p0);
    const v4i16_t b = __builtin_amdgcn_ds_read_tr16_b64_v4i16((LAS v4i16_t*)p1);
    return (bf16x8){a[0], a[1], a[2], a[3], b[0], b[1], b[2], b[3]};
}
__device__ __forceinline__ void unpack8(const u32x4 w, float (&x)[8]) {
    x[0] = bf_lo(w.x); x[1] = bf_hi(w.x); x[2] = bf_lo(w.y); x[3] = bf_hi(w.y); x[4] = bf_lo(w.z); x[5] = bf_hi(w.z); x[6] = bf_lo(w.w); x[7] = bf_hi(w.w);
}
__device__ __forceinline__ u32x4 pack8(const float (&x)[8]) {
    u32x4 w; w.x = cvt_pk_bf16(x[0], x[1]); w.y = cvt_pk_bf16(x[2], x[3]); w.z = cvt_pk_bf16(x[4], x[5]); w.w = cvt_pk_bf16(x[6], x[7]); return w;
}

struct MixP {
    const bf16_t* Z; bf16_t* YC; const float* IG; const float* LF; const float* LNS;
    const bf16_t* WSb;
    const float *gm_ws, *lng, *lnb, *bs, *mlnorm;
    bf16_t* KV; float *NLOC, *NST, *CH, *MST;
    const float *stC, *stN, *stM;
    float *oCp, *oNp, *oMp, *oVp, *oCs, *oNs, *oMs, *oVs;
};

__device__ __forceinline__ void gmlp_unit(LAS unsigned char* lds, const MixP& P, int b, int c, int h, int tid) {
    const int lane = tid & 63, w = __builtin_amdgcn_readfirstlane(tid >> 6), fr = lane & 15, kq = lane >> 4, q = fr >> 2, p = fr & 3;
    const int r0 = b * 2048 + c * 128;
    LAS unsigned char* img = lds + IMG0;
    LAS float* mst = (LAS float*)(lds + SC_OFF);
    const int ch = tid & 15;
    u32x4 raw[4];
#pragma unroll
    for (int i = 0; i < 4; ++i) raw[i] = *(const u32x4*)(P.Z + (size_t)(r0 + (tid >> 4) + 32 * i) * ZLD + ZVG + h * 128 + ch * 8);
    f32x4 st4[4];
    if (tid < 128) { const f32x4* sp = (const f32x4*)(P.LNS + (size_t)(r0 + tid) * 16);
#pragma unroll
        for (int j = 0; j < 4; ++j) st4[j] = sp[j]; }
    float g8[8], b8[8];
    { const float* gp = P.lng + h * 128 + ch * 8; const float* bp = P.lnb + h * 128 + ch * 8;
      const f32x4 a = *(const f32x4*)gp, a2 = *(const f32x4*)(gp + 4), c0 = *(const f32x4*)bp, c1 = *(const f32x4*)(bp + 4);
#pragma unroll
      for (int e = 0; e < 4; ++e) { g8[e] = a[e]; g8[4 + e] = a2[e]; b8[e] = c0[e]; b8[4 + e] = c1[e]; } }
    const bf16_t* Wrow = P.WSb + ((size_t)h * 128 + 16 * w + fr) * 128 + 8 * kq;
    bf16x8 wf[4];
#pragma unroll
    for (int st = 0; st < 4; ++st) wf[st] = *(const bf16x8*)(Wrow + 32 * st);
    const bf16_t* urow = P.Z + (size_t)(r0 + 16 * w + fr) * ZLD + ZU + h * 128 + 4 * kq;
    u32x2 uw[8];
#pragma unroll
    for (int n = 0; n < 8; ++n) uw[n] = *(const u32x2*)(urow + 16 * n);
    const float bsv = P.bs[h * 128 + 16 * w + fr];
    if (tid < 128) { const float s1 = (st4[0][0] + st4[0][2]) + (st4[1][0] + st4[1][2]) + (st4[2][0] + st4[2][2]) + (st4[3][0] + st4[3][2]);
        const float s2 = (st4[0][1] + st4[0][3]) + (st4[1][1] + st4[1][3]) + (st4[2][1] + st4[2][3]) + (st4[3][1] + st4[3][3]);
        const float mean = s1 * (1.0f / 512.0f), var = fmaxf(s2 * (1.0f / 512.0f) - mean * mean, 0.f);
        mst[tid] = mean; mst[128 + tid] = 1.0f / sqrtf(var + EPS); }
    __syncthreads();
    float* vout = (c == 15) ? P.oVp + (size_t)b * 128 * 512 : nullptr;
#pragma unroll
    for (int i = 0; i < 4; ++i) { const int t = (tid >> 4) + 32 * i; const float mean = mst[t], rstd = mst[128 + t];
        float x[8]; unpack8(raw[i], x);
#pragma unroll
        for (int e = 0; e < 8; ++e) x[e] = (x[e] - mean) * rstd * g8[e] + b8[e];
        *(LAS u32x4*)(img + t * TS + ch * 16) = pack8(x);
        if (vout) { float* vo = vout + (size_t)t * 512 + h * 128 + ch * 8; *(f32x4*)vo = (f32x4){x[0], x[1], x[2], x[3]}; *(f32x4*)(vo + 4) = (f32x4){x[4], x[5], x[6], x[7]}; } }
    __syncthreads();
    f32x4 acc[8];
#pragma unroll
    for (int n = 0; n < 8; ++n) acc[n] = (f32x4){0.f, 0.f, 0.f, 0.f};
    const int nsteps = (w >> 1) + 1;
    LAS const unsigned char* trb = img + (8 * kq + q) * TS + 8 * p;
#pragma unroll
    for (int st = 0; st < 4; ++st) if (st < nsteps) {
#pragma unroll
        for (int n = 0; n < 8; ++n) { const bf16x8 vf = tr2(trb + (32 * st) * TS + 32 * n, trb + (32 * st + 4) * TS + 32 * n);
            acc[n] = __builtin_amdgcn_mfma_f32_16x16x32_bf16(vf, wf[st], acc[n], 0, 0, 0); }
    }
    { const int t = 16 * w + fr;
      bf16_t* yrow = P.YC + (size_t)(r0 + t) * 1024 + h * 128 + 4 * kq;
#pragma unroll
      for (int n = 0; n < 8; ++n) { u32x2 o;
          o.x = cvt_pk_bf16(bf_lo(uw[n].x) * (acc[n][0] + bsv), bf_hi(uw[n].x) * (acc[n][1] + bsv));
          o.y = cvt_pk_bf16(bf_lo(uw[n].y) * (acc[n][2] + bsv), bf_hi(uw[n].y) * (acc[n][3] + bsv));
          *(u32x2*)(yrow + 16 * n) = o; } }
    __syncthreads();
}

__device__ __forceinline__ void kv_unit(LAS unsigned char* lds, const MixP& P, int b, int h, int c, int tid) {
    const int lane = tid & 63, w = __builtin_amdgcn_readfirstlane(tid >> 6), fr = lane & 15, kq = lane >> 4, q = fr >> 2, p = fr & 3;
    const int r0 = b * 2048 + c * 128, unit = (b * 4 + h) * 16 + c;
    LAS float* wl = (LAS float*)(lds + SC_OFF);
    float lf0 = 0.f, lf1 = 0.f, ig0 = 0.f, ig1 = 0.f;
    if (w == 0) { const int s0 = r0 + 2 * lane; lf0 = P.LF[(size_t)s0 * 4 + h]; lf1 = P.LF[(size_t)(s0 + 1) * 4 + h]; ig0 = P.IG[(size_t)s0 * 4 + h]; ig1 = P.IG[(size_t)(s0 + 1) * 4 + h]; }
    u32x4 kraw[4], vraw[4];
#pragma unroll
    for (int i = 0; i < 4; ++i) { const int id = tid + 512 * i, row = id >> 4, ch = id & 15;
        const bf16_t* zr = P.Z + (size_t)(r0 + row) * ZLD + h * 128 + ch * 8; kraw[i] = *(const u32x4*)(zr + ZK); vraw[i] = *(const u32x4*)(zr + ZV); }
    if (w == 0) {
        const float Pc = scan_add(lf0 + lf1, lane), b1 = Pc, b0 = Pc - lf1, B = __shfl(Pc, 63);
        const float x0 = ig0 - b0, x1 = ig1 - b1, xm = wave_max(fmaxf(x0, x1));
        wl[2 * lane] = __expf(x0 - xm); wl[2 * lane + 1] = __expf(x1 - xm);
        if (lane == 0) { P.CH[unit * 2] = B; P.CH[unit * 2 + 1] = B + xm; }
    }
    __syncthreads();
#pragma unroll
    for (int i = 0; i < 4; ++i) { const int id = tid + 512 * i, row = id >> 4, ch = id & 15;
        float x[8]; unpack8(kraw[i], x); const float ws = wl[row];
#pragma unroll
        for (int e = 0; e < 8; ++e) x[e] *= ws;
        *(LAS u32x4*)(lds + IMG0 + row * TS + ch * 16) = pack8(x);
        *(LAS u32x4*)(lds + IMG1 + row * TS + ch * 16) = vraw[i]; }
    __syncthreads();
    f32x4 acc[8], accn = (f32x4){0.f, 0.f, 0.f, 0.f};
#pragma unroll
    for (int n = 0; n < 8; ++n) acc[n] = (f32x4){0.f, 0.f, 0.f, 0.f};
    const bf16x8 ones = (bf16x8){0x3F80, 0x3F80, 0x3F80, 0x3F80, 0x3F80, 0x3F80, 0x3F80, 0x3F80};
    LAS const unsigned char* trk = lds + IMG0 + (8 * kq + q) * TS + 8 * p + 32 * w;
    LAS const unsigned char* trv = lds + IMG1 + (8 * kq + q) * TS + 8 * p;
#pragma unroll
    for (int st = 0; st < 4; ++st) {
        const bf16x8 kf = tr2(trk + (32 * st) * TS, trk + (32 * st + 4) * TS);
        accn = __builtin_amdgcn_mfma_f32_16x16x32_bf16(ones, kf, accn, 0, 0, 0);
#pragma unroll
        for (int n = 0; n < 8; ++n) { const bf16x8 vf = tr2(trv + (32 * st) * TS + 32 * n, trv + (32 * st + 4) * TS + 32 * n);
            acc[n] = __builtin_amdgcn_mfma_f32_16x16x32_bf16(vf, kf, acc[n], 0, 0, 0); }
    }
    bf16_t* kvp = P.KV + (size_t)unit * 16384 + (16 * w + fr) * 128 + 4 * kq;
#pragma unroll
    for (int n = 0; n < 8; ++n) { u32x2 o; o.x = cvt_pk_bf16(acc[n][0], acc[n][1]); o.y = cvt_pk_bf16(acc[n][2], acc[n][3]); *(u32x2*)(kvp + 16 * n) = o; }
    if (kq == 0) P.NLOC[unit * 128 + 16 * w + fr] = accn[0];
    __syncthreads();
}

__device__ __forceinline__ void scan_unit(const MixP& P, int bh, int slice, int tid) {
    const size_t base = (size_t)bh * 16 * 16384 + slice * 2048 + tid * 4;
    f32x4 C = (f32x4){0.f, 0.f, 0.f, 0.f}; float M = 0.f, nv = 0.f;
    const bool nthr = (slice == 0 && tid < 128);
    u32x2 kvv[16];
#pragma unroll
    for (int c = 0; c < 16; ++c) kvv[c] = *(const u32x2*)(P.KV + base + (size_t)c * 16384);
#pragma unroll
    for (int c = 0; c < 16; ++c) {
        const float B = P.CH[(bh * 16 + c) * 2], a = P.CH[(bh * 16 + c) * 2 + 1];
        const float Mn = fmaxf(B + M, a), dec = __expf(B + M - Mn), add = __expf(a - Mn);
        bf16_t* kp = P.KV + base + (size_t)c * 16384;
        const f32x4 kv = (f32x4){bf_lo(kvv[c].x), bf_hi(kvv[c].x), bf_lo(kvv[c].y), bf_hi(kvv[c].y)};
        { u32x2 o; o.x = cvt_pk_bf16(C[0], C[1]); o.y = cvt_pk_bf16(C[2], C[3]); *(u32x2*)kp = o; }
        C = dec * C + add * kv;
        if (nthr) { const float nl = P.NLOC[(bh * 16 + c) * 128 + tid]; P.NST[(bh * 16 + c) * 128 + tid] = nv; nv = dec * nv + add * nl; if (tid == 0) P.MST[bh * 16 + c] = M; }
        M = Mn;
    }
    *(f32x4*)(P.oCp + (size_t)bh * 16384 + slice * 2048 + tid * 4) = C;
    if (nthr) { P.oNp[bh * 128 + tid] = nv; if (tid == 0) P.oMp[bh] = M; }
}

__device__ __forceinline__ void mlo_unit(LAS unsigned char* lds, const MixP& P, int b, int h, int c, int tid) {
    const int lane = tid & 63, w = __builtin_amdgcn_readfirstlane(tid >> 6), fr = lane & 15, kq = lane >> 4, q = fr >> 2, p = fr & 3;
    const int r0 = b * 2048 + c * 128, unit = (b * 4 + h) * 16 + c;
    LAS float* xs = (LAS float*)(lds + SC_OFF); LAS float* ys = xs + 128; LAS float* wint = xs + 256; LAS float* emt = xs + 384; LAS float* nst = xs + 512;
    const float Mc = P.MST[unit];
    float lf0 = 0.f, lf1 = 0.f, ig0 = 0.f, ig1 = 0.f, n0v = 0.f, n1v = 0.f;
    if (w == 0) { const int s0 = r0 + 2 * lane; lf0 = P.LF[(size_t)s0 * 4 + h]; lf1 = P.LF[(size_t)(s0 + 1) * 4 + h]; ig0 = P.IG[(size_t)s0 * 4 + h]; ig1 = P.IG[(size_t)(s0 + 1) * 4 + h]; }
    else if (w == 1) { n0v = P.NST[unit * 128 + lane]; n1v = P.NST[unit * 128 + lane + 64]; }
    const int t = 16 * w + fr;
    const bf16_t* zrow = P.Z + (size_t)(r0 + t) * ZLD + h * 128;
    u32x4 kraw[4], vraw[4], craw[4]; bf16x8 qf[4];
#pragma unroll
    for (int i = 0; i < 4; ++i) { const int id = tid + 512 * i, row = id >> 4, ch = id & 15;
        const bf16_t* zr = P.Z + (size_t)(r0 + row) * ZLD + h * 128 + ch * 8; kraw[i] = *(const u32x4*)(zr + ZK); vraw[i] = *(const u32x4*)(zr + ZV); }
    { const bf16_t* cs = P.KV + (size_t)unit * 16384;
#pragma unroll
      for (int i = 0; i < 4; ++i) { const int id = tid + 512 * i, row = id >> 4, ch = id & 15; craw[i] = *(const u32x4*)(cs + row * 128 + ch * 8); } }
#pragma unroll
    for (int ds = 0; ds < 4; ++ds) qf[ds] = *(const bf16x8*)(zrow + ZQ + 32 * ds + 8 * kq);
    if (w == 0) {
        const float Pc = scan_add(lf0 + lf1, lane), b1 = Pc, b0 = Pc - lf1;
        const float x0 = ig0 - b0, x1 = ig1 - b1;
        const float PM = scan_max(fmaxf(x0, x1), lane); float prev = __shfl_up(PM, 1); if (lane == 0) prev = -INFINITY;
        const float y0 = fmaxf(Mc, fmaxf(prev, x0)), y1 = fmaxf(Mc, PM);
        xs[2 * lane] = x0; xs[2 * lane + 1] = x1; ys[2 * lane] = y0; ys[2 * lane + 1] = y1;
        wint[2 * lane] = __expf(Mc - y0); wint[2 * lane + 1] = __expf(Mc - y1);
        emt[2 * lane] = __expf(-(b0 + y0)); emt[2 * lane + 1] = __expf(-(b1 + y1));
    } else if (w == 1) { nst[lane] = n0v; nst[lane + 64] = n1v; }
#pragma unroll
    for (int i = 0; i < 4; ++i) { const int id = tid + 512 * i, row = id >> 4, ch = id & 15;
        *(LAS u32x4*)(lds + IMG0 + row * TS + ch * 16) = kraw[i];
        *(LAS u32x4*)(lds + IMG1 + row * TS + ch * 16) = vraw[i];
        *(LAS u32x4*)(lds + IMG2 + row * TS + ch * 16) = craw[i]; }
    __syncthreads();
    u32x2 ow[8];
#pragma unroll
    for (int n = 0; n < 8; ++n) ow[n] = *(const u32x2*)(zrow + ZO + 16 * n + 4 * kq);
    float dn = 0.f;
#pragma unroll
    for (int ds = 0; ds < 4; ++ds)
#pragma unroll
        for (int e = 0; e < 8; ++e) dn += __uint_as_float(((unsigned)(unsigned short)qf[ds][e]) << 16) * nst[32 * ds + 8 * kq + e];
    dn += __shfl_xor(dn, 16); dn += __shfl_xor(dn, 32);
    LAS const unsigned char* trv = lds + IMG1 + (4 * kq + q) * TS + 8 * p;
    LAS const unsigned char* trc = lds + IMG2 + (8 * kq + q) * TS + 8 * p;
    const float wi = wint[t];
    f32x4 o1[8];
#pragma unroll
    for (int n = 0; n < 8; ++n) o1[n] = (f32x4){0.f, 0.f, 0.f, 0.f};
#pragma unroll
    for (int ds = 0; ds < 4; ++ds)
#pragma unroll
        for (int n = 0; n < 8; ++n) { const bf16x8 cf = tr2(trc + (32 * ds) * TS + 32 * n, trc + (32 * ds + 4) * TS + 32 * n);
            o1[n] = __builtin_amdgcn_mfma_f32_16x16x32_bf16(cf, qf[ds], o1[n], 0, 0, 0); }
#pragma unroll
    for (int n = 0; n < 8; ++n) o1[n] = o1[n] * wi;
    f32x4 aS[8];
#pragma unroll
    for (int j = 0; j < 8; ++j) aS[j] = (f32x4){0.f, 0.f, 0.f, 0.f};
#pragma unroll
    for (int j = 0; j < 8; ++j) if (j <= w) {
#pragma unroll
        for (int ds = 0; ds < 4; ++ds) { const bf16x8 kf = *(LAS const bf16x8*)(lds + IMG0 + (16 * j + fr) * TS + (32 * ds + 8 * kq) * 2);
            aS[j] = __builtin_amdgcn_mfma_f32_16x16x32_bf16(kf, qf[ds], aS[j], 0, 0, 0); } }
    const float yt = ys[t]; float dsum = 0.f;
#pragma unroll
    for (int j = 0; j < 8; ++j) if (j <= w) {
#pragma unroll
        for (int r = 0; r < 4; ++r) { const int s = 16 * j + 4 * kq + r; const float wg = (s <= t) ? __expf(xs[s] - yt) : 0.f; aS[j][r] *= wg; dsum += aS[j][r]; } }
    dsum += __shfl_xor(dsum, 16); dsum += __shfl_xor(dsum, 32);
    const float den = dsum + wi * dn, rinv = 1.0f / fmaxf(fabsf(den), emt[t]);
#pragma unroll
    for (int st = 0; st < 4; ++st) if (2 * st <= w) {
        u32x4 sw; sw.x = cvt_pk_bf16(aS[2 * st][0], aS[2 * st][1]); sw.y = cvt_pk_bf16(aS[2 * st][2], aS[2 * st][3]);
        sw.z = cvt_pk_bf16(aS[2 * st + 1][0], aS[2 * st + 1][1]); sw.w = cvt_pk_bf16(aS[2 * st + 1][2], aS[2 * st + 1][3]);
        const bf16x8 sf = __builtin_bit_cast(bf16x8, sw);
#pragma unroll
        for (int n = 0; n < 8; ++n) { const bf16x8 vf = tr2(trv + (32 * st) * TS + 32 * n, trv + (32 * st + 16) * TS + 32 * n);
            o1[n] = __builtin_amdgcn_mfma_f32_16x16x32_bf16(vf, sf, o1[n], 0, 0, 0); } }
    float ssq = 0.f;
#pragma unroll
    for (int n = 0; n < 8; ++n)
#pragma unroll
        for (int r = 0; r < 4; ++r) { const float hv = o1[n][r] * rinv; o1[n][r] = hv; ssq += hv * hv; }
    ssq += __shfl_xor(ssq, 16); ssq += __shfl_xor(ssq, 32);
    const float rn = 1.0f / sqrtf(ssq * (1.0f / 128.0f) + EPS);
    bf16_t* yrow = P.YC + (size_t)(r0 + t) * 1024 + 512 + h * 128 + 4 * kq;
#pragma unroll
    for (int n = 0; n < 8; ++n) { const f32x4 g = *(const f32x4*)(P.mlnorm + h * 128 + 4 * kq + 16 * n); u32x2 o;
        o.x = cvt_pk_bf16(bf_lo(ow[n].x) * o1[n][0] * rn * g[0], bf_hi(ow[n].x) * o1[n][1] * rn * g[1]);
        o.y = cvt_pk_bf16(bf_lo(ow[n].y) * o1[n][2] * rn * g[2], bf_hi(ow[n].y) * o1[n][3] * rn * g[3]);
        *(u32x2*)(yrow + 16 * n) = o; }
    __syncthreads();
}

__device__ __forceinline__ void sample_unit(LAS unsigned char* lds, const MixP& P, int b, int h, int tid) {
    const int lane = tid & 63, w = __builtin_amdgcn_readfirstlane(tid >> 6);
    const int r0 = NP + b * 8, bh = b * 4 + h;
    LAS float* ql = (LAS float*)lds; LAS float* kl = ql + 1024; LAS float* vl = ql + 2048; LAS float* vnl = ql + 3072; LAS float* Sl = ql + 4096;
    LAS float* gsx = ql + 4160; LAS float* gsy = gsx + 8; LAS float* gwi = gsx + 16; LAS float* gem = gsx + 24; LAS float* gwe = gsx + 32; LAS float* gsc = gsx + 40; LAS float* qn = gsx + 48;
    LAS float* red = (LAS float*)(lds + 32768);
    f32x4 cvv[8];
    { const float* cs = P.stC + (size_t)bh * 16384 + (tid >> 5) * 128 + 4 * (tid & 31);
#pragma unroll
      for (int i = 0; i < 8; ++i) cvv[i] = *(const f32x4*)(cs + (size_t)(16 * i) * 128); }
    if (tid == 0) {
        const float m0 = P.stM[bh]; float bc = 0.f, pm = -INFINITY, mt = 0.f; float xv[8];
#pragma unroll
        for (int t = 0; t < 8; ++t) { const float lf = P.LF[(size_t)(r0 + t) * 4 + h], ig = P.IG[(size_t)(r0 + t) * 4 + h];
            bc += lf; const float x = ig - bc; pm = fmaxf(pm, x); const float y = fmaxf(m0, pm); mt = bc + y; xv[t] = x;
            gsx[t] = x; gsy[t] = y; gwi[t] = __expf(m0 - y); gem[t] = __expf(-mt); }
        const float mnew = mt;
#pragma unroll
        for (int t = 0; t < 8; ++t) gwe[t] = __expf(bc + xv[t] - mnew);
        gsc[0] = __expf(bc + m0 - mnew); gsc[1] = mnew;
    }
    { const int t = tid >> 6, e = 2 * (tid & 63); const bf16_t* zr = P.Z + (size_t)(r0 + t) * ZLD + h * 128 + e;
      const unsigned qw = *(const unsigned*)(zr + ZQ), kw = *(const unsigned*)(zr + ZK), vw = *(const unsigned*)(zr + ZV);
      ql[t * 128 + e] = bf_lo(qw); ql[t * 128 + e + 1] = bf_hi(qw); kl[t * 128 + e] = bf_lo(kw); kl[t * 128 + e + 1] = bf_hi(kw); vl[t * 128 + e] = bf_lo(vw); vl[t * 128 + e + 1] = bf_hi(vw); }
    { const int t = w;
      const u32x4 raw = *(const u32x4*)(P.Z + (size_t)(r0 + t) * ZLD + ZVG + 8 * lane);
      float x[8]; unpack8(raw, x);
      float s = ((x[0] + x[1]) + (x[2] + x[3])) + ((x[4] + x[5]) + (x[6] + x[7]));
      const float mean = wave_sum(s) * (1.0f / 512.0f); float q2 = 0.f;
#pragma unroll
      for (int e = 0; e < 8; ++e) { x[e] -= mean; q2 += x[e] * x[e]; }
      const float rstd = 1.0f / sqrtf(wave_sum(q2) * (1.0f / 512.0f) + EPS);
      if ((lane >> 4) == h) { const f32x4 a = *(const f32x4*)(P.lng + 8 * lane), a2 = *(const f32x4*)(P.lng + 8 * lane + 4), c0 = *(const f32x4*)(P.lnb + 8 * lane), c1 = *(const f32x4*)(P.lnb + 8 * lane + 4);
#pragma unroll
          for (int e = 0; e < 4; ++e) { x[e] = x[e] * rstd * a[e] + c0[e]; x[4 + e] = x[4 + e] * rstd * a2[e] + c1[e]; }
          float* vo = P.oVs + ((size_t)b * 8 + t) * 512 + 8 * lane; *(f32x4*)vo = (f32x4){x[0], x[1], x[2], x[3]}; *(f32x4*)(vo + 4) = (f32x4){x[4], x[5], x[6], x[7]};
#pragma unroll
          for (int e = 0; e < 8; ++e) vnl[t * 128 + 8 * (lane & 15) + e] = x[e]; } }
    __syncthreads();
    if (tid < 64) { const int t = tid >> 3, s = tid & 7; float dot = 0.f;
        for (int d = 0; d < 128; ++d) dot += ql[t * 128 + d] * kl[s * 128 + d];
        Sl[tid] = (s <= t) ? dot * __expf(gsx[s] - gsy[t]) : 0.f; }
    else if (tid < 72) { const int t = tid - 64; float dot = 0.f; for (int d = 0; d < 128; ++d) dot += ql[t * 128 + d] * P.stN[bh * 128 + d]; qn[t] = dot; }
    { const int t = w, e = 2 * lane; float s0 = 0.f, s1 = 0.f;
      for (int j = 0; j <= t; ++j) { const float wv = P.gm_ws[(size_t)h * 16384 + t * 128 + j]; s0 += wv * vnl[j * 128 + e]; s1 += wv * vnl[j * 128 + e + 1]; }
      const float bsv = P.bs[h * 128 + t]; const unsigned uw = *(const unsigned*)(P.Z + (size_t)(r0 + t) * ZLD + ZU + h * 128 + e);
      *(unsigned*)(P.YC + (size_t)(r0 + t) * 1024 + h * 128 + e) = cvt_pk_bf16(bf_lo(uw) * (s0 + bsv), bf_hi(uw) * (s1 + bsv)); }
    const float dec = gsc[0];
    { const int eg = tid & 31, dq = tid >> 5;
      f32x4 aq[8];
#pragma unroll
      for (int t = 0; t < 8; ++t) aq[t] = (f32x4){0.f, 0.f, 0.f, 0.f};
      f32x4 v4[8];
#pragma unroll
      for (int s = 0; s < 8; ++s) v4[s] = *(LAS const f32x4*)(vl + s * 128 + 4 * eg);
      float* co = P.oCs + (size_t)bh * 16384;
#pragma unroll
      for (int i = 0; i < 8; ++i) { const int d = dq + 16 * i; const f32x4 cv = cvv[i];
          f32x4 cn = dec * cv;
#pragma unroll
          for (int t = 0; t < 8; ++t) { aq[t] += ql[t * 128 + d] * cv; cn += (gwe[t] * kl[t * 128 + d]) * v4[t]; }
          *(f32x4*)(co + d * 128 + 4 * eg) = cn; }
#pragma unroll
      for (int t = 0; t < 8; ++t) *(LAS f32x4*)(red + (dq * 8 + t) * 128 + 4 * eg) = aq[t]; }
    __syncthreads();
    { const int t = w, e = 2 * lane; float qc0 = 0.f, qc1 = 0.f;
#pragma unroll
      for (int dq = 0; dq < 16; ++dq) { qc0 += red[(dq * 8 + t) * 128 + e]; qc1 += red[(dq * 8 + t) * 128 + e + 1]; }
      float n0 = 0.f, n1 = 0.f, dsum = 0.f;
#pragma unroll
      for (int s = 0; s < 8; ++s) { const float sv = Sl[t * 8 + s]; n0 += sv * vl[s * 128 + e]; n1 += sv * vl[s * 128 + e + 1]; dsum += sv; }
      const float wi = gwi[t], den = dsum + wi * qn[t], rinv = 1.0f / fmaxf(fabsf(den), gem[t]);
      const float h0 = (n0 + wi * qc0) * rinv, h1 = (n1 + wi * qc1) * rinv;
      const float rn = 1.0f / sqrtf(wave_sum(h0 * h0 + h1 * h1) * (1.0f / 128.0f) + EPS);
      const unsigned ow = *(const unsigned*)(P.Z + (size_t)(r0 + t) * ZLD + ZO + h * 128 + e);
      *(unsigned*)(P.YC + (size_t)(r0 + t) * 1024 + 512 + h * 128 + e) = cvt_pk_bf16(bf_lo(ow) * h0 * rn * P.mlnorm[h * 128 + e], bf_hi(ow) * h1 * rn * P.mlnorm[h * 128 + e + 1]); }
    if (tid < 128) { float nn = dec * P.stN[bh * 128 + tid];
#pragma unroll
        for (int s = 0; s < 8; ++s) nn += gwe[s] * kl[s * 128 + tid];
        P.oNs[bh * 128 + tid] = nn; if (tid == 0) P.oMs[bh] = gsc[1]; }
    __syncthreads();
}
}
namespace sg {
using pg8::bf16_t; using pg8::bf16x8; using pg8::f32x4; using pg8::u32x4; using pg8::u32x2; using pg8::cvt_pk_bf16; using pg8::bf_lo; using pg8::bf_hi; using pg8::sigmoid_f; using pg8::gelu_tanh_f; using pg8::row_rs;
constexpr int ROW0 = 16384;

struct Epi { bf16_t* O; int ldc; const float* rn; const bf16_t* Hb; bf16_t* Ho; float* SSO; const float* SSI; const bf16_t* PROJ; };

template <int MODE> __device__ __forceinline__ void epilogue(const Epi& E, int lrow, int ct, int kq, f32x4 (&acc)[4]) {
    const int row = ROW0 + lrow;
    float rs = 1.f;
    if (MODE == 3) rs = E.rn[row];
    if (MODE == 4) { rs = row_rs(E.SSI, row); rs = rs * rs; }
    if (MODE == 5) rs = row_rs(E.SSI, row);
    float sq = 0.f;
#pragma unroll
    for (int n = 0; n < 4; ++n) { const int col = 64 * ct + 16 * n + 4 * kq; f32x4 v = acc[n];
        if (MODE == 0) {
            if (col < 1024) {
#pragma unroll
                for (int e = 0; e < 4; ++e) v[e] = gelu_tanh_f(v[e]); }
            else if (col >= 2560) {
#pragma unroll
                for (int e = 0; e < 4; ++e) v[e] = sigmoid_f(v[e]); }
        }
        if (MODE == 2) {
#pragma unroll
            for (int e = 0; e < 4; ++e) { const float a = fmaxf(v[e], 0.f); v[e] = a * a; } }
        if (MODE <= 2) { u32x2 w; w.x = cvt_pk_bf16(v[0], v[1]); w.y = cvt_pk_bf16(v[2], v[3]); *(u32x2*)(E.O + (size_t)row * E.ldc + col) = w; continue; }
        const size_t off = (size_t)row * 1024 + col;
        const u32x2 hw = *(const u32x2*)(E.Hb + off); const f32x4 r = (f32x4){bf_lo(hw.x), bf_hi(hw.x), bf_lo(hw.y), bf_hi(hw.y)};
        if (MODE == 3) v = r * rs + v;
        else if (MODE == 4) v = r + v * rs;
        else { const u32x2 pw = *(const u32x2*)(E.PROJ + off);
            v[0] = r[0] + sigmoid_f(v[0] * rs) * bf_lo(pw.x); v[1] = r[1] + sigmoid_f(v[1] * rs) * bf_hi(pw.x); v[2] = r[2] + sigmoid_f(v[2] * rs) * bf_lo(pw.y); v[3] = r[3] + sigmoid_f(v[3] * rs) * bf_hi(pw.y); }
        { u32x2 w; w.x = cvt_pk_bf16(v[0], v[1]); w.y = cvt_pk_bf16(v[2], v[3]); *(u32x2*)(E.Ho + off) = w; }
        sq += (v[0] * v[0] + v[1] * v[1]) + (v[2] * v[2] + v[3] * v[3]); }
    if (MODE >= 3) { sq += __shfl_xor(sq, 16); sq += __shfl_xor(sq, 32); if (kq == 0) E.SSO[(size_t)row * 16 + ct] = sq; }
}

constexpr int KT = 128;
__device__ __forceinline__ int toff(int row, int ch) { return (row << 8) + ((ch ^ (row & 15)) << 4); }
struct Issue { int u, kt, left; };
__device__ __forceinline__ void issue_tile(LAS unsigned char* st, Issue& I, const bf16_t* A, const bf16_t* Bt, int K, int nkt, int G, int w, int lane) {
    if (I.left > 0) {
        const bf16_t* ab = A + (size_t)(64 * (I.u & 15)) * K + I.kt * KT; const bf16_t* bb = Bt + (size_t)(64 * (I.u >> 4)) * K + I.kt * KT;
#pragma unroll
        for (int jj = 0; jj < 2; ++jj) { const int j = 2 * w + jj, row = 4 * j + (lane >> 4), ch = (lane & 15) ^ (row & 15);
            __builtin_amdgcn_global_load_lds((const unsigned*)(ab + (size_t)row * K + ch * 8), (LAS unsigned*)(st + j * 1024), 16, 0, 0);
            __builtin_amdgcn_global_load_lds((const unsigned*)(bb + (size_t)row * K + ch * 8), (LAS unsigned*)(st + 16384 + j * 1024), 16, 0, 0); }
        --I.left; if (++I.kt == nkt) { I.kt = 0; I.u += G; }
    } else {
#pragma unroll
        for (int jj = 0; jj < 2; ++jj) { const int j = 2 * w + jj, row = 4 * j + (lane >> 4), ch = (lane & 15) ^ (row & 15);
            __builtin_amdgcn_global_load_lds((const unsigned*)(A + (size_t)row * K + ch * 8), (LAS unsigned*)(st + j * 1024), 16, 0, 0);
            __builtin_amdgcn_global_load_lds((const unsigned*)(Bt + (size_t)row * K + ch * 8), (LAS unsigned*)(st + 16384 + j * 1024), 16, 0, 0); }
    }
}
template <int MODE> __device__ __forceinline__ void phase(LAS unsigned char* lds, const bf16_t* A0, const bf16_t* Bt, int K, int N, const Epi& E, int vcu, int G, int tid) {
    const int lane = tid & 63, w = __builtin_amdgcn_readfirstlane(tid >> 6), fr = lane & 15, kq = lane >> 4, wm = w & 3, wk = w >> 2;
    const bf16_t* A = A0 + (size_t)ROW0 * K;
    const int nu = 16 * (N >> 6), nkt = K / KT;
    if (vcu >= nu) return;
    const int nmine = (nu - vcu + G - 1) / G, total = nmine * nkt;
    f32x4 acc[4];
#pragma unroll
    for (int n = 0; n < 4; ++n) acc[n] = (f32x4){0.f, 0.f, 0.f, 0.f};
    Issue I{vcu, 0, total};
    issue_tile(lds, I, A, Bt, K, nkt, G, w, lane); issue_tile(lds + 32768, I, A, Bt, K, nkt, G, w, lane); issue_tile(lds + 65536, I, A, Bt, K, nkt, G, w, lane);
    int kt = 0, u = vcu;
    for (int i = 0; i < total; ++i) {
        asm volatile("s_waitcnt vmcnt(8)" ::: "memory");
        __builtin_amdgcn_s_barrier();
        asm volatile("" ::: "memory");
        issue_tile(lds + ((i + 3) & 3) * 32768, I, A, Bt, K, nkt, G, w, lane);
        { LAS const unsigned char* st = lds + (i & 3) * 32768;
#pragma unroll
          for (int ks = 0; ks < 2; ++ks) { const int ch = 4 * (2 * wk + ks) + kq;
              const bf16x8 af = *(LAS const bf16x8*)(st + toff(16 * wm + fr, ch));
#pragma unroll
              for (int n = 0; n < 4; ++n) { const bf16x8 bf = *(LAS const bf16x8*)(st + 16384 + toff(16 * n + fr, ch));
                  acc[n] = __builtin_amdgcn_mfma_f32_16x16x32_bf16(bf, af, acc[n], 0, 0, 0); } } }
        if (kt + 1 == nkt) {
            LAS f32x4* xch = (LAS f32x4*)(lds + 131072) + (wm * 64 + lane) * 4;
            if (wk == 1) {
#pragma unroll
                for (int n = 0; n < 4; ++n) { xch[n] = acc[n]; acc[n] = (f32x4){0.f, 0.f, 0.f, 0.f}; } }
            asm volatile("s_waitcnt lgkmcnt(0)" ::: "memory"); __builtin_amdgcn_s_barrier(); asm volatile("" ::: "memory");
            if (wk == 0) {
#pragma unroll
                for (int n = 0; n < 4; ++n) acc[n] += xch[n];
                epilogue<MODE>(E, 64 * (u & 15) + 16 * wm + fr, u >> 4, kq, acc);
#pragma unroll
                for (int n = 0; n < 4; ++n) acc[n] = (f32x4){0.f, 0.f, 0.f, 0.f}; }
            kt = 0; u += G;
        } else ++kt;
    }
    asm volatile("s_waitcnt vmcnt(0) lgkmcnt(0)" ::: "memory"); __builtin_amdgcn_s_barrier(); asm volatile("" ::: "memory");
}

__device__ __forceinline__ int toff128(int row, int ch) { return (row << 7) + ((ch ^ ((row >> 1) & 7)) << 4); }
__device__ __forceinline__ void issue_tile128(LAS unsigned char* st, Issue& I, const bf16_t* A, const bf16_t* Bt, int K, int nkt, int G, int w, int lane) {
    const bool live = I.left > 0;
    const bf16_t* ab = live ? A + (size_t)(128 * (I.u & 7)) * K + I.kt * 64 : A; const bf16_t* bb = live ? Bt + (size_t)(128 * (I.u >> 3)) * K + I.kt * 64 : Bt;
#pragma unroll
    for (int jj = 0; jj < 2; ++jj) { const int j = 2 * w + jj, row = 8 * j + (lane >> 3), ch = (lane & 7) ^ ((row >> 1) & 7);
        __builtin_amdgcn_global_load_lds((const unsigned*)(ab + (size_t)row * K + ch * 8), (LAS unsigned*)(st + j * 1024), 16, 0, 0);
        __builtin_amdgcn_global_load_lds((const unsigned*)(bb + (size_t)row * K + ch * 8), (LAS unsigned*)(st + 16384 + j * 1024), 16, 0, 0); }
    if (live) { --I.left; if (++I.kt == nkt) { I.kt = 0; I.u += G; } }
}
template <int MODE> __device__ __forceinline__ void phase128(LAS unsigned char* lds, const bf16_t* A0, const bf16_t* Bt, int K, int N, const Epi& E, int vcu, int G, int tid) {
    static_assert(MODE == 0 || MODE == 2, "phase128: bf16-store epilogues only");
    const int lane = tid & 63, w = __builtin_amdgcn_readfirstlane(tid >> 6), fr = lane & 15, kq = lane >> 4, wm = w >> 2, wn = w & 3;
    const bf16_t* A = A0 + (size_t)ROW0 * K;
    const int nu = 8 * (N >> 7), nkt = K / 64;
    if (vcu >= nu) return;
    const int nmine = (nu - vcu + G - 1) / G, total = nmine * nkt;
    f32x4 acc[4][2];
#pragma unroll
    for (int m = 0; m < 4; ++m) { acc[m][0] = (f32x4){0.f, 0.f, 0.f, 0.f}; acc[m][1] = (f32x4){0.f, 0.f, 0.f, 0.f}; }
    Issue I{vcu, 0, total};
    issue_tile128(lds, I, A, Bt, K, nkt, G, w, lane); issue_tile128(lds + 32768, I, A, Bt, K, nkt, G, w, lane); issue_tile128(lds + 65536, I, A, Bt, K, nkt, G, w, lane);
    int kt = 0, u = vcu;
    for (int i = 0; i < total; ++i) {
        asm volatile("s_waitcnt vmcnt(8)" ::: "memory");
        __builtin_amdgcn_s_barrier();
        asm volatile("" ::: "memory");
        issue_tile128(lds + ((i + 3) & 3) * 32768, I, A, Bt, K, nkt, G, w, lane);
        { LAS const unsigned char* st = lds + (i & 3) * 32768;
#pragma unroll
          for (int ks = 0; ks < 2; ++ks) { const int ch = 4 * ks + kq;
              const bf16x8 b0 = *(LAS const bf16x8*)(st + 16384 + toff128(32 * wn + fr, ch)), b1 = *(LAS const bf16x8*)(st + 16384 + toff128(32 * wn + 16 + fr, ch));
#pragma unroll
              for (int m = 0; m < 4; ++m) { const bf16x8 af = *(LAS const bf16x8*)(st + toff128(64 * wm + 16 * m + fr, ch));
                  acc[m][0] = __builtin_amdgcn_mfma_f32_16x16x32_bf16(b0, af, acc[m][0], 0, 0, 0); acc[m][1] = __builtin_amdgcn_mfma_f32_16x16x32_bf16(b1, af, acc[m][1], 0, 0, 0); } } }
        if (kt + 1 == nkt) {
            const int rt = u & 7, ct = u >> 3;
#pragma unroll
            for (int m = 0; m < 4; ++m) { const int row = ROW0 + 128 * rt + 64 * wm + 16 * m + fr;
#pragma unroll
                for (int n = 0; n < 2; ++n) { const int col = 128 * ct + 32 * wn + 16 * n + 4 * kq; f32x4 v = acc[m][n];
                    if (MODE == 0) {
                        if (col < 1024) {
#pragma unroll
                            for (int e = 0; e < 4; ++e) v[e] = gelu_tanh_f(v[e]); }
                        else if (col >= 2560) {
#pragma unroll
                            for (int e = 0; e < 4; ++e) v[e] = sigmoid_f(v[e]); } }
                    if (MODE == 2) {
#pragma unroll
                        for (int e = 0; e < 4; ++e) { const float a = fmaxf(v[e], 0.f); v[e] = a * a; } }
                    u32x2 o; o.x = cvt_pk_bf16(v[0], v[1]); o.y = cvt_pk_bf16(v[2], v[3]); *(u32x2*)(E.O + (size_t)row * E.ldc + col) = o;
                    acc[m][n] = (f32x4){0.f, 0.f, 0.f, 0.f}; } }
            kt = 0; u += G;
        } else ++kt;
    }
    asm volatile("s_waitcnt vmcnt(0) lgkmcnt(0)" ::: "memory"); __builtin_amdgcn_s_barrier(); asm volatile("" ::: "memory");
}
}

#ifndef HOST_DUP_PHASE
#define HOST_DUP_PHASE -1
#endif
#ifndef TP_A
#define TP_A -1
#define TP_B -1
#endif
#ifndef HOST_DUP_FLAGS
#define HOST_DUP_FLAGS 1
#endif
#ifndef HOST_EXTRA_BARS
#define HOST_EXTRA_BARS 0
#endif
#ifndef MK_ONE_LAUNCH
#define MK_ONE_LAUNCH 1
#endif
constexpr int NWAVES = 8;
constexpr int D = 1024, NPR = 16384, NSR = 1024, M = NPR + NSR, NIN = 3072, INC = 3080, FF = 4096, PLE = 256;
constexpr int N_PHASES = 10;
constexpr size_t MiB = 1u << 20;
constexpr size_t WS_CTL = 0, CTL_ZERO_BYTES = 65536;
constexpr int CW_BAR = 1024;
constexpr size_t WS_WIN = 1 * MiB;
constexpr size_t WS_WOUT = WS_WIN + (size_t)NIN * D * 2;
constexpr size_t WS_WUP = WS_WOUT + (size_t)D * D * 2;
constexpr size_t WS_WDOWN = WS_WUP + (size_t)FF * D * 2;
constexpr size_t WS_WGATE = WS_WDOWN + (size_t)D * FF * 2;
constexpr size_t WS_WPROJ = WS_WGATE + (size_t)D * D * 2;
constexpr size_t WS_WSB = WS_WPROJ + (size_t)D * PLE * 2;
constexpr size_t WS_IG = WS_WSB + 4 * 128 * 128 * 2;
constexpr size_t WS_LF = WS_IG + (size_t)M * 16;
constexpr size_t WS_SS1 = WS_LF + (size_t)M * 16;
constexpr size_t WS_SS2 = WS_SS1 + (size_t)M * 64;
constexpr size_t WS_SS3 = WS_SS2 + (size_t)M * 64;
constexpr size_t WS_CH = WS_SS3 + (size_t)M * 64;
constexpr size_t WS_MST = WS_CH + 4096;
constexpr size_t WS_NLOC = WS_MST + 4096;
constexpr size_t WS_NST = WS_NLOC + 512 * 128 * 4;
constexpr size_t WS_RN = WS_NST + 512 * 128 * 4;
constexpr size_t WS_LNS = WS_RN + 69632;
constexpr size_t WS_PE = WS_LNS + (size_t)16384 * 64;
constexpr size_t WS_RA = WS_PE + (size_t)M * PLE * 2;
constexpr size_t WS_RB = WS_RA + (size_t)M * D * 2;
constexpr size_t WS_YC = WS_RB + (size_t)M * NIN * 2;
constexpr size_t WS_KV = WS_RB + (size_t)M * FF * 2;
constexpr size_t WS_END = WS_KV + (size_t)M * D * 2;
static_assert(WS_END <= 256 * MiB, "d_ws map");
static_assert(WS_WIN % 256 == 0 && WS_IG % 256 == 0 && WS_PE % 256 == 0 && WS_RA % 256 == 0 && WS_RB % 256 == 0 && WS_YC % 256 == 0 && WS_KV % 256 == 0, "alignment");
constexpr size_t O_Y = 0, O_CP = (size_t)M * D, O_NP = O_CP + 8 * 4 * 16384, O_MP = O_NP + 8 * 4 * 128, O_VP = O_MP + 32, O_CS = O_VP + 8 * 128 * 512,
                 O_NS = O_CS + (size_t)128 * 4 * 16384, O_MS = O_NS + 128 * 4 * 128, O_VS = O_MS + 512, O_END = O_VS + 128 * 8 * 512;
constexpr int RING_OFF = 0, RING_BYTES = 131072, XCH_BYTES = 16384, LDSCTL_OFF = RING_BYTES + XCH_BYTES, MISC_OFF = LDSCTL_OFF + 320, LDS_BYTES = LDSCTL_OFF + 1024;

typedef unsigned short bf16;
typedef unsigned v4u __attribute__((ext_vector_type(4)));
typedef float f32x4 __attribute__((ext_vector_type(4)));
#define GAS __attribute__((address_space(1)))
typedef GAS unsigned gu32;
#define RLX_AGENT __ATOMIC_RELAXED, __HIP_MEMORY_SCOPE_AGENT
#define LDS_WAIT() asm volatile("s_waitcnt lgkmcnt(0)" ::: "memory")

struct Args { const float* in[24]; float* out; unsigned char* ws; int ph_lo, ph_hi, flags, extra_bars; };

#define XB_TMO      128
#define XB_XCNT(j)  (256  + 64 * (j))
#define XB_XSUB(j)  (1280 + 64 * (j))
#define XB_XGEN(j)  (2304 + 64 * (j))
#define XB_TOP      3328
#define XB_TOPGEN   3392
#define XCD_BAR_WORDS 3456
#define XB_SPIN_CAP (1u << 18)

__device__ __forceinline__ unsigned xb_ld(unsigned* p)              { return __hip_atomic_load(p, __ATOMIC_RELAXED, __HIP_MEMORY_SCOPE_AGENT); }
__device__ __forceinline__ unsigned xb_add(unsigned* p, unsigned v) { return __hip_atomic_fetch_add(p, v, __ATOMIC_RELAXED, __HIP_MEMORY_SCOPE_AGENT); }
__device__ __forceinline__ unsigned xb_xcc_id() { return (unsigned)__builtin_amdgcn_s_getreg((3 << 11) | 20) & 0xFu; }
#define XB_SPIN(cond, bar) do { unsigned _sp = 0; while (cond) { __builtin_amdgcn_s_sleep(1); \
    if ((++_sp & 255u) == 0u) { if (xb_ld(&(bar)[XB_TMO])) break; if (_sp > XB_SPIN_CAP) { atomicAdd(&(bar)[XB_TMO], 1u); break; } } } } while (0)

struct XcdBarrier {
    unsigned* bar; unsigned x;
    volatile LAS unsigned* st;
};

__device__ __forceinline__ XcdBarrier xcd_barrier_post(unsigned* bar, volatile LAS unsigned* st) {
    XcdBarrier b; b.bar = bar; b.x = xb_xcc_id(); b.st = st;
    if (threadIdx.x == 0) (void)xb_add(&bar[XB_XCNT(b.x)], 1u);
    return b;
}
__device__ __forceinline__ void xcd_barrier_complete(unsigned* bar, unsigned x, unsigned& nloc, unsigned& nx) {
    const unsigned G = gridDim.x * gridDim.y * gridDim.z;
    unsigned sum, cnt, mine, sp = 0u;
    for (;;) {
        sum = 0u; cnt = 0u; mine = 0u;
#pragma unroll
        for (unsigned j = 0; j < 16; ++j) { const unsigned c = xb_ld(&bar[XB_XCNT(j)]); sum += c; cnt += (c > 0u) ? 1u : 0u; mine = (j == x) ? c : mine; }
        if (sum == G) break;
        __builtin_amdgcn_s_sleep(1);
        if ((++sp & 255u) == 0u) { if (xb_ld(&bar[XB_TMO])) break; if (sp > XB_SPIN_CAP) { atomicAdd(&bar[XB_TMO], 1u); break; } }
    }
    nloc = mine > 0u ? mine : 1u; nx = cnt > 0u ? cnt : 1u;
}

__device__ __forceinline__ void xcd_barrier(const XcdBarrier& b) {
    asm volatile("s_waitcnt vmcnt(0)" ::: "memory");
    __syncthreads();
    if (threadIdx.x == 0) {
        unsigned* bar = b.bar;
        __builtin_amdgcn_s_waitcnt(0);
        unsigned nloc = b.st[0], nx = b.st[1];
        if (nloc == 0u) { xcd_barrier_complete(bar, b.x, nloc, nx); b.st[0] = nloc; b.st[1] = nx; }
        const unsigned old = xb_add(&bar[XB_XSUB(b.x)], 1u);
        const unsigned gen = old / nloc;
        if (old + 1u == (gen + 1u) * nloc) {
            __builtin_amdgcn_fence(__ATOMIC_RELEASE, "agent");
            asm volatile("s_waitcnt vmcnt(0)" ::: "memory");
            const unsigned og = xb_add(&bar[XB_TOP], 1u);
            const unsigned tg = og / nx;
            if (og + 1u == (tg + 1u) * nx) xb_add(&bar[XB_TOPGEN], 1u);
            else XB_SPIN(xb_ld(&bar[XB_TOPGEN]) == tg, bar);
            __builtin_amdgcn_fence(__ATOMIC_ACQUIRE, "agent");
            xb_add(&bar[XB_XGEN(b.x)], 1u);
            asm volatile("s_waitcnt vmcnt(0)" ::: "memory");
        } else {
            XB_SPIN(xb_ld(&bar[XB_XGEN(b.x)]) == gen, bar);
            __builtin_amdgcn_fence(__ATOMIC_ACQUIRE, "agent");
            asm volatile("s_waitcnt vmcnt(0)" ::: "memory");
        }
    }
    __syncthreads();
}

__device__ __forceinline__ void p0_transpose_item(const float* W, int ldw, int K, int N, const float* gain, bf16* WT, LAS float* scr, int item, int lane, bool kscale) {
    const int nblk = N / 32, kb = item / nblk, nb = item % nblk, k0 = 64 * kb, n0 = 32 * nb;
    const float cs = (kscale && n0 >= 1536 && n0 < 2048) ? 0.08838834764831845f : 1.0f;
    float wv[32];
#pragma unroll
    for (int i = 0; i < 32; ++i) { const int kk = 2 * i + (lane >> 5); wv[i] = W[(size_t)(k0 + kk) * ldw + n0 + (lane & 31)]; }
#pragma unroll
    for (int i = 0; i < 32; ++i) { const int kk = 2 * i + (lane >> 5); const float g = gain ? gain[k0 + kk] * cs : cs; scr[kk * 33 + (lane & 31)] = wv[i] * g; }
    LDS_WAIT(); asm volatile("" ::: "memory");
    const int c = lane & 7;
#pragma unroll
    for (int j = 0; j < 4; ++j) { const int n = (lane >> 3) + 8 * j; const LAS float* s = scr + (8 * c) * 33 + n;
        v4u o; o.x = pg8::cvt_pk_bf16(s[0 * 33], s[1 * 33]); o.y = pg8::cvt_pk_bf16(s[2 * 33], s[3 * 33]); o.z = pg8::cvt_pk_bf16(s[4 * 33], s[5 * 33]); o.w = pg8::cvt_pk_bf16(s[6 * 33], s[7 * 33]);
        *(v4u*)(WT + (size_t)(n0 + n) * K + k0 + 8 * c) = o; }
    LDS_WAIT(); asm volatile("" ::: "memory");
}

__device__ __forceinline__ float log_sigmoid_f(float x) { return fminf(x, 0.f) - log1pf(__expf(-fabsf(x))); }

struct RowIn { f32x4 v[4]; f32x4 pv; };
__device__ __forceinline__ void p0_row_load(const Args& A, int m, int lane, RowIn& R) {
    const float* xrow = (m < NPR) ? A.in[0] + (size_t)m * D : A.in[1] + (size_t)(m - NPR) * D;
    const float* prow = (m < NPR) ? A.in[2] + (size_t)m * PLE : A.in[3] + (size_t)(m - NPR) * PLE;
    const f32x4* xr = (const f32x4*)xrow + lane;
#pragma unroll
    for (int j = 0; j < 4; ++j) R.v[j] = xr[64 * j];
    R.pv = *((const f32x4*)prow + lane);
}
__device__ __forceinline__ void p0_row_finish(unsigned char* ws, int m, int lane, RowIn& R, const float (&gwt)[4][4][8], float gbias) {
    float s = 0.f;
#pragma unroll
    for (int j = 0; j < 4; ++j) s += (R.v[j][0] * R.v[j][0] + R.v[j][1] * R.v[j][1]) + (R.v[j][2] * R.v[j][2] + R.v[j][3] * R.v[j][3]);
    const float rnv = sqrtf(mix::wave_sum(s) * (1.0f / D) + 1e-6f), rinv = 1.0f / rnv;
    if (lane == 8) ((float*)(ws + WS_RN))[m] = rnv;
    unsigned long long* o8 = (unsigned long long*)((bf16*)(ws + WS_RA) + (size_t)m * D) + lane;
    float g8[8];
#pragma unroll
    for (int q = 0; q < 8; ++q) g8[q] = 0.f;
#pragma unroll
    for (int j = 0; j < 4; ++j) { const f32x4 v = R.v[j] * rinv;
        o8[64 * j] = (unsigned long long)pg8::cvt_pk_bf16(v[0], v[1]) | ((unsigned long long)pg8::cvt_pk_bf16(v[2], v[3]) << 32);
#pragma unroll
        for (int c = 0; c < 4; ++c)
#pragma unroll
            for (int q = 0; q < 8; ++q) g8[q] += v[c] * gwt[j][c][q]; }
#pragma unroll
    for (int q = 0; q < 8; ++q) g8[q] = mix::row_sum16(g8[q]);
    const int q8 = lane & 7;
    float val = q8 == 0 ? g8[0] : q8 == 1 ? g8[1] : q8 == 2 ? g8[2] : q8 == 3 ? g8[3] : q8 == 4 ? g8[4] : q8 == 5 ? g8[5] : q8 == 6 ? g8[6] : g8[7];
    val += __shfl_xor(val, 16); val += __shfl_xor(val, 32);
    if (lane < 4) ((float*)(ws + WS_IG))[(size_t)m * 4 + lane] = val + gbias;
    else if (lane < 8) ((float*)(ws + WS_LF))[(size_t)m * 4 + lane - 4] = log_sigmoid_f(val + gbias);
    *((unsigned long long*)((bf16*)(ws + WS_PE) + (size_t)m * PLE) + lane) = (unsigned long long)pg8::cvt_pk_bf16(R.pv[0], R.pv[1]) | ((unsigned long long)pg8::cvt_pk_bf16(R.pv[2], R.pv[3]) << 32);
}

__device__ __forceinline__ void p0_prologue(const Args& A, LAS unsigned char* lds, int vcu, int G, int tid) {
    const int lane = tid & 63, wave = __builtin_amdgcn_readfirstlane(tid >> 6);
    unsigned char* ws = A.ws;
    LAS float* scr = (LAS float*)(lds + RING_OFF + wave * 8704);
    LAS float* gtab = (LAS float*)(lds + RING_OFF + 8 * 8704);
    const int gw = vcu * NWAVES + wave, NGW = G * NWAVES;
    for (int k = tid; k < D; k += NWAVES * 64) { const float g = A.in[7][k]; const float* wp = A.in[8] + (size_t)k * INC + NIN;
        const f32x4 a = *(const f32x4*)wp, b = *(const f32x4*)(wp + 4); *(LAS f32x4*)(gtab + k * 8) = a * g; *(LAS f32x4*)(gtab + k * 8 + 4) = b * g; }
    constexpr int I_IN = (D / 64) * (NIN / 32), I_OUT = (D / 64) * (D / 32), I_UP = (D / 64) * (FF / 32), I_DOWN = (FF / 64) * (D / 32), I_GATE = I_OUT, I_PROJ = (PLE / 64) * (D / 32);
    constexpr int NITEMS = I_IN + I_OUT + I_UP + I_DOWN + I_GATE + I_PROJ;
    for (int it = gw; it < NITEMS; it += NGW) {
        int r = it;
        if (r < I_IN) { p0_transpose_item(A.in[8], INC, D, NIN, A.in[7], (bf16*)(ws + WS_WIN), scr, r, lane, true); continue; } r -= I_IN;
        if (r < I_OUT) { p0_transpose_item(A.in[16], D, D, D, nullptr, (bf16*)(ws + WS_WOUT), scr, r, lane, false); continue; } r -= I_OUT;
        if (r < I_UP) { p0_transpose_item(A.in[18], FF, D, FF, A.in[17], (bf16*)(ws + WS_WUP), scr, r, lane, false); continue; } r -= I_UP;
        if (r < I_DOWN) { p0_transpose_item(A.in[19], D, FF, D, nullptr, (bf16*)(ws + WS_WDOWN), scr, r, lane, false); continue; } r -= I_DOWN;
        if (r < I_GATE) { p0_transpose_item(A.in[21], D, D, D, A.in[20], (bf16*)(ws + WS_WGATE), scr, r, lane, false); continue; } r -= I_GATE;
        p0_transpose_item(A.in[22], D, PLE, D, nullptr, (bf16*)(ws + WS_WPROJ), scr, r, lane, false);
    }
    { const int gt = vcu * 512 + tid, NT = G * 512; const float* wsrc = A.in[11]; bf16* wdst = (bf16*)(ws + WS_WSB);
      for (int i = gt; i < 4 * 128 * 128 / 4; i += NT) { const int e = 4 * i, t = (e >> 7) & 127, j = e & 127; const f32x4 v = *(const f32x4*)(wsrc + e);
          pg8::u32x2 o; o.x = pg8::cvt_pk_bf16(j <= t ? v[0] : 0.f, j + 1 <= t ? v[1] : 0.f); o.y = pg8::cvt_pk_bf16(j + 2 <= t ? v[2] : 0.f, j + 3 <= t ? v[3] : 0.f);
          *(pg8::u32x2*)(wdst + e) = o; } }
    __syncthreads();
    float gwt[4][4][8];
#pragma unroll
    for (int j = 0; j < 4; ++j)
#pragma unroll
        for (int c = 0; c < 4; ++c) { const LAS float* gp = gtab + (4 * lane + 256 * j + c) * 8; const f32x4 a = *(const LAS f32x4*)gp, b = *(const LAS f32x4*)(gp + 4);
#pragma unroll
            for (int q = 0; q < 4; ++q) { gwt[j][c][q] = a[q]; gwt[j][c][4 + q] = b[q]; } }
    const float gbias = (lane < 4) ? A.in[13][lane & 3] : A.in[14][lane & 3];
    for (int m = gw; m < M; m += 2 * NGW) {
        const int m2 = (m + NGW < M) ? m + NGW : m;
        RowIn R0, R1; p0_row_load(A, m, lane, R0); p0_row_load(A, m2, lane, R1);
        p0_row_finish(ws, m, lane, R0, gwt, gbias);
        p0_row_finish(ws, m2, lane, R1, gwt, gbias);
    }
    __syncthreads();
}

__device__ __forceinline__ void p7_final(const Args& A, int vcu, int G, int tid) {
    const int lane = tid & 63, wave = __builtin_amdgcn_readfirstlane(tid >> 6);
    const int gw = vcu * NWAVES + wave, NGW = G * NWAVES;
    const float* ss = (const float*)(A.ws + WS_SS3); const bf16* Hb = (const bf16*)(A.ws + WS_RB);
    const f32x4 g0 = *((const f32x4*)A.in[23] + 2 * lane), g1 = *((const f32x4*)A.in[23] + 2 * lane + 1), g2 = *((const f32x4*)A.in[23] + 128 + 2 * lane), g3 = *((const f32x4*)A.in[23] + 128 + 2 * lane + 1);
    for (int m = gw; m < M; m += NGW) {
        const float rs = pg8::row_rs(ss, m);
        const v4u a = *((const v4u*)(Hb + (size_t)m * D) + lane), b = *((const v4u*)(Hb + (size_t)m * D) + 64 + lane);
        f32x4* yr = (f32x4*)(A.out + (size_t)m * D);
        yr[2 * lane] = (f32x4){pg8::bf_lo(a.x), pg8::bf_hi(a.x), pg8::bf_lo(a.y), pg8::bf_hi(a.y)} * rs * g0;
        yr[2 * lane + 1] = (f32x4){pg8::bf_lo(a.z), pg8::bf_hi(a.z), pg8::bf_lo(a.w), pg8::bf_hi(a.w)} * rs * g1;
        yr[128 + 2 * lane] = (f32x4){pg8::bf_lo(b.x), pg8::bf_hi(b.x), pg8::bf_lo(b.y), pg8::bf_hi(b.y)} * rs * g2;
        yr[128 + 2 * lane + 1] = (f32x4){pg8::bf_lo(b.z), pg8::bf_hi(b.z), pg8::bf_lo(b.w), pg8::bf_hi(b.w)} * rs * g3;
    }
}

__global__ void __launch_bounds__(NWAVES * 64, 2) hymba_fwd(Args args) {
    extern __shared__ __attribute__((aligned(16))) unsigned char lds_raw[];
    LAS unsigned char* lds = (LAS unsigned char*)lds_raw;
    const int tid = threadIdx.x, G = gridDim.x, bx = blockIdx.x;
    const int vcu = (G % 8 == 0) ? (bx % 8) * (G / 8) + bx / 8 : bx;
    unsigned char* ws = args.ws;
#ifndef DUP_PHASE
#define DUP_PHASE -1
#endif
    const int lo = args.ph_lo, hi = args.ph_hi;
#ifndef PH_MASK
#define PH_MASK 0xffff
#endif
#define INC_(k) (((PH_MASK >> (k)) & 1) && lo <= (k) && (k) < hi)
#if DUP_PHASE >= 0
#define IN(k) for (int rep_ = 0; rep_ < ((DUP_PHASE == (k)) ? 2 : 1); ++rep_) if (INC_(k))
#define GRID_BAR(k) do { if (INC_((k) + 1)) xcd_barrier(bar); } while (0)
#else
#define IN(k) if (INC_(k))
#define GRID_BAR(k) do { if (INC_((k) + 1)) xcd_barrier(bar); } while (0)
#endif
    for (int u = tid; u < (LDS_BYTES - LDSCTL_OFF) / 4; u += NWAVES * 64) ((LAS unsigned*)(lds + LDSCTL_OFF))[u] = 0u;
    __syncthreads();
    XcdBarrier bar = xcd_barrier_post((unsigned*)(ws + WS_CTL) + CW_BAR, (volatile LAS unsigned*)(lds + MISC_OFF) + 8);
    float* OUT = args.out;
    const int FL = args.flags;
#if TP_A >= 0
    unsigned long long tp_a = 0ull, tp_b = 0ull;
#define STAMP(id) do { if ((id) == TP_A || (id) == TP_B) { asm volatile("s_waitcnt vmcnt(0) lgkmcnt(0)" ::: "memory"); const unsigned long long t_ = __builtin_amdgcn_s_memrealtime(); if ((id) == TP_A) tp_a = t_; if ((id) == TP_B) tp_b = t_; } } while (0)
#else
#define STAMP(id) do { } while (0)
#endif
    bf16* RA = (bf16*)(ws + WS_RA); bf16* Zb = (bf16*)(ws + WS_RB); bf16* YC = (bf16*)(ws + WS_YC); bf16* HID = (bf16*)(ws + WS_RB); bf16* H3 = (bf16*)(ws + WS_RB);     bf16* PROJ = (bf16*)args.out;
    float* SS1 = (float*)(ws + WS_SS1); float* SS2 = (float*)(ws + WS_SS2); float* SS3 = (float*)(ws + WS_SS3);
    mix::MixP MP;
    MP.Z = Zb; MP.YC = YC; MP.IG = (const float*)(ws + WS_IG); MP.LF = (const float*)(ws + WS_LF); MP.LNS = (const float*)(ws + WS_LNS); MP.WSb = (const bf16*)(ws + WS_WSB);
    MP.gm_ws = args.in[11]; MP.lng = args.in[9]; MP.lnb = args.in[10]; MP.bs = args.in[12]; MP.mlnorm = args.in[15];
    MP.KV = (bf16*)(ws + WS_KV); MP.NLOC = (float*)(ws + WS_NLOC); MP.NST = (float*)(ws + WS_NST); MP.CH = (float*)(ws + WS_CH); MP.MST = (float*)(ws + WS_MST);
    MP.stC = args.in[4]; MP.stN = args.in[5]; MP.stM = args.in[6];
    MP.oCp = OUT + O_CP; MP.oNp = OUT + O_NP; MP.oMp = OUT + O_MP; MP.oVp = OUT + O_VP; MP.oCs = OUT + O_CS; MP.oNs = OUT + O_NS; MP.oMs = OUT + O_MS; MP.oVs = OUT + O_VS;

    STAMP(0);
    IN(0) { p0_prologue(args, lds, vcu, G, tid); STAMP(1); GRID_BAR(0); for (int eb = 0; eb < args.extra_bars; ++eb) xcd_barrier(bar); }
    STAMP(2);
    IN(1) {
        pg8::Gemm g{RA, (const bf16*)(ws + WS_WIN), NPR, NIN, D}; pg8::StaticOrder S; S.init(NPR, NIN, G, bx);
        pg8::EpiBf16<0> E{Zb, NIN, (float*)(ws + WS_LNS)};
        if (!(FL & 2)) pg8::gemm_phase<pg8::EpiBf16<0>, pg8::StaticOrder, true, true>(lds + RING_OFF, g, S, E);
        STAMP(3);
        if (!(FL & 4)) { const sg::Epi SE{Zb, NIN, nullptr, nullptr, nullptr, nullptr, nullptr, nullptr}; sg::phase128<0>(lds + RING_OFF, RA, (const bf16*)(ws + WS_WIN), D, NIN, SE, vcu, G, tid); }
        GRID_BAR(1);
    }
    STAMP(4);
    IN(2) {
        for (int u = vcu; u < 1024; u += G) {
            if (u < 512) { if (FL & 16) continue; const int bc = u >> 2, h = u & 3; mix::gmlp_unit(lds, MP, bc >> 4, bc & 15, h, tid); }
            else { if (FL & 32) continue; if (u == vcu + 512) STAMP(5); const int v = u - 512; mix::kv_unit(lds, MP, v >> 6, (v >> 4) & 3, v & 15, tid); }
        }
        GRID_BAR(2);
    }
    STAMP(6);
    IN(3) {
        if (!(FL & 1)) for (int u = vcu; u < 256; u += G) mix::scan_unit(MP, u >> 3, u & 7, tid);
        STAMP(7);
        if (!(FL & 64)) for (int u = vcu; u < 512; u += G) mix::sample_unit(lds, MP, u >> 2, u & 3, tid);
        STAMP(21);
        if (!(FL & 128)) { pg8::Gemm g{(const bf16*)(ws + WS_PE), (const bf16*)(ws + WS_WPROJ), NPR, D, PLE}; pg8::StaticOrder S; S.init(NPR, D, G, bx);
          pg8::EpiBf16<1> E{PROJ, D, nullptr};
          if (!(FL & 2)) pg8::gemm_phase<pg8::EpiBf16<1>, pg8::StaticOrder, true, true>(lds + RING_OFF, g, S, E);
          STAMP(22);
          const sg::Epi SE{PROJ, D, nullptr, nullptr, nullptr, nullptr, nullptr, nullptr}; if (!(FL & 4)) sg::phase<1>(lds + RING_OFF, (const bf16*)(ws + WS_PE), (const bf16*)(ws + WS_WPROJ), PLE, D, SE, vcu, G, tid); }
        GRID_BAR(3);
    }
    STAMP(8);
    IN(4) {
        for (int rep = 0; rep < ((FL & 256) ? 3 : 1); ++rep)
        for (int u = vcu; u < 512; u += G) mix::mlo_unit(lds, MP, u >> 6, (u >> 4) & 3, u & 15, tid);
        GRID_BAR(4);
    }
    STAMP(10);
    IN(5) {
        pg8::Gemm g{YC, (const bf16*)(ws + WS_WOUT), NPR, D, D}; pg8::StaticOrder S; S.init(NPR, D, G, bx);
        pg8::EpiRes<0> E{(const float*)(ws + WS_RN), RA, RA, SS1, nullptr, nullptr};
        if (!(FL & 2)) pg8::gemm_phase<pg8::EpiRes<0>, pg8::StaticOrder, true, true>(lds + RING_OFF, g, S, E);
        STAMP(11);
        if (!(FL & 4)) { const sg::Epi SE{nullptr, 0, (const float*)(ws + WS_RN), RA, RA, SS1, nullptr, nullptr}; sg::phase<3>(lds + RING_OFF, YC, (const bf16*)(ws + WS_WOUT), D, D, SE, vcu, G, tid); }
        GRID_BAR(5);
    }
    STAMP(12);
    IN(6) {
        pg8::Gemm g{RA, (const bf16*)(ws + WS_WUP), NPR, FF, D}; pg8::StaticOrder S; S.init(NPR, FF, G, bx);
        pg8::EpiBf16<2> E{HID, FF, nullptr};
        if (!(FL & 2)) pg8::gemm_phase<pg8::EpiBf16<2>, pg8::StaticOrder, true, true>(lds + RING_OFF, g, S, E);
        STAMP(13);
        if (!(FL & 4)) { const sg::Epi SE{HID, FF, nullptr, nullptr, nullptr, nullptr, nullptr, nullptr}; sg::phase128<2>(lds + RING_OFF, RA, (const bf16*)(ws + WS_WUP), D, FF, SE, vcu, G, tid); }
        GRID_BAR(6);
    }
    STAMP(14);
    IN(7) {
        pg8::Gemm g{HID, (const bf16*)(ws + WS_WDOWN), NPR, D, FF}; pg8::StaticOrder S; S.init(NPR, D, G, bx);
        pg8::EpiRes<1> E{nullptr, RA, (FL & 8) ? (bf16*)(ws + WS_KV) : RA, (FL & 8) ? SS3 : SS2, SS1, nullptr};
        if (!(FL & 2)) pg8::gemm_phase<pg8::EpiRes<1>, pg8::StaticOrder, true, true>(lds + RING_OFF, g, S, E);
        STAMP(15);
        if (!(FL & 4)) { const sg::Epi SE{nullptr, 0, nullptr, RA, (FL & 8) ? (bf16*)(ws + WS_KV) : RA, (FL & 8) ? SS3 : SS2, SS1, nullptr}; sg::phase<4>(lds + RING_OFF, HID, (const bf16*)(ws + WS_WDOWN), FF, D, SE, vcu, G, tid); }
        GRID_BAR(7);
    }
    STAMP(16);
    IN(8) {
        pg8::Gemm g{RA, (const bf16*)(ws + WS_WGATE), NPR, D, D}; pg8::StaticOrder S; S.init(NPR, D, G, bx);
        pg8::EpiRes<2> E{nullptr, RA, (FL & 8) ? (bf16*)(ws + WS_KV) : H3, (FL & 8) ? SS1 : SS3, SS2, PROJ};
        if (!(FL & 2)) pg8::gemm_phase<pg8::EpiRes<2>, pg8::StaticOrder, true, true>(lds + RING_OFF, g, S, E);
        STAMP(17);
        if (!(FL & 4)) { const sg::Epi SE{nullptr, 0, nullptr, RA, (FL & 8) ? (bf16*)(ws + WS_KV) : H3, (FL & 8) ? SS1 : SS3, SS2, PROJ}; sg::phase<5>(lds + RING_OFF, RA, (const bf16*)(ws + WS_WGATE), D, D, SE, vcu, G, tid); }
        GRID_BAR(8);
    }
    STAMP(18);
    IN(9) p7_final(args, vcu, G, tid);
    STAMP(20);
#if TP_A >= 0
    if (bx == 0 && tid == 0) { asm volatile("s_waitcnt vmcnt(0)" ::: "memory"); OUT[O_MP] = (float)(tp_b - tp_a); }
#endif
#undef IN
#undef GRID_BAR
}

extern "C" void kernel_launch(void* const* d_in, const int* in_sizes, int n_in, void* d_out, int out_size, void* d_ws, size_t ws_size, hipStream_t stream) {
    static int grid = 0;
    if (grid == 0) {
        if (n_in != 24 || (size_t)out_size != O_END || ws_size < WS_END) { fprintf(stderr, "kernel_launch: unexpected problem shape (n_in %d, out %d, ws %zu)\n", n_in, out_size, ws_size); grid = -1; return; }
        int dev = 0, cus = 0, per_cu = 0;
        if (hipGetDevice(&dev) != hipSuccess || hipDeviceGetAttribute(&cus, hipDeviceAttributeMultiprocessorCount, dev) != hipSuccess) { grid = -1; return; }
        if (hipFuncSetAttribute((const void*)hymba_fwd, hipFuncAttributeMaxDynamicSharedMemorySize, LDS_BYTES) != hipSuccess) { fprintf(stderr, "kernel_launch: hipFuncSetAttribute failed\n"); grid = -1; return; }
        if (hipOccupancyMaxActiveBlocksPerMultiprocessor(&per_cu, (const void*)hymba_fwd, NWAVES * 64, LDS_BYTES) != hipSuccess || per_cu < 1) { fprintf(stderr, "kernel_launch: occupancy query says %d blocks per CU\n", per_cu); per_cu = 1; }
        (void)hipGetLastError();
        grid = cus * (per_cu < 1 ? per_cu : 1);
    }
    if (grid < 0) return;
    Args a{};
    for (int i = 0; i < 24; ++i) a.in[i] = (const float*)d_in[i];
    a.out = (float*)d_out; a.ws = (unsigned char*)d_ws;
#if MK_ONE_LAUNCH
    if (hipMemsetAsync((char*)d_ws + WS_CTL, 0, CTL_ZERO_BYTES, stream) != hipSuccess) { fprintf(stderr, "kernel_launch: memset of the control words failed\n"); return; }
    void* kargs[] = {&a};
#if HOST_DUP_PHASE >= 0
    const int cuts[4] = {0, HOST_DUP_PHASE + 1, HOST_DUP_PHASE, N_PHASES};
    for (int li = 0; li < 3; ++li) {
        a.ph_lo = (li == 1) ? HOST_DUP_PHASE : (li == 2 ? HOST_DUP_PHASE + 1 : 0); a.ph_hi = (li == 0 || li == 1) ? HOST_DUP_PHASE + 1 : N_PHASES; a.flags = (li == 1) ? HOST_DUP_FLAGS : 0;
        if (li > 0) (void)hipMemsetAsync((char*)d_ws + WS_CTL, 0, CTL_ZERO_BYTES, stream);
        (void)hipLaunchCooperativeKernel((const void*)hymba_fwd, dim3(grid), dim3(NWAVES * 64), kargs, LDS_BYTES, stream);
    }
    (void)cuts;
#else
    a.ph_lo = 0; a.ph_hi = N_PHASES; a.extra_bars = HOST_EXTRA_BARS;
    const hipError_t e = hipLaunchCooperativeKernel((const void*)hymba_fwd, dim3(grid), dim3(NWAVES * 64), kargs, LDS_BYTES, stream);
    if (e != hipSuccess) fprintf(stderr, "kernel_launch: cooperative launch failed: %s (grid %d)\n", hipGetErrorString(e), grid);
#endif
#else
    if (hipMemsetAsync((char*)d_ws + WS_CTL, 0, CTL_ZERO_BYTES, stream) != hipSuccess) return;
    for (int ph = 0; ph < N_PHASES; ++ph) {
        a.ph_lo = ph; a.ph_hi = ph + 1;
        hipLaunchKernelGGL(hymba_fwd, dim3(grid), dim3(NWAVES * 64), LDS_BYTES, stream, a);
    }
#endif
}
```

```cpp
#include <hip/hip_runtime.h>
#include <cstdio>
#include <cstdint>
namespace pg8 {
#define PG8_LAS __attribute__((address_space(3)))
typedef unsigned short bf16_t;
typedef short bf16x8 __attribute__((ext_vector_type(8)));
typedef float f32x4 __attribute__((ext_vector_type(4)));
typedef unsigned u32x4 __attribute__((ext_vector_type(4)));
constexpr int BM = 256, BK = 64, HALF = 128, HTB = HALF * BK * 2  , STAGE_BYTES = 8 * HTB, NXCD = 8, WGM = 8;

__host__ __device__ __forceinline__ int lds_byte(int r, int c) { const int st = (r >> 4) * 2 + (c >> 5), rr = r & 15, cc = c & 31, ob = rr * 64 + cc * 2; return st * 1024 + (ob ^ (((ob >> 9) & 1) << 5)); }
__host__ __device__ __forceinline__ void stage_rc(int b, int& R, int& C) { const int st = b / 1024, sb = b % 1024, swz = sb ^ (((sb >> 9) & 1) << 5); R = (st >> 1) * 16 + swz / 64; C = (st & 1) * 32 + (swz % 64) / 2; }
__host__ __device__ __forceinline__ int perm32(int rho) { const int n = rho >> 4, i = rho & 15; return 8 * (i >> 2) + 4 * n + (i & 3); }

struct Unit { int pm, pn; };
struct Gemm { const bf16_t* A; const bf16_t* Bt; int M, N, K; };

struct StaticOrder {
    int nM, nN, nwg, G, c;
    __host__ __device__ void init(int M, int N, int G_, int c_) { nM = M / BM; nN = N / BM; nwg = nM * nN; G = G_; c = c_; }
    __host__ __device__ bool next(int i, Unit& u) const {
        const long L = (long)i * G + c; if (L >= nwg) return false;
        int wgid = (int)L; { const int q = nwg / NXCD, r = nwg % NXCD, xcd = wgid % NXCD, off = wgid / NXCD; wgid = (xcd < r ? xcd * (q + 1) : r * (q + 1) + (xcd - r) * q) + off; }
        const int nig = WGM * nN, gid = wgid / nig, fm = gid * WGM, gsz = (nM - fm) < WGM ? (nM - fm) : WGM;
        u.pm = fm + ((wgid % nig) % gsz); u.pn = (wgid % nig) / gsz; return true;
    }
    __device__ __forceinline__ void a_ready(const Unit&) const {}
    __device__ __forceinline__ void done(const Unit&) const {}
};


typedef float f32x2 __attribute__((ext_vector_type(2)));
typedef __bf16 bf16x2_t __attribute__((ext_vector_type(2)));
typedef unsigned u32x2 __attribute__((ext_vector_type(2)));
__device__ __forceinline__ unsigned cvt_pk_bf16(float lo, float hi) { f32x2 v = {lo, hi}; bf16x2_t b = __builtin_convertvector(v, bf16x2_t); return __builtin_bit_cast(unsigned, b); }
__device__ __forceinline__ float bf_lo(unsigned w) { return __uint_as_float(w << 16); }
__device__ __forceinline__ float bf_hi(unsigned w) { return __uint_as_float(w & 0xffff0000u); }
__device__ __forceinline__ void pair8(const f32x4& a, const f32x4& b, float (&v)[8]) {
#pragma unroll
    for (int r = 0; r < 4; ++r) { const auto s = __builtin_amdgcn_permlane16_swap(__float_as_uint(a[r]), __float_as_uint(b[r]), false, false); v[r] = __uint_as_float(s[0]); v[4 + r] = __uint_as_float(s[1]); }
}
__device__ __forceinline__ float sigmoid_f(float x) { return __builtin_amdgcn_rcpf(1.0f + __builtin_amdgcn_exp2f(-1.4426950408889634f * x)); }
__device__ __forceinline__ float gelu_tanh_f(float x) { const float t = x * (1.5957691216057308f + 0.07135481627159149f * x * x); return x * sigmoid_f(t); }

constexpr float NORM_EPS = 1e-6f;
__device__ __forceinline__ float row_rs(const float* ss, int row) {
    const f32x4* p = (const f32x4*)(ss + (size_t)row * 16); const f32x4 a = p[0], b = p[1], c = p[2], d = p[3];
    const float s = ((a[0] + a[1]) + (a[2] + a[3])) + ((b[0] + b[1]) + (b[2] + b[3])) + ((c[0] + c[1]) + (c[2] + c[3])) + ((d[0] + d[1]) + (d[2] + d[3]));
    return 1.0f / sqrtf(s * (1.0f / 1024.0f) + NORM_EPS);
}

template <int MODE> struct EpiBf16 {
    static constexpr bool PERM = true, AFTER_DRAIN = false;
    bf16_t* O; int ldc; float* lns;
    __device__ __forceinline__ void operator()(const f32x4 (&acc)[2][2][4][2], const Unit& u, int wr, int wc, int fr, int fq) const {
        const int row0 = u.pm * BM + wr * 64 + fr, col0 = u.pn * BM + wc * 32 + 8 * fq;
        const int act = (MODE == 0) ? (u.pn < 4 ? 1 : (u.pn >= 10 ? 2 : 0)) : 0;
#pragma unroll
        for (int ai = 0; ai < 2; ++ai)
#pragma unroll
            for (int m = 0; m < 4; ++m) { const int row = row0 + ai * HALF + m * 16; bf16_t* rowp = O + (size_t)row * ldc + col0; float s1 = 0.f, s2 = 0.f;
#pragma unroll
                for (int bj = 0; bj < 2; ++bj) { f32x4 v0 = acc[ai][bj][m][0], v1 = acc[ai][bj][m][1];
                    if (MODE == 0) {
                        if (act == 1) {
#pragma unroll
                            for (int e = 0; e < 4; ++e) { v0[e] = gelu_tanh_f(v0[e]); v1[e] = gelu_tanh_f(v1[e]); } }
                        else if (act == 2) {
#pragma unroll
                            for (int e = 0; e < 4; ++e) { v0[e] = sigmoid_f(v0[e]); v1[e] = sigmoid_f(v1[e]); } }
                    }
                    if (MODE == 2) {
#pragma unroll
                        for (int e = 0; e < 4; ++e) { const float a = fmaxf(v0[e], 0.f), b = fmaxf(v1[e], 0.f); v0[e] = a * a; v1[e] = b * b; } }
                    if (MODE == 0) { const f32x4 t = v0 + v1, q = v0 * v0 + v1 * v1; s1 += (t[0] + t[1]) + (t[2] + t[3]); s2 += (q[0] + q[1]) + (q[2] + q[3]); }
                    u32x4 w; w.x = cvt_pk_bf16(v0[0], v0[1]); w.y = cvt_pk_bf16(v0[2], v0[3]); w.z = cvt_pk_bf16(v1[0], v1[1]); w.w = cvt_pk_bf16(v1[2], v1[3]);
                    *(u32x4*)(rowp + bj * HALF) = w; }
                if (MODE == 0 && (u.pn == 2 || u.pn == 3)) {
                    s1 += __shfl_xor(s1, 16); s1 += __shfl_xor(s1, 32); s2 += __shfl_xor(s2, 16); s2 += __shfl_xor(s2, 32);
                    if (fq == 0) *(f32x2*)(lns + ((size_t)row * 8 + (u.pn - 2) * 4 + wc) * 2) = (f32x2){s1, s2}; } }
    }
};

template <int MODE> struct EpiRes {
    static constexpr bool PERM = true, AFTER_DRAIN = false;
    const float* rn;
    const bf16_t* Hb; bf16_t* Ho; float* SSO; const float* SSI; const bf16_t* PROJ;
    __device__ __forceinline__ void operator()(const f32x4 (&acc)[2][2][4][2], const Unit& u, int wr, int wc, int fr, int fq) const {
        const int row0 = u.pm * BM + wr * 64 + fr, col0 = u.pn * BM + wc * 32 + 8 * fq;
#pragma unroll
        for (int ai = 0; ai < 2; ++ai)
#pragma unroll
            for (int m = 0; m < 4; ++m) { const int row = row0 + ai * HALF + m * 16; const size_t off = (size_t)row * 1024 + col0;
                float rsc; if (MODE != 0) { rsc = row_rs(SSI, row); if (MODE == 1) rsc = rsc * rsc; } else rsc = rn[row];
                float sq = 0.f;
#pragma unroll
                for (int bj = 0; bj < 2; ++bj) { const size_t o2 = off + bj * HALF;
                    const u32x4 hw = *(const u32x4*)(Hb + o2);
                    const float r[8] = {bf_lo(hw.x), bf_hi(hw.x), bf_lo(hw.y), bf_hi(hw.y), bf_lo(hw.z), bf_hi(hw.z), bf_lo(hw.w), bf_hi(hw.w)};
                    const f32x4 a0 = acc[ai][bj][m][0], a1 = acc[ai][bj][m][1]; const float a[8] = {a0[0], a0[1], a0[2], a0[3], a1[0], a1[1], a1[2], a1[3]};
                    float h[8];
                    if (MODE == 0) {
#pragma unroll
                        for (int e = 0; e < 8; ++e) h[e] = r[e] * rsc + a[e]; }
                    else if (MODE == 1) {
#pragma unroll
                        for (int e = 0; e < 8; ++e) h[e] = r[e] + a[e] * rsc; }
                    else { const u32x4 pw = *(const u32x4*)(PROJ + o2);
                        const float p[8] = {bf_lo(pw.x), bf_hi(pw.x), bf_lo(pw.y), bf_hi(pw.y), bf_lo(pw.z), bf_hi(pw.z), bf_lo(pw.w), bf_hi(pw.w)};
#pragma unroll
                        for (int e = 0; e < 8; ++e) h[e] = r[e] + sigmoid_f(a[e] * rsc) * p[e]; }
                    u32x4 w; w.x = cvt_pk_bf16(h[0], h[1]); w.y = cvt_pk_bf16(h[2], h[3]); w.z = cvt_pk_bf16(h[4], h[5]); w.w = cvt_pk_bf16(h[6], h[7]); *(u32x4*)(Ho + o2) = w;
#pragma unroll
                    for (int e = 0; e < 8; ++e) sq += h[e] * h[e]; }
                sq += __shfl_xor(sq, 16); sq += __shfl_xor(sq, 32);
                if (fq == 0) SSO[(size_t)row * 16 + u.pn * 4 + wc] = sq; }
    }
};

template <class Epi, class Sched, bool ALIGN_EPI = false, bool SP2 = false>
__device__ __forceinline__ void gemm_phase(PG8_LAS unsigned char* lds, const Gemm g, const Sched& S, const Epi& E) {
    const int tid = threadIdx.x, wid = __builtin_amdgcn_readfirstlane(tid >> 6), lane = tid & 63, wr = wid >> 2, wc = wid & 3, fr = lane & 15, fq = lane >> 4;
    int K = g.K; asm volatile("" : "+s"(K));
    const int nt = K / BK;
    unsigned voffA[2], voffB[2];
#pragma unroll
    for (int i = 0; i < 2; ++i) { int R, C; stage_rc(tid * 16 + i * 8192, R, C); const int Rb = Epi::PERM ? ((R & ~31) + perm32(R & 31)) : R;
        voffA[i] = (unsigned)(R * K + C) * 2u; voffB[i] = (unsigned)(Rb * K + C) * 2u; }
    const size_t kstep = (size_t)(BK * 2);
    const size_t hstep = (size_t)HALF * K * 2;
    const size_t tstep = 2 * hstep;
    const unsigned ldsw = (unsigned)wid * 1024u;
    const int aoff = lds_byte(wr * 64 + fr, fq * 8), boff = lds_byte(wc * 32 + fr, fq * 8);
#define PG8_SA(b, h) (((b) * 2 + (h)) * HTB)
#define PG8_SB(b, h) ((4 + (b) * 2 + (h)) * HTB)
#define PG8_STAGE(bufoff, gbase, voff) do { _Pragma("unroll") for (int _i = 0; _i < 2; ++_i) \
        __builtin_amdgcn_global_load_lds((const unsigned*)((const char*)(gbase) + (voff)[_i]), (PG8_LAS unsigned*)(lds + (bufoff) + ldsw + _i * 8192), 16, 0, 0); } while (0)
#define PG8_LDA(dst, b, h) do { _Pragma("unroll") for (int m = 0; m < 4; ++m) _Pragma("unroll") for (int k = 0; k < 2; ++k) dst[m][k] = *(const PG8_LAS bf16x8*)(lds + PG8_SA(b, h) + aoff + m * 2048 + k * 1024); } while (0)
#define PG8_LDB(dst, b, h) do { _Pragma("unroll") for (int n = 0; n < 2; ++n) _Pragma("unroll") for (int k = 0; k < 2; ++k) dst[n][k] = *(const PG8_LAS bf16x8*)(lds + PG8_SB(b, h) + boff + n * 2048 + k * 1024); } while (0)
#define PG8_MMA(ai, bj, At, Bt) do { __builtin_amdgcn_s_setprio(1); _Pragma("unroll") for (int m = 0; m < 4; ++m) _Pragma("unroll") for (int n = 0; n < 2; ++n) _Pragma("unroll") for (int k = 0; k < 2; ++k) \
        acc[ai][bj][m][n] = __builtin_amdgcn_mfma_f32_16x16x32_bf16(Bt[n][k], At[m][k], acc[ai][bj][m][n], 0, 0, 0); __builtin_amdgcn_s_setprio(0); } while (0)
#define PG8_WAIT_V(n) asm volatile("s_waitcnt vmcnt(" #n ")" ::: "memory")
#define PG8_WAIT_L(n) asm volatile("s_waitcnt lgkmcnt(" #n ")" ::: "memory")
#define PG8_BAR __builtin_amdgcn_s_barrier()
#define PG8_SCHED __builtin_amdgcn_sched_barrier(0)
    Unit cur, nxt; int ui = 0;
    if (!S.next(0, cur)) return;
    f32x4 acc[2][2][4][2];
#pragma unroll
    for (int a = 0; a < 2; ++a)
#pragma unroll
        for (int b = 0; b < 2; ++b)
#pragma unroll
            for (int m = 0; m < 4; ++m)
#pragma unroll
                for (int n = 0; n < 2; ++n) acc[a][b][m][n] = (f32x4){0.f, 0.f, 0.f, 0.f};
    bf16x8 At[4][2], B0[2][2], B1[2][2];
    const char* cA = (const char*)g.A + (size_t)cur.pm * tstep; const char* cB = (const char*)g.Bt + (size_t)cur.pn * tstep;
    S.a_ready(cur);
    if constexpr (SP2) {
        PG8_STAGE(PG8_SB(0, 0), cB, voffB); PG8_STAGE(PG8_SB(0, 1), cB + hstep, voffB); PG8_STAGE(PG8_SA(0, 0), cA, voffA); PG8_STAGE(PG8_SA(0, 1), cA + hstep, voffA);
        if (wr == 1) PG8_BAR;
        PG8_WAIT_V(2); PG8_BAR;
        PG8_STAGE(PG8_SB(1, 0), cB + kstep, voffB); PG8_STAGE(PG8_SA(1, 0), cA + kstep, voffA); PG8_STAGE(PG8_SB(1, 1), cB + hstep + kstep, voffB);
        PG8_WAIT_V(6); PG8_BAR;
    } else {
        PG8_STAGE(PG8_SB(0, 0), cB, voffB); PG8_STAGE(PG8_SA(0, 0), cA, voffA); PG8_STAGE(PG8_SB(0, 1), cB + hstep, voffB); PG8_STAGE(PG8_SA(0, 1), cA + hstep, voffA);
        if (wr == 1) PG8_BAR;
        PG8_WAIT_V(4); PG8_BAR;
        PG8_STAGE(PG8_SB(1, 0), cB + kstep, voffB); PG8_STAGE(PG8_SA(1, 0), cA + kstep, voffA); PG8_STAGE(PG8_SB(1, 1), cB + hstep + kstep, voffB);
        PG8_WAIT_V(6); PG8_BAR;
    }
    for (;;) {
        const bool has_next = S.next(ui + 1, nxt);
        const char* nA = has_next ? (const char*)g.A + (size_t)nxt.pm * tstep : cA; const char* nB = has_next ? (const char*)g.Bt + (size_t)nxt.pn * tstep : cB;
        for (int t = 0; t < nt; t += 2) {
            const bool last = (t == nt - 2);
            const char* a1 = cA + (size_t)(t + 1) * kstep;
            const char* a2 = last ? nA : cA + (size_t)(t + 2) * kstep; const char* b2 = last ? nB : cB + (size_t)(t + 2) * kstep;
            const char* a3 = a2 + kstep; const char* b3 = b2 + kstep;
            if (last && has_next) S.a_ready(nxt);
            if constexpr (SP2) {
            PG8_LDB(B0, 0, 0); PG8_LDB(B1, 0, 1); PG8_SCHED; PG8_LDA(At, 0, 0); PG8_STAGE(PG8_SA(1, 1), a1 + hstep, voffA);
            PG8_WAIT_V(8); PG8_WAIT_L(0); PG8_BAR; PG8_MMA(0, 0, At, B0); PG8_MMA(0, 1, At, B1); PG8_BAR; PG8_SCHED;
            PG8_LDA(At, 0, 1); PG8_STAGE(PG8_SB(0, 0), b2, voffB); PG8_STAGE(PG8_SB(0, 1), b2 + hstep, voffB); PG8_STAGE(PG8_SA(0, 0), a2, voffA);
            PG8_WAIT_V(8); PG8_WAIT_L(0); PG8_BAR; PG8_MMA(1, 0, At, B0); PG8_MMA(1, 1, At, B1); PG8_BAR; PG8_SCHED;
            PG8_LDB(B0, 1, 0); PG8_LDB(B1, 1, 1); PG8_SCHED; PG8_LDA(At, 1, 0); PG8_STAGE(PG8_SA(0, 1), a2 + hstep, voffA);
            PG8_WAIT_V(8); PG8_WAIT_L(0); PG8_BAR; PG8_MMA(0, 0, At, B0); PG8_MMA(0, 1, At, B1); PG8_BAR; PG8_SCHED;
            PG8_LDA(At, 1, 1); PG8_STAGE(PG8_SB(1, 0), b3, voffB); PG8_STAGE(PG8_SB(1, 1), b3 + hstep, voffB); PG8_STAGE(PG8_SA(1, 0), a3, voffA);
            PG8_WAIT_V(8); PG8_WAIT_L(0); PG8_BAR; PG8_MMA(1, 0, At, B0); PG8_MMA(1, 1, At, B1); PG8_BAR; PG8_SCHED;
            } else {
            PG8_LDB(B0, 0, 0); PG8_SCHED; PG8_LDA(At, 0, 0); PG8_STAGE(PG8_SA(1, 1), a1 + hstep, voffA);
            PG8_WAIT_L(8); PG8_BAR; PG8_WAIT_L(0); PG8_MMA(0, 0, At, B0); PG8_BAR; PG8_SCHED;
            PG8_LDB(B1, 0, 1); PG8_STAGE(PG8_SB(0, 0), b2, voffB);
            PG8_BAR; PG8_WAIT_L(0); PG8_MMA(0, 1, At, B1); PG8_BAR;
            PG8_LDA(At, 0, 1); PG8_STAGE(PG8_SA(0, 0), a2, voffA);
            PG8_BAR; PG8_WAIT_L(0); PG8_MMA(1, 0, At, B0); PG8_BAR; PG8_SCHED;
            PG8_STAGE(PG8_SB(0, 1), b2 + hstep, voffB);
            PG8_WAIT_V(6); PG8_BAR; PG8_MMA(1, 1, At, B1); PG8_BAR;
            PG8_LDB(B0, 1, 0); PG8_SCHED; PG8_LDA(At, 1, 0); PG8_STAGE(PG8_SA(0, 1), a2 + hstep, voffA);
            PG8_WAIT_L(8); PG8_BAR; PG8_WAIT_L(0); PG8_MMA(0, 0, At, B0); PG8_BAR; PG8_SCHED;
            PG8_LDB(B1, 1, 1); PG8_STAGE(PG8_SB(1, 0), b3, voffB);
            PG8_BAR; PG8_WAIT_L(0); PG8_MMA(0, 1, At, B1); PG8_BAR;
            PG8_LDA(At, 1, 1); PG8_STAGE(PG8_SA(1, 0), a3, voffA);
            PG8_BAR; PG8_WAIT_L(0); PG8_MMA(1, 0, At, B0); PG8_BAR; PG8_SCHED;
            PG8_STAGE(PG8_SB(1, 1), b3 + hstep, voffB);
            PG8_WAIT_V(6); PG8_BAR; PG8_MMA(1, 1, At, B1); PG8_BAR;
            }
        }
        if constexpr (ALIGN_EPI) { if (wr == 0) PG8_BAR; }
        if constexpr (!Epi::AFTER_DRAIN) { E(acc, cur, wr, wc, fr, fq); S.done(cur); }
        if (!has_next) break;
#pragma unroll
        for (int a = 0; a < 2; ++a)
#pragma unroll
            for (int b = 0; b < 2; ++b)
#pragma unroll
                for (int m = 0; m < 4; ++m)
#pragma unroll
                    for (int n = 0; n < 2; ++n) acc[a][b][m][n] = (f32x4){0.f, 0.f, 0.f, 0.f};
        cur = nxt; cA = nA; cB = nB; ++ui;
        if constexpr (ALIGN_EPI) { if (wr == 1) PG8_BAR; }
    }
    PG8_WAIT_V(0);
    if constexpr (!ALIGN_EPI) { if (wr == 0) PG8_BAR; }
    PG8_BAR;
    if constexpr (Epi::AFTER_DRAIN) { E.fused(acc, cur, wr, wc, fr, fq, lds, wid, lane); S.done(cur); }
#undef PG8_SA
#undef PG8_SB
#undef PG8_STAGE
#undef PG8_LDA
#undef PG8_LDB
#undef PG8_MMA
#undef PG8_WAIT_V
#undef PG8_WAIT_L
#undef PG8_BAR
#undef PG8_SCHED
}
}

namespace mix {
#define LAS __attribute__((address_space(3)))
using pg8::bf16_t; using pg8::bf16x8; using pg8::f32x4; using pg8::u32x4; using pg8::u32x2; using pg8::cvt_pk_bf16; using pg8::bf_lo; using pg8::bf_hi; using pg8::sigmoid_f; using pg8::pair8;
typedef short v4i16_t __attribute__((ext_vector_type(4)));
constexpr int NP = 16384, NS = 1024, ZLD = 3072;
constexpr int ZU = 0, ZVG = 512, ZQ = 1024, ZK = 1536, ZV = 2048, ZO = 2560;
constexpr int TS = 288;
constexpr int IMG = 128 * TS;
constexpr int IMG0 = 0, IMG1 = IMG, IMG2 = 2 * IMG, SC_OFF = 3 * IMG;
constexpr float EPS = 1e-6f;

template <int CTRL> __device__ __forceinline__ float dpp_mov(float v) { return __int_as_float(__builtin_amdgcn_update_dpp(0, __float_as_int(v), CTRL, 0xF, 0xF, true)); }
__device__ __forceinline__ float row_sum16(float v) { v += dpp_mov<0xB1>(v); v += dpp_mov<0x4E>(v); v += dpp_mov<0x141>(v); v += dpp_mov<0x140>(v); return v; }
__device__ __forceinline__ float row_max16(float v) { v = fmaxf(v, dpp_mov<0xB1>(v)); v = fmaxf(v, dpp_mov<0x4E>(v)); v = fmaxf(v, dpp_mov<0x141>(v)); v = fmaxf(v, dpp_mov<0x140>(v)); return v; }
__device__ __forceinline__ float rl(float v, int l) { return __int_as_float(__builtin_amdgcn_readlane(__float_as_int(v), l)); }
__device__ __forceinline__ float wave_sum(float v) { v = row_sum16(v); return (rl(v, 0) + rl(v, 16)) + (rl(v, 32) + rl(v, 48)); }
__device__ __forceinline__ float wave_max(float v) { v = row_max16(v); return fmaxf(fmaxf(rl(v, 0), rl(v, 16)), fmaxf(rl(v, 32), rl(v, 48))); }
__device__ __forceinline__ float scan_add(float v, int lane) {
#pragma unroll
    for (int o = 1; o < 64; o <<= 1) { const float t = __shfl_up(v, o); if (lane >= o) v += t; }
    return v;
}
__device__ __forceinline__ float scan_max(float v, int lane) {
#pragma unroll
    for (int o = 1; o < 64; o <<= 1) { const float t = __shfl_up(v, o); if (lane >= o) v = fmaxf(v, t); }
    return v;
}
__device__ __forceinline__ bf16x8 tr2(LAS const unsigned char* p0, LAS const unsigned char* p1) {
    const v4i16_t a = __builtin_amdgcn_ds_read_tr16_b64_v4i16((LAS v4i16_t*)p0);
    const v4i16_t b = __builtin_amdgcn_ds_read_tr16_b64_v4i16((LAS v4i16_t*)p1);
    return (bf16x8){a[0], a[1], a[2], a[3], b[0], b[1], b[2], b[3]};
}
__device__ __forceinline__ void unpack8(const u32x4 w, float (&x)[8]) {
    x[0] = bf_lo(w.x); x[1] = bf_hi(w.x); x[2] = bf_lo(w.y); x[3] = bf_hi(w.y); x[4] = bf_lo(w.z); x[5] = bf_hi(w.z); x[6] = bf_lo(w.w); x[7] = bf_hi(w.w);
}
__device__ __forceinline__ u32x4 pack8(const float (&x)[8]) {
    u32x4 w; w.x = cvt_pk_bf16(x[0], x[1]); w.y = cvt_pk_bf16(x[2], x[3]); w.z = cvt_pk_bf16(x[4], x[5]); w.w = cvt_pk_bf16(x[6], x[7]); return w;
}

struct MixP {
    const bf16_t* Z; bf16_t* YC; const float* IG; const float* LF; const float* LNS;
    const bf16_t* WSb;
    const float *gm_ws, *lng, *lnb, *bs, *mlnorm;
    bf16_t* KV; float *NLOC, *NST, *CH, *MST;
    const float *stC, *stN, *stM;
    float *oCp, *oNp, *oMp, *oVp, *oCs, *oNs, *oMs, *oVs;
};

__device__ __forceinline__ void gmlp_unit(LAS unsigned char* lds, const MixP& P, int b, int c, int h, int tid) {
    const int lane = tid & 63, w = __builtin_amdgcn_readfirstlane(tid >> 6), fr = lane & 15, kq = lane >> 4, q = fr >> 2, p = fr & 3;
    const int r0 = b * 2048 + c * 128;
    LAS unsigned char* img = lds + IMG0;
    LAS float* mst = (LAS float*)(lds + SC_OFF);
    const int ch = tid & 15;
    u32x4 raw[4];
#pragma unroll
    for (int i = 0; i < 4; ++i) raw[i] = *(const u32x4*)(P.Z + (size_t)(r0 + (tid >> 4) + 32 * i) * ZLD + ZVG + h * 128 + ch * 8);
    f32x4 st4[4];
    if (tid < 128) { const f32x4* sp = (const f32x4*)(P.LNS + (size_t)(r0 + tid) * 16);
#pragma unroll
        for (int j = 0; j < 4; ++j) st4[j] = sp[j]; }
    float g8[8], b8[8];
    { const float* gp = P.lng + h * 128 + ch * 8; const float* bp = P.lnb + h * 128 + ch * 8;
      const f32x4 a = *(const f32x4*)gp, a2 = *(const f32x4*)(gp + 4), c0 = *(const f32x4*)bp, c1 = *(const f32x4*)(bp + 4);
#pragma unroll
      for (int e = 0; e < 4; ++e) { g8[e] = a[e]; g8[4 + e] = a2[e]; b8[e] = c0[e]; b8[4 + e] = c1[e]; } }
    const bf16_t* Wrow = P.WSb + ((size_t)h * 128 + 16 * w + fr) * 128 + 8 * kq;
    bf16x8 wf[4];
#pragma unroll
    for (int st = 0; st < 4; ++st) wf[st] = *(const bf16x8*)(Wrow + 32 * st);
    const int fo = 16 * (kq & 1) + 8 * (kq >> 1);
    const bf16_t* urow = P.Z + (size_t)(r0 + 16 * w + fr) * ZLD + ZU + h * 128 + fo;
    u32x4 uw[4];
#pragma unroll
    for (int g = 0; g < 4; ++g) uw[g] = *(const u32x4*)(urow + 32 * g);
    const float bsv = P.bs[h * 128 + 16 * w + fr];
    if (tid < 128) { const float s1 = (st4[0][0] + st4[0][2]) + (st4[1][0] + st4[1][2]) + (st4[2][0] + st4[2][2]) + (st4[3][0] + st4[3][2]);
        const float s2 = (st4[0][1] + st4[0][3]) + (st4[1][1] + st4[1][3]) + (st4[2][1] + st4[2][3]) + (st4[3][1] + st4[3][3]);
        const float mean = s1 * (1.0f / 512.0f), var = fmaxf(s2 * (1.0f / 512.0f) - mean * mean, 0.f);
        mst[tid] = mean; mst[128 + tid] = 1.0f / sqrtf(var + EPS); }
    __syncthreads();
    float* vout = (c == 15) ? P.oVp + (size_t)b * 128 * 512 : nullptr;
#pragma unroll
    for (int i = 0; i < 4; ++i) { const int t = (tid >> 4) + 32 * i; const float mean = mst[t], rstd = mst[128 + t];
        float x[8]; unpack8(raw[i], x);
#pragma unroll
        for (int e = 0; e < 8; ++e) x[e] = (x[e] - mean) * rstd * g8[e] + b8[e];
        *(LAS u32x4*)(img + t * TS + ch * 16) = pack8(x);
        if (vout) { float* vo = vout + (size_t)t * 512 + h * 128 + ch * 8; *(f32x4*)vo = (f32x4){x[0], x[1], x[2], x[3]}; *(f32x4*)(vo + 4) = (f32x4){x[4], x[5], x[6], x[7]}; } }
    __syncthreads();
    f32x4 acc[8];
#pragma unroll
    for (int n = 0; n < 8; ++n) acc[n] = (f32x4){0.f, 0.f, 0.f, 0.f};
    const int nsteps = (w >> 1) + 1;
    LAS const unsigned char* trb = img + (8 * kq + q) * TS + 8 * p;
#pragma unroll
    for (int st = 0; st < 4; ++st) if (st < nsteps) {
#pragma unroll
        for (int n = 0; n < 8; ++n) { const bf16x8 vf = tr2(trb + (32 * st) * TS + 32 * n, trb + (32 * st + 4) * TS + 32 * n);
            acc[n] = __builtin_amdgcn_mfma_f32_16x16x32_bf16(vf, wf[st], acc[n], 0, 0, 0); }
    }
    { const int t = 16 * w + fr;
      bf16_t* yrow = P.YC + (size_t)(r0 + t) * 1024 + h * 128 + fo;
#pragma unroll
      for (int g = 0; g < 4; ++g) { float v[8], uf[8]; pair8(acc[2 * g], acc[2 * g + 1], v); unpack8(uw[g], uf);
#pragma unroll
          for (int e = 0; e < 8; ++e) v[e] = uf[e] * (v[e] + bsv);
          *(u32x4*)(yrow + 32 * g) = pack8(v); } }
    __syncthreads();
}

__device__ __forceinline__ void kv_unit(LAS unsigned char* lds, const MixP& P, int b, int h, int c, int tid) {
    const int lane = tid & 63, w = __builtin_amdgcn_readfirstlane(tid >> 6), fr = lane & 15, kq = lane >> 4, q = fr >> 2, p = fr & 3;
    const int r0 = b * 2048 + c * 128, unit = (b * 4 + h) * 16 + c;
    LAS float* wl = (LAS float*)(lds + SC_OFF);
    float lf0 = 0.f, lf1 = 0.f, ig0 = 0.f, ig1 = 0.f;
    if (w == 0) { const int s0 = r0 + 2 * lane; lf0 = P.LF[(size_t)s0 * 4 + h]; lf1 = P.LF[(size_t)(s0 + 1) * 4 + h]; ig0 = P.IG[(size_t)s0 * 4 + h]; ig1 = P.IG[(size_t)(s0 + 1) * 4 + h]; }
    u32x4 kraw[4], vraw[4];
#pragma unroll
    for (int i = 0; i < 4; ++i) { const int id = tid + 512 * i, row = id >> 4, ch = id & 15;
        const bf16_t* zr = P.Z + (size_t)(r0 + row) * ZLD + h * 128 + ch * 8; kraw[i] = *(const u32x4*)(zr + ZK); vraw[i] = *(const u32x4*)(zr + ZV); }
    if (w == 0) {
        const float Pc = scan_add(lf0 + lf1, lane), b1 = Pc, b0 = Pc - lf1, B = __shfl(Pc, 63);
        const float x0 = ig0 - b0, x1 = ig1 - b1, xm = wave_max(fmaxf(x0, x1));
        wl[2 * lane] = __expf(x0 - xm); wl[2 * lane + 1] = __expf(x1 - xm);
        if (lane == 0) { P.CH[unit * 2] = B; P.CH[unit * 2 + 1] = B + xm; }
    }
    __syncthreads();
#pragma unroll
    for (int i = 0; i < 4; ++i) { const int id = tid + 512 * i, row = id >> 4, ch = id & 15;
        float x[8]; unpack8(kraw[i], x); const float ws = wl[row];
#pragma unroll
        for (int e = 0; e < 8; ++e) x[e] *= ws;
        *(LAS u32x4*)(lds + IMG0 + row * TS + ch * 16) = pack8(x);
        *(LAS u32x4*)(lds + IMG1 + row * TS + ch * 16) = vraw[i]; }
    __syncthreads();
    f32x4 acc[8], accn = (f32x4){0.f, 0.f, 0.f, 0.f};
#pragma unroll
    for (int n = 0; n < 8; ++n) acc[n] = (f32x4){0.f, 0.f, 0.f, 0.f};
    const bf16x8 ones = (bf16x8){0x3F80, 0x3F80, 0x3F80, 0x3F80, 0x3F80, 0x3F80, 0x3F80, 0x3F80};
    LAS const unsigned char* trk = lds + IMG0 + (8 * kq + q) * TS + 8 * p + 32 * w;
    LAS const unsigned char* trv = lds + IMG1 + (8 * kq + q) * TS + 8 * p;
#pragma unroll
    for (int st = 0; st < 4; ++st) {
        const bf16x8 kf = tr2(trk + (32 * st) * TS, trk + (32 * st + 4) * TS);
        accn = __builtin_amdgcn_mfma_f32_16x16x32_bf16(ones, kf, accn, 0, 0, 0);
#pragma unroll
        for (int n = 0; n < 8; ++n) { const bf16x8 vf = tr2(trv + (32 * st) * TS + 32 * n, trv + (32 * st + 4) * TS + 32 * n);
            acc[n] = __builtin_amdgcn_mfma_f32_16x16x32_bf16(vf, kf, acc[n], 0, 0, 0); }
    }
    bf16_t* kvp = P.KV + (size_t)unit * 16384 + (16 * w + fr) * 128 + 16 * (kq & 1) + 8 * (kq >> 1);
#pragma unroll
    for (int g = 0; g < 4; ++g) { float v[8]; pair8(acc[2 * g], acc[2 * g + 1], v); *(u32x4*)(kvp + 32 * g) = pack8(v); }
    if (kq == 0) P.NLOC[unit * 128 + 16 * w + fr] = accn[0];
    __syncthreads();
}

__device__ __forceinline__ void scan_unit(const MixP& P, int bh, int slice, int tid) {
    const size_t base = (size_t)bh * 16 * 16384 + slice * 2048 + tid * 4;
    f32x4 C = (f32x4){0.f, 0.f, 0.f, 0.f}; float M = 0.f, nv = 0.f;
    const bool nthr = (slice == 0 && tid < 128);
    u32x2 kvv[16];
#pragma unroll
    for (int c = 0; c < 16; ++c) kvv[c] = *(const u32x2*)(P.KV + base + (size_t)c * 16384);
#pragma unroll
    for (int c = 0; c < 16; ++c) {
        const float B = P.CH[(bh * 16 + c) * 2], a = P.CH[(bh * 16 + c) * 2 + 1];
        const float Mn = fmaxf(B + M, a), dec = __expf(B + M - Mn), add = __expf(a - Mn);
        bf16_t* kp = P.KV + base + (size_t)c * 16384;
        const f32x4 kv = (f32x4){bf_lo(kvv[c].x), bf_hi(kvv[c].x), bf_lo(kvv[c].y), bf_hi(kvv[c].y)};
        { u32x2 o; o.x = cvt_pk_bf16(C[0], C[1]); o.y = cvt_pk_bf16(C[2], C[3]); *(u32x2*)kp = o; }
        C = dec * C + add * kv;
        if (nthr) { const float nl = P.NLOC[(bh * 16 + c) * 128 + tid]; P.NST[(bh * 16 + c) * 128 + tid] = nv; nv = dec * nv + add * nl; if (tid == 0) P.MST[bh * 16 + c] = M; }
        M = Mn;
    }
    *(f32x4*)(P.oCp + (size_t)bh * 16384 + slice * 2048 + tid * 4) = C;
    if (nthr) { P.oNp[bh * 128 + tid] = nv; if (tid == 0) P.oMp[bh] = M; }
}

__device__ __forceinline__ void mlo_unit(LAS unsigned char* lds, const MixP& P, int b, int h, int c, int tid) {
    const int lane = tid & 63, w = __builtin_amdgcn_readfirstlane(tid >> 6), fr = lane & 15, kq = lane >> 4, q = fr >> 2, p = fr & 3;
    const int r0 = b * 2048 + c * 128, unit = (b * 4 + h) * 16 + c;
    LAS float* xs = (LAS float*)(lds + SC_OFF); LAS float* ys = xs + 128; LAS float* wint = xs + 256; LAS float* emt = xs + 384; LAS float* nst = xs + 512;
    const float Mc = P.MST[unit];
    float lf0 = 0.f, lf1 = 0.f, ig0 = 0.f, ig1 = 0.f, n0v = 0.f, n1v = 0.f;
    if (w == 0) { const int s0 = r0 + 2 * lane; lf0 = P.LF[(size_t)s0 * 4 + h]; lf1 = P.LF[(size_t)(s0 + 1) * 4 + h]; ig0 = P.IG[(size_t)s0 * 4 + h]; ig1 = P.IG[(size_t)(s0 + 1) * 4 + h]; }
    else if (w == 1) { n0v = P.NST[unit * 128 + lane]; n1v = P.NST[unit * 128 + lane + 64]; }
    const int t = 16 * w + fr;
    const bf16_t* zrow = P.Z + (size_t)(r0 + t) * ZLD + h * 128;
    u32x4 kraw[4], vraw[4], craw[4]; bf16x8 qf[4];
#pragma unroll
    for (int i = 0; i < 4; ++i) { const int id = tid + 512 * i, row = id >> 4, ch = id & 15;
        const bf16_t* zr = P.Z + (size_t)(r0 + row) * ZLD + h * 128 + ch * 8; kraw[i] = *(const u32x4*)(zr + ZK); vraw[i] = *(const u32x4*)(zr + ZV); }
    { const bf16_t* cs = P.KV + (size_t)unit * 16384;
#pragma unroll
      for (int i = 0; i < 4; ++i) { const int id = tid + 512 * i, row = id >> 4, ch = id & 15; craw[i] = *(const u32x4*)(cs + row * 128 + ch * 8); } }
#pragma unroll
    for (int ds = 0; ds < 4; ++ds) qf[ds] = *(const bf16x8*)(zrow + ZQ + 32 * ds + 8 * kq);
    if (w == 0) {
        const float Pc = scan_add(lf0 + lf1, lane), b1 = Pc, b0 = Pc - lf1;
        const float x0 = ig0 - b0, x1 = ig1 - b1;
        const float PM = scan_max(fmaxf(x0, x1), lane); float prev = __shfl_up(PM, 1); if (lane == 0) prev = -INFINITY;
        const float y0 = fmaxf(Mc, fmaxf(prev, x0)), y1 = fmaxf(Mc, PM);
        xs[2 * lane] = x0; xs[2 * lane + 1] = x1; ys[2 * lane] = y0; ys[2 * lane + 1] = y1;
        wint[2 * lane] = __expf(Mc - y0); wint[2 * lane + 1] = __expf(Mc - y1);
        emt[2 * lane] = __expf(-(b0 + y0)); emt[2 * lane + 1] = __expf(-(b1 + y1));
    } else if (w == 1) { nst[lane] = n0v; nst[lane + 64] = n1v; }
#pragma unroll
    for (int i = 0; i < 4; ++i) { const int id = tid + 512 * i, row = id >> 4, ch = id & 15;
        *(LAS u32x4*)(lds + IMG0 + row * TS + ch * 16) = kraw[i];
        *(LAS u32x4*)(lds + IMG1 + row * TS + ch * 16) = vraw[i];
        *(LAS u32x4*)(lds + IMG2 + row * TS + ch * 16) = craw[i]; }
    __syncthreads();
    const int fo = 16 * (kq & 1) + 8 * (kq >> 1);
    u32x4 ow[4];
#pragma unroll
    for (int g = 0; g < 4; ++g) ow[g] = *(const u32x4*)(zrow + ZO + 32 * g + fo);
    float dn = 0.f;
#pragma unroll
    for (int ds = 0; ds < 4; ++ds)
#pragma unroll
        for (int e = 0; e < 8; ++e) dn += __uint_as_float(((unsigned)(unsigned short)qf[ds][e]) << 16) * nst[32 * ds + 8 * kq + e];
    dn += __shfl_xor(dn, 16); dn += __shfl_xor(dn, 32);
    LAS const unsigned char* trv = lds + IMG1 + (4 * kq + q) * TS + 8 * p;
    LAS const unsigned char* trc = lds + IMG2 + (8 * kq + q) * TS + 8 * p;
    const float wi = wint[t];
    f32x4 o1[8];
#pragma unroll
    for (int n = 0; n < 8; ++n) o1[n] = (f32x4){0.f, 0.f, 0.f, 0.f};
#pragma unroll
    for (int ds = 0; ds < 4; ++ds)
#pragma unroll
        for (int n = 0; n < 8; ++n) { const bf16x8 cf = tr2(trc + (32 * ds) * TS + 32 * n, trc + (32 * ds + 4) * TS + 32 * n);
            o1[n] = __builtin_amdgcn_mfma_f32_16x16x32_bf16(cf, qf[ds], o1[n], 0, 0, 0); }
#pragma unroll
    for (int n = 0; n < 8; ++n) o1[n] = o1[n] * wi;
    f32x4 aS[8];
#pragma unroll
    for (int j = 0; j < 8; ++j) aS[j] = (f32x4){0.f, 0.f, 0.f, 0.f};
#pragma unroll
    for (int j = 0; j < 8; ++j) if (j <= w) {
#pragma unroll
        for (int ds = 0; ds < 4; ++ds) { const bf16x8 kf = *(LAS const bf16x8*)(lds + IMG0 + (16 * j + fr) * TS + (32 * ds + 8 * kq) * 2);
            aS[j] = __builtin_amdgcn_mfma_f32_16x16x32_bf16(kf, qf[ds], aS[j], 0, 0, 0); } }
    const float yt = ys[t]; float dsum = 0.f;
#pragma unroll
    for (int j = 0; j < 8; ++j) if (j <= w) {
#pragma unroll
        for (int r = 0; r < 4; ++r) { const int s = 16 * j + 4 * kq + r; const float wg = (s <= t) ? __expf(xs[s] - yt) : 0.f; aS[j][r] *= wg; dsum += aS[j][r]; } }
    dsum += __shfl_xor(dsum, 16); dsum += __shfl_xor(dsum, 32);
    const float den = dsum + wi * dn, rinv = 1.0f / fmaxf(fabsf(den), emt[t]);
#pragma unroll
    for (int st = 0; st < 4; ++st) if (2 * st <= w) {
        u32x4 sw; sw.x = cvt_pk_bf16(aS[2 * st][0], aS[2 * st][1]); sw.y = cvt_pk_bf16(aS[2 * st][2], aS[2 * st][3]);
        sw.z = cvt_pk_bf16(aS[2 * st + 1][0], aS[2 * st + 1][1]); sw.w = cvt_pk_bf16(aS[2 * st + 1][2], aS[2 * st + 1][3]);
        const bf16x8 sf = __builtin_bit_cast(bf16x8, sw);
#pragma unroll
        for (int n = 0; n < 8; ++n) { const bf16x8 vf = tr2(trv + (32 * st) * TS + 32 * n, trv + (32 * st + 16) * TS + 32 * n);
            o1[n] = __builtin_amdgcn_mfma_f32_16x16x32_bf16(vf, sf, o1[n], 0, 0, 0); } }
    float ssq = 0.f;
#pragma unroll
    for (int n = 0; n < 8; ++n)
#pragma unroll
        for (int r = 0; r < 4; ++r) { const float hv = o1[n][r] * rinv; o1[n][r] = hv; ssq += hv * hv; }
    ssq += __shfl_xor(ssq, 16); ssq += __shfl_xor(ssq, 32);
    const float rn = 1.0f / sqrtf(ssq * (1.0f / 128.0f) + EPS);
    bf16_t* yrow = P.YC + (size_t)(r0 + t) * 1024 + 512 + h * 128 + fo;
#pragma unroll
    for (int g = 0; g < 4; ++g) { float v[8], of[8]; pair8(o1[2 * g], o1[2 * g + 1], v); unpack8(ow[g], of);
        const f32x4 g0 = *(const f32x4*)(P.mlnorm + h * 128 + 32 * g + fo), g1 = *(const f32x4*)(P.mlnorm + h * 128 + 32 * g + fo + 4);
#pragma unroll
        for (int e = 0; e < 4; ++e) { v[e] = of[e] * v[e] * rn * g0[e]; v[4 + e] = of[4 + e] * v[4 + e] * rn * g1[e]; }
        *(u32x4*)(yrow + 32 * g) = pack8(v); }
    __syncthreads();
}

__device__ __forceinline__ void sample_unit(LAS unsigned char* lds, const MixP& P, int b, int h, int tid) {
    const int lane = tid & 63, w = __builtin_amdgcn_readfirstlane(tid >> 6);
    const int r0 = NP + b * 8, bh = b * 4 + h;
    LAS float* ql = (LAS float*)lds; LAS float* kl = ql + 1024; LAS float* vl = ql + 2048; LAS float* vnl = ql + 3072; LAS float* Sl = ql + 4096;
    LAS float* gsx = ql + 4160; LAS float* gsy = gsx + 8; LAS float* gwi = gsx + 16; LAS float* gem = gsx + 24; LAS float* gwe = gsx + 32; LAS float* gsc = gsx + 40; LAS float* qn = gsx + 48;
    LAS float* red = (LAS float*)(lds + 32768);
    f32x4 cvv[8];
    { const float* cs = P.stC + (size_t)bh * 16384 + (tid >> 5) * 128 + 4 * (tid & 31);
#pragma unroll
      for (int i = 0; i < 8; ++i) cvv[i] = *(const f32x4*)(cs + (size_t)(16 * i) * 128); }
    if (tid == 0) {
        const float m0 = P.stM[bh]; float bc = 0.f, pm = -INFINITY, mt = 0.f; float xv[8];
#pragma unroll
        for (int t = 0; t < 8; ++t) { const float lf = P.LF[(size_t)(r0 + t) * 4 + h], ig = P.IG[(size_t)(r0 + t) * 4 + h];
            bc += lf; const float x = ig - bc; pm = fmaxf(pm, x); const float y = fmaxf(m0, pm); mt = bc + y; xv[t] = x;
            gsx[t] = x; gsy[t] = y; gwi[t] = __expf(m0 - y); gem[t] = __expf(-mt); }
        const float mnew = mt;
#pragma unroll
        for (int t = 0; t < 8; ++t) gwe[t] = __expf(bc + xv[t] - mnew);
        gsc[0] = __expf(bc + m0 - mnew); gsc[1] = mnew;
    }
    { const int t = tid >> 6, e = 2 * (tid & 63); const bf16_t* zr = P.Z + (size_t)(r0 + t) * ZLD + h * 128 + e;
      const unsigned qw = *(const unsigned*)(zr + ZQ), kw = *(const unsigned*)(zr + ZK), vw = *(const unsigned*)(zr + ZV);
      ql[t * 128 + e] = bf_lo(qw); ql[t * 128 + e + 1] = bf_hi(qw); kl[t * 128 + e] = bf_lo(kw); kl[t * 128 + e + 1] = bf_hi(kw); vl[t * 128 + e] = bf_lo(vw); vl[t * 128 + e + 1] = bf_hi(vw); }
    { const int t = w;
      const u32x4 raw = *(const u32x4*)(P.Z + (size_t)(r0 + t) * ZLD + ZVG + 8 * lane);
      float x[8]; unpack8(raw, x);
      float s = ((x[0] + x[1]) + (x[2] + x[3])) + ((x[4] + x[5]) + (x[6] + x[7]));
      const float mean = wave_sum(s) * (1.0f / 512.0f); float q2 = 0.f;
#pragma unroll
      for (int e = 0; e < 8; ++e) { x[e] -= mean; q2 += x[e] * x[e]; }
      const float rstd = 1.0f / sqrtf(wave_sum(q2) * (1.0f / 512.0f) + EPS);
      if ((lane >> 4) == h) { const f32x4 a = *(const f32x4*)(P.lng + 8 * lane), a2 = *(const f32x4*)(P.lng + 8 * lane + 4), c0 = *(const f32x4*)(P.lnb + 8 * lane), c1 = *(const f32x4*)(P.lnb + 8 * lane + 4);
#pragma unroll
          for (int e = 0; e < 4; ++e) { x[e] = x[e] * rstd * a[e] + c0[e]; x[4 + e] = x[4 + e] * rstd * a2[e] + c1[e]; }
          float* vo = P.oVs + ((size_t)b * 8 + t) * 512 + 8 * lane; *(f32x4*)vo = (f32x4){x[0], x[1], x[2], x[3]}; *(f32x4*)(vo + 4) = (f32x4){x[4], x[5], x[6], x[7]};
#pragma unroll
          for (int e = 0; e < 8; ++e) vnl[t * 128 + 8 * (lane & 15) + e] = x[e]; } }
    __syncthreads();
    if (tid < 64) { const int t = tid >> 3, s = tid & 7; float dot = 0.f;
        for (int d = 0; d < 128; ++d) dot += ql[t * 128 + d] * kl[s * 128 + d];
        Sl[tid] = (s <= t) ? dot * __expf(gsx[s] - gsy[t]) : 0.f; }
    else if (tid < 72) { const int t = tid - 64; float dot = 0.f; for (int d = 0; d < 128; ++d) dot += ql[t * 128 + d] * P.stN[bh * 128 + d]; qn[t] = dot; }
    { const int t = w, e = 2 * lane; float s0 = 0.f, s1 = 0.f;
      for (int j = 0; j <= t; ++j) { const float wv = P.gm_ws[(size_t)h * 16384 + t * 128 + j]; s0 += wv * vnl[j * 128 + e]; s1 += wv * vnl[j * 128 + e + 1]; }
      const float bsv = P.bs[h * 128 + t]; const unsigned uw = *(const unsigned*)(P.Z + (size_t)(r0 + t) * ZLD + ZU + h * 128 + e);
      *(unsigned*)(P.YC + (size_t)(r0 + t) * 1024 + h * 128 + e) = cvt_pk_bf16(bf_lo(uw) * (s0 + bsv), bf_hi(uw) * (s1 + bsv)); }
    const float dec = gsc[0];
    { const int eg = tid & 31, dq = tid >> 5;
      f32x4 aq[8];
#pragma unroll
      for (int t = 0; t < 8; ++t) aq[t] = (f32x4){0.f, 0.f, 0.f, 0.f};
      f32x4 v4[8];
#pragma unroll
      for (int s = 0; s < 8; ++s) v4[s] = *(LAS const f32x4*)(vl + s * 128 + 4 * eg);
      float* co = P.oCs + (size_t)bh * 16384;
#pragma unroll
      for (int i = 0; i < 8; ++i) { const int d = dq + 16 * i; const f32x4 cv = cvv[i];
          f32x4 cn = dec * cv;
#pragma unroll
          for (int t = 0; t < 8; ++t) { aq[t] += ql[t * 128 + d] * cv; cn += (gwe[t] * kl[t * 128 + d]) * v4[t]; }
          *(f32x4*)(co + d * 128 + 4 * eg) = cn; }
#pragma unroll
      for (int t = 0; t < 8; ++t) *(LAS f32x4*)(red + (dq * 8 + t) * 128 + 4 * eg) = aq[t]; }
    __syncthreads();
    { const int t = w, e = 2 * lane; float qc0 = 0.f, qc1 = 0.f;
#pragma unroll
      for (int dq = 0; dq < 16; ++dq) { qc0 += red[(dq * 8 + t) * 128 + e]; qc1 += red[(dq * 8 + t) * 128 + e + 1]; }
      float n0 = 0.f, n1 = 0.f, dsum = 0.f;
#pragma unroll
      for (int s = 0; s < 8; ++s) { const float sv = Sl[t * 8 + s]; n0 += sv * vl[s * 128 + e]; n1 += sv * vl[s * 128 + e + 1]; dsum += sv; }
      const float wi = gwi[t], den = dsum + wi * qn[t], rinv = 1.0f / fmaxf(fabsf(den), gem[t]);
      const float h0 = (n0 + wi * qc0) * rinv, h1 = (n1 + wi * qc1) * rinv;
      const float rn = 1.0f / sqrtf(wave_sum(h0 * h0 + h1 * h1) * (1.0f / 128.0f) + EPS);
      const unsigned ow = *(const unsigned*)(P.Z + (size_t)(r0 + t) * ZLD + ZO + h * 128 + e);
      *(unsigned*)(P.YC + (size_t)(r0 + t) * 1024 + 512 + h * 128 + e) = cvt_pk_bf16(bf_lo(ow) * h0 * rn * P.mlnorm[h * 128 + e], bf_hi(ow) * h1 * rn * P.mlnorm[h * 128 + e + 1]); }
    if (tid < 128) { float nn = dec * P.stN[bh * 128 + tid];
#pragma unroll
        for (int s = 0; s < 8; ++s) nn += gwe[s] * kl[s * 128 + tid];
        P.oNs[bh * 128 + tid] = nn; if (tid == 0) P.oMs[bh] = gsc[1]; }
    __syncthreads();
}
}
namespace sg {
using pg8::bf16_t; using pg8::bf16x8; using pg8::f32x4; using pg8::u32x4; using pg8::u32x2; using pg8::cvt_pk_bf16; using pg8::bf_lo; using pg8::bf_hi; using pg8::sigmoid_f; using pg8::gelu_tanh_f; using pg8::row_rs; using pg8::pair8;
constexpr int ROW0 = 16384;

struct Epi { bf16_t* O; int ldc; const float* rn; const bf16_t* Hb; bf16_t* Ho; float* SSO; const float* SSI; const bf16_t* PROJ; };

template <int MODE> __device__ __forceinline__ void epilogue(const Epi& E, int lrow, int ct, int kq, f32x4 (&acc)[4]) {
    const int row = ROW0 + lrow;
    float rs = 1.f;
    if (MODE == 3) rs = E.rn[row];
    if (MODE == 4) { rs = row_rs(E.SSI, row); rs = rs * rs; }
    if (MODE == 5) rs = row_rs(E.SSI, row);
    float sq = 0.f;
#pragma unroll
    for (int g = 0; g < 2; ++g) { const int col = 64 * ct + 32 * g + 16 * (kq & 1) + 8 * (kq >> 1); float v[8]; pair8(acc[2 * g], acc[2 * g + 1], v);
        if (MODE == 0) {
            if (col < 1024) {
#pragma unroll
                for (int e = 0; e < 8; ++e) v[e] = gelu_tanh_f(v[e]); }
            else if (col >= 2560) {
#pragma unroll
                for (int e = 0; e < 8; ++e) v[e] = sigmoid_f(v[e]); }
        }
        if (MODE == 2) {
#pragma unroll
            for (int e = 0; e < 8; ++e) { const float a = fmaxf(v[e], 0.f); v[e] = a * a; } }
        if (MODE <= 2) { u32x4 w; w.x = cvt_pk_bf16(v[0], v[1]); w.y = cvt_pk_bf16(v[2], v[3]); w.z = cvt_pk_bf16(v[4], v[5]); w.w = cvt_pk_bf16(v[6], v[7]); *(u32x4*)(E.O + (size_t)row * E.ldc + col) = w; continue; }
        const size_t off = (size_t)row * 1024 + col;
        const u32x4 hw = *(const u32x4*)(E.Hb + off); const float r[8] = {bf_lo(hw.x), bf_hi(hw.x), bf_lo(hw.y), bf_hi(hw.y), bf_lo(hw.z), bf_hi(hw.z), bf_lo(hw.w), bf_hi(hw.w)};
        if (MODE == 3) {
#pragma unroll
            for (int e = 0; e < 8; ++e) v[e] = r[e] * rs + v[e]; }
        else if (MODE == 4) {
#pragma unroll
            for (int e = 0; e < 8; ++e) v[e] = r[e] + v[e] * rs; }
        else { const u32x4 pw = *(const u32x4*)(E.PROJ + off); const float pr[8] = {bf_lo(pw.x), bf_hi(pw.x), bf_lo(pw.y), bf_hi(pw.y), bf_lo(pw.z), bf_hi(pw.z), bf_lo(pw.w), bf_hi(pw.w)};
#pragma unroll
            for (int e = 0; e < 8; ++e) v[e] = r[e] + sigmoid_f(v[e] * rs) * pr[e]; }
        { u32x4 w; w.x = cvt_pk_bf16(v[0], v[1]); w.y = cvt_pk_bf16(v[2], v[3]); w.z = cvt_pk_bf16(v[4], v[5]); w.w = cvt_pk_bf16(v[6], v[7]); *(u32x4*)(E.Ho + off) = w; }
#pragma unroll
        for (int e = 0; e < 8; ++e) sq += v[e] * v[e]; }
    if (MODE >= 3) { sq += __shfl_xor(sq, 16); sq += __shfl_xor(sq, 32); if (kq == 0) E.SSO[(size_t)row * 16 + ct] = sq; }
}

constexpr int KT = 128;
__device__ __forceinline__ int toff(int row, int ch) { return (row << 8) + ((ch ^ (row & 15)) << 4); }
struct Issue { int u, kt, left; };
__device__ __forceinline__ void issue_tile(LAS unsigned char* st, Issue& I, const bf16_t* A, const bf16_t* Bt, int K, int nkt, int G, int w, int lane) {
    if (I.left > 0) {
        const bf16_t* ab = A + (size_t)(64 * (I.u & 15)) * K + I.kt * KT; const bf16_t* bb = Bt + (size_t)(64 * (I.u >> 4)) * K + I.kt * KT;
#pragma unroll
        for (int jj = 0; jj < 2; ++jj) { const int j = 2 * w + jj, row = 4 * j + (lane >> 4), ch = (lane & 15) ^ (row & 15);
            __builtin_amdgcn_global_load_lds((const unsigned*)(ab + (size_t)row * K + ch * 8), (LAS unsigned*)(st + j * 1024), 16, 0, 0);
            __builtin_amdgcn_global_load_lds((const unsigned*)(bb + (size_t)row * K + ch * 8), (LAS unsigned*)(st + 16384 + j * 1024), 16, 0, 0); }
        --I.left; if (++I.kt == nkt) { I.kt = 0; I.u += G; }
    } else {
#pragma unroll
        for (int jj = 0; jj < 2; ++jj) { const int j = 2 * w + jj, row = 4 * j + (lane >> 4), ch = (lane & 15) ^ (row & 15);
            __builtin_amdgcn_global_load_lds((const unsigned*)(A + (size_t)row * K + ch * 8), (LAS unsigned*)(st + j * 1024), 16, 0, 0);
            __builtin_amdgcn_global_load_lds((const unsigned*)(Bt + (size_t)row * K + ch * 8), (LAS unsigned*)(st + 16384 + j * 1024), 16, 0, 0); }
    }
}
template <int MODE> __device__ __forceinline__ void phase(LAS unsigned char* lds, const bf16_t* A0, const bf16_t* Bt, int K, int N, const Epi& E, int vcu, int G, int tid) {
    const int lane = tid & 63, w = __builtin_amdgcn_readfirstlane(tid >> 6), fr = lane & 15, kq = lane >> 4, wm = w & 3, wk = w >> 2;
    const bf16_t* A = A0 + (size_t)ROW0 * K;
    const int nu = 16 * (N >> 6), nkt = K / KT;
    if (vcu >= nu) return;
    const int nmine = (nu - vcu + G - 1) / G, total = nmine * nkt;
    f32x4 acc[4];
#pragma unroll
    for (int n = 0; n < 4; ++n) acc[n] = (f32x4){0.f, 0.f, 0.f, 0.f};
    Issue I{vcu, 0, total};
    issue_tile(lds, I, A, Bt, K, nkt, G, w, lane); issue_tile(lds + 32768, I, A, Bt, K, nkt, G, w, lane); issue_tile(lds + 65536, I, A, Bt, K, nkt, G, w, lane);
    int kt = 0, u = vcu;
    for (int i = 0; i < total; ++i) {
        asm volatile("s_waitcnt vmcnt(8)" ::: "memory");
        __builtin_amdgcn_s_barrier();
        asm volatile("" ::: "memory");
        issue_tile(lds + ((i + 3) & 3) * 32768, I, A, Bt, K, nkt, G, w, lane);
        { LAS const unsigned char* st = lds + (i & 3) * 32768;
#pragma unroll
          for (int ks = 0; ks < 2; ++ks) { const int ch = 4 * (2 * wk + ks) + kq;
              const bf16x8 af = *(LAS const bf16x8*)(st + toff(16 * wm + fr, ch));
#pragma unroll
              for (int n = 0; n < 4; ++n) { const bf16x8 bf = *(LAS const bf16x8*)(st + 16384 + toff(16 * n + fr, ch));
                  acc[n] = __builtin_amdgcn_mfma_f32_16x16x32_bf16(bf, af, acc[n], 0, 0, 0); } } }
        if (kt + 1 == nkt) {
            LAS f32x4* xch = (LAS f32x4*)(lds + 131072) + (wm * 64 + lane) * 4;
            if (wk == 1) {
#pragma unroll
                for (int n = 0; n < 4; ++n) { xch[n] = acc[n]; acc[n] = (f32x4){0.f, 0.f, 0.f, 0.f}; } }
            asm volatile("s_waitcnt lgkmcnt(0)" ::: "memory"); __builtin_amdgcn_s_barrier(); asm volatile("" ::: "memory");
            if (wk == 0) {
#pragma unroll
                for (int n = 0; n < 4; ++n) acc[n] += xch[n];
                epilogue<MODE>(E, 64 * (u & 15) + 16 * wm + fr, u >> 4, kq, acc);
#pragma unroll
                for (int n = 0; n < 4; ++n) acc[n] = (f32x4){0.f, 0.f, 0.f, 0.f}; }
            kt = 0; u += G;
        } else ++kt;
    }
    asm volatile("s_waitcnt vmcnt(0) lgkmcnt(0)" ::: "memory"); __builtin_amdgcn_s_barrier(); asm volatile("" ::: "memory");
}

__device__ __forceinline__ int toff128(int row, int ch) { return (row << 7) + ((ch ^ ((row >> 1) & 7)) << 4); }
__device__ __forceinline__ void issue_tile128(LAS unsigned char* st, Issue& I, const bf16_t* A, const bf16_t* Bt, int K, int nkt, int G, int w, int lane) {
    const bool live = I.left > 0;
    const bf16_t* ab = live ? A + (size_t)(128 * (I.u & 7)) * K + I.kt * 64 : A; const bf16_t* bb = live ? Bt + (size_t)(128 * (I.u >> 3)) * K + I.kt * 64 : Bt;
#pragma unroll
    for (int jj = 0; jj < 2; ++jj) { const int j = 2 * w + jj, row = 8 * j + (lane >> 3), ch = (lane & 7) ^ ((row >> 1) & 7);
        __builtin_amdgcn_global_load_lds((const unsigned*)(ab + (size_t)row * K + ch * 8), (LAS unsigned*)(st + j * 1024), 16, 0, 0);
        __builtin_amdgcn_global_load_lds((const unsigned*)(bb + (size_t)row * K + ch * 8), (LAS unsigned*)(st + 16384 + j * 1024), 16, 0, 0); }
    if (live) { --I.left; if (++I.kt == nkt) { I.kt = 0; I.u += G; } }
}
template <int MODE> __device__ __forceinline__ void phase128(LAS unsigned char* lds, const bf16_t* A0, const bf16_t* Bt, int K, int N, const Epi& E, int vcu, int G, int tid) {
    static_assert(MODE == 0 || MODE == 2, "phase128: bf16-store epilogues only");
    const int lane = tid & 63, w = __builtin_amdgcn_readfirstlane(tid >> 6), fr = lane & 15, kq = lane >> 4, wm = w >> 2, wn = w & 3;
    const bf16_t* A = A0 + (size_t)ROW0 * K;
    const int nu = 8 * (N >> 7), nkt = K / 64;
    if (vcu >= nu) return;
    const int nmine = (nu - vcu + G - 1) / G, total = nmine * nkt;
    f32x4 acc[4][2];
#pragma unroll
    for (int m = 0; m < 4; ++m) { acc[m][0] = (f32x4){0.f, 0.f, 0.f, 0.f}; acc[m][1] = (f32x4){0.f, 0.f, 0.f, 0.f}; }
    Issue I{vcu, 0, total};
    issue_tile128(lds, I, A, Bt, K, nkt, G, w, lane); issue_tile128(lds + 32768, I, A, Bt, K, nkt, G, w, lane); issue_tile128(lds + 65536, I, A, Bt, K, nkt, G, w, lane);
    int kt = 0, u = vcu;
    for (int i = 0; i < total; ++i) {
        asm volatile("s_waitcnt vmcnt(8)" ::: "memory");
        __builtin_amdgcn_s_barrier();
        asm volatile("" ::: "memory");
        issue_tile128(lds + ((i + 3) & 3) * 32768, I, A, Bt, K, nkt, G, w, lane);
        { LAS const unsigned char* st = lds + (i & 3) * 32768;
#pragma unroll
          for (int ks = 0; ks < 2; ++ks) { const int ch = 4 * ks + kq;
              const bf16x8 b0 = *(LAS const bf16x8*)(st + 16384 + toff128(32 * wn + fr, ch)), b1 = *(LAS const bf16x8*)(st + 16384 + toff128(32 * wn + 16 + fr, ch));
#pragma unroll
              for (int m = 0; m < 4; ++m) { const bf16x8 af = *(LAS const bf16x8*)(st + toff128(64 * wm + 16 * m + fr, ch));
                  acc[m][0] = __builtin_amdgcn_mfma_f32_16x16x32_bf16(b0, af, acc[m][0], 0, 0, 0); acc[m][1] = __builtin_amdgcn_mfma_f32_16x16x32_bf16(b1, af, acc[m][1], 0, 0, 0); } } }
        if (kt + 1 == nkt) {
            const int rt = u & 7, ct = u >> 3;
#pragma unroll
            for (int m = 0; m < 4; ++m) { const int row = ROW0 + 128 * rt + 64 * wm + 16 * m + fr;
                { const int col = 128 * ct + 32 * wn + 16 * (kq & 1) + 8 * (kq >> 1); float v[8]; pair8(acc[m][0], acc[m][1], v);
                    if (MODE == 0) {
                        if (col < 1024) {
#pragma unroll
                            for (int e = 0; e < 8; ++e) v[e] = gelu_tanh_f(v[e]); }
                        else if (col >= 2560) {
#pragma unroll
                            for (int e = 0; e < 8; ++e) v[e] = sigmoid_f(v[e]); } }
                    if (MODE == 2) {
#pragma unroll
                        for (int e = 0; e < 8; ++e) { const float a = fmaxf(v[e], 0.f); v[e] = a * a; } }
                    u32x4 o; o.x = cvt_pk_bf16(v[0], v[1]); o.y = cvt_pk_bf16(v[2], v[3]); o.z = cvt_pk_bf16(v[4], v[5]); o.w = cvt_pk_bf16(v[6], v[7]); *(u32x4*)(E.O + (size_t)row * E.ldc + col) = o;
                    acc[m][0] = (f32x4){0.f, 0.f, 0.f, 0.f}; acc[m][1] = (f32x4){0.f, 0.f, 0.f, 0.f}; } }
            kt = 0; u += G;
        } else ++kt;
    }
    asm volatile("s_waitcnt vmcnt(0) lgkmcnt(0)" ::: "memory"); __builtin_amdgcn_s_barrier(); asm volatile("" ::: "memory");
}
}

#ifndef HOST_DUP_PHASE
#define HOST_DUP_PHASE -1
#endif
#ifndef TP_A
#define TP_A -1
#define TP_B -1
#endif
#ifndef HOST_DUP_FLAGS
#define HOST_DUP_FLAGS 1
#endif
#ifndef HOST_EXTRA_BARS
#define HOST_EXTRA_BARS 0
#endif
#ifndef MK_ONE_LAUNCH
#define MK_ONE_LAUNCH 1
#endif
constexpr int NWAVES = 8;
constexpr int D = 1024, NPR = 16384, NSR = 1024, M = NPR + NSR, NIN = 3072, INC = 3080, FF = 4096, PLE = 256;
constexpr int N_PHASES = 10;
constexpr size_t MiB = 1u << 20;
constexpr size_t WS_CTL = 0, CTL_ZERO_BYTES = 65536;
constexpr int CW_BAR = 1024;
constexpr size_t WS_WIN = 1 * MiB;
constexpr size_t WS_WOUT = WS_WIN + (size_t)NIN * D * 2;
constexpr size_t WS_WUP = WS_WOUT + (size_t)D * D * 2;
constexpr size_t WS_WDOWN = WS_WUP + (size_t)FF * D * 2;
constexpr size_t WS_WGATE = WS_WDOWN + (size_t)D * FF * 2;
constexpr size_t WS_WPROJ = WS_WGATE + (size_t)D * D * 2;
constexpr size_t WS_WSB = WS_WPROJ + (size_t)D * PLE * 2;
constexpr size_t WS_IG = WS_WSB + 4 * 128 * 128 * 2;
constexpr size_t WS_LF = WS_IG + (size_t)M * 16;
constexpr size_t WS_SS1 = WS_LF + (size_t)M * 16;
constexpr size_t WS_SS2 = WS_SS1 + (size_t)M * 64;
constexpr size_t WS_SS3 = WS_SS2 + (size_t)M * 64;
constexpr size_t WS_CH = WS_SS3 + (size_t)M * 64;
constexpr size_t WS_MST = WS_CH + 4096;
constexpr size_t WS_NLOC = WS_MST + 4096;
constexpr size_t WS_NST = WS_NLOC + 512 * 128 * 4;
constexpr size_t WS_RN = WS_NST + 512 * 128 * 4;
constexpr size_t WS_LNS = WS_RN + 69632;
constexpr size_t WS_PE = WS_LNS + (size_t)16384 * 64;
constexpr size_t WS_RA = WS_PE + (size_t)M * PLE * 2;
constexpr size_t WS_RB = WS_RA + (size_t)M * D * 2;
constexpr size_t WS_YC = WS_RB + (size_t)M * NIN * 2;
constexpr size_t WS_KV = WS_RB + (size_t)M * FF * 2;
constexpr size_t WS_END = WS_KV + (size_t)M * D * 2;
static_assert(WS_END <= 256 * MiB, "d_ws map");
static_assert(WS_WIN % 256 == 0 && WS_IG % 256 == 0 && WS_PE % 256 == 0 && WS_RA % 256 == 0 && WS_RB % 256 == 0 && WS_YC % 256 == 0 && WS_KV % 256 == 0, "alignment");
constexpr size_t O_Y = 0, O_CP = (size_t)M * D, O_NP = O_CP + 8 * 4 * 16384, O_MP = O_NP + 8 * 4 * 128, O_VP = O_MP + 32, O_CS = O_VP + 8 * 128 * 512,
                 O_NS = O_CS + (size_t)128 * 4 * 16384, O_MS = O_NS + 128 * 4 * 128, O_VS = O_MS + 512, O_END = O_VS + 128 * 8 * 512;
constexpr int RING_OFF = 0, RING_BYTES = 131072, XCH_BYTES = 16384, LDSCTL_OFF = RING_BYTES + XCH_BYTES, MISC_OFF = LDSCTL_OFF + 320, LDS_BYTES = LDSCTL_OFF + 1024;

typedef unsigned short bf16;
typedef unsigned v4u __attribute__((ext_vector_type(4)));
typedef float f32x4 __attribute__((ext_vector_type(4)));
#define GAS __attribute__((address_space(1)))
typedef GAS unsigned gu32;
#define RLX_AGENT __ATOMIC_RELAXED, __HIP_MEMORY_SCOPE_AGENT
#define LDS_WAIT() asm volatile("s_waitcnt lgkmcnt(0)" ::: "memory")

struct Args { const float* in[24]; float* out; unsigned char* ws; int ph_lo, ph_hi, flags, extra_bars; };

#define XB_TMO      128
#define XB_XCNT(j)  (256  + 64 * (j))
#define XB_XSUB(j)  (1280 + 64 * (j))
#define XB_XGEN(j)  (2304 + 64 * (j))
#define XB_TOP      3328
#define XB_TOPGEN   3392
#define XCD_BAR_WORDS 3456
#define XB_SPIN_CAP (1u << 18)

__device__ __forceinline__ unsigned xb_ld(unsigned* p)              { return __hip_atomic_load(p, __ATOMIC_RELAXED, __HIP_MEMORY_SCOPE_AGENT); }
__device__ __forceinline__ unsigned xb_add(unsigned* p, unsigned v) { return __hip_atomic_fetch_add(p, v, __ATOMIC_RELAXED, __HIP_MEMORY_SCOPE_AGENT); }
__device__ __forceinline__ unsigned xb_xcc_id() { return (unsigned)__builtin_amdgcn_s_getreg((3 << 11) | 20) & 0xFu; }
#define XB_SPIN(cond, bar) do { unsigned _sp = 0; while (cond) { __builtin_amdgcn_s_sleep(1); \
    if ((++_sp & 255u) == 0u) { if (xb_ld(&(bar)[XB_TMO])) break; if (_sp > XB_SPIN_CAP) { atomicAdd(&(bar)[XB_TMO], 1u); break; } } } } while (0)

struct XcdBarrier {
    unsigned* bar; unsigned x;
    volatile LAS unsigned* st;
};

__device__ __forceinline__ XcdBarrier xcd_barrier_post(unsigned* bar, volatile LAS unsigned* st) {
    XcdBarrier b; b.bar = bar; b.x = xb_xcc_id(); b.st = st;
    if (threadIdx.x == 0) (void)xb_add(&bar[XB_XCNT(b.x)], 1u);
    return b;
}
__device__ __forceinline__ void xcd_barrier_complete(unsigned* bar, unsigned x, unsigned& nloc, unsigned& nx) {
    const unsigned G = gridDim.x * gridDim.y * gridDim.z;
    unsigned sum, cnt, mine, sp = 0u;
    for (;;) {
        sum = 0u; cnt = 0u; mine = 0u;
#pragma unroll
        for (unsigned j = 0; j < 16; ++j) { const unsigned c = xb_ld(&bar[XB_XCNT(j)]); sum += c; cnt += (c > 0u) ? 1u : 0u; mine = (j == x) ? c : mine; }
        if (sum == G) break;
        __builtin_amdgcn_s_sleep(1);
        if ((++sp & 255u) == 0u) { if (xb_ld(&bar[XB_TMO])) break; if (sp > XB_SPIN_CAP) { atomicAdd(&bar[XB_TMO], 1u); break; } }
    }
    nloc = mine > 0u ? mine : 1u; nx = cnt > 0u ? cnt : 1u;
}

__device__ __forceinline__ void xcd_barrier(const XcdBarrier& b) {
    asm volatile("s_waitcnt vmcnt(0)" ::: "memory");
    __syncthreads();
    if (threadIdx.x == 0) {
        unsigned* bar = b.bar;
        __builtin_amdgcn_s_waitcnt(0);
        unsigned nloc = b.st[0], nx = b.st[1];
        if (nloc == 0u) { xcd_barrier_complete(bar, b.x, nloc, nx); b.st[0] = nloc; b.st[1] = nx; }
        const unsigned old = xb_add(&bar[XB_XSUB(b.x)], 1u);
        const unsigned gen = old / nloc;
        if (old + 1u == (gen + 1u) * nloc) {
            __builtin_amdgcn_fence(__ATOMIC_RELEASE, "agent");
            asm volatile("s_waitcnt vmcnt(0)" ::: "memory");
            const unsigned og = xb_add(&bar[XB_TOP], 1u);
            const unsigned tg = og / nx;
            if (og + 1u == (tg + 1u) * nx) xb_add(&bar[XB_TOPGEN], 1u);
            else XB_SPIN(xb_ld(&bar[XB_TOPGEN]) == tg, bar);
            __builtin_amdgcn_fence(__ATOMIC_ACQUIRE, "agent");
            xb_add(&bar[XB_XGEN(b.x)], 1u);
            asm volatile("s_waitcnt vmcnt(0)" ::: "memory");
        } else {
            XB_SPIN(xb_ld(&bar[XB_XGEN(b.x)]) == gen, bar);
            __builtin_amdgcn_fence(__ATOMIC_ACQUIRE, "agent");
            asm volatile("s_waitcnt vmcnt(0)" ::: "memory");
        }
    }
    __syncthreads();
}

__device__ __forceinline__ void p0_transpose_item(const float* W, int ldw, int K, int N, const float* gain, bf16* WT, LAS float* scr, int item, int lane, bool kscale) {
    const int nblk = N / 32, kb = item / nblk, nb = item % nblk, k0 = 64 * kb, n0 = 32 * nb;
    const float cs = (kscale && n0 >= 1536 && n0 < 2048) ? 0.08838834764831845f : 1.0f;
    float wv[32];
#pragma unroll
    for (int i = 0; i < 32; ++i) { const int kk = 2 * i + (lane >> 5); wv[i] = W[(size_t)(k0 + kk) * ldw + n0 + (lane & 31)]; }
#pragma unroll
    for (int i = 0; i < 32; ++i) { const int kk = 2 * i + (lane >> 5); const float g = gain ? gain[k0 + kk] * cs : cs; scr[kk * 33 + (lane & 31)] = wv[i] * g; }
    LDS_WAIT(); asm volatile("" ::: "memory");
    const int c = lane & 7;
#pragma unroll
    for (int j = 0; j < 4; ++j) { const int n = (lane >> 3) + 8 * j; const LAS float* s = scr + (8 * c) * 33 + n;
        v4u o; o.x = pg8::cvt_pk_bf16(s[0 * 33], s[1 * 33]); o.y = pg8::cvt_pk_bf16(s[2 * 33], s[3 * 33]); o.z = pg8::cvt_pk_bf16(s[4 * 33], s[5 * 33]); o.w = pg8::cvt_pk_bf16(s[6 * 33], s[7 * 33]);
        *(v4u*)(WT + (size_t)(n0 + n) * K + k0 + 8 * c) = o; }
    LDS_WAIT(); asm volatile("" ::: "memory");
}

__device__ __forceinline__ float log_sigmoid_f(float x) { return fminf(x, 0.f) - log1pf(__expf(-fabsf(x))); }

struct RowIn { f32x4 v[4]; f32x4 pv; };
__device__ __forceinline__ void p0_row_load(const Args& A, int m, int lane, RowIn& R) {
    const float* xrow = (m < NPR) ? A.in[0] + (size_t)m * D : A.in[1] + (size_t)(m - NPR) * D;
    const float* prow = (m < NPR) ? A.in[2] + (size_t)m * PLE : A.in[3] + (size_t)(m - NPR) * PLE;
    const f32x4* xr = (const f32x4*)xrow + lane;
#pragma unroll
    for (int j = 0; j < 4; ++j) R.v[j] = xr[64 * j];
    R.pv = *((const f32x4*)prow + lane);
}
__device__ __forceinline__ void p0_row_finish(unsigned char* ws, int m, int lane, RowIn& R, const float (&gwt)[4][4][8], float gbias) {
    float s = 0.f;
#pragma unroll
    for (int j = 0; j < 4; ++j) s += (R.v[j][0] * R.v[j][0] + R.v[j][1] * R.v[j][1]) + (R.v[j][2] * R.v[j][2] + R.v[j][3] * R.v[j][3]);
    const float rnv = sqrtf(mix::wave_sum(s) * (1.0f / D) + 1e-6f), rinv = 1.0f / rnv;
    if (lane == 8) ((float*)(ws + WS_RN))[m] = rnv;
    unsigned long long* o8 = (unsigned long long*)((bf16*)(ws + WS_RA) + (size_t)m * D) + lane;
    float g8[8];
#pragma unroll
    for (int q = 0; q < 8; ++q) g8[q] = 0.f;
#pragma unroll
    for (int j = 0; j < 4; ++j) { const f32x4 v = R.v[j] * rinv;
        o8[64 * j] = (unsigned long long)pg8::cvt_pk_bf16(v[0], v[1]) | ((unsigned long long)pg8::cvt_pk_bf16(v[2], v[3]) << 32);
#pragma unroll
        for (int c = 0; c < 4; ++c)
#pragma unroll
            for (int q = 0; q < 8; ++q) g8[q] += v[c] * gwt[j][c][q]; }
#pragma unroll
    for (int q = 0; q < 8; ++q) g8[q] = mix::row_sum16(g8[q]);
    const int q8 = lane & 7;
    float val = q8 == 0 ? g8[0] : q8 == 1 ? g8[1] : q8 == 2 ? g8[2] : q8 == 3 ? g8[3] : q8 == 4 ? g8[4] : q8 == 5 ? g8[5] : q8 == 6 ? g8[6] : g8[7];
    val += __shfl_xor(val, 16); val += __shfl_xor(val, 32);
    if (lane < 4) ((float*)(ws + WS_IG))[(size_t)m * 4 + lane] = val + gbias;
    else if (lane < 8) ((float*)(ws + WS_LF))[(size_t)m * 4 + lane - 4] = log_sigmoid_f(val + gbias);
    *((unsigned long long*)((bf16*)(ws + WS_PE) + (size_t)m * PLE) + lane) = (unsigned long long)pg8::cvt_pk_bf16(R.pv[0], R.pv[1]) | ((unsigned long long)pg8::cvt_pk_bf16(R.pv[2], R.pv[3]) << 32);
}

__device__ __forceinline__ void p0_prologue(const Args& A, LAS unsigned char* lds, int vcu, int G, int tid) {
    const int lane = tid & 63, wave = __builtin_amdgcn_readfirstlane(tid >> 6);
    unsigned char* ws = A.ws;
    LAS float* scr = (LAS float*)(lds + RING_OFF + wave * 8704);
    LAS float* gtab = (LAS float*)(lds + RING_OFF + 8 * 8704);
    const int gw = vcu * NWAVES + wave, NGW = G * NWAVES;
    for (int k = tid; k < D; k += NWAVES * 64) { const float g = A.in[7][k]; const float* wp = A.in[8] + (size_t)k * INC + NIN;
        const f32x4 a = *(const f32x4*)wp, b = *(const f32x4*)(wp + 4); *(LAS f32x4*)(gtab + k * 8) = a * g; *(LAS f32x4*)(gtab + k * 8 + 4) = b * g; }
    constexpr int I_IN = (D / 64) * (NIN / 32), I_OUT = (D / 64) * (D / 32), I_UP = (D / 64) * (FF / 32), I_DOWN = (FF / 64) * (D / 32), I_GATE = I_OUT, I_PROJ = (PLE / 64) * (D / 32);
    constexpr int NITEMS = I_IN + I_OUT + I_UP + I_DOWN + I_GATE + I_PROJ;
    for (int it = gw; it < NITEMS; it += NGW) {
        int r = it;
        if (r < I_IN) { p0_transpose_item(A.in[8], INC, D, NIN, A.in[7], (bf16*)(ws + WS_WIN), scr, r, lane, true); continue; } r -= I_IN;
        if (r < I_OUT) { p0_transpose_item(A.in[16], D, D, D, nullptr, (bf16*)(ws + WS_WOUT), scr, r, lane, false); continue; } r -= I_OUT;
        if (r < I_UP) { p0_transpose_item(A.in[18], FF, D, FF, A.in[17], (bf16*)(ws + WS_WUP), scr, r, lane, false); continue; } r -= I_UP;
        if (r < I_DOWN) { p0_transpose_item(A.in[19], D, FF, D, nullptr, (bf16*)(ws + WS_WDOWN), scr, r, lane, false); continue; } r -= I_DOWN;
        if (r < I_GATE) { p0_transpose_item(A.in[21], D, D, D, A.in[20], (bf16*)(ws + WS_WGATE), scr, r, lane, false); continue; } r -= I_GATE;
        p0_transpose_item(A.in[22], D, PLE, D, nullptr, (bf16*)(ws + WS_WPROJ), scr, r, lane, false);
    }
    { const int gt = vcu * 512 + tid, NT = G * 512; const float* wsrc = A.in[11]; bf16* wdst = (bf16*)(ws + WS_WSB);
      for (int i = gt; i < 4 * 128 * 128 / 4; i += NT) { const int e = 4 * i, t = (e >> 7) & 127, j = e & 127; const f32x4 v = *(const f32x4*)(wsrc + e);
          pg8::u32x2 o; o.x = pg8::cvt_pk_bf16(j <= t ? v[0] : 0.f, j + 1 <= t ? v[1] : 0.f); o.y = pg8::cvt_pk_bf16(j + 2 <= t ? v[2] : 0.f, j + 3 <= t ? v[3] : 0.f);
          *(pg8::u32x2*)(wdst + e) = o; } }
    __syncthreads();
    float gwt[4][4][8];
#pragma unroll
    for (int j = 0; j < 4; ++j)
#pragma unroll
        for (int c = 0; c < 4; ++c) { const LAS float* gp = gtab + (4 * lane + 256 * j + c) * 8; const f32x4 a = *(const LAS f32x4*)gp, b = *(const LAS f32x4*)(gp + 4);
#pragma unroll
            for (int q = 0; q < 4; ++q) { gwt[j][c][q] = a[q]; gwt[j][c][4 + q] = b[q]; } }
    const float gbias = (lane < 4) ? A.in[13][lane & 3] : A.in[14][lane & 3];
    for (int m = gw; m < M; m += 2 * NGW) {
        const int m2 = (m + NGW < M) ? m + NGW : m;
        RowIn R0, R1; p0_row_load(A, m, lane, R0); p0_row_load(A, m2, lane, R1);
        p0_row_finish(ws, m, lane, R0, gwt, gbias);
        p0_row_finish(ws, m2, lane, R1, gwt, gbias);
    }
    __syncthreads();
}

__device__ __forceinline__ void p7_final(const Args& A, int vcu, int G, int tid) {
    const int lane = tid & 63, wave = __builtin_amdgcn_readfirstlane(tid >> 6);
    const int gw = vcu * NWAVES + wave, NGW = G * NWAVES;
    const float* ss = (const float*)(A.ws + WS_SS3); const bf16* Hb = (const bf16*)(A.ws + WS_RB);
    const f32x4 g0 = *((const f32x4*)A.in[23] + 2 * lane), g1 = *((const f32x4*)A.in[23] + 2 * lane + 1), g2 = *((const f32x4*)A.in[23] + 128 + 2 * lane), g3 = *((const f32x4*)A.in[23] + 128 + 2 * lane + 1);
    for (int m = gw; m < M; m += NGW) {
        const float rs = pg8::row_rs(ss, m);
        const v4u a = *((const v4u*)(Hb + (size_t)m * D) + lane), b = *((const v4u*)(Hb + (size_t)m * D) + 64 + lane);
        f32x4* yr = (f32x4*)(A.out + (size_t)m * D);
        yr[2 * lane] = (f32x4){pg8::bf_lo(a.x), pg8::bf_hi(a.x), pg8::bf_lo(a.y), pg8::bf_hi(a.y)} * rs * g0;
        yr[2 * lane + 1] = (f32x4){pg8::bf_lo(a.z), pg8::bf_hi(a.z), pg8::bf_lo(a.w), pg8::bf_hi(a.w)} * rs * g1;
        yr[128 + 2 * lane] = (f32x4){pg8::bf_lo(b.x), pg8::bf_hi(b.x), pg8::bf_lo(b.y), pg8::bf_hi(b.y)} * rs * g2;
        yr[128 + 2 * lane + 1] = (f32x4){pg8::bf_lo(b.z), pg8::bf_hi(b.z), pg8::bf_lo(b.w), pg8::bf_hi(b.w)} * rs * g3;
    }
}

__global__ void __launch_bounds__(NWAVES * 64, 2) hymba_fwd(Args args) {
    extern __shared__ __attribute__((aligned(16))) unsigned char lds_raw[];
    LAS unsigned char* lds = (LAS unsigned char*)lds_raw;
    const int tid = threadIdx.x, G = gridDim.x, bx = blockIdx.x;
    const int vcu = (G % 8 == 0) ? (bx % 8) * (G / 8) + bx / 8 : bx;
    unsigned char* ws = args.ws;
#ifndef DUP_PHASE
#define DUP_PHASE -1
#endif
    const int lo = args.ph_lo, hi = args.ph_hi;
#ifndef PH_MASK
#define PH_MASK 0xffff
#endif
#define INC_(k) (((PH_MASK >> (k)) & 1) && lo <= (k) && (k) < hi)
#if DUP_PHASE >= 0
#define IN(k) for (int rep_ = 0; rep_ < ((DUP_PHASE == (k)) ? 2 : 1); ++rep_) if (INC_(k))
#define GRID_BAR(k) do { if (INC_((k) + 1)) xcd_barrier(bar); } while (0)
#else
#define IN(k) if (INC_(k))
#define GRID_BAR(k) do { if (INC_((k) + 1)) xcd_barrier(bar); } while (0)
#endif
    for (int u = tid; u < (LDS_BYTES - LDSCTL_OFF) / 4; u += NWAVES * 64) ((LAS unsigned*)(lds + LDSCTL_OFF))[u] = 0u;
    __syncthreads();
    XcdBarrier bar = xcd_barrier_post((unsigned*)(ws + WS_CTL) + CW_BAR, (volatile LAS unsigned*)(lds + MISC_OFF) + 8);
    float* OUT = args.out;
    const int FL = args.flags;
#if TP_A >= 0
    unsigned long long tp_a = 0ull, tp_b = 0ull;
#define STAMP(id) do { if ((id) == TP_A || (id) == TP_B) { asm volatile("s_waitcnt vmcnt(0) lgkmcnt(0)" ::: "memory"); const unsigned long long t_ = __builtin_amdgcn_s_memrealtime(); if ((id) == TP_A) tp_a = t_; if ((id) == TP_B) tp_b = t_; } } while (0)
#else
#define STAMP(id) do { } while (0)
#endif
    bf16* RA = (bf16*)(ws + WS_RA); bf16* Zb = (bf16*)(ws + WS_RB); bf16* YC = (bf16*)(ws + WS_YC); bf16* HID = (bf16*)(ws + WS_RB); bf16* H3 = (bf16*)(ws + WS_RB);     bf16* PROJ = (bf16*)args.out;
    float* SS1 = (float*)(ws + WS_SS1); float* SS2 = (float*)(ws + WS_SS2); float* SS3 = (float*)(ws + WS_SS3);
    mix::MixP MP;
    MP.Z = Zb; MP.YC = YC; MP.IG = (const float*)(ws + WS_IG); MP.LF = (const float*)(ws + WS_LF); MP.LNS = (const float*)(ws + WS_LNS); MP.WSb = (const bf16*)(ws + WS_WSB);
    MP.gm_ws = args.in[11]; MP.lng = args.in[9]; MP.lnb = args.in[10]; MP.bs = args.in[12]; MP.mlnorm = args.in[15];
    MP.KV = (bf16*)(ws + WS_KV); MP.NLOC = (float*)(ws + WS_NLOC); MP.NST = (float*)(ws + WS_NST); MP.CH = (float*)(ws + WS_CH); MP.MST = (float*)(ws + WS_MST);
    MP.stC = args.in[4]; MP.stN = args.in[5]; MP.stM = args.in[6];
    MP.oCp = OUT + O_CP; MP.oNp = OUT + O_NP; MP.oMp = OUT + O_MP; MP.oVp = OUT + O_VP; MP.oCs = OUT + O_CS; MP.oNs = OUT + O_NS; MP.oMs = OUT + O_MS; MP.oVs = OUT + O_VS;

    STAMP(0);
    IN(0) { p0_prologue(args, lds, vcu, G, tid); STAMP(1); GRID_BAR(0); for (int eb = 0; eb < args.extra_bars; ++eb) xcd_barrier(bar); }
    STAMP(2);
    IN(1) {
        pg8::Gemm g{RA, (const bf16*)(ws + WS_WIN), NPR, NIN, D}; pg8::StaticOrder S; S.init(NPR, NIN, G, bx);
        pg8::EpiBf16<0> E{Zb, NIN, (float*)(ws + WS_LNS)};
        if (!(FL & 2)) pg8::gemm_phase<pg8::EpiBf16<0>, pg8::StaticOrder, true, true>(lds + RING_OFF, g, S, E);
        STAMP(3);
        if (!(FL & 4)) { const sg::Epi SE{Zb, NIN, nullptr, nullptr, nullptr, nullptr, nullptr, nullptr}; sg::phase128<0>(lds + RING_OFF, RA, (const bf16*)(ws + WS_WIN), D, NIN, SE, vcu, G, tid); }
        GRID_BAR(1);
    }
    STAMP(4);
    IN(2) {
        for (int u = vcu; u < 1024; u += G) {
            if (u < 512) { if (FL & 16) continue; const int bc = u >> 2, h = u & 3; mix::gmlp_unit(lds, MP, bc >> 4, bc & 15, h, tid); }
            else { if (FL & 32) continue; if (u == vcu + 512) STAMP(5); const int v = u - 512; mix::kv_unit(lds, MP, v >> 6, (v >> 4) & 3, v & 15, tid); }
        }
        GRID_BAR(2);
    }
    STAMP(6);
    IN(3) {
        if (!(FL & 1)) for (int u = vcu; u < 256; u += G) mix::scan_unit(MP, u >> 3, u & 7, tid);
        STAMP(7);
        if (!(FL & 64)) for (int u = vcu; u < 512; u += G) mix::sample_unit(lds, MP, u >> 2, u & 3, tid);
        STAMP(21);
        if (!(FL & 128)) { pg8::Gemm g{(const bf16*)(ws + WS_PE), (const bf16*)(ws + WS_WPROJ), NPR, D, PLE}; pg8::StaticOrder S; S.init(NPR, D, G, bx);
          pg8::EpiBf16<1> E{PROJ, D, nullptr};
          if (!(FL & 2)) pg8::gemm_phase<pg8::EpiBf16<1>, pg8::StaticOrder, true, true>(lds + RING_OFF, g, S, E);
          STAMP(22);
          const sg::Epi SE{PROJ, D, nullptr, nullptr, nullptr, nullptr, nullptr, nullptr}; if (!(FL & 4)) sg::phase<1>(lds + RING_OFF, (const bf16*)(ws + WS_PE), (const bf16*)(ws + WS_WPROJ), PLE, D, SE, vcu, G, tid); }
        GRID_BAR(3);
    }
    STAMP(8);
    IN(4) {
        for (int rep = 0; rep < ((FL & 256) ? 3 : 1); ++rep)
        for (int u = vcu; u < 512; u += G) mix::mlo_unit(lds, MP, u >> 6, (u >> 4) & 3, u & 15, tid);
        GRID_BAR(4);
    }
    STAMP(10);
    IN(5) {
        pg8::Gemm g{YC, (const bf16*)(ws + WS_WOUT), NPR, D, D}; pg8::StaticOrder S; S.init(NPR, D, G, bx);
        pg8::EpiRes<0> E{(const float*)(ws + WS_RN), RA, RA, SS1, nullptr, nullptr};
        if (!(FL & 2)) pg8::gemm_phase<pg8::EpiRes<0>, pg8::StaticOrder, true, true>(lds + RING_OFF, g, S, E);
        STAMP(11);
        if (!(FL & 4)) { const sg::Epi SE{nullptr, 0, (const float*)(ws + WS_RN), RA, RA, SS1, nullptr, nullptr}; sg::phase<3>(lds + RING_OFF, YC, (const bf16*)(ws + WS_WOUT), D, D, SE, vcu, G, tid); }
        GRID_BAR(5);
    }
    STAMP(12);
    IN(6) {
        pg8::Gemm g{RA, (const bf16*)(ws + WS_WUP), NPR, FF, D}; pg8::StaticOrder S; S.init(NPR, FF, G, bx);
        pg8::EpiBf16<2> E{HID, FF, nullptr};
        if (!(FL & 2)) pg8::gemm_phase<pg8::EpiBf16<2>, pg8::StaticOrder, true, true>(lds + RING_OFF, g, S, E);
        STAMP(13);
        if (!(FL & 4)) { const sg::Epi SE{HID, FF, nullptr, nullptr, nullptr, nullptr, nullptr, nullptr}; sg::phase128<2>(lds + RING_OFF, RA, (const bf16*)(ws + WS_WUP), D, FF, SE, vcu, G, tid); }
        GRID_BAR(6);
    }
    STAMP(14);
    IN(7) {
        pg8::Gemm g{HID, (const bf16*)(ws + WS_WDOWN), NPR, D, FF}; pg8::StaticOrder S; S.init(NPR, D, G, bx);
        pg8::EpiRes<1> E{nullptr, RA, (FL & 8) ? (bf16*)(ws + WS_KV) : RA, (FL & 8) ? SS3 : SS2, SS1, nullptr};
        if (!(FL & 2)) pg8::gemm_phase<pg8::EpiRes<1>, pg8::StaticOrder, true, true>(lds + RING_OFF, g, S, E);
        STAMP(15);
        if (!(FL & 4)) { const sg::Epi SE{nullptr, 0, nullptr, RA, (FL & 8) ? (bf16*)(ws + WS_KV) : RA, (FL & 8) ? SS3 : SS2, SS1, nullptr}; sg::phase<4>(lds + RING_OFF, HID, (const bf16*)(ws + WS_WDOWN), FF, D, SE, vcu, G, tid); }
        GRID_BAR(7);
    }
    STAMP(16);
    IN(8) {
        pg8::Gemm g{RA, (const bf16*)(ws + WS_WGATE), NPR, D, D}; pg8::StaticOrder S; S.init(NPR, D, G, bx);
        pg8::EpiRes<2> E{nullptr, RA, (FL & 8) ? (bf16*)(ws + WS_KV) : H3, (FL & 8) ? SS1 : SS3, SS2, PROJ};
        if (!(FL & 2)) pg8::gemm_phase<pg8::EpiRes<2>, pg8::StaticOrder, true, true>(lds + RING_OFF, g, S, E);
        STAMP(17);
        if (!(FL & 4)) { const sg::Epi SE{nullptr, 0, nullptr, RA, (FL & 8) ? (bf16*)(ws + WS_KV) : H3, (FL & 8) ? SS1 : SS3, SS2, PROJ}; sg::phase<5>(lds + RING_OFF, RA, (const bf16*)(ws + WS_WGATE), D, D, SE, vcu, G, tid); }
        GRID_BAR(8);
    }
    STAMP(18);
    IN(9) p7_final(args, vcu, G, tid);
    STAMP(20);
#if TP_A >= 0
    if (bx == 0 && tid == 0) { asm volatile("s_waitcnt vmcnt(0)" ::: "memory"); OUT[O_MP] = (float)(tp_b - tp_a); }
#endif
#undef IN
#undef GRID_BAR
}

extern "C" void kernel_launch(void* const* d_in, const int* in_sizes, int n_in, void* d_out, int out_size, void* d_ws, size_t ws_size, hipStream_t stream) {
    static int grid = 0;
    if (grid == 0) {
        if (n_in != 24 || (size_t)out_size != O_END || ws_size < WS_END) { fprintf(stderr, "kernel_launch: unexpected problem shape (n_in %d, out %d, ws %zu)\n", n_in, out_size, ws_size); grid = -1; return; }
        int dev = 0, cus = 0, per_cu = 0;
        if (hipGetDevice(&dev) != hipSuccess || hipDeviceGetAttribute(&cus, hipDeviceAttributeMultiprocessorCount, dev) != hipSuccess) { grid = -1; return; }
        if (hipFuncSetAttribute((const void*)hymba_fwd, hipFuncAttributeMaxDynamicSharedMemorySize, LDS_BYTES) != hipSuccess) { fprintf(stderr, "kernel_launch: hipFuncSetAttribute failed\n"); grid = -1; return; }
        if (hipOccupancyMaxActiveBlocksPerMultiprocessor(&per_cu, (const void*)hymba_fwd, NWAVES * 64, LDS_BYTES) != hipSuccess || per_cu < 1) { fprintf(stderr, "kernel_launch: occupancy query says %d blocks per CU\n", per_cu); per_cu = 1; }
        (void)hipGetLastError();
        grid = cus * (per_cu < 1 ? per_cu : 1);
    }
    if (grid < 0) return;
    Args a{};
    for (int i = 0; i < 24; ++i) a.in[i] = (const float*)d_in[i];
    a.out = (float*)d_out; a.ws = (unsigned char*)d_ws;
#if MK_ONE_LAUNCH
    if (hipMemsetAsync((char*)d_ws + WS_CTL, 0, CTL_ZERO_BYTES, stream) != hipSuccess) { fprintf(stderr, "kernel_launch: memset of the control words failed\n"); return; }
    void* kargs[] = {&a};
#if HOST_DUP_PHASE >= 0
    const int cuts[4] = {0, HOST_DUP_PHASE + 1, HOST_DUP_PHASE, N_PHASES};
    for (int li = 0; li < 3; ++li) {
        a.ph_lo = (li == 1) ? HOST_DUP_PHASE : (li == 2 ? HOST_DUP_PHASE + 1 : 0); a.ph_hi = (li == 0 || li == 1) ? HOST_DUP_PHASE + 1 : N_PHASES; a.flags = (li == 1) ? HOST_DUP_FLAGS : 0;
        if (li > 0) (void)hipMemsetAsync((char*)d_ws + WS_CTL, 0, CTL_ZERO_BYTES, stream);
        (void)hipLaunchCooperativeKernel((const void*)hymba_fwd, dim3(grid), dim3(NWAVES * 64), kargs, LDS_BYTES, stream);
    }
    (void)cuts;
#else
    a.ph_lo = 0; a.ph_hi = N_PHASES; a.extra_bars = HOST_EXTRA_BARS;
    const hipError_t e = hipLaunchCooperativeKernel((const void*)hymba_fwd, dim3(grid), dim3(NWAVES * 64), kargs, LDS_BYTES, stream);
    if (e != hipSuccess) fprintf(stderr, "kernel_launch: cooperative launch failed: %s (grid %d)\n", hipGetErrorString(e), grid);
#endif
#else
    if (hipMemsetAsync((char*)d_ws + WS_CTL, 0, CTL_ZERO_BYTES, stream) != hipSuccess) return;
    for (int ph = 0; ph < N_PHASES; ++ph) {
        a.ph_lo = ph; a.ph_hi = ph + 1;
        hipLaunchKernelGGL(hymba_fwd, dim3(grid), dim3(NWAVES * 64), LDS_BYTES, stream, a);
    }
#endif
}
```

```cpp
#include <hip/hip_runtime.h>
#include <cstdio>
#include <cstdint>
namespace pg8 {
#define PG8_LAS __attribute__((address_space(3)))
typedef unsigned short bf16_t;
typedef short bf16x8 __attribute__((ext_vector_type(8)));
typedef float f32x4 __attribute__((ext_vector_type(4)));
typedef unsigned u32x4 __attribute__((ext_vector_type(4)));
constexpr int BM = 256, BK = 64, HALF = 128, HTB = HALF * BK * 2  , STAGE_BYTES = 8 * HTB, NXCD = 8, WGM = 8;

__host__ __device__ __forceinline__ int lds_byte(int r, int c) { const int st = (r >> 4) * 2 + (c >> 5), rr = r & 15, cc = c & 31, ob = rr * 64 + cc * 2; return st * 1024 + (ob ^ (((ob >> 9) & 1) << 5)); }
__host__ __device__ __forceinline__ void stage_rc(int b, int& R, int& C) { const int st = b / 1024, sb = b % 1024, swz = sb ^ (((sb >> 9) & 1) << 5); R = (st >> 1) * 16 + swz / 64; C = (st & 1) * 32 + (swz % 64) / 2; }
__host__ __device__ __forceinline__ int perm32(int rho) { const int n = rho >> 4, i = rho & 15; return 8 * (i >> 2) + 4 * n + (i & 3); }

struct Unit { int pm, pn; };
struct Gemm { const bf16_t* A; const bf16_t* Bt; int M, N, K; };

struct StaticOrder {
    int nM, nN, nwg, G, c;
    __host__ __device__ void init(int M, int N, int G_, int c_) { nM = M / BM; nN = N / BM; nwg = nM * nN; G = G_; c = c_; }
    __host__ __device__ bool next(int i, Unit& u) const {
        const long L = (long)i * G + c; if (L >= nwg) return false;
        int wgid = (int)L; { const int q = nwg / NXCD, r = nwg % NXCD, xcd = wgid % NXCD, off = wgid / NXCD; wgid = (xcd < r ? xcd * (q + 1) : r * (q + 1) + (xcd - r) * q) + off; }
        const int nig = WGM * nN, gid = wgid / nig, fm = gid * WGM, gsz = (nM - fm) < WGM ? (nM - fm) : WGM;
        u.pm = fm + ((wgid % nig) % gsz); u.pn = (wgid % nig) / gsz; return true;
    }
    __device__ __forceinline__ void a_ready(const Unit&) const {}
    __device__ __forceinline__ void done(const Unit&) const {}
};


typedef float f32x2 __attribute__((ext_vector_type(2)));
typedef __bf16 bf16x2_t __attribute__((ext_vector_type(2)));
typedef unsigned u32x2 __attribute__((ext_vector_type(2)));
__device__ __forceinline__ unsigned cvt_pk_bf16(float lo, float hi) { f32x2 v = {lo, hi}; bf16x2_t b = __builtin_convertvector(v, bf16x2_t); return __builtin_bit_cast(unsigned, b); }
__device__ __forceinline__ float bf_lo(unsigned w) { return __uint_as_float(w << 16); }
__device__ __forceinline__ float bf_hi(unsigned w) { return __uint_as_float(w & 0xffff0000u); }
__device__ __forceinline__ void pair8(const f32x4& a, const f32x4& b, float (&v)[8]) {
#pragma unroll
    for (int r = 0; r < 4; ++r) { const auto s = __builtin_amdgcn_permlane16_swap(__float_as_uint(a[r]), __float_as_uint(b[r]), false, false); v[r] = __uint_as_float(s[0]); v[4 + r] = __uint_as_float(s[1]); }
}
__device__ __forceinline__ float sigmoid_f(float x) { return __builtin_amdgcn_rcpf(1.0f + __builtin_amdgcn_exp2f(-1.4426950408889634f * x)); }
__device__ __forceinline__ float gelu_tanh_f(float x) { const float t = x * (1.5957691216057308f + 0.07135481627159149f * x * x); return x * sigmoid_f(t); }

constexpr float NORM_EPS = 1e-6f;
__device__ __forceinline__ float row_rs(const float* ss, int row) {
    const f32x4* p = (const f32x4*)(ss + (size_t)row * 16); const f32x4 a = p[0], b = p[1], c = p[2], d = p[3];
    const float s = ((a[0] + a[1]) + (a[2] + a[3])) + ((b[0] + b[1]) + (b[2] + b[3])) + ((c[0] + c[1]) + (c[2] + c[3])) + ((d[0] + d[1]) + (d[2] + d[3]));
    return 1.0f / sqrtf(s * (1.0f / 1024.0f) + NORM_EPS);
}

template <int MODE> struct EpiBf16 {
    static constexpr bool PERM = true, AFTER_DRAIN = false;
    bf16_t* O; int ldc; float* lns;
    __device__ __forceinline__ void operator()(const f32x4 (&acc)[2][2][4][2], const Unit& u, int wr, int wc, int fr, int fq) const {
        const int row0 = u.pm * BM + wr * 64 + fr, col0 = u.pn * BM + wc * 32 + 8 * fq;
        const int act = (MODE == 0) ? (u.pn < 4 ? 1 : (u.pn >= 10 ? 2 : 0)) : 0;
#pragma unroll
        for (int ai = 0; ai < 2; ++ai)
#pragma unroll
            for (int m = 0; m < 4; ++m) { const int row = row0 + ai * HALF + m * 16; bf16_t* rowp = O + (size_t)row * ldc + col0; float s1 = 0.f, s2 = 0.f;
#pragma unroll
                for (int bj = 0; bj < 2; ++bj) { f32x4 v0 = acc[ai][bj][m][0], v1 = acc[ai][bj][m][1];
                    if (MODE == 0) {
                        if (act == 1) {
#pragma unroll
                            for (int e = 0; e < 4; ++e) { v0[e] = gelu_tanh_f(v0[e]); v1[e] = gelu_tanh_f(v1[e]); } }
                        else if (act == 2) {
#pragma unroll
                            for (int e = 0; e < 4; ++e) { v0[e] = sigmoid_f(v0[e]); v1[e] = sigmoid_f(v1[e]); } }
                    }
                    if (MODE == 2) {
#pragma unroll
                        for (int e = 0; e < 4; ++e) { const float a = fmaxf(v0[e], 0.f), b = fmaxf(v1[e], 0.f); v0[e] = a * a; v1[e] = b * b; } }
                    if (MODE == 0) { const f32x4 t = v0 + v1, q = v0 * v0 + v1 * v1; s1 += (t[0] + t[1]) + (t[2] + t[3]); s2 += (q[0] + q[1]) + (q[2] + q[3]); }
                    u32x4 w; w.x = cvt_pk_bf16(v0[0], v0[1]); w.y = cvt_pk_bf16(v0[2], v0[3]); w.z = cvt_pk_bf16(v1[0], v1[1]); w.w = cvt_pk_bf16(v1[2], v1[3]);
                    *(u32x4*)(rowp + bj * HALF) = w; }
                if (MODE == 0 && (u.pn == 2 || u.pn == 3)) {
                    s1 += __shfl_xor(s1, 16); s1 += __shfl_xor(s1, 32); s2 += __shfl_xor(s2, 16); s2 += __shfl_xor(s2, 32);
                    if (fq == 0) *(f32x2*)(lns + ((size_t)row * 8 + (u.pn - 2) * 4 + wc) * 2) = (f32x2){s1, s2}; } }
    }
};

template <int MODE> struct EpiRes {
    static constexpr bool PERM = true, AFTER_DRAIN = false;
    const float* rn;
    const bf16_t* Hb; bf16_t* Ho; float* SSO; const float* SSI; const bf16_t* PROJ;
    __device__ __forceinline__ void operator()(const f32x4 (&acc)[2][2][4][2], const Unit& u, int wr, int wc, int fr, int fq) const {
        const int row0 = u.pm * BM + wr * 64 + fr, col0 = u.pn * BM + wc * 32 + 8 * fq;
#pragma unroll
        for (int ai = 0; ai < 2; ++ai)
#pragma unroll
            for (int m = 0; m < 4; ++m) { const int row = row0 + ai * HALF + m * 16; const size_t off = (size_t)row * 1024 + col0;
                float rsc; if (MODE != 0) { rsc = row_rs(SSI, row); if (MODE == 1) rsc = rsc * rsc; } else rsc = rn[row];
                float sq = 0.f;
#pragma unroll
                for (int bj = 0; bj < 2; ++bj) { const size_t o2 = off + bj * HALF;
                    const u32x4 hw = *(const u32x4*)(Hb + o2);
                    const float r[8] = {bf_lo(hw.x), bf_hi(hw.x), bf_lo(hw.y), bf_hi(hw.y), bf_lo(hw.z), bf_hi(hw.z), bf_lo(hw.w), bf_hi(hw.w)};
                    const f32x4 a0 = acc[ai][bj][m][0], a1 = acc[ai][bj][m][1]; const float a[8] = {a0[0], a0[1], a0[2], a0[3], a1[0], a1[1], a1[2], a1[3]};
                    float h[8];
                    if (MODE == 0) {
#pragma unroll
                        for (int e = 0; e < 8; ++e) h[e] = r[e] * rsc + a[e]; }
                    else if (MODE == 1) {
#pragma unroll
                        for (int e = 0; e < 8; ++e) h[e] = r[e] + a[e] * rsc; }
                    else { const u32x4 pw = *(const u32x4*)(PROJ + o2);
                        const float p[8] = {bf_lo(pw.x), bf_hi(pw.x), bf_lo(pw.y), bf_hi(pw.y), bf_lo(pw.z), bf_hi(pw.z), bf_lo(pw.w), bf_hi(pw.w)};
#pragma unroll
                        for (int e = 0; e < 8; ++e) h[e] = r[e] + sigmoid_f(a[e] * rsc) * p[e]; }
                    u32x4 w; w.x = cvt_pk_bf16(h[0], h[1]); w.y = cvt_pk_bf16(h[2], h[3]); w.z = cvt_pk_bf16(h[4], h[5]); w.w = cvt_pk_bf16(h[6], h[7]); *(u32x4*)(Ho + o2) = w;
#pragma unroll
                    for (int e = 0; e < 8; ++e) sq += h[e] * h[e]; }
                sq += __shfl_xor(sq, 16); sq += __shfl_xor(sq, 32);
                if (fq == 0) SSO[(size_t)row * 16 + u.pn * 4 + wc] = sq; }
    }
};

template <class Epi, class Sched, bool ALIGN_EPI = false, bool SP2 = false>
__device__ __forceinline__ void gemm_phase(PG8_LAS unsigned char* lds, const Gemm g, const Sched& S, const Epi& E) {
    const int tid = threadIdx.x, wid = __builtin_amdgcn_readfirstlane(tid >> 6), lane = tid & 63, wr = wid >> 2, wc = wid & 3, fr = lane & 15, fq = lane >> 4;
    int K = g.K; asm volatile("" : "+s"(K));
    const int nt = K / BK;
    unsigned voffA[2], voffB[2];
#pragma unroll
    for (int i = 0; i < 2; ++i) { int R, C; stage_rc(tid * 16 + i * 8192, R, C); const int Rb = Epi::PERM ? ((R & ~31) + perm32(R & 31)) : R;
        voffA[i] = (unsigned)(R * K + C) * 2u; voffB[i] = (unsigned)(Rb * K + C) * 2u; }
    const size_t kstep = (size_t)(BK * 2);
    const size_t hstep = (size_t)HALF * K * 2;
    const size_t tstep = 2 * hstep;
    const unsigned ldsw = (unsigned)wid * 1024u;
    const int aoff = lds_byte(wr * 64 + fr, fq * 8), boff = lds_byte(wc * 32 + fr, fq * 8);
#define PG8_SA(b, h) (((b) * 2 + (h)) * HTB)
#define PG8_SB(b, h) ((4 + (b) * 2 + (h)) * HTB)
#define PG8_STAGE(bufoff, gbase, voff) do { _Pragma("unroll") for (int _i = 0; _i < 2; ++_i) \
        __builtin_amdgcn_global_load_lds((const unsigned*)((const char*)(gbase) + (voff)[_i]), (PG8_LAS unsigned*)(lds + (bufoff) + ldsw + _i * 8192), 16, 0, 0); } while (0)
#define PG8_LDA(dst, b, h) do { _Pragma("unroll") for (int m = 0; m < 4; ++m) _Pragma("unroll") for (int k = 0; k < 2; ++k) dst[m][k] = *(const PG8_LAS bf16x8*)(lds + PG8_SA(b, h) + aoff + m * 2048 + k * 1024); } while (0)
#define PG8_LDB(dst, b, h) do { _Pragma("unroll") for (int n = 0; n < 2; ++n) _Pragma("unroll") for (int k = 0; k < 2; ++k) dst[n][k] = *(const PG8_LAS bf16x8*)(lds + PG8_SB(b, h) + boff + n * 2048 + k * 1024); } while (0)
#define PG8_MMA(ai, bj, At, Bt) do { __builtin_amdgcn_s_setprio(1); _Pragma("unroll") for (int m = 0; m < 4; ++m) _Pragma("unroll") for (int n = 0; n < 2; ++n) _Pragma("unroll") for (int k = 0; k < 2; ++k) \
        acc[ai][bj][m][n] = __builtin_amdgcn_mfma_f32_16x16x32_bf16(Bt[n][k], At[m][k], acc[ai][bj][m][n], 0, 0, 0); __builtin_amdgcn_s_setprio(0); } while (0)
#define PG8_WAIT_V(n) asm volatile("s_waitcnt vmcnt(" #n ")" ::: "memory")
#define PG8_WAIT_L(n) asm volatile("s_waitcnt lgkmcnt(" #n ")" ::: "memory")
#define PG8_BAR __builtin_amdgcn_s_barrier()
#define PG8_SCHED __builtin_amdgcn_sched_barrier(0)
    Unit cur, nxt; int ui = 0;
    if (!S.next(0, cur)) return;
    f32x4 acc[2][2][4][2];
#pragma unroll
    for (int a = 0; a < 2; ++a)
#pragma unroll
        for (int b = 0; b < 2; ++b)
#pragma unroll
            for (int m = 0; m < 4; ++m)
#pragma unroll
                for (int n = 0; n < 2; ++n) acc[a][b][m][n] = (f32x4){0.f, 0.f, 0.f, 0.f};
    bf16x8 At[4][2], B0[2][2], B1[2][2];
    const char* cA = (const char*)g.A + (size_t)cur.pm * tstep; const char* cB = (const char*)g.Bt + (size_t)cur.pn * tstep;
    S.a_ready(cur);
    if constexpr (SP2) {
        PG8_STAGE(PG8_SB(0, 0), cB, voffB); PG8_STAGE(PG8_SB(0, 1), cB + hstep, voffB); PG8_STAGE(PG8_SA(0, 0), cA, voffA); PG8_STAGE(PG8_SA(0, 1), cA + hstep, voffA);
        if (wr == 1) PG8_BAR;
        PG8_WAIT_V(2); PG8_BAR;
        PG8_STAGE(PG8_SB(1, 0), cB + kstep, voffB); PG8_STAGE(PG8_SA(1, 0), cA + kstep, voffA); PG8_STAGE(PG8_SB(1, 1), cB + hstep + kstep, voffB);
        PG8_WAIT_V(6); PG8_BAR;
    } else {
        PG8_STAGE(PG8_SB(0, 0), cB, voffB); PG8_STAGE(PG8_SA(0, 0), cA, voffA); PG8_STAGE(PG8_SB(0, 1), cB + hstep, voffB); PG8_STAGE(PG8_SA(0, 1), cA + hstep, voffA);
        if (wr == 1) PG8_BAR;
        PG8_WAIT_V(4); PG8_BAR;
        PG8_STAGE(PG8_SB(1, 0), cB + kstep, voffB); PG8_STAGE(PG8_SA(1, 0), cA + kstep, voffA); PG8_STAGE(PG8_SB(1, 1), cB + hstep + kstep, voffB);
        PG8_WAIT_V(6); PG8_BAR;
    }
    for (;;) {
        const bool has_next = S.next(ui + 1, nxt);
        const char* nA = has_next ? (const char*)g.A + (size_t)nxt.pm * tstep : cA; const char* nB = has_next ? (const char*)g.Bt + (size_t)nxt.pn * tstep : cB;
        for (int t = 0; t < nt; t += 2) {
            const bool last = (t == nt - 2);
            const char* a1 = cA + (size_t)(t + 1) * kstep;
            const char* a2 = last ? nA : cA + (size_t)(t + 2) * kstep; const char* b2 = last ? nB : cB + (size_t)(t + 2) * kstep;
            const char* a3 = a2 + kstep; const char* b3 = b2 + kstep;
            if (last && has_next) S.a_ready(nxt);
            if constexpr (SP2) {
            PG8_LDB(B0, 0, 0); PG8_LDB(B1, 0, 1); PG8_SCHED; PG8_LDA(At, 0, 0); PG8_STAGE(PG8_SA(1, 1), a1 + hstep, voffA);
            PG8_WAIT_V(8); PG8_WAIT_L(0); PG8_BAR; PG8_MMA(0, 0, At, B0); PG8_MMA(0, 1, At, B1); PG8_BAR; PG8_SCHED;
            PG8_LDA(At, 0, 1); PG8_STAGE(PG8_SB(0, 0), b2, voffB); PG8_STAGE(PG8_SB(0, 1), b2 + hstep, voffB); PG8_STAGE(PG8_SA(0, 0), a2, voffA);
            PG8_WAIT_V(8); PG8_WAIT_L(0); PG8_BAR; PG8_MMA(1, 0, At, B0); PG8_MMA(1, 1, At, B1); PG8_BAR; PG8_SCHED;
            PG8_LDB(B0, 1, 0); PG8_LDB(B1, 1, 1); PG8_SCHED; PG8_LDA(At, 1, 0); PG8_STAGE(PG8_SA(0, 1), a2 + hstep, voffA);
            PG8_WAIT_V(8); PG8_WAIT_L(0); PG8_BAR; PG8_MMA(0, 0, At, B0); PG8_MMA(0, 1, At, B1); PG8_BAR; PG8_SCHED;
            PG8_LDA(At, 1, 1); PG8_STAGE(PG8_SB(1, 0), b3, voffB); PG8_STAGE(PG8_SB(1, 1), b3 + hstep, voffB); PG8_STAGE(PG8_SA(1, 0), a3, voffA);
            PG8_WAIT_V(8); PG8_WAIT_L(0); PG8_BAR; PG8_MMA(1, 0, At, B0); PG8_MMA(1, 1, At, B1); PG8_BAR; PG8_SCHED;
            } else {
            PG8_LDB(B0, 0, 0); PG8_SCHED; PG8_LDA(At, 0, 0); PG8_STAGE(PG8_SA(1, 1), a1 + hstep, voffA);
            PG8_WAIT_L(8); PG8_BAR; PG8_WAIT_L(0); PG8_MMA(0, 0, At, B0); PG8_BAR; PG8_SCHED;
            PG8_LDB(B1, 0, 1); PG8_STAGE(PG8_SB(0, 0), b2, voffB);
            PG8_BAR; PG8_WAIT_L(0); PG8_MMA(0, 1, At, B1); PG8_BAR;
            PG8_LDA(At, 0, 1); PG8_STAGE(PG8_SA(0, 0), a2, voffA);
            PG8_BAR; PG8_WAIT_L(0); PG8_MMA(1, 0, At, B0); PG8_BAR; PG8_SCHED;
            PG8_STAGE(PG8_SB(0, 1), b2 + hstep, voffB);
            PG8_WAIT_V(6); PG8_BAR; PG8_MMA(1, 1, At, B1); PG8_BAR;
            PG8_LDB(B0, 1, 0); PG8_SCHED; PG8_LDA(At, 1, 0); PG8_STAGE(PG8_SA(0, 1), a2 + hstep, voffA);
            PG8_WAIT_L(8); PG8_BAR; PG8_WAIT_L(0); PG8_MMA(0, 0, At, B0); PG8_BAR; PG8_SCHED;
            PG8_LDB(B1, 1, 1); PG8_STAGE(PG8_SB(1, 0), b3, voffB);
            PG8_BAR; PG8_WAIT_L(0); PG8_MMA(0, 1, At, B1); PG8_BAR;
            PG8_LDA(At, 1, 1); PG8_STAGE(PG8_SA(1, 0), a3, voffA);
            PG8_BAR; PG8_WAIT_L(0); PG8_MMA(1, 0, At, B0); PG8_BAR; PG8_SCHED;
            PG8_STAGE(PG8_SB(1, 1), b3 + hstep, voffB);
            PG8_WAIT_V(6); PG8_BAR; PG8_MMA(1, 1, At, B1); PG8_BAR;
            }
        }
        if constexpr (ALIGN_EPI) { if (wr == 0) PG8_BAR; }
        if constexpr (!Epi::AFTER_DRAIN) { E(acc, cur, wr, wc, fr, fq); S.done(cur); }
        if (!has_next) break;
#pragma unroll
        for (int a = 0; a < 2; ++a)
#pragma unroll
            for (int b = 0; b < 2; ++b)
#pragma unroll
                for (int m = 0; m < 4; ++m)
#pragma unroll
                    for (int n = 0; n < 2; ++n) acc[a][b][m][n] = (f32x4){0.f, 0.f, 0.f, 0.f};
        cur = nxt; cA = nA; cB = nB; ++ui;
        if constexpr (ALIGN_EPI) { if (wr == 1) PG8_BAR; }
    }
    PG8_WAIT_V(0);
    if constexpr (!ALIGN_EPI) { if (wr == 0) PG8_BAR; }
    PG8_BAR;
    if constexpr (Epi::AFTER_DRAIN) { E.fused(acc, cur, wr, wc, fr, fq, lds, wid, lane); S.done(cur); }
#undef PG8_SA
#undef PG8_SB
#undef PG8_STAGE
#undef PG8_LDA
#undef PG8_LDB
#undef PG8_MMA
#undef PG8_WAIT_V
#undef PG8_WAIT_L
#undef PG8_BAR
#undef PG8_SCHED
}
}

namespace mix {
#define LAS __attribute__((address_space(3)))
using pg8::bf16_t; using pg8::bf16x8; using pg8::f32x4; using pg8::u32x4; using pg8::u32x2; using pg8::cvt_pk_bf16; using pg8::bf_lo; using pg8::bf_hi; using pg8::sigmoid_f; using pg8::pair8;
typedef short v4i16_t __attribute__((ext_vector_type(4)));
constexpr int NP = 16384, NS = 1024, ZLD = 3072;
constexpr int ZU = 0, ZVG = 512, ZQ = 1024, ZK = 1536, ZV = 2048, ZO = 2560;
constexpr int TS = 288;
constexpr int IMG = 128 * TS;
constexpr int IMG0 = 0, IMG1 = IMG, IMG2 = 2 * IMG, SC_OFF = 3 * IMG;
constexpr float EPS = 1e-6f;

template <int CTRL> __device__ __forceinline__ float dpp_mov(float v) { return __int_as_float(__builtin_amdgcn_update_dpp(0, __float_as_int(v), CTRL, 0xF, 0xF, true)); }
__device__ __forceinline__ float row_sum16(float v) { v += dpp_mov<0xB1>(v); v += dpp_mov<0x4E>(v); v += dpp_mov<0x141>(v); v += dpp_mov<0x140>(v); return v; }
__device__ __forceinline__ float row_max16(float v) { v = fmaxf(v, dpp_mov<0xB1>(v)); v = fmaxf(v, dpp_mov<0x4E>(v)); v = fmaxf(v, dpp_mov<0x141>(v)); v = fmaxf(v, dpp_mov<0x140>(v)); return v; }
__device__ __forceinline__ float rl(float v, int l) { return __int_as_float(__builtin_amdgcn_readlane(__float_as_int(v), l)); }
__device__ __forceinline__ float wave_sum(float v) { v = row_sum16(v); return (rl(v, 0) + rl(v, 16)) + (rl(v, 32) + rl(v, 48)); }
__device__ __forceinline__ float wave_max(float v) { v = row_max16(v); return fmaxf(fmaxf(rl(v, 0), rl(v, 16)), fmaxf(rl(v, 32), rl(v, 48))); }
__device__ __forceinline__ float scan_add(float v, int lane) {
#pragma unroll
    for (int o = 1; o < 64; o <<= 1) { const float t = __shfl_up(v, o); if (lane >= o) v += t; }
    return v;
}
__device__ __forceinline__ float scan_max(float v, int lane) {
#pragma unroll
    for (int o = 1; o < 64; o <<= 1) { const float t = __shfl_up(v, o); if (lane >= o) v = fmaxf(v, t); }
    return v;
}
__device__ __forceinline__ bf16x8 tr2(LAS const unsigned char* p0, LAS const unsigned char* p1) {
    const v4i16_t a = __builtin_amdgcn_ds_read_tr16_b64_v4i16((LAS v4i16_t*)p0);
    const v4i16_t b = __builtin_amdgcn_ds_read_tr16_b64_v4i16((LAS v4i16_t*)p1);
    return (bf16x8){a[0], a[1], a[2], a[3], b[0], b[1], b[2], b[3]};
}
__device__ __forceinline__ void unpack8(const u32x4 w, float (&x)[8]) {
    x[0] = bf_lo(w.x); x[1] = bf_hi(w.x); x[2] = bf_lo(w.y); x[3] = bf_hi(w.y); x[4] = bf_lo(w.z); x[5] = bf_hi(w.z); x[6] = bf_lo(w.w); x[7] = bf_hi(w.w);
}
__device__ __forceinline__ u32x4 pack8(const float (&x)[8]) {
    u32x4 w; w.x = cvt_pk_bf16(x[0], x[1]); w.y = cvt_pk_bf16(x[2], x[3]); w.z = cvt_pk_bf16(x[4], x[5]); w.w = cvt_pk_bf16(x[6], x[7]); return w;
}

struct MixP {
    const bf16_t* Z; bf16_t* YC; const float* IG; const float* LF; const float* LNS;
    const bf16_t* WSb;
    const float *gm_ws, *lng, *lnb, *bs, *mlnorm;
    bf16_t* KV; float *NLOC, *NST, *CH, *MST;
    const float *stC, *stN, *stM;
    float *oCp, *oNp, *oMp, *oVp, *oCs, *oNs, *oMs, *oVs;
};

__device__ __forceinline__ void gmlp_unit(LAS unsigned char* lds, const MixP& P, int b, int c, int h, int tid) {
    const int lane = tid & 63, w = __builtin_amdgcn_readfirstlane(tid >> 6), fr = lane & 15, kq = lane >> 4, q = fr >> 2, p = fr & 3;
    const int r0 = b * 2048 + c * 128;
    LAS unsigned char* img = lds + IMG0;
    LAS float* mst = (LAS float*)(lds + SC_OFF);
    const int ch = tid & 15;
    u32x4 raw[4];
#pragma unroll
    for (int i = 0; i < 4; ++i) raw[i] = *(const u32x4*)(P.Z + (size_t)(r0 + (tid >> 4) + 32 * i) * ZLD + ZVG + h * 128 + ch * 8);
    f32x4 st4[4];
    if (tid < 128) { const f32x4* sp = (const f32x4*)(P.LNS + (size_t)(r0 + tid) * 16);
#pragma unroll
        for (int j = 0; j < 4; ++j) st4[j] = sp[j]; }
    float g8[8], b8[8];
    { const float* gp = P.lng + h * 128 + ch * 8; const float* bp = P.lnb + h * 128 + ch * 8;
      const f32x4 a = *(const f32x4*)gp, a2 = *(const f32x4*)(gp + 4), c0 = *(const f32x4*)bp, c1 = *(const f32x4*)(bp + 4);
#pragma unroll
      for (int e = 0; e < 4; ++e) { g8[e] = a[e]; g8[4 + e] = a2[e]; b8[e] = c0[e]; b8[4 + e] = c1[e]; } }
    const bf16_t* Wrow = P.WSb + ((size_t)h * 128 + 16 * w + fr) * 128 + 8 * kq;
    bf16x8 wf[4];
#pragma unroll
    for (int st = 0; st < 4; ++st) wf[st] = *(const bf16x8*)(Wrow + 32 * st);
    const int fo = 16 * (kq & 1) + 8 * (kq >> 1);
    const bf16_t* urow = P.Z + (size_t)(r0 + 16 * w + fr) * ZLD + ZU + h * 128 + fo;
    u32x4 uw[4];
#pragma unroll
    for (int g = 0; g < 4; ++g) uw[g] = *(const u32x4*)(urow + 32 * g);
    const float bsv = P.bs[h * 128 + 16 * w + fr];
    if (tid < 128) { const float s1 = (st4[0][0] + st4[0][2]) + (st4[1][0] + st4[1][2]) + (st4[2][0] + st4[2][2]) + (st4[3][0] + st4[3][2]);
        const float s2 = (st4[0][1] + st4[0][3]) + (st4[1][1] + st4[1][3]) + (st4[2][1] + st4[2][3]) + (st4[3][1] + st4[3][3]);
        const float mean = s1 * (1.0f / 512.0f), var = fmaxf(s2 * (1.0f / 512.0f) - mean * mean, 0.f);
        mst[tid] = mean; mst[128 + tid] = 1.0f / sqrtf(var + EPS); }
    __syncthreads();
    float* vout = (c == 15) ? P.oVp + (size_t)b * 128 * 512 : nullptr;
#pragma unroll
    for (int i = 0; i < 4; ++i) { const int t = (tid >> 4) + 32 * i; const float mean = mst[t], rstd = mst[128 + t];
        float x[8]; unpack8(raw[i], x);
#pragma unroll
        for (int e = 0; e < 8; ++e) x[e] = (x[e] - mean) * rstd * g8[e] + b8[e];
        *(LAS u32x4*)(img + t * TS + ch * 16) = pack8(x);
        if (vout) { float* vo = vout + (size_t)t * 512 + h * 128 + ch * 8; *(f32x4*)vo = (f32x4){x[0], x[1], x[2], x[3]}; *(f32x4*)(vo + 4) = (f32x4){x[4], x[5], x[6], x[7]}; } }
    __syncthreads();
    f32x4 acc[8];
#pragma unroll
    for (int n = 0; n < 8; ++n) acc[n] = (f32x4){0.f, 0.f, 0.f, 0.f};
    const int nsteps = (w >> 1) + 1;
    LAS const unsigned char* trb = img + (8 * kq + q) * TS + 8 * p;
#pragma unroll
    for (int st = 0; st < 4; ++st) if (st < nsteps) {
#pragma unroll
        for (int n = 0; n < 8; ++n) { const bf16x8 vf = tr2(trb + (32 * st) * TS + 32 * n, trb + (32 * st + 4) * TS + 32 * n);
            acc[n] = __builtin_amdgcn_mfma_f32_16x16x32_bf16(vf, wf[st], acc[n], 0, 0, 0); }
    }
    { const int t = 16 * w + fr;
      bf16_t* yrow = P.YC + (size_t)(r0 + t) * 1024 + h * 128 + fo;
#pragma unroll
      for (int g = 0; g < 4; ++g) { float v[8], uf[8]; pair8(acc[2 * g], acc[2 * g + 1], v); unpack8(uw[g], uf);
#pragma unroll
          for (int e = 0; e < 8; ++e) v[e] = uf[e] * (v[e] + bsv);
          *(u32x4*)(yrow + 32 * g) = pack8(v); } }
    __syncthreads();
}

__device__ __forceinline__ void kv_unit(LAS unsigned char* lds, const MixP& P, int b, int h, int c, int tid) {
    const int lane = tid & 63, w = __builtin_amdgcn_readfirstlane(tid >> 6), fr = lane & 15, kq = lane >> 4, q = fr >> 2, p = fr & 3;
    const int r0 = b * 2048 + c * 128, unit = (b * 4 + h) * 16 + c;
    LAS float* wl = (LAS float*)(lds + SC_OFF);
    float lf0 = 0.f, lf1 = 0.f, ig0 = 0.f, ig1 = 0.f;
    if (w == 0) { const int s0 = r0 + 2 * lane; lf0 = P.LF[(size_t)s0 * 4 + h]; lf1 = P.LF[(size_t)(s0 + 1) * 4 + h]; ig0 = P.IG[(size_t)s0 * 4 + h]; ig1 = P.IG[(size_t)(s0 + 1) * 4 + h]; }
    u32x4 kraw[4], vraw[4];
#pragma unroll
    for (int i = 0; i < 4; ++i) { const int id = tid + 512 * i, row = id >> 4, ch = id & 15;
        const bf16_t* zr = P.Z + (size_t)(r0 + row) * ZLD + h * 128 + ch * 8; kraw[i] = *(const u32x4*)(zr + ZK); vraw[i] = *(const u32x4*)(zr + ZV); }
    if (w == 0) {
        const float Pc = scan_add(lf0 + lf1, lane), b1 = Pc, b0 = Pc - lf1, B = __shfl(Pc, 63);
        const float x0 = ig0 - b0, x1 = ig1 - b1, xm = wave_max(fmaxf(x0, x1));
        wl[2 * lane] = __expf(x0 - xm); wl[2 * lane + 1] = __expf(x1 - xm);
        if (lane == 0) { P.CH[unit * 2] = B; P.CH[unit * 2 + 1] = B + xm; }
    }
    __syncthreads();
#pragma unroll
    for (int i = 0; i < 4; ++i) { const int id = tid + 512 * i, row = id >> 4, ch = id & 15;
        float x[8]; unpack8(kraw[i], x); const float ws = wl[row];
#pragma unroll
        for (int e = 0; e < 8; ++e) x[e] *= ws;
        *(LAS u32x4*)(lds + IMG0 + row * TS + ch * 16) = pack8(x);
        *(LAS u32x4*)(lds + IMG1 + row * TS + ch * 16) = vraw[i]; }
    __syncthreads();
    f32x4 acc[8], accn = (f32x4){0.f, 0.f, 0.f, 0.f};
#pragma unroll
    for (int n = 0; n < 8; ++n) acc[n] = (f32x4){0.f, 0.f, 0.f, 0.f};
    const bf16x8 ones = (bf16x8){0x3F80, 0x3F80, 0x3F80, 0x3F80, 0x3F80, 0x3F80, 0x3F80, 0x3F80};
    LAS const unsigned char* trk = lds + IMG0 + (8 * kq + q) * TS + 8 * p + 32 * w;
    LAS const unsigned char* trv = lds + IMG1 + (8 * kq + q) * TS + 8 * p;
#pragma unroll
    for (int st = 0; st < 4; ++st) {
        const bf16x8 kf = tr2(trk + (32 * st) * TS, trk + (32 * st + 4) * TS);
        accn = __builtin_amdgcn_mfma_f32_16x16x32_bf16(ones, kf, accn, 0, 0, 0);
#pragma unroll
        for (int n = 0; n < 8; ++n) { const bf16x8 vf = tr2(trv + (32 * st) * TS + 32 * n, trv + (32 * st + 4) * TS + 32 * n);
            acc[n] = __builtin_amdgcn_mfma_f32_16x16x32_bf16(vf, kf, acc[n], 0, 0, 0); }
    }
    bf16_t* kvp = P.KV + (size_t)unit * 16384 + (16 * w + fr) * 128 + 16 * (kq & 1) + 8 * (kq >> 1);
#pragma unroll
    for (int g = 0; g < 4; ++g) { float v[8]; pair8(acc[2 * g], acc[2 * g + 1], v); *(u32x4*)(kvp + 32 * g) = pack8(v); }
    if (kq == 0) P.NLOC[unit * 128 + 16 * w + fr] = accn[0];
    __syncthreads();
}

__device__ __forceinline__ void scan_unit(const MixP& P, int bh, int slice, int tid) {
    const size_t base = (size_t)bh * 16 * 16384 + slice * 2048 + tid * 4;
    f32x4 C = (f32x4){0.f, 0.f, 0.f, 0.f}; float M = 0.f, nv = 0.f;
    const bool nthr = (slice == 0 && tid < 128);
    u32x2 kvv[16];
#pragma unroll
    for (int c = 0; c < 16; ++c) kvv[c] = *(const u32x2*)(P.KV + base + (size_t)c * 16384);
#pragma unroll
    for (int c = 0; c < 16; ++c) {
        const float B = P.CH[(bh * 16 + c) * 2], a = P.CH[(bh * 16 + c) * 2 + 1];
        const float Mn = fmaxf(B + M, a), dec = __expf(B + M - Mn), add = __expf(a - Mn);
        bf16_t* kp = P.KV + base + (size_t)c * 16384;
        const f32x4 kv = (f32x4){bf_lo(kvv[c].x), bf_hi(kvv[c].x), bf_lo(kvv[c].y), bf_hi(kvv[c].y)};
        { u32x2 o; o.x = cvt_pk_bf16(C[0], C[1]); o.y = cvt_pk_bf16(C[2], C[3]); *(u32x2*)kp = o; }
        C = dec * C + add * kv;
        if (nthr) { const float nl = P.NLOC[(bh * 16 + c) * 128 + tid]; P.NST[(bh * 16 + c) * 128 + tid] = nv; nv = dec * nv + add * nl; if (tid == 0) P.MST[bh * 16 + c] = M; }
        M = Mn;
    }
    *(f32x4*)(P.oCp + (size_t)bh * 16384 + slice * 2048 + tid * 4) = C;
    if (nthr) { P.oNp[bh * 128 + tid] = nv; if (tid == 0) P.oMp[bh] = M; }
}

__device__ __forceinline__ void mlo_unit(LAS unsigned char* lds, const MixP& P, int b, int h, int c, int tid) {
    const int lane = tid & 63, w = __builtin_amdgcn_readfirstlane(tid >> 6), fr = lane & 15, kq = lane >> 4, q = fr >> 2, p = fr & 3;
    const int r0 = b * 2048 + c * 128, unit = (b * 4 + h) * 16 + c;
    LAS float* xs = (LAS float*)(lds + SC_OFF); LAS float* ys = xs + 128; LAS float* wint = xs + 256; LAS float* emt = xs + 384; LAS float* nst = xs + 512;
    const float Mc = P.MST[unit];
    float lf0 = 0.f, lf1 = 0.f, ig0 = 0.f, ig1 = 0.f, n0v = 0.f, n1v = 0.f;
    if (w == 0) { const int s0 = r0 + 2 * lane; lf0 = P.LF[(size_t)s0 * 4 + h]; lf1 = P.LF[(size_t)(s0 + 1) * 4 + h]; ig0 = P.IG[(size_t)s0 * 4 + h]; ig1 = P.IG[(size_t)(s0 + 1) * 4 + h]; }
    else if (w == 1) { n0v = P.NST[unit * 128 + lane]; n1v = P.NST[unit * 128 + lane + 64]; }
    const int t = 16 * w + fr;
    const bf16_t* zrow = P.Z + (size_t)(r0 + t) * ZLD + h * 128;
    u32x4 kraw[4], vraw[4], craw[4]; bf16x8 qf[4];
#pragma unroll
    for (int i = 0; i < 4; ++i) { const int id = tid + 512 * i, row = id >> 4, ch = id & 15;
        const bf16_t* zr = P.Z + (size_t)(r0 + row) * ZLD + h * 128 + ch * 8; kraw[i] = *(const u32x4*)(zr + ZK); vraw[i] = *(const u32x4*)(zr + ZV); }
    { const bf16_t* cs = P.KV + (size_t)unit * 16384;
#pragma unroll
      for (int i = 0; i < 4; ++i) { const int id = tid + 512 * i, row = id >> 4, ch = id & 15; craw[i] = *(const u32x4*)(cs + row * 128 + ch * 8); } }
#pragma unroll
    for (int ds = 0; ds < 4; ++ds) qf[ds] = *(const bf16x8*)(zrow + ZQ + 32 * ds + 8 * kq);
    if (w == 0) {
        const float Pc = scan_add(lf0 + lf1, lane), b1 = Pc, b0 = Pc - lf1;
        const float x0 = ig0 - b0, x1 = ig1 - b1;
        const float PM = scan_max(fmaxf(x0, x1), lane); float prev = __shfl_up(PM, 1); if (lane == 0) prev = -INFINITY;
        const float y0 = fmaxf(Mc, fmaxf(prev, x0)), y1 = fmaxf(Mc, PM);
        xs[2 * lane] = x0; xs[2 * lane + 1] = x1; ys[2 * lane] = y0; ys[2 * lane + 1] = y1;
        wint[2 * lane] = __expf(Mc - y0); wint[2 * lane + 1] = __expf(Mc - y1);
        emt[2 * lane] = __expf(-(b0 + y0)); emt[2 * lane + 1] = __expf(-(b1 + y1));
    } else if (w == 1) { nst[lane] = n0v; nst[lane + 64] = n1v; }
#pragma unroll
    for (int i = 0; i < 4; ++i) { const int id = tid + 512 * i, row = id >> 4, ch = id & 15;
        *(LAS u32x4*)(lds + IMG0 + row * TS + ch * 16) = kraw[i];
        *(LAS u32x4*)(lds + IMG1 + row * TS + ch * 16) = vraw[i];
        *(LAS u32x4*)(lds + IMG2 + row * TS + ch * 16) = craw[i]; }
    __syncthreads();
    const int fo = 16 * (kq & 1) + 8 * (kq >> 1);
    u32x4 ow[4];
#pragma unroll
    for (int g = 0; g < 4; ++g) ow[g] = *(const u32x4*)(zrow + ZO + 32 * g + fo);
    float dn = 0.f;
#pragma unroll
    for (int ds = 0; ds < 4; ++ds)
#pragma unroll
        for (int e = 0; e < 8; ++e) dn += __uint_as_float(((unsigned)(unsigned short)qf[ds][e]) << 16) * nst[32 * ds + 8 * kq + e];
    dn += __shfl_xor(dn, 16); dn += __shfl_xor(dn, 32);
    LAS const unsigned char* trv = lds + IMG1 + (4 * kq + q) * TS + 8 * p;
    LAS const unsigned char* trc = lds + IMG2 + (8 * kq + q) * TS + 8 * p;
    const float wi = wint[t];
    f32x4 o1[8];
#pragma unroll
    for (int n = 0; n < 8; ++n) o1[n] = (f32x4){0.f, 0.f, 0.f, 0.f};
#pragma unroll
    for (int ds = 0; ds < 4; ++ds)
#pragma unroll
        for (int n = 0; n < 8; ++n) { const bf16x8 cf = tr2(trc + (32 * ds) * TS + 32 * n, trc + (32 * ds + 4) * TS + 32 * n);
            o1[n] = __builtin_amdgcn_mfma_f32_16x16x32_bf16(cf, qf[ds], o1[n], 0, 0, 0); }
#pragma unroll
    for (int n = 0; n < 8; ++n) o1[n] = o1[n] * wi;
    f32x4 aS[8];
#pragma unroll
    for (int j = 0; j < 8; ++j) aS[j] = (f32x4){0.f, 0.f, 0.f, 0.f};
#pragma unroll
    for (int j = 0; j < 8; ++j) if (j <= w) {
#pragma unroll
        for (int ds = 0; ds < 4; ++ds) { const bf16x8 kf = *(LAS const bf16x8*)(lds + IMG0 + (16 * j + fr) * TS + (32 * ds + 8 * kq) * 2);
            aS[j] = __builtin_amdgcn_mfma_f32_16x16x32_bf16(kf, qf[ds], aS[j], 0, 0, 0); } }
    const float yt = ys[t]; float dsum = 0.f;
#pragma unroll
    for (int j = 0; j < 8; ++j) if (j <= w) {
#pragma unroll
        for (int r = 0; r < 4; ++r) { const int s = 16 * j + 4 * kq + r; const float wg = (s <= t) ? __expf(xs[s] - yt) : 0.f; aS[j][r] *= wg; dsum += aS[j][r]; } }
    dsum += __shfl_xor(dsum, 16); dsum += __shfl_xor(dsum, 32);
    const float den = dsum + wi * dn, rinv = 1.0f / fmaxf(fabsf(den), emt[t]);
#pragma unroll
    for (int st = 0; st < 4; ++st) if (2 * st <= w) {
        u32x4 sw; sw.x = cvt_pk_bf16(aS[2 * st][0], aS[2 * st][1]); sw.y = cvt_pk_bf16(aS[2 * st][2], aS[2 * st][3]);
        sw.z = cvt_pk_bf16(aS[2 * st + 1][0], aS[2 * st + 1][1]); sw.w = cvt_pk_bf16(aS[2 * st + 1][2], aS[2 * st + 1][3]);
        const bf16x8 sf = __builtin_bit_cast(bf16x8, sw);
#pragma unroll
        for (int n = 0; n < 8; ++n) { const bf16x8 vf = tr2(trv + (32 * st) * TS + 32 * n, trv + (32 * st + 16) * TS + 32 * n);
            o1[n] = __builtin_amdgcn_mfma_f32_16x16x32_bf16(vf, sf, o1[n], 0, 0, 0); } }
    float ssq = 0.f;
#pragma unroll
    for (int n = 0; n < 8; ++n)
#pragma unroll
        for (int r = 0; r < 4; ++r) { const float hv = o1[n][r] * rinv; o1[n][r] = hv; ssq += hv * hv; }
    ssq += __shfl_xor(ssq, 16); ssq += __shfl_xor(ssq, 32);
    const float rn = 1.0f / sqrtf(ssq * (1.0f / 128.0f) + EPS);
    bf16_t* yrow = P.YC + (size_t)(r0 + t) * 1024 + 512 + h * 128 + fo;
#pragma unroll
    for (int g = 0; g < 4; ++g) { float v[8], of[8]; pair8(o1[2 * g], o1[2 * g + 1], v); unpack8(ow[g], of);
        const f32x4 g0 = *(const f32x4*)(P.mlnorm + h * 128 + 32 * g + fo), g1 = *(const f32x4*)(P.mlnorm + h * 128 + 32 * g + fo + 4);
#pragma unroll
        for (int e = 0; e < 4; ++e) { v[e] = of[e] * v[e] * rn * g0[e]; v[4 + e] = of[4 + e] * v[4 + e] * rn * g1[e]; }
        *(u32x4*)(yrow + 32 * g) = pack8(v); }
    __syncthreads();
}

__device__ __forceinline__ void sample_unit(LAS unsigned char* lds, const MixP& P, int b, int h, int tid) {
    const int lane = tid & 63, w = __builtin_amdgcn_readfirstlane(tid >> 6);
    const int r0 = NP + b * 8, bh = b * 4 + h;
    LAS float* ql = (LAS float*)lds; LAS float* kl = ql + 1024; LAS float* vl = ql + 2048; LAS float* vnl = ql + 3072; LAS float* Sl = ql + 4096;
    LAS float* gsx = ql + 4160; LAS float* gsy = gsx + 8; LAS float* gwi = gsx + 16; LAS float* gem = gsx + 24; LAS float* gwe = gsx + 32; LAS float* gsc = gsx + 40; LAS float* qn = gsx + 48;
    LAS float* red = (LAS float*)(lds + 32768);
    f32x4 cvv[8];
    { const float* cs = P.stC + (size_t)bh * 16384 + (tid >> 5) * 128 + 4 * (tid & 31);
#pragma unroll
      for (int i = 0; i < 8; ++i) cvv[i] = *(const f32x4*)(cs + (size_t)(16 * i) * 128); }
    if (tid == 0) {
        const float m0 = P.stM[bh]; float bc = 0.f, pm = -INFINITY, mt = 0.f; float xv[8];
#pragma unroll
        for (int t = 0; t < 8; ++t) { const float lf = P.LF[(size_t)(r0 + t) * 4 + h], ig = P.IG[(size_t)(r0 + t) * 4 + h];
            bc += lf; const float x = ig - bc; pm = fmaxf(pm, x); const float y = fmaxf(m0, pm); mt = bc + y; xv[t] = x;
            gsx[t] = x; gsy[t] = y; gwi[t] = __expf(m0 - y); gem[t] = __expf(-mt); }
        const float mnew = mt;
#pragma unroll
        for (int t = 0; t < 8; ++t) gwe[t] = __expf(bc + xv[t] - mnew);
        gsc[0] = __expf(bc + m0 - mnew); gsc[1] = mnew;
    }
    { const int t = tid >> 6, e = 2 * (tid & 63); const bf16_t* zr = P.Z + (size_t)(r0 + t) * ZLD + h * 128 + e;
      const unsigned qw = *(const unsigned*)(zr + ZQ), kw = *(const unsigned*)(zr + ZK), vw = *(const unsigned*)(zr + ZV);
      ql[t * 128 + e] = bf_lo(qw); ql[t * 128 + e + 1] = bf_hi(qw); kl[t * 128 + e] = bf_lo(kw); kl[t * 128 + e + 1] = bf_hi(kw); vl[t * 128 + e] = bf_lo(vw); vl[t * 128 + e + 1] = bf_hi(vw); }
    { const int t = w;
      const u32x4 raw = *(const u32x4*)(P.Z + (size_t)(r0 + t) * ZLD + ZVG + 8 * lane);
      float x[8]; unpack8(raw, x);
      float s = ((x[0] + x[1]) + (x[2] + x[3])) + ((x[4] + x[5]) + (x[6] + x[7]));
      const float mean = wave_sum(s) * (1.0f / 512.0f); float q2 = 0.f;
#pragma unroll
      for (int e = 0; e < 8; ++e) { x[e] -= mean; q2 += x[e] * x[e]; }
      const float rstd = 1.0f / sqrtf(wave_sum(q2) * (1.0f / 512.0f) + EPS);
      if ((lane >> 4) == h) { const f32x4 a = *(const f32x4*)(P.lng + 8 * lane), a2 = *(const f32x4*)(P.lng + 8 * lane + 4), c0 = *(const f32x4*)(P.lnb + 8 * lane), c1 = *(const f32x4*)(P.lnb + 8 * lane + 4);
#pragma unroll
          for (int e = 0; e < 4; ++e) { x[e] = x[e] * rstd * a[e] + c0[e]; x[4 + e] = x[4 + e] * rstd * a2[e] + c1[e]; }
          float* vo = P.oVs + ((size_t)b * 8 + t) * 512 + 8 * lane; *(f32x4*)vo = (f32x4){x[0], x[1], x[2], x[3]}; *(f32x4*)(vo + 4) = (f32x4){x[4], x[5], x[6], x[7]};
#pragma unroll
          for (int e = 0; e < 8; ++e) vnl[t * 128 + 8 * (lane & 15) + e] = x[e]; } }
    __syncthreads();
    if (tid < 64) { const int t = tid >> 3, s = tid & 7; float dot = 0.f;
        for (int d = 0; d < 128; ++d) dot += ql[t * 128 + d] * kl[s * 128 + d];
        Sl[tid] = (s <= t) ? dot * __expf(gsx[s] - gsy[t]) : 0.f; }
    else if (tid < 72) { const int t = tid - 64; float dot = 0.f; for (int d = 0; d < 128; ++d) dot += ql[t * 128 + d] * P.stN[bh * 128 + d]; qn[t] = dot; }
    { const int t = w, e = 2 * lane; float s0 = 0.f, s1 = 0.f;
      for (int j = 0; j <= t; ++j) { const float wv = P.gm_ws[(size_t)h * 16384 + t * 128 + j]; s0 += wv * vnl[j * 128 + e]; s1 += wv * vnl[j * 128 + e + 1]; }
      const float bsv = P.bs[h * 128 + t]; const unsigned uw = *(const unsigned*)(P.Z + (size_t)(r0 + t) * ZLD + ZU + h * 128 + e);
      *(unsigned*)(P.YC + (size_t)(r0 + t) * 1024 + h * 128 + e) = cvt_pk_bf16(bf_lo(uw) * (s0 + bsv), bf_hi(uw) * (s1 + bsv)); }
    const float dec = gsc[0];
    { const int eg = tid & 31, dq = tid >> 5;
      f32x4 aq[8];
#pragma unroll
      for (int t = 0; t < 8; ++t) aq[t] = (f32x4){0.f, 0.f, 0.f, 0.f};
      f32x4 v4[8];
#pragma unroll
      for (int s = 0; s < 8; ++s) v4[s] = *(LAS const f32x4*)(vl + s * 128 + 4 * eg);
      float* co = P.oCs + (size_t)bh * 16384;
#pragma unroll
      for (int i = 0; i < 8; ++i) { const int d = dq + 16 * i; const f32x4 cv = cvv[i];
          f32x4 cn = dec * cv;
#pragma unroll
          for (int t = 0; t < 8; ++t) { aq[t] += ql[t * 128 + d] * cv; cn += (gwe[t] * kl[t * 128 + d]) * v4[t]; }
          *(f32x4*)(co + d * 128 + 4 * eg) = cn; }
#pragma unroll
      for (int t = 0; t < 8; ++t) *(LAS f32x4*)(red + (dq * 8 + t) * 128 + 4 * eg) = aq[t]; }
    __syncthreads();
    { const int t = w, e = 2 * lane; float qc0 = 0.f, qc1 = 0.f;
#pragma unroll
      for (int dq = 0; dq < 16; ++dq) { qc0 += red[(dq * 8 + t) * 128 + e]; qc1 += red[(dq * 8 + t) * 128 + e + 1]; }
      float n0 = 0.f, n1 = 0.f, dsum = 0.f;
#pragma unroll
      for (int s = 0; s < 8; ++s) { const float sv = Sl[t * 8 + s]; n0 += sv * vl[s * 128 + e]; n1 += sv * vl[s * 128 + e + 1]; dsum += sv; }
      const float wi = gwi[t], den = dsum + wi * qn[t], rinv = 1.0f / fmaxf(fabsf(den), gem[t]);
      const float h0 = (n0 + wi * qc0) * rinv, h1 = (n1 + wi * qc1) * rinv;
      const float rn = 1.0f / sqrtf(wave_sum(h0 * h0 + h1 * h1) * (1.0f / 128.0f) + EPS);
      const unsigned ow = *(const unsigned*)(P.Z + (size_t)(r0 + t) * ZLD + ZO + h * 128 + e);
      *(unsigned*)(P.YC + (size_t)(r0 + t) * 1024 + 512 + h * 128 + e) = cvt_pk_bf16(bf_lo(ow) * h0 * rn * P.mlnorm[h * 128 + e], bf_hi(ow) * h1 * rn * P.mlnorm[h * 128 + e + 1]); }
    if (tid < 128) { float nn = dec * P.stN[bh * 128 + tid];
#pragma unroll
        for (int s = 0; s < 8; ++s) nn += gwe[s] * kl[s * 128 + tid];
        P.oNs[bh * 128 + tid] = nn; if (tid == 0) P.oMs[bh] = gsc[1]; }
    __syncthreads();
}
}
namespace sg {
using pg8::bf16_t; using pg8::bf16x8; using pg8::f32x4; using pg8::u32x4; using pg8::u32x2; using pg8::cvt_pk_bf16; using pg8::bf_lo; using pg8::bf_hi; using pg8::sigmoid_f; using pg8::gelu_tanh_f; using pg8::row_rs; using pg8::pair8;
constexpr int ROW0 = 16384;

struct Epi { bf16_t* O; int ldc; const float* rn; const bf16_t* Hb; bf16_t* Ho; float* SSO; const float* SSI; const bf16_t* PROJ; };

template <int MODE> __device__ __forceinline__ void epilogue(const Epi& E, int lrow, int ct, int kq, f32x4 (&acc)[4]) {
    const int row = ROW0 + lrow;
    float rs = 1.f;
    if (MODE == 3) rs = E.rn[row];
    if (MODE == 4) { rs = row_rs(E.SSI, row); rs = rs * rs; }
    if (MODE == 5) rs = row_rs(E.SSI, row);
    float sq = 0.f;
#pragma unroll
    for (int g = 0; g < 2; ++g) { const int col = 64 * ct + 32 * g + 16 * (kq & 1) + 8 * (kq >> 1); float v[8]; pair8(acc[2 * g], acc[2 * g + 1], v);
        if (MODE == 0) {
            if (col < 1024) {
#pragma unroll
                for (int e = 0; e < 8; ++e) v[e] = gelu_tanh_f(v[e]); }
            else if (col >= 2560) {
#pragma unroll
                for (int e = 0; e < 8; ++e) v[e] = sigmoid_f(v[e]); }
        }
        if (MODE == 2) {
#pragma unroll
            for (int e = 0; e < 8; ++e) { const float a = fmaxf(v[e], 0.f); v[e] = a * a; } }
        if (MODE <= 2) { u32x4 w; w.x = cvt_pk_bf16(v[0], v[1]); w.y = cvt_pk_bf16(v[2], v[3]); w.z = cvt_pk_bf16(v[4], v[5]); w.w = cvt_pk_bf16(v[6], v[7]); *(u32x4*)(E.O + (size_t)row * E.ldc + col) = w; continue; }
        const size_t off = (size_t)row * 1024 + col;
        const u32x4 hw = *(const u32x4*)(E.Hb + off); const float r[8] = {bf_lo(hw.x), bf_hi(hw.x), bf_lo(hw.y), bf_hi(hw.y), bf_lo(hw.z), bf_hi(hw.z), bf_lo(hw.w), bf_hi(hw.w)};
        if (MODE == 3) {
#pragma unroll
            for (int e = 0; e < 8; ++e) v[e] = r[e] * rs + v[e]; }
        else if (MODE == 4) {
#pragma unroll
            for (int e = 0; e < 8; ++e) v[e] = r[e] + v[e] * rs; }
        else { const u32x4 pw = *(const u32x4*)(E.PROJ + off); const float pr[8] = {bf_lo(pw.x), bf_hi(pw.x), bf_lo(pw.y), bf_hi(pw.y), bf_lo(pw.z), bf_hi(pw.z), bf_lo(pw.w), bf_hi(pw.w)};
#pragma unroll
            for (int e = 0; e < 8; ++e) v[e] = r[e] + sigmoid_f(v[e] * rs) * pr[e]; }
        { u32x4 w; w.x = cvt_pk_bf16(v[0], v[1]); w.y = cvt_pk_bf16(v[2], v[3]); w.z = cvt_pk_bf16(v[4], v[5]); w.w = cvt_pk_bf16(v[6], v[7]); *(u32x4*)(E.Ho + off) = w; }
#pragma unroll
        for (int e = 0; e < 8; ++e) sq += v[e] * v[e]; }
    if (MODE >= 3) { sq += __shfl_xor(sq, 16); sq += __shfl_xor(sq, 32); if (kq == 0) E.SSO[(size_t)row * 16 + ct] = sq; }
}

constexpr int KT = 128;
__device__ __forceinline__ int toff(int row, int ch) { return (row << 8) + ((ch ^ (row & 15)) << 4); }
struct Issue { int u, kt, left; };
__device__ __forceinline__ void issue_tile(LAS unsigned char* st, Issue& I, const bf16_t* A, const bf16_t* Bt, int K, int nkt, int G, int w, int lane) {
    if (I.left > 0) {
        const bf16_t* ab = A + (size_t)(64 * (I.u & 15)) * K + I.kt * KT; const bf16_t* bb = Bt + (size_t)(64 * (I.u >> 4)) * K + I.kt * KT;
#pragma unroll
        for (int jj = 0; jj < 2; ++jj) { const int j = 2 * w + jj, row = 4 * j + (lane >> 4), ch = (lane & 15) ^ (row & 15);
            __builtin_amdgcn_global_load_lds((const unsigned*)(ab + (size_t)row * K + ch * 8), (LAS unsigned*)(st + j * 1024), 16, 0, 0);
            __builtin_amdgcn_global_load_lds((const unsigned*)(bb + (size_t)row * K + ch * 8), (LAS unsigned*)(st + 16384 + j * 1024), 16, 0, 0); }
        --I.left; if (++I.kt == nkt) { I.kt = 0; I.u += G; }
    } else {
#pragma unroll
        for (int jj = 0; jj < 2; ++jj) { const int j = 2 * w + jj, row = 4 * j + (lane >> 4), ch = (lane & 15) ^ (row & 15);
            __builtin_amdgcn_global_load_lds((const unsigned*)(A + (size_t)row * K + ch * 8), (LAS unsigned*)(st + j * 1024), 16, 0, 0);
            __builtin_amdgcn_global_load_lds((const unsigned*)(Bt + (size_t)row * K + ch * 8), (LAS unsigned*)(st + 16384 + j * 1024), 16, 0, 0); }
    }
}
template <int MODE> __device__ __forceinline__ void phase(LAS unsigned char* lds, const bf16_t* A0, const bf16_t* Bt, int K, int N, const Epi& E, int vcu, int G, int tid) {
    const int lane = tid & 63, w = __builtin_amdgcn_readfirstlane(tid >> 6), fr = lane & 15, kq = lane >> 4, wm = w & 3, wk = w >> 2;
    const bf16_t* A = A0 + (size_t)ROW0 * K;
    const int nu = 16 * (N >> 6), nkt = K / KT;
    if (vcu >= nu) return;
    const int nmine = (nu - vcu + G - 1) / G, total = nmine * nkt;
    f32x4 acc[4];
#pragma unroll
    for (int n = 0; n < 4; ++n) acc[n] = (f32x4){0.f, 0.f, 0.f, 0.f};
    Issue I{vcu, 0, total};
    issue_tile(lds, I, A, Bt, K, nkt, G, w, lane); issue_tile(lds + 32768, I, A, Bt, K, nkt, G, w, lane); issue_tile(lds + 65536, I, A, Bt, K, nkt, G, w, lane);
    int kt = 0, u = vcu;
    for (int i = 0; i < total; ++i) {
        asm volatile("s_waitcnt vmcnt(8)" ::: "memory");
        __builtin_amdgcn_s_barrier();
        asm volatile("" ::: "memory");
        { LAS const unsigned char* st = lds + (i & 3) * 32768;
          bf16x8 af[2], bf[2][4];
          { const int ch = 4 * (2 * wk) + kq; af[0] = *(LAS const bf16x8*)(st + toff(16 * wm + fr, ch));
#pragma unroll
            for (int n = 0; n < 4; ++n) bf[0][n] = *(LAS const bf16x8*)(st + 16384 + toff(16 * n + fr, ch)); }
          issue_tile(lds + ((i + 3) & 3) * 32768, I, A, Bt, K, nkt, G, w, lane);
          { const int ch = 4 * (2 * wk + 1) + kq; af[1] = *(LAS const bf16x8*)(st + toff(16 * wm + fr, ch));
#pragma unroll
            for (int n = 0; n < 4; ++n) bf[1][n] = *(LAS const bf16x8*)(st + 16384 + toff(16 * n + fr, ch)); }
#pragma unroll
          for (int ks = 0; ks < 2; ++ks)
#pragma unroll
              for (int n = 0; n < 4; ++n) acc[n] = __builtin_amdgcn_mfma_f32_16x16x32_bf16(bf[ks][n], af[ks], acc[n], 0, 0, 0); }
        if (kt + 1 == nkt) {
            LAS f32x4* xch = (LAS f32x4*)(lds + 131072) + (wm * 64 + lane) * 4;
            if (wk == 1) {
#pragma unroll
                for (int n = 0; n < 4; ++n) { xch[n] = acc[n]; acc[n] = (f32x4){0.f, 0.f, 0.f, 0.f}; } }
            asm volatile("s_waitcnt lgkmcnt(0)" ::: "memory"); __builtin_amdgcn_s_barrier(); asm volatile("" ::: "memory");
            if (wk == 0) {
#pragma unroll
                for (int n = 0; n < 4; ++n) acc[n] += xch[n];
                epilogue<MODE>(E, 64 * (u & 15) + 16 * wm + fr, u >> 4, kq, acc);
#pragma unroll
                for (int n = 0; n < 4; ++n) acc[n] = (f32x4){0.f, 0.f, 0.f, 0.f}; }
            kt = 0; u += G;
        } else ++kt;
    }
    asm volatile("s_waitcnt vmcnt(0) lgkmcnt(0)" ::: "memory"); __builtin_amdgcn_s_barrier(); asm volatile("" ::: "memory");
}

__device__ __forceinline__ int toff128(int row, int ch) { return (row << 7) + ((ch ^ ((row >> 1) & 7)) << 4); }
__device__ __forceinline__ void issue_tile128(LAS unsigned char* st, Issue& I, const bf16_t* A, const bf16_t* Bt, int K, int nkt, int G, int w, int lane) {
    const bool live = I.left > 0;
    const bf16_t* ab = live ? A + (size_t)(128 * (I.u & 7)) * K + I.kt * 64 : A; const bf16_t* bb = live ? Bt + (size_t)(128 * (I.u >> 3)) * K + I.kt * 64 : Bt;
#pragma unroll
    for (int jj = 0; jj < 2; ++jj) { const int j = 2 * w + jj, row = 8 * j + (lane >> 3), ch = (lane & 7) ^ ((row >> 1) & 7);
        __builtin_amdgcn_global_load_lds((const unsigned*)(ab + (size_t)row * K + ch * 8), (LAS unsigned*)(st + j * 1024), 16, 0, 0);
        __builtin_amdgcn_global_load_lds((const unsigned*)(bb + (size_t)row * K + ch * 8), (LAS unsigned*)(st + 16384 + j * 1024), 16, 0, 0); }
    if (live) { --I.left; if (++I.kt == nkt) { I.kt = 0; I.u += G; } }
}
template <int MODE> __device__ __forceinline__ void phase128(LAS unsigned char* lds, const bf16_t* A0, const bf16_t* Bt, int K, int N, const Epi& E, int vcu, int G, int tid) {
    static_assert(MODE == 0 || MODE == 2, "phase128: bf16-store epilogues only");
    const int lane = tid & 63, w = __builtin_amdgcn_readfirstlane(tid >> 6), fr = lane & 15, kq = lane >> 4, wm = w >> 2, wn = w & 3;
    const bf16_t* A = A0 + (size_t)ROW0 * K;
    const int nu = 8 * (N >> 7), nkt = K / 64;
    if (vcu >= nu) return;
    const int nmine = (nu - vcu + G - 1) / G, total = nmine * nkt;
    f32x4 acc[4][2];
#pragma unroll
    for (int m = 0; m < 4; ++m) { acc[m][0] = (f32x4){0.f, 0.f, 0.f, 0.f}; acc[m][1] = (f32x4){0.f, 0.f, 0.f, 0.f}; }
    Issue I{vcu, 0, total};
    issue_tile128(lds, I, A, Bt, K, nkt, G, w, lane); issue_tile128(lds + 32768, I, A, Bt, K, nkt, G, w, lane); issue_tile128(lds + 65536, I, A, Bt, K, nkt, G, w, lane);
    int kt = 0, u = vcu;
    for (int i = 0; i < total; ++i) {
        asm volatile("s_waitcnt vmcnt(8)" ::: "memory");
        __builtin_amdgcn_s_barrier();
        asm volatile("" ::: "memory");
        { LAS const unsigned char* st = lds + (i & 3) * 32768;
          bf16x8 bb[2][2], aa[2][4];
          { const int ch = kq; bb[0][0] = *(LAS const bf16x8*)(st + 16384 + toff128(32 * wn + fr, ch)); bb[0][1] = *(LAS const bf16x8*)(st + 16384 + toff128(32 * wn + 16 + fr, ch));
#pragma unroll
            for (int m = 0; m < 4; ++m) aa[0][m] = *(LAS const bf16x8*)(st + toff128(64 * wm + 16 * m + fr, ch)); }
          issue_tile128(lds + ((i + 3) & 3) * 32768, I, A, Bt, K, nkt, G, w, lane);
          { const int ch = 4 + kq; bb[1][0] = *(LAS const bf16x8*)(st + 16384 + toff128(32 * wn + fr, ch)); bb[1][1] = *(LAS const bf16x8*)(st + 16384 + toff128(32 * wn + 16 + fr, ch));
#pragma unroll
            for (int m = 0; m < 4; ++m) aa[1][m] = *(LAS const bf16x8*)(st + toff128(64 * wm + 16 * m + fr, ch)); }
#pragma unroll
          for (int ks = 0; ks < 2; ++ks)
#pragma unroll
              for (int m = 0; m < 4; ++m) { acc[m][0] = __builtin_amdgcn_mfma_f32_16x16x32_bf16(bb[ks][0], aa[ks][m], acc[m][0], 0, 0, 0); acc[m][1] = __builtin_amdgcn_mfma_f32_16x16x32_bf16(bb[ks][1], aa[ks][m], acc[m][1], 0, 0, 0); } }
        if (kt + 1 == nkt) {
            const int rt = u & 7, ct = u >> 3;
#pragma unroll
            for (int m = 0; m < 4; ++m) { const int row = ROW0 + 128 * rt + 64 * wm + 16 * m + fr;
                { const int col = 128 * ct + 32 * wn + 16 * (kq & 1) + 8 * (kq >> 1); float v[8]; pair8(acc[m][0], acc[m][1], v);
                    if (MODE == 0) {
                        if (col < 1024) {
#pragma unroll
                            for (int e = 0; e < 8; ++e) v[e] = gelu_tanh_f(v[e]); }
                        else if (col >= 2560) {
#pragma unroll
                            for (int e = 0; e < 8; ++e) v[e] = sigmoid_f(v[e]); } }
                    if (MODE == 2) {
#pragma unroll
                        for (int e = 0; e < 8; ++e) { const float a = fmaxf(v[e], 0.f); v[e] = a * a; } }
                    u32x4 o; o.x = cvt_pk_bf16(v[0], v[1]); o.y = cvt_pk_bf16(v[2], v[3]); o.z = cvt_pk_bf16(v[4], v[5]); o.w = cvt_pk_bf16(v[6], v[7]); *(u32x4*)(E.O + (size_t)row * E.ldc + col) = o;
                    acc[m][0] = (f32x4){0.f, 0.f, 0.f, 0.f}; acc[m][1] = (f32x4){0.f, 0.f, 0.f, 0.f}; } }
            kt = 0; u += G;
        } else ++kt;
    }
    asm volatile("s_waitcnt vmcnt(0) lgkmcnt(0)" ::: "memory"); __builtin_amdgcn_s_barrier(); asm volatile("" ::: "memory");
}
}

#ifndef HOST_DUP_PHASE
#define HOST_DUP_PHASE -1
#endif
#ifndef TP_A
#define TP_A -1
#define TP_B -1
#endif
#ifndef HOST_DUP_FLAGS
#define HOST_DUP_FLAGS 1
#endif
#ifndef HOST_EXTRA_BARS
#define HOST_EXTRA_BARS 0
#endif
#ifndef MK_ONE_LAUNCH
#define MK_ONE_LAUNCH 1
#endif
constexpr int NWAVES = 8;
constexpr int D = 1024, NPR = 16384, NSR = 1024, M = NPR + NSR, NIN = 3072, INC = 3080, FF = 4096, PLE = 256;
constexpr int N_PHASES = 10;
constexpr size_t MiB = 1u << 20;
constexpr size_t WS_CTL = 0, CTL_ZERO_BYTES = 65536;
constexpr int CW_BAR = 1024;
constexpr size_t WS_WIN = 1 * MiB;
constexpr size_t WS_WOUT = WS_WIN + (size_t)NIN * D * 2;
constexpr size_t WS_WUP = WS_WOUT + (size_t)D * D * 2;
constexpr size_t WS_WDOWN = WS_WUP + (size_t)FF * D * 2;
constexpr size_t WS_WGATE = WS_WDOWN + (size_t)D * FF * 2;
constexpr size_t WS_WPROJ = WS_WGATE + (size_t)D * D * 2;
constexpr size_t WS_WSB = WS_WPROJ + (size_t)D * PLE * 2;
constexpr size_t WS_IG = WS_WSB + 4 * 128 * 128 * 2;
constexpr size_t WS_LF = WS_IG + (size_t)M * 16;
constexpr size_t WS_SS1 = WS_LF + (size_t)M * 16;
constexpr size_t WS_SS2 = WS_SS1 + (size_t)M * 64;
constexpr size_t WS_SS3 = WS_SS2 + (size_t)M * 64;
constexpr size_t WS_CH = WS_SS3 + (size_t)M * 64;
constexpr size_t WS_MST = WS_CH + 4096;
constexpr size_t WS_NLOC = WS_MST + 4096;
constexpr size_t WS_NST = WS_NLOC + 512 * 128 * 4;
constexpr size_t WS_RN = WS_NST + 512 * 128 * 4;
constexpr size_t WS_LNS = WS_RN + 69632;
constexpr size_t WS_PE = WS_LNS + (size_t)16384 * 64;
constexpr size_t WS_RA = WS_PE + (size_t)M * PLE * 2;
constexpr size_t WS_RB = WS_RA + (size_t)M * D * 2;
constexpr size_t WS_YC = WS_RB + (size_t)M * NIN * 2;
constexpr size_t WS_KV = WS_RB + (size_t)M * FF * 2;
constexpr size_t WS_END = WS_KV + (size_t)M * D * 2;
static_assert(WS_END <= 256 * MiB, "d_ws map");
static_assert(WS_WIN % 256 == 0 && WS_IG % 256 == 0 && WS_PE % 256 == 0 && WS_RA % 256 == 0 && WS_RB % 256 == 0 && WS_YC % 256 == 0 && WS_KV % 256 == 0, "alignment");
constexpr size_t O_Y = 0, O_CP = (size_t)M * D, O_NP = O_CP + 8 * 4 * 16384, O_MP = O_NP + 8 * 4 * 128, O_VP = O_MP + 32, O_CS = O_VP + 8 * 128 * 512,
                 O_NS = O_CS + (size_t)128 * 4 * 16384, O_MS = O_NS + 128 * 4 * 128, O_VS = O_MS + 512, O_END = O_VS + 128 * 8 * 512;
constexpr int RING_OFF = 0, RING_BYTES = 131072, XCH_BYTES = 16384, LDSCTL_OFF = RING_BYTES + XCH_BYTES, MISC_OFF = LDSCTL_OFF + 320, LDS_BYTES = LDSCTL_OFF + 1024;

typedef unsigned short bf16;
typedef unsigned v4u __attribute__((ext_vector_type(4)));
typedef float f32x4 __attribute__((ext_vector_type(4)));
#define GAS __attribute__((address_space(1)))
typedef GAS unsigned gu32;
#define RLX_AGENT __ATOMIC_RELAXED, __HIP_MEMORY_SCOPE_AGENT
#define LDS_WAIT() asm volatile("s_waitcnt lgkmcnt(0)" ::: "memory")

struct Args { const float* in[24]; float* out; unsigned char* ws; int ph_lo, ph_hi, flags, extra_bars; };

#define XB_TMO      128
#define XB_XCNT(j)  (256  + 64 * (j))
#define XB_XSUB(j)  (1280 + 64 * (j))
#define XB_XGEN(j)  (2304 + 64 * (j))
#define XB_TOP      3328
#define XB_TOPGEN   3392
#define XCD_BAR_WORDS 3456
#define XB_SPIN_CAP (1u << 18)

__device__ __forceinline__ unsigned xb_ld(unsigned* p)              { return __hip_atomic_load(p, __ATOMIC_RELAXED, __HIP_MEMORY_SCOPE_AGENT); }
__device__ __forceinline__ unsigned xb_add(unsigned* p, unsigned v) { return __hip_atomic_fetch_add(p, v, __ATOMIC_RELAXED, __HIP_MEMORY_SCOPE_AGENT); }
__device__ __forceinline__ unsigned xb_xcc_id() { return (unsigned)__builtin_amdgcn_s_getreg((3 << 11) | 20) & 0xFu; }
#define XB_SPIN(cond, bar) do { unsigned _sp = 0; while (cond) { __builtin_amdgcn_s_sleep(1); \
    if ((++_sp & 255u) == 0u) { if (xb_ld(&(bar)[XB_TMO])) break; if (_sp > XB_SPIN_CAP) { atomicAdd(&(bar)[XB_TMO], 1u); break; } } } } while (0)

struct XcdBarrier {
    unsigned* bar; unsigned x;
    volatile LAS unsigned* st;
};

__device__ __forceinline__ XcdBarrier xcd_barrier_post(unsigned* bar, volatile LAS unsigned* st) {
    XcdBarrier b; b.bar = bar; b.x = xb_xcc_id(); b.st = st;
    if (threadIdx.x == 0) (void)xb_add(&bar[XB_XCNT(b.x)], 1u);
    return b;
}
__device__ __forceinline__ void xcd_barrier_complete(unsigned* bar, unsigned x, unsigned& nloc, unsigned& nx) {
    const unsigned G = gridDim.x * gridDim.y * gridDim.z;
    unsigned sum, cnt, mine, sp = 0u;
    for (;;) {
        sum = 0u; cnt = 0u; mine = 0u;
#pragma unroll
        for (unsigned j = 0; j < 16; ++j) { const unsigned c = xb_ld(&bar[XB_XCNT(j)]); sum += c; cnt += (c > 0u) ? 1u : 0u; mine = (j == x) ? c : mine; }
        if (sum == G) break;
        __builtin_amdgcn_s_sleep(1);
        if ((++sp & 255u) == 0u) { if (xb_ld(&bar[XB_TMO])) break; if (sp > XB_SPIN_CAP) { atomicAdd(&bar[XB_TMO], 1u); break; } }
    }
    nloc = mine > 0u ? mine : 1u; nx = cnt > 0u ? cnt : 1u;
}

__device__ __forceinline__ void xcd_barrier(const XcdBarrier& b) {
    asm volatile("s_waitcnt vmcnt(0)" ::: "memory");
    __syncthreads();
    if (threadIdx.x == 0) {
        unsigned* bar = b.bar;
        __builtin_amdgcn_s_waitcnt(0);
        unsigned nloc = b.st[0], nx = b.st[1];
        if (nloc == 0u) { xcd_barrier_complete(bar, b.x, nloc, nx); b.st[0] = nloc; b.st[1] = nx; }
        const unsigned old = xb_add(&bar[XB_XSUB(b.x)], 1u);
        const unsigned gen = old / nloc;
        if (old + 1u == (gen + 1u) * nloc) {
            __builtin_amdgcn_fence(__ATOMIC_RELEASE, "agent");
            asm volatile("s_waitcnt vmcnt(0)" ::: "memory");
            const unsigned og = xb_add(&bar[XB_TOP], 1u);
            const unsigned tg = og / nx;
            if (og + 1u == (tg + 1u) * nx) xb_add(&bar[XB_TOPGEN], 1u);
            else XB_SPIN(xb_ld(&bar[XB_TOPGEN]) == tg, bar);
            __builtin_amdgcn_fence(__ATOMIC_ACQUIRE, "agent");
            xb_add(&bar[XB_XGEN(b.x)], 1u);
            asm volatile("s_waitcnt vmcnt(0)" ::: "memory");
        } else {
            XB_SPIN(xb_ld(&bar[XB_XGEN(b.x)]) == gen, bar);
            __builtin_amdgcn_fence(__ATOMIC_ACQUIRE, "agent");
            asm volatile("s_waitcnt vmcnt(0)" ::: "memory");
        }
    }
    __syncthreads();
}

__device__ __forceinline__ void p0_transpose_item(const float* W, int ldw, int K, int N, const float* gain, bf16* WT, LAS float* scr, int item, int lane, bool kscale) {
    const int nblk = N / 32, kb = item / nblk, nb = item % nblk, k0 = 64 * kb, n0 = 32 * nb;
    const float cs = (kscale && n0 >= 1536 && n0 < 2048) ? 0.08838834764831845f : 1.0f;
    float wv[32];
#pragma unroll
    for (int i = 0; i < 32; ++i) { const int kk = 2 * i + (lane >> 5); wv[i] = W[(size_t)(k0 + kk) * ldw + n0 + (lane & 31)]; }
#pragma unroll
    for (int i = 0; i < 32; ++i) { const int kk = 2 * i + (lane >> 5); const float g = gain ? gain[k0 + kk] * cs : cs; scr[kk * 33 + (lane & 31)] = wv[i] * g; }
    LDS_WAIT(); asm volatile("" ::: "memory");
    const int c = lane & 7;
#pragma unroll
    for (int j = 0; j < 4; ++j) { const int n = (lane >> 3) + 8 * j; const LAS float* s = scr + (8 * c) * 33 + n;
        v4u o; o.x = pg8::cvt_pk_bf16(s[0 * 33], s[1 * 33]); o.y = pg8::cvt_pk_bf16(s[2 * 33], s[3 * 33]); o.z = pg8::cvt_pk_bf16(s[4 * 33], s[5 * 33]); o.w = pg8::cvt_pk_bf16(s[6 * 33], s[7 * 33]);
        *(v4u*)(WT + (size_t)(n0 + n) * K + k0 + 8 * c) = o; }
    LDS_WAIT(); asm volatile("" ::: "memory");
}

__device__ __forceinline__ float log_sigmoid_f(float x) { return fminf(x, 0.f) - log1pf(__expf(-fabsf(x))); }

struct RowIn { f32x4 v[4]; f32x4 pv; };
__device__ __forceinline__ void p0_row_load(const Args& A, int m, int lane, RowIn& R) {
    const float* xrow = (m < NPR) ? A.in[0] + (size_t)m * D : A.in[1] + (size_t)(m - NPR) * D;
    const float* prow = (m < NPR) ? A.in[2] + (size_t)m * PLE : A.in[3] + (size_t)(m - NPR) * PLE;
    const f32x4* xr = (const f32x4*)xrow + lane;
#pragma unroll
    for (int j = 0; j < 4; ++j) R.v[j] = xr[64 * j];
    R.pv = *((const f32x4*)prow + lane);
}
__device__ __forceinline__ void p0_row_finish(unsigned char* ws, int m, int lane, RowIn& R, const float (&gwt)[4][4][8], float gbias) {
    float s = 0.f;
#pragma unroll
    for (int j = 0; j < 4; ++j) s += (R.v[j][0] * R.v[j][0] + R.v[j][1] * R.v[j][1]) + (R.v[j][2] * R.v[j][2] + R.v[j][3] * R.v[j][3]);
    const float rnv = sqrtf(mix::wave_sum(s) * (1.0f / D) + 1e-6f), rinv = 1.0f / rnv;
    if (lane == 8) ((float*)(ws + WS_RN))[m] = rnv;
    unsigned long long* o8 = (unsigned long long*)((bf16*)(ws + WS_RA) + (size_t)m * D) + lane;
    float g8[8];
#pragma unroll
    for (int q = 0; q < 8; ++q) g8[q] = 0.f;
#pragma unroll
    for (int j = 0; j < 4; ++j) { const f32x4 v = R.v[j] * rinv;
        o8[64 * j] = (unsigned long long)pg8::cvt_pk_bf16(v[0], v[1]) | ((unsigned long long)pg8::cvt_pk_bf16(v[2], v[3]) << 32);
#pragma unroll
        for (int c = 0; c < 4; ++c)
#pragma unroll
            for (int q = 0; q < 8; ++q) g8[q] += v[c] * gwt[j][c][q]; }
#pragma unroll
    for (int q = 0; q < 8; ++q) g8[q] = mix::row_sum16(g8[q]);
    const int q8 = lane & 7;
    float val = q8 == 0 ? g8[0] : q8 == 1 ? g8[1] : q8 == 2 ? g8[2] : q8 == 3 ? g8[3] : q8 == 4 ? g8[4] : q8 == 5 ? g8[5] : q8 == 6 ? g8[6] : g8[7];
    val += __shfl_xor(val, 16); val += __shfl_xor(val, 32);
    if (lane < 4) ((float*)(ws + WS_IG))[(size_t)m * 4 + lane] = val + gbias;
    else if (lane < 8) ((float*)(ws + WS_LF))[(size_t)m * 4 + lane - 4] = log_sigmoid_f(val + gbias);
    *((unsigned long long*)((bf16*)(ws + WS_PE) + (size_t)m * PLE) + lane) = (unsigned long long)pg8::cvt_pk_bf16(R.pv[0], R.pv[1]) | ((unsigned long long)pg8::cvt_pk_bf16(R.pv[2], R.pv[3]) << 32);
}

__device__ __forceinline__ void p0_prologue(const Args& A, LAS unsigned char* lds, int vcu, int G, int tid) {
    const int lane = tid & 63, wave = __builtin_amdgcn_readfirstlane(tid >> 6);
    unsigned char* ws = A.ws;
    LAS float* scr = (LAS float*)(lds + RING_OFF + wave * 8704);
    LAS float* gtab = (LAS float*)(lds + RING_OFF + 8 * 8704);
    const int gw = vcu * NWAVES + wave, NGW = G * NWAVES;
    for (int k = tid; k < D; k += NWAVES * 64) { const float g = A.in[7][k]; const float* wp = A.in[8] + (size_t)k * INC + NIN;
        const f32x4 a = *(const f32x4*)wp, b = *(const f32x4*)(wp + 4); *(LAS f32x4*)(gtab + k * 8) = a * g; *(LAS f32x4*)(gtab + k * 8 + 4) = b * g; }
    constexpr int I_IN = (D / 64) * (NIN / 32), I_OUT = (D / 64) * (D / 32), I_UP = (D / 64) * (FF / 32), I_DOWN = (FF / 64) * (D / 32), I_GATE = I_OUT, I_PROJ = (PLE / 64) * (D / 32);
    constexpr int NITEMS = I_IN + I_OUT + I_UP + I_DOWN + I_GATE + I_PROJ;
    for (int it = gw; it < NITEMS; it += NGW) {
        int r = it;
        if (r < I_IN) { p0_transpose_item(A.in[8], INC, D, NIN, A.in[7], (bf16*)(ws + WS_WIN), scr, r, lane, true); continue; } r -= I_IN;
        if (r < I_OUT) { p0_transpose_item(A.in[16], D, D, D, nullptr, (bf16*)(ws + WS_WOUT), scr, r, lane, false); continue; } r -= I_OUT;
        if (r < I_UP) { p0_transpose_item(A.in[18], FF, D, FF, A.in[17], (bf16*)(ws + WS_WUP), scr, r, lane, false); continue; } r -= I_UP;
        if (r < I_DOWN) { p0_transpose_item(A.in[19], D, FF, D, nullptr, (bf16*)(ws + WS_WDOWN), scr, r, lane, false); continue; } r -= I_DOWN;
        if (r < I_GATE) { p0_transpose_item(A.in[21], D, D, D, A.in[20], (bf16*)(ws + WS_WGATE), scr, r, lane, false); continue; } r -= I_GATE;
        p0_transpose_item(A.in[22], D, PLE, D, nullptr, (bf16*)(ws + WS_WPROJ), scr, r, lane, false);
    }
    { const int gt = vcu * 512 + tid, NT = G * 512; const float* wsrc = A.in[11]; bf16* wdst = (bf16*)(ws + WS_WSB);
      for (int i = gt; i < 4 * 128 * 128 / 4; i += NT) { const int e = 4 * i, t = (e >> 7) & 127, j = e & 127; const f32x4 v = *(const f32x4*)(wsrc + e);
          pg8::u32x2 o; o.x = pg8::cvt_pk_bf16(j <= t ? v[0] : 0.f, j + 1 <= t ? v[1] : 0.f); o.y = pg8::cvt_pk_bf16(j + 2 <= t ? v[2] : 0.f, j + 3 <= t ? v[3] : 0.f);
          *(pg8::u32x2*)(wdst + e) = o; } }
    __syncthreads();
    float gwt[4][4][8];
#pragma unroll
    for (int j = 0; j < 4; ++j)
#pragma unroll
        for (int c = 0; c < 4; ++c) { const LAS float* gp = gtab + (4 * lane + 256 * j + c) * 8; const f32x4 a = *(const LAS f32x4*)gp, b = *(const LAS f32x4*)(gp + 4);
#pragma unroll
            for (int q = 0; q < 4; ++q) { gwt[j][c][q] = a[q]; gwt[j][c][4 + q] = b[q]; } }
    const float gbias = (lane < 4) ? A.in[13][lane & 3] : A.in[14][lane & 3];
    for (int m = gw; m < M; m += 2 * NGW) {
        const int m2 = (m + NGW < M) ? m + NGW : m;
        RowIn R0, R1; p0_row_load(A, m, lane, R0); p0_row_load(A, m2, lane, R1);
        p0_row_finish(ws, m, lane, R0, gwt, gbias);
        p0_row_finish(ws, m2, lane, R1, gwt, gbias);
    }
    __syncthreads();
}

__device__ __forceinline__ void p7_final(const Args& A, int vcu, int G, int tid) {
    const int lane = tid & 63, wave = __builtin_amdgcn_readfirstlane(tid >> 6);
    const int gw = vcu * NWAVES + wave, NGW = G * NWAVES;
    const float* ss = (const float*)(A.ws + WS_SS3); const bf16* Hb = (const bf16*)(A.ws + WS_RB);
    const f32x4 g0 = *((const f32x4*)A.in[23] + 2 * lane), g1 = *((const f32x4*)A.in[23] + 2 * lane + 1), g2 = *((const f32x4*)A.in[23] + 128 + 2 * lane), g3 = *((const f32x4*)A.in[23] + 128 + 2 * lane + 1);
    for (int m = gw; m < M; m += NGW) {
        const float rs = pg8::row_rs(ss, m);
        const v4u a = *((const v4u*)(Hb + (size_t)m * D) + lane), b = *((const v4u*)(Hb + (size_t)m * D) + 64 + lane);
        f32x4* yr = (f32x4*)(A.out + (size_t)m * D);
        yr[2 * lane] = (f32x4){pg8::bf_lo(a.x), pg8::bf_hi(a.x), pg8::bf_lo(a.y), pg8::bf_hi(a.y)} * rs * g0;
        yr[2 * lane + 1] = (f32x4){pg8::bf_lo(a.z), pg8::bf_hi(a.z), pg8::bf_lo(a.w), pg8::bf_hi(a.w)} * rs * g1;
        yr[128 + 2 * lane] = (f32x4){pg8::bf_lo(b.x), pg8::bf_hi(b.x), pg8::bf_lo(b.y), pg8::bf_hi(b.y)} * rs * g2;
        yr[128 + 2 * lane + 1] = (f32x4){pg8::bf_lo(b.z), pg8::bf_hi(b.z), pg8::bf_lo(b.w), pg8::bf_hi(b.w)} * rs * g3;
    }
}

__global__ void __launch_bounds__(NWAVES * 64, 2) hymba_fwd(Args args) {
    extern __shared__ __attribute__((aligned(16))) unsigned char lds_raw[];
    LAS unsigned char* lds = (LAS unsigned char*)lds_raw;
    const int tid = threadIdx.x, G = gridDim.x, bx = blockIdx.x;
    const int vcu = (G % 8 == 0) ? (bx % 8) * (G / 8) + bx / 8 : bx;
    unsigned char* ws = args.ws;
#ifndef DUP_PHASE
#define DUP_PHASE -1
#endif
    const int lo = args.ph_lo, hi = args.ph_hi;
#ifndef PH_MASK
#define PH_MASK 0xffff
#endif
#define INC_(k) (((PH_MASK >> (k)) & 1) && lo <= (k) && (k) < hi)
#if DUP_PHASE >= 0
#define IN(k) for (int rep_ = 0; rep_ < ((DUP_PHASE == (k)) ? 2 : 1); ++rep_) if (INC_(k))
#define GRID_BAR(k) do { if (INC_((k) + 1)) xcd_barrier(bar); } while (0)
#else
#define IN(k) if (INC_(k))
#define GRID_BAR(k) do { if (INC_((k) + 1)) xcd_barrier(bar); } while (0)
#endif
    for (int u = tid; u < (LDS_BYTES - LDSCTL_OFF) / 4; u += NWAVES * 64) ((LAS unsigned*)(lds + LDSCTL_OFF))[u] = 0u;
    __syncthreads();
    XcdBarrier bar = xcd_barrier_post((unsigned*)(ws + WS_CTL) + CW_BAR, (volatile LAS unsigned*)(lds + MISC_OFF) + 8);
    float* OUT = args.out;
    const int FL = args.flags;
#if TP_A >= 0
    unsigned long long tp_a = 0ull, tp_b = 0ull;
#define STAMP(id) do { if ((id) == TP_A || (id) == TP_B) { asm volatile("s_waitcnt vmcnt(0) lgkmcnt(0)" ::: "memory"); const unsigned long long t_ = __builtin_amdgcn_s_memrealtime(); if ((id) == TP_A) tp_a = t_; if ((id) == TP_B) tp_b = t_; } } while (0)
#else
#define STAMP(id) do { } while (0)
#endif
    bf16* RA = (bf16*)(ws + WS_RA); bf16* Zb = (bf16*)(ws + WS_RB); bf16* YC = (bf16*)(ws + WS_YC); bf16* HID = (bf16*)(ws + WS_RB); bf16* H3 = (bf16*)(ws + WS_RB);     bf16* PROJ = (bf16*)args.out;
    float* SS1 = (float*)(ws + WS_SS1); float* SS2 = (float*)(ws + WS_SS2); float* SS3 = (float*)(ws + WS_SS3);
    mix::MixP MP;
    MP.Z = Zb; MP.YC = YC; MP.IG = (const float*)(ws + WS_IG); MP.LF = (const float*)(ws + WS_LF); MP.LNS = (const float*)(ws + WS_LNS); MP.WSb = (const bf16*)(ws + WS_WSB);
    MP.gm_ws = args.in[11]; MP.lng = args.in[9]; MP.lnb = args.in[10]; MP.bs = args.in[12]; MP.mlnorm = args.in[15];
    MP.KV = (bf16*)(ws + WS_KV); MP.NLOC = (float*)(ws + WS_NLOC); MP.NST = (float*)(ws + WS_NST); MP.CH = (float*)(ws + WS_CH); MP.MST = (float*)(ws + WS_MST);
    MP.stC = args.in[4]; MP.stN = args.in[5]; MP.stM = args.in[6];
    MP.oCp = OUT + O_CP; MP.oNp = OUT + O_NP; MP.oMp = OUT + O_MP; MP.oVp = OUT + O_VP; MP.oCs = OUT + O_CS; MP.oNs = OUT + O_NS; MP.oMs = OUT + O_MS; MP.oVs = OUT + O_VS;

    STAMP(0);
    IN(0) { p0_prologue(args, lds, vcu, G, tid); STAMP(1); GRID_BAR(0); for (int eb = 0; eb < args.extra_bars; ++eb) xcd_barrier(bar); }
    STAMP(2);
    IN(1) {
        pg8::Gemm g{RA, (const bf16*)(ws + WS_WIN), NPR, NIN, D}; pg8::StaticOrder S; S.init(NPR, NIN, G, bx);
        pg8::EpiBf16<0> E{Zb, NIN, (float*)(ws + WS_LNS)};
        if (!(FL & 2)) pg8::gemm_phase<pg8::EpiBf16<0>, pg8::StaticOrder, true, true>(lds + RING_OFF, g, S, E);
        STAMP(3);
        if (!(FL & 4)) { const sg::Epi SE{Zb, NIN, nullptr, nullptr, nullptr, nullptr, nullptr, nullptr}; sg::phase128<0>(lds + RING_OFF, RA, (const bf16*)(ws + WS_WIN), D, NIN, SE, vcu, G, tid); }
        GRID_BAR(1);
    }
    STAMP(4);
    IN(2) {
        for (int u = vcu; u < 1024; u += G) {
            if (u < 512) { if (FL & 16) continue; const int bc = u >> 2, h = u & 3; mix::gmlp_unit(lds, MP, bc >> 4, bc & 15, h, tid); }
            else { if (FL & 32) continue; if (u == vcu + 512) STAMP(5); const int v = u - 512; mix::kv_unit(lds, MP, v >> 6, (v >> 4) & 3, v & 15, tid); }
        }
        GRID_BAR(2);
    }
    STAMP(6);
    IN(3) {
        if (!(FL & 1)) for (int u = vcu; u < 256; u += G) mix::scan_unit(MP, u >> 3, u & 7, tid);
        STAMP(7);
        if (!(FL & 64)) for (int u = vcu; u < 512; u += G) mix::sample_unit(lds, MP, u >> 2, u & 3, tid);
        STAMP(21);
        if (!(FL & 128)) { pg8::Gemm g{(const bf16*)(ws + WS_PE), (const bf16*)(ws + WS_WPROJ), NPR, D, PLE}; pg8::StaticOrder S; S.init(NPR, D, G, bx);
          pg8::EpiBf16<1> E{PROJ, D, nullptr};
          if (!(FL & 2)) pg8::gemm_phase<pg8::EpiBf16<1>, pg8::StaticOrder, true, true>(lds + RING_OFF, g, S, E);
          STAMP(22);
          const sg::Epi SE{PROJ, D, nullptr, nullptr, nullptr, nullptr, nullptr, nullptr}; if (!(FL & 4)) sg::phase<1>(lds + RING_OFF, (const bf16*)(ws + WS_PE), (const bf16*)(ws + WS_WPROJ), PLE, D, SE, vcu, G, tid); }
        GRID_BAR(3);
    }
    STAMP(8);
    IN(4) {
        for (int rep = 0; rep < ((FL & 256) ? 3 : 1); ++rep)
        for (int u = vcu; u < 512; u += G) mix::mlo_unit(lds, MP, u >> 6, (u >> 4) & 3, u & 15, tid);
        GRID_BAR(4);
    }
    STAMP(10);
    IN(5) {
        pg8::Gemm g{YC, (const bf16*)(ws + WS_WOUT), NPR, D, D}; pg8::StaticOrder S; S.init(NPR, D, G, bx);
        pg8::EpiRes<0> E{(const float*)(ws + WS_RN), RA, RA, SS1, nullptr, nullptr};
        if (!(FL & 2)) pg8::gemm_phase<pg8::EpiRes<0>, pg8::StaticOrder, true, true>(lds + RING_OFF, g, S, E);
        STAMP(11);
        if (!(FL & 4)) { const sg::Epi SE{nullptr, 0, (const float*)(ws + WS_RN), RA, RA, SS1, nullptr, nullptr}; sg::phase<3>(lds + RING_OFF, YC, (const bf16*)(ws + WS_WOUT), D, D, SE, vcu, G, tid); }
        GRID_BAR(5);
    }
    STAMP(12);
    IN(6) {
        pg8::Gemm g{RA, (const bf16*)(ws + WS_WUP), NPR, FF, D}; pg8::StaticOrder S; S.init(NPR, FF, G, bx);
        pg8::EpiBf16<2> E{HID, FF, nullptr};
        if (!(FL & 2)) pg8::gemm_phase<pg8::EpiBf16<2>, pg8::StaticOrder, true, true>(lds + RING_OFF, g, S, E);
        STAMP(13);
        if (!(FL & 4)) { const sg::Epi SE{HID, FF, nullptr, nullptr, nullptr, nullptr, nullptr, nullptr}; sg::phase128<2>(lds + RING_OFF, RA, (const bf16*)(ws + WS_WUP), D, FF, SE, vcu, G, tid); }
        GRID_BAR(6);
    }
    STAMP(14);
    IN(7) {
        pg8::Gemm g{HID, (const bf16*)(ws + WS_WDOWN), NPR, D, FF}; pg8::StaticOrder S; S.init(NPR, D, G, bx);
        pg8::EpiRes<1> E{nullptr, RA, (FL & 8) ? (bf16*)(ws + WS_KV) : RA, (FL & 8) ? SS3 : SS2, SS1, nullptr};
        if (!(FL & 2)) pg8::gemm_phase<pg8::EpiRes<1>, pg8::StaticOrder, true, true>(lds + RING_OFF, g, S, E);
        STAMP(15);
        if (!(FL & 4)) { const sg::Epi SE{nullptr, 0, nullptr, RA, (FL & 8) ? (bf16*)(ws + WS_KV) : RA, (FL & 8) ? SS3 : SS2, SS1, nullptr}; sg::phase<4>(lds + RING_OFF, HID, (const bf16*)(ws + WS_WDOWN), FF, D, SE, vcu, G, tid); }
        GRID_BAR(7);
    }
    STAMP(16);
    IN(8) {
        pg8::Gemm g{RA, (const bf16*)(ws + WS_WGATE), NPR, D, D}; pg8::StaticOrder S; S.init(NPR, D, G, bx);
        pg8::EpiRes<2> E{nullptr, RA, (FL & 8) ? (bf16*)(ws + WS_KV) : H3, (FL & 8) ? SS1 : SS3, SS2, PROJ};
        if (!(FL & 2)) pg8::gemm_phase<pg8::EpiRes<2>, pg8::StaticOrder, true, true>(lds + RING_OFF, g, S, E);
        STAMP(17);
        if (!(FL & 4)) { const sg::Epi SE{nullptr, 0, nullptr, RA, (FL & 8) ? (bf16*)(ws + WS_KV) : H3, (FL & 8) ? SS1 : SS3, SS2, PROJ}; sg::phase<5>(lds + RING_OFF, RA, (const bf16*)(ws + WS_WGATE), D, D, SE, vcu, G, tid); }
        GRID_BAR(8);
    }
    STAMP(18);
    IN(9) p7_final(args, vcu, G, tid);
    STAMP(20);
#if TP_A >= 0
    if (bx == 0 && tid == 0) { asm volatile("s_waitcnt vmcnt(0)" ::: "memory"); OUT[O_MP] = (float)(tp_b - tp_a); }
#endif
#undef IN
#undef GRID_BAR
}

extern "C" void kernel_launch(void* const* d_in, const int* in_sizes, int n_in, void* d_out, int out_size, void* d_ws, size_t ws_size, hipStream_t stream) {
    static int grid = 0;
    if (grid == 0) {
        if (n_in != 24 || (size_t)out_size != O_END || ws_size < WS_END) { fprintf(stderr, "kernel_launch: unexpected problem shape (n_in %d, out %d, ws %zu)\n", n_in, out_size, ws_size); grid = -1; return; }
        int dev = 0, cus = 0, per_cu = 0;
        if (hipGetDevice(&dev) != hipSuccess || hipDeviceGetAttribute(&cus, hipDeviceAttributeMultiprocessorCount, dev) != hipSuccess) { grid = -1; return; }
        if (hipFuncSetAttribute((const void*)hymba_fwd, hipFuncAttributeMaxDynamicSharedMemorySize, LDS_BYTES) != hipSuccess) { fprintf(stderr, "kernel_launch: hipFuncSetAttribute failed\n"); grid = -1; return; }
        if (hipOccupancyMaxActiveBlocksPerMultiprocessor(&per_cu, (const void*)hymba_fwd, NWAVES * 64, LDS_BYTES) != hipSuccess || per_cu < 1) { fprintf(stderr, "kernel_launch: occupancy query says %d blocks per CU\n", per_cu); per_cu = 1; }
        (void)hipGetLastError();
        grid = cus * (per_cu < 1 ? per_cu : 1);
    }
    if (grid < 0) return;
    Args a{};
    for (int i = 0; i < 24; ++i) a.in[i] = (const float*)d_in[i];
    a.out = (float*)d_out; a.ws = (unsigned char*)d_ws;
#if MK_ONE_LAUNCH
    if (hipMemsetAsync((char*)d_ws + WS_CTL, 0, CTL_ZERO_BYTES, stream) != hipSuccess) { fprintf(stderr, "kernel_launch: memset of the control words failed\n"); return; }
    void* kargs[] = {&a};
#if HOST_DUP_PHASE >= 0
    const int cuts[4] = {0, HOST_DUP_PHASE + 1, HOST_DUP_PHASE, N_PHASES};
    for (int li = 0; li < 3; ++li) {
        a.ph_lo = (li == 1) ? HOST_DUP_PHASE : (li == 2 ? HOST_DUP_PHASE + 1 : 0); a.ph_hi = (li == 0 || li == 1) ? HOST_DUP_PHASE + 1 : N_PHASES; a.flags = (li == 1) ? HOST_DUP_FLAGS : 0;
        if (li > 0) (void)hipMemsetAsync((char*)d_ws + WS_CTL, 0, CTL_ZERO_BYTES, stream);
        (void)hipLaunchCooperativeKernel((const void*)hymba_fwd, dim3(grid), dim3(NWAVES * 64), kargs, LDS_BYTES, stream);
    }
    (void)cuts;
#else
    a.ph_lo = 0; a.ph_hi = N_PHASES; a.extra_bars = HOST_EXTRA_BARS;
    const hipError_t e = hipLaunchCooperativeKernel((const void*)hymba_fwd, dim3(grid), dim3(NWAVES * 64), kargs, LDS_BYTES, stream);
    if (e != hipSuccess) fprintf(stderr, "kernel_launch: cooperative launch failed: %s (grid %d)\n", hipGetErrorString(e), grid);
#endif
#else
    if (hipMemsetAsync((char*)d_ws + WS_CTL, 0, CTL_ZERO_BYTES, stream) != hipSuccess) return;
    for (int ph = 0; ph < N_PHASES; ++ph) {
        a.ph_lo = ph; a.ph_hi = ph + 1;
        hipLaunchKernelGGL(hymba_fwd, dim3(grid), dim3(NWAVES * 64), LDS_BYTES, stream, a);
    }
#endif
}
```
